# Optimizing an MI355X kernel written in HIP

```python
import math
import jax, jax.numpy as jnp
from jax import lax
import numpy as np

D_MODEL = 1024
BATCH = 8
SEQ = 4096
DEPTH = 2

N_META = 16
BLOCK = 128
N_PAD = BLOCK - N_META
NEG_INF = -1e30

FOX_HEADS = 8
FOX_HEAD_DIM = 64
FOX_WIDTH = FOX_HEADS * FOX_HEAD_DIM

MLA_HEADS = 8
MLA_NOPE_DIM = 64
MLA_ROPE_DIM = 32
MLA_V_DIM = 64
MLA_Q_RANK = 384
MLA_KV_RANK = 256
MLA_WIDTH = MLA_HEADS * MLA_V_DIM
ROPE_THETA = 10000.0

N_EXPERTS = 16
N_GROUPS = 4
EXPERTS_PER_GROUP = N_EXPERTS // N_GROUPS
TOP_K = 2
D_EXPERT = 256

LN_EPS = 1e-5
RMS_EPS = 1e-6
ALPHA = (2 * DEPTH) ** 0.25
BETA = (8 * DEPTH) ** -0.25

OFF_FOX_Q = FOX_WIDTH
OFF_FOX_K = OFF_FOX_Q + FOX_WIDTH
OFF_FOX_V = OFF_FOX_K + FOX_WIDTH
OFF_FOX_F = OFF_FOX_V + FOX_HEADS
OFF_MLA_CQ = OFF_FOX_F + MLA_Q_RANK
OFF_MLA_CKV = OFF_MLA_CQ + MLA_KV_RANK
OFF_MLA_KR = OFF_MLA_CKV + MLA_ROPE_DIM
OFF_G_FOX = OFF_MLA_KR + D_MODEL
IN_COLS = OFF_G_FOX + D_MODEL
SPLITS = (OFF_FOX_Q, OFF_FOX_K, OFF_FOX_V, OFF_FOX_F, OFF_MLA_CQ, OFF_MLA_CKV, OFF_MLA_KR, OFF_G_FOX)

kernel_name = "fox_mla_gated_hybrid_moe_deepnorm"


def layer_norm(x, g, b):
    xf = x.astype(jnp.float32)
    mu = jnp.mean(xf, axis=-1, keepdims=True)
    var = jnp.mean(jnp.square(xf - mu), axis=-1, keepdims=True)
    return ((xf - mu) * lax.rsqrt(var + LN_EPS) * g.astype(jnp.float32) + b.astype(jnp.float32)).astype(x.dtype)


def rms_norm(x, g):
    xf = x.astype(jnp.float32)
    ms = jnp.mean(jnp.square(xf), axis=-1, keepdims=True)
    return (xf * lax.rsqrt(ms + RMS_EPS) * g.astype(jnp.float32)).astype(x.dtype)


def rope(x, pos):
    half = x.shape[-1] // 2
    inv = ROPE_THETA ** (-jnp.arange(half, dtype=jnp.float32) / half)
    ang = pos.astype(jnp.float32)[:, None] * inv[None, :]
    cos = jnp.cos(ang)[:, None, :]
    sin = jnp.sin(ang)[:, None, :]
    xf = x.astype(jnp.float32)
    x1, x2 = xf[..., :half], xf[..., half:]
    return jnp.concatenate([x1 * cos - x2 * sin, x2 * cos + x1 * sin], axis=-1).astype(x.dtype)


def blocked_causal_attention(q, k, v, scale, decay=None):
    lp = q.shape[2]
    outs = []
    for i in range(lp // BLOCK):
        q0, q1 = i * BLOCK, (i + 1) * BLOCK
        s = jnp.einsum("bhqd,bhkd->bhqk", q[:, :, q0:q1], k[:, :, :q1],
                       preferred_element_type=jnp.float32) * scale
        if decay is not None:
            s = s + decay[:, :, q0:q1, None] - decay[:, :, None, :q1]
        qi = jnp.arange(q0, q1)[:, None]
        ki = jnp.arange(q1)[None, :]
        s = jnp.where((ki <= qi) & (ki >= N_PAD), s, NEG_INF)
        p = jax.nn.softmax(s, axis=-1)
        outs.append(jnp.einsum("bhqk,bhkd->bhqd", p.astype(v.dtype), v[:, :, :q1]))
    return jnp.concatenate(outs, axis=2)


def _pad_seq(t):
    widths = [(0, 0)] * t.ndim
    widths[2] = (N_PAD, 0)
    return jnp.pad(t, widths)


def hybrid_mixer(h, pos, w_in, fox_f_bias, fox_w_o, mla_q_norm, mla_w_uq, mla_kv_norm, mla_w_ukv,
                 mla_w_o, w_out):
    b, l, _ = h.shape
    proj = h @ w_in
    q_f, k_f, v_f, f_logit, c_q, c_kv, k_r, g_fox, g_mla = jnp.split(proj, SPLITS, axis=-1)

    def to_heads(t, n_heads):
        return t.reshape(b, l, n_heads, -1).transpose(0, 2, 1, 3)

    log_f = jax.nn.log_sigmoid(f_logit.astype(jnp.float32) + fox_f_bias.astype(jnp.float32))
    decay = jnp.cumsum(log_f, axis=1).transpose(0, 2, 1)
    decay = jnp.pad(decay, ((0, 0), (0, 0), (N_PAD, 0)))
    o_fox = blocked_causal_attention(_pad_seq(to_heads(q_f, FOX_HEADS)), _pad_seq(to_heads(k_f, FOX_HEADS)),
                                     _pad_seq(to_heads(v_f, FOX_HEADS)), FOX_HEAD_DIM ** -0.5, decay)
    o_fox = o_fox[:, :, N_PAD:].transpose(0, 2, 1, 3).reshape(b, l, FOX_WIDTH)
    y_fox = o_fox @ fox_w_o

    q_all = (rms_norm(c_q, mla_q_norm) @ mla_w_uq).reshape(b, l, MLA_HEADS, MLA_NOPE_DIM + MLA_ROPE_DIM)
    q_nope, q_rot = q_all[..., :MLA_NOPE_DIM], rope(q_all[..., MLA_NOPE_DIM:], pos)
    kv = (rms_norm(c_kv, mla_kv_norm) @ mla_w_ukv).reshape(b, l, MLA_HEADS, MLA_NOPE_DIM + MLA_V_DIM)
    k_nope, v_m = kv[..., :MLA_NOPE_DIM], kv[..., MLA_NOPE_DIM:]
    k_rot = jnp.broadcast_to(rope(k_r[:, :, None, :], pos), (b, l, MLA_HEADS, MLA_ROPE_DIM))
    q_m = jnp.concatenate([q_nope, q_rot], axis=-1).transpose(0, 2, 1, 3)
    k_m = jnp.concatenate([k_nope, k_rot], axis=-1).transpose(0, 2, 1, 3)
    v_m = v_m.transpose(0, 2, 1, 3)
    o_mla = blocked_causal_attention(_pad_seq(q_m), _pad_seq(k_m), _pad_seq(v_m),
                                     (MLA_NOPE_DIM + MLA_ROPE_DIM) ** -0.5)
    o_mla = o_mla[:, :, N_PAD:].transpose(0, 2, 1, 3).reshape(b, l, MLA_WIDTH)
    y_mla = o_mla @ mla_w_o

    merged = jax.nn.sigmoid(g_fox) * y_fox + jax.nn.sigmoid(g_mla) * y_mla
    return merged @ w_out


def grouped_moe(x, router_w, router_b, w_gate, w_up, w_down):
    b, l, d = x.shape
    t = x.reshape(b * l, d)
    scores = jax.nn.sigmoid((t @ router_w).astype(jnp.float32))
    biased = (scores + router_b.astype(jnp.float32)).reshape(-1, N_GROUPS, EXPERTS_PER_GROUP)
    group_score = jnp.sum(lax.top_k(biased, TOP_K)[0], axis=-1)
    g_sel = jnp.argmax(group_score, axis=-1)
    in_group = jnp.take_along_axis(biased, g_sel[:, None, None], axis=1)[:, 0]
    _, local = lax.top_k(in_group, TOP_K)
    expert_idx = g_sel[:, None] * EXPERTS_PER_GROUP + local
    sel = jnp.take_along_axis(scores, expert_idx, axis=1)
    gates = sel / jnp.sum(sel, axis=-1, keepdims=True)
    combine = jnp.sum(jax.nn.one_hot(expert_idx, N_EXPERTS, dtype=jnp.float32) * gates[..., None], axis=1)
    combine = combine.astype(t.dtype)
    y = jnp.zeros_like(t)
    for e in range(N_EXPERTS):
        hid = jax.nn.silu(t @ w_gate[e]) * (t @ w_up[e])
        y = y + combine[:, e:e + 1] * (hid @ w_down[e])
    return y.reshape(b, l, d)


def setup_inputs(seed: int = 0) -> dict:
    key = jax.random.key(seed)
    ks = jax.random.split(key, 24)
    f32 = jnp.float32
    nrm = lambda k, shape, scale: jax.random.normal(k, shape, f32) * scale
    gain = lambda k, shape: 1.0 + 0.02 * jax.random.normal(k, shape, f32)
    return {
        "x": jax.random.normal(ks[0], (BATCH, SEQ, D_MODEL), f32),
        "meta_tokens": nrm(ks[1], (N_META, D_MODEL), 1.0),
        "ln_in_g": gain(ks[2], (D_MODEL,)),
        "ln_in_b": nrm(ks[3], (D_MODEL,), 0.02),
        "w_in": nrm(ks[4], (DEPTH, D_MODEL, IN_COLS), D_MODEL ** -0.5),
        "fox_f_bias": 2.0 + nrm(ks[5], (DEPTH, FOX_HEADS), 0.1),
        "fox_w_o": nrm(ks[6], (DEPTH, FOX_WIDTH, D_MODEL), BETA * FOX_WIDTH ** -0.5),
        "mla_q_norm": gain(ks[7], (DEPTH, MLA_Q_RANK)),
        "mla_w_uq": nrm(ks[8], (DEPTH, MLA_Q_RANK, MLA_HEADS * (MLA_NOPE_DIM + MLA_ROPE_DIM)), MLA_Q_RANK ** -0.5),
        "mla_kv_norm": gain(ks[9], (DEPTH, MLA_KV_RANK)),
        "mla_w_ukv": nrm(ks[10], (DEPTH, MLA_KV_RANK, MLA_HEADS * (MLA_NOPE_DIM + MLA_V_DIM)), MLA_KV_RANK ** -0.5),
        "mla_w_o": nrm(ks[11], (DEPTH, MLA_WIDTH, D_MODEL), BETA * MLA_WIDTH ** -0.5),
        "w_out": nrm(ks[12], (DEPTH, D_MODEL, D_MODEL), BETA * D_MODEL ** -0.5),
        "ln1_g": gain(ks[13], (DEPTH, D_MODEL)),
        "ln1_b": nrm(ks[14], (DEPTH, D_MODEL), 0.02),
        "router_w": nrm(ks[15], (D_MODEL, N_EXPERTS), D_MODEL ** -0.5),
        "router_b": nrm(ks[16], (N_EXPERTS,), 0.01),
        "w_gate": nrm(ks[17], (DEPTH, N_EXPERTS, D_MODEL, D_EXPERT), D_MODEL ** -0.5),
        "w_up": nrm(ks[18], (DEPTH, N_EXPERTS, D_MODEL, D_EXPERT), D_MODEL ** -0.5),
        "w_down": nrm(ks[19], (DEPTH, N_EXPERTS, D_EXPERT, D_MODEL), BETA * D_EXPERT ** -0.5),
        "ln2_g": gain(ks[20], (DEPTH, D_MODEL)),
        "ln2_b": nrm(ks[21], (DEPTH, D_MODEL), 0.02),
    }


def reference(x, meta_tokens, ln_in_g, ln_in_b, w_in, fox_f_bias, fox_w_o, mla_q_norm, mla_w_uq,
              mla_kv_norm, mla_w_ukv, mla_w_o, w_out, ln1_g, ln1_b, router_w, router_b,
              w_gate, w_up, w_down, ln2_g, ln2_b):
    b = x.shape[0]
    meta = jnp.broadcast_to(meta_tokens[None].astype(x.dtype), (b, N_META, D_MODEL))
    h = jnp.concatenate([meta, x], axis=1)
    pos = jnp.arange(h.shape[1], dtype=jnp.int32)
    h = layer_norm(h, ln_in_g, ln_in_b)
    for i in range(DEPTH):
        mix = hybrid_mixer(h, pos, w_in[i], fox_f_bias[i], fox_w_o[i], mla_q_norm[i], mla_w_uq[i],
                           mla_kv_norm[i], mla_w_ukv[i], mla_w_o[i], w_out[i])
        h = layer_norm(ALPHA * h + mix, ln1_g[i], ln1_b[i])
        ffn = grouped_moe(h, router_w, router_b, w_gate[i], w_up[i], w_down[i])
        h = layer_norm(ALPHA * h + ffn, ln2_g[i], ln2_b[i])
    return h[:, N_META:]
```

```cpp
#include <hip/hip_runtime.h>
#include <cstdio>
#include <cstdint>

#define LAS __attribute__((address_space(3)))
typedef unsigned short bf16_t;
typedef short bf16x8 __attribute__((ext_vector_type(8)));
typedef short s16x4 __attribute__((ext_vector_type(4)));
typedef float f32x4 __attribute__((ext_vector_type(4)));
typedef float f32x2_t __attribute__((ext_vector_type(2)));
typedef __bf16 bf16x2_t __attribute__((ext_vector_type(2)));
typedef float f32x16 __attribute__((ext_vector_type(16)));
typedef unsigned u32x4 __attribute__((ext_vector_type(4)));
typedef unsigned u32x2 __attribute__((ext_vector_type(2)));

constexpr int NB = 8, SEQ = 4096, NMETA = 16, LSEQ = 4112, T = NB * LSEQ  , TP = 33024  , DM = 1024;
constexpr int NPANEL = TP / 256;
constexpr int NEXP = 16;
constexpr float ALPHA = 1.41421356237309515f;
constexpr float LOG2E = 1.4426950408889634f;
constexpr float C2F = 0.125f * LOG2E;
constexpr float C2M = 0.14724444602590310f;
constexpr int CSP = 4160;

constexpr size_t MiB = 1ull << 20;
constexpr size_t WS_CTL = 0, CTL_BYTES = 1 * MiB;
constexpr size_t WS_ROPE = 1 * MiB;
constexpr size_t WS_LF = 2 * MiB;
constexpr size_t WS_CS = 4 * MiB;
constexpr size_t WS_TOK = 6 * MiB;
constexpr size_t WS_LIST = 8 * MiB;
constexpr size_t WS_W = 12 * MiB;
constexpr size_t WS_H = 88 * MiB;
constexpr size_t WS_X = 153 * MiB;
constexpr size_t S512 = (size_t)TP * 512 * 2, S768 = (size_t)TP * 768 * 2, S1024 = (size_t)TP * 1024 * 2;
constexpr size_t X_QF = 0, X_KF = S512, X_VF = 2 * S512, X_RAW = 3 * S512, X_QM = 3 * S512 + S768, X_KM = 3 * S512 + 2 * S768,
                 X_VM = 3 * S512 + 3 * S768, X_OM = 4 * S512 + 3 * S768, X_END = 5 * S512 + 3 * S768;
constexpr size_t X_GATES = X_KF;
constexpr size_t X_MERGED = X_KM;
constexpr size_t X_Z = X_KF;
constexpr size_t X_H1 = X_KM;
constexpr size_t X_HID = X_QF;
constexpr size_t X_YS = 36 * MiB;
constexpr int NSLOT_TILES = 273, NSLOT = NSLOT_TILES * 256;
constexpr size_t WS_END = WS_X + X_END;
static_assert(X_GATES + (size_t)TP * 2048 * 2 <= X_KM, "gates");
static_assert(X_MERGED + S1024 <= X_OM, "merged");
static_assert(X_HID + (size_t)NSLOT * 256 * 2 <= X_YS, "hid");
static_assert(X_YS + (size_t)NSLOT * 1024 * 2 <= X_KM, "ys");
static_assert(WS_W + 2ull * 19693568ull * 2ull <= WS_H, "weights");
static_assert(WS_H + S1024 <= WS_X, "h");
constexpr size_t W_BT1 = 0, W_BT2 = W_BT1 + 2304ull * 1024, W_FOXO = W_BT2 + 2048ull * 1024, W_MLAO = W_FOXO + 1024ull * 512,
                 W_UQ = W_MLAO + 1024ull * 512, W_UKV = W_UQ + 768ull * 384, W_OUT = W_UKV + 1024ull * 256, W_MOE1 = W_OUT + 1024ull * 1024,
                 W_MOE2 = W_MOE1 + 16ull * 512 * 1024, W_LAYER = W_MOE2 + 16ull * 1024 * 256;
static_assert(W_LAYER == 19693568ull, "weights per layer");
constexpr int CW_BAR = 4096;
constexpr int CW_QCTR = 8192;
constexpr int CW_ECNT = 12288;

constexpr int RING_BYTES = 131072;
constexpr int MISC_OFF = RING_BYTES;
constexpr int LDS_BYTES = 147456;

__device__ __forceinline__ unsigned pk_bf16(float lo, float hi) { f32x2_t v = {lo, hi}; bf16x2_t b = __builtin_convertvector(v, bf16x2_t); return __builtin_bit_cast(unsigned, b); }
__device__ __forceinline__ float bf_lo(unsigned u) { return __uint_as_float(u << 16); }
__device__ __forceinline__ float bf_hi(unsigned u) { return __uint_as_float(u & 0xffff0000u); }
__device__ __forceinline__ float wave_sum(float v) {
#pragma unroll
    for (int o = 1; o < 64; o <<= 1) v += __shfl_xor(v, o);
    return v;
}
#define LDS_WAIT() asm volatile("s_waitcnt lgkmcnt(0)" ::: "memory")
#define RLX_AGENT __ATOMIC_RELAXED, __HIP_MEMORY_SCOPE_AGENT

#define XB_TMO      128
#define XB_XCNT(j)  (256  + 64 * (j))
#define XB_XSUB(j)  (1280 + 64 * (j))
#define XB_XGEN(j)  (2304 + 64 * (j))
#define XB_TOP      3328
#define XB_TOPGEN   3392
#define XCD_BAR_WORDS 3456
#define XB_SPIN_CAP (1u << 20)
__device__ __forceinline__ unsigned xb_ld(unsigned* p)              { return __hip_atomic_load(p, __ATOMIC_RELAXED, __HIP_MEMORY_SCOPE_AGENT); }
__device__ __forceinline__ unsigned xb_add(unsigned* p, unsigned v) { return __hip_atomic_fetch_add(p, v, __ATOMIC_RELAXED, __HIP_MEMORY_SCOPE_AGENT); }
__device__ __forceinline__ unsigned xb_xcc_id() { return (unsigned)__builtin_amdgcn_s_getreg((3 << 11) | 20) & 0xFu; }
#define XB_SPIN(cond, bar) do { unsigned _sp = 0; while (cond) { __builtin_amdgcn_s_sleep(1); \
    if ((++_sp & 255u) == 0u) { if (xb_ld(&(bar)[XB_TMO])) break; if (_sp > XB_SPIN_CAP) { atomicAdd(&(bar)[XB_TMO], 1u); break; } } } } while (0)
struct XcdBarrier { unsigned* bar; unsigned x; volatile LAS unsigned* st; };
__device__ __forceinline__ XcdBarrier xcd_barrier_post(unsigned* bar, volatile LAS unsigned* st) {
    XcdBarrier b; b.bar = bar; b.x = xb_xcc_id(); b.st = st;
    if (threadIdx.x == 0) (void)xb_add(&bar[XB_XCNT(b.x)], 1u);
    return b;
}
__device__ __forceinline__ void xcd_barrier_complete(unsigned* bar, unsigned x, unsigned& nloc, unsigned& nx) {
    const unsigned G = gridDim.x * gridDim.y * gridDim.z;
    unsigned sum, cnt, mine, sp = 0u;
    for (;;) {
        sum = 0u; cnt = 0u; mine = 0u;
#pragma unroll
        for (unsigned j = 0; j < 16; ++j) { const unsigned c = xb_ld(&bar[XB_XCNT(j)]); sum += c; cnt += (c > 0u) ? 1u : 0u; mine = (j == x) ? c : mine; }
        if (sum == G) break;
        __builtin_amdgcn_s_sleep(1);
        if ((++sp & 255u) == 0u) { if (xb_ld(&bar[XB_TMO])) break; if (sp > XB_SPIN_CAP) { atomicAdd(&bar[XB_TMO], 1u); break; } }
    }
    nloc = mine > 0u ? mine : 1u; nx = cnt > 0u ? cnt : 1u;
}
__device__ __forceinline__ void xcd_barrier(const XcdBarrier& b) {
    asm volatile("s_waitcnt vmcnt(0)" ::: "memory");
    __syncthreads();
    if (threadIdx.x == 0) {
        unsigned* bar = b.bar; unsigned bx = b.x; asm volatile("" : "+s"(bar), "+s"(bx));
        __builtin_amdgcn_s_waitcnt(0);
        unsigned nloc = b.st[0], nx = b.st[1];
        if (nloc == 0u) { xcd_barrier_complete(bar, bx, nloc, nx); b.st[0] = nloc; b.st[1] = nx; }
        const unsigned old = xb_add(&bar[XB_XSUB(bx)], 1u);
        const unsigned gen = old / nloc;
        if (old + 1u == (gen + 1u) * nloc) {
            __builtin_amdgcn_fence(__ATOMIC_RELEASE, "agent");
            asm volatile("s_waitcnt vmcnt(0)" ::: "memory");
            const unsigned og = xb_add(&bar[XB_TOP], 1u);
            const unsigned tg = og / nx;
            if (og + 1u == (tg + 1u) * nx) xb_add(&bar[XB_TOPGEN], 1u);
            else XB_SPIN(xb_ld(&bar[XB_TOPGEN]) == tg, bar);
            __builtin_amdgcn_fence(__ATOMIC_ACQUIRE, "agent");
            xb_add(&bar[XB_XGEN(bx)], 1u);
            asm volatile("s_waitcnt vmcnt(0)" ::: "memory");
        } else {
            XB_SPIN(xb_ld(&bar[XB_XGEN(bx)]) == gen, bar);
            __builtin_amdgcn_fence(__ATOMIC_ACQUIRE, "agent");
            asm volatile("s_waitcnt vmcnt(0)" ::: "memory");
        }
    }
    __syncthreads();
}

namespace pg8 {
constexpr int BM = 256, BK = 64, HALF = 128, HTB = HALF * BK * 2, STAGE_BYTES = 8 * HTB;
__device__ __forceinline__ int lds_byte(int r, int c) { const int st = (r >> 4) * 2 + (c >> 5), rr = r & 15, cc = c & 31, ob = rr * 64 + cc * 2; return st * 1024 + (ob ^ (((ob >> 9) & 1) << 5)); }
__device__ __forceinline__ void stage_rc(int b, int& R, int& C) { const int st = b / 1024, sb = b % 1024, swz = sb ^ (((sb >> 9) & 1) << 5); R = (st >> 1) * 16 + swz / 64; C = (st & 1) * 32 + (swz % 64) / 2; }
__device__ __forceinline__ int perm32(int rho) { const int n = rho >> 4, i = rho & 15; return 8 * (i >> 2) + 4 * n + (i & 3); }
struct Unit { const char* A; const char* B; int pm, pn, aux; };
typedef f32x4 Acc[2][2][4][2];

__device__ __forceinline__ void tile_of(int L, int nM, int nN, int& pm, int& pn) {
    const int nwg = nM * nN; int wgid = L;
    { const int q = nwg / 8, r = nwg % 8, xcd = wgid % 8, off = wgid / 8; wgid = (xcd < r ? xcd * (q + 1) : r * (q + 1) + (xcd - r) * q) + off; }
    const int nig = 8 * nN, gid = wgid / nig, fm = gid * 8, gsz = (nM - fm) < 8 ? (nM - fm) : 8;
    pm = fm + ((wgid % nig) % gsz); pn = (wgid % nig) / gsz;
}

template <class Epi, class Sched, bool GATHER>
__device__ __forceinline__ void gemm_phase(LAS unsigned char* lds, const int K, const int lda, const int ldb, const Sched& S, const Epi& E) {
    int tid_l = threadIdx.x; asm volatile("" : "+v"(tid_l));
    const int tid = tid_l, wid = __builtin_amdgcn_readfirstlane(tid >> 6), lane = tid & 63, wr = wid >> 2, wc = wid & 3, fr = lane & 15, fq = lane >> 4;
    int nt = K / BK; asm volatile("" : "+s"(nt));
    unsigned voA[2][2], voB[2]; int Rr[2], Cc[2];
#pragma unroll
    for (int i = 0; i < 2; ++i) { int R, C; stage_rc(tid * 16 + i * 8192, R, C); const int Rb = Epi::PERM ? ((R & ~31) + perm32(R & 31)) : R;
        Rr[i] = R; Cc[i] = C; voA[0][i] = (unsigned)(R * lda + C) * 2u; voA[1][i] = (unsigned)((R + HALF) * lda + C) * 2u; voB[i] = (unsigned)(Rb * ldb + C) * 2u; }
    const size_t kstep = (size_t)(BK * 2);
    const size_t hstepB = (size_t)HALF * ldb * 2;
    const unsigned ldsw = (unsigned)wid * 1024u;
    const int aoff = lds_byte(wr * 64 + fr, fq * 8), boff = lds_byte(wc * 32 + fr, fq * 8);
#define PG8_SA(b, h) (((b) * 2 + (h)) * HTB)
#define PG8_SB(b, h) ((4 + (b) * 2 + (h)) * HTB)
#define PG8_STAGE2(bufoff, gbase, o0, o1) do { \
        __builtin_amdgcn_global_load_lds((const unsigned*)((const char*)(gbase) + (o0)), (LAS unsigned*)(lds + (bufoff) + ldsw), 16, 0, 0); \
        __builtin_amdgcn_global_load_lds((const unsigned*)((const char*)(gbase) + (o1)), (LAS unsigned*)(lds + (bufoff) + ldsw + 8192), 16, 0, 0); } while (0)
#define PG8_STA(b, h, gbase, VO) PG8_STAGE2(PG8_SA(b, h), gbase, (VO)[h][0], (VO)[h][1])
#define PG8_STB(b, h, gbase) PG8_STAGE2(PG8_SB(b, h), (gbase) + (h) * hstepB, voB[0], voB[1])
#define PG8_LDA(dst, b, h) do { _Pragma("unroll") for (int m = 0; m < 4; ++m) _Pragma("unroll") for (int k = 0; k < 2; ++k) dst[m][k] = *(const LAS bf16x8*)(lds + PG8_SA(b, h) + aoff + m * 2048 + k * 1024); } while (0)
#define PG8_LDB(dst, b, h) do { _Pragma("unroll") for (int n = 0; n < 2; ++n) _Pragma("unroll") for (int k = 0; k < 2; ++k) dst[n][k] = *(const LAS bf16x8*)(lds + PG8_SB(b, h) + boff + n * 2048 + k * 1024); } while (0)
#define PG8_MMA(ai, bj, At, Bt) do { __builtin_amdgcn_s_setprio(1); _Pragma("unroll") for (int m = 0; m < 4; ++m) _Pragma("unroll") for (int n = 0; n < 2; ++n) _Pragma("unroll") for (int k = 0; k < 2; ++k) \
        acc[ai][bj][m][n] = __builtin_amdgcn_mfma_f32_16x16x32_bf16(Bt[n][k], At[m][k], acc[ai][bj][m][n], 0, 0, 0); __builtin_amdgcn_s_setprio(0); } while (0)
#define PG8_WAIT_V(n) asm volatile("s_waitcnt vmcnt(" #n ")" ::: "memory")
#define PG8_WAIT_L(n) asm volatile("s_waitcnt lgkmcnt(" #n ")" ::: "memory")
#define PG8_BAR __builtin_amdgcn_s_barrier()
#define PG8_SCHED __builtin_amdgcn_sched_barrier(0)
    Unit cur, nxt; int ui = 0;
    if (!S.next(0, cur)) return;
    Acc acc;
#pragma unroll
    for (int a = 0; a < 2; ++a)
#pragma unroll
        for (int b = 0; b < 2; ++b)
#pragma unroll
            for (int m = 0; m < 4; ++m)
#pragma unroll
                for (int n = 0; n < 2; ++n) acc[a][b][m][n] = (f32x4){0.f, 0.f, 0.f, 0.f};
    bf16x8 At[4][2], B0[2][2], B1[2][2];
    const char* cA = cur.A; const char* cB = cur.B;
    if constexpr (GATHER) {
#pragma unroll
        for (int h = 0; h < 2; ++h)
#pragma unroll
            for (int i = 0; i < 2; ++i) voA[h][i] = S.row_off(cur, Rr[i] + h * HALF) + (unsigned)Cc[i] * 2u;
    }
    PG8_STB(0, 0, cB); PG8_STB(0, 1, cB); PG8_STA(0, 0, cA, voA); PG8_STA(0, 1, cA, voA);
    if (wr == 1) PG8_BAR;
    PG8_WAIT_V(2); PG8_BAR;
    PG8_STB(1, 0, cB + kstep); PG8_STA(1, 0, cA + kstep, voA); PG8_STB(1, 1, cB + kstep);
    PG8_WAIT_V(6); PG8_BAR;
    for (;;) {
        const bool has_next = S.next(ui + 1, nxt);
        const char* nA = has_next ? nxt.A : cA; const char* nB = has_next ? nxt.B : cB;
        unsigned vnA[2][2];
        if constexpr (GATHER) {
#pragma unroll
            for (int h = 0; h < 2; ++h)
#pragma unroll
                for (int i = 0; i < 2; ++i) vnA[h][i] = has_next ? (S.row_off(nxt, Rr[i] + h * HALF) + (unsigned)Cc[i] * 2u) : voA[h][i];
        }
        for (int t = 0; t < nt; t += 2) {
            const bool last = (t == nt - 2);
            const char* a1 = cA + (size_t)(t + 1) * kstep;
            const char* a2 = last ? nA : cA + (size_t)(t + 2) * kstep; const char* b2 = last ? nB : cB + (size_t)(t + 2) * kstep;
            const char* a3 = a2 + kstep; const char* b3 = b2 + kstep;
            unsigned vs[2][2];
#pragma unroll
            for (int h = 0; h < 2; ++h)
#pragma unroll
                for (int i = 0; i < 2; ++i) { if constexpr (GATHER) vs[h][i] = last ? vnA[h][i] : voA[h][i]; else vs[h][i] = voA[h][i]; }
            PG8_LDB(B0, 0, 0); PG8_LDB(B1, 0, 1); PG8_SCHED; PG8_LDA(At, 0, 0); PG8_STA(1, 1, a1, voA);
            PG8_WAIT_V(8); PG8_WAIT_L(0); PG8_BAR; PG8_MMA(0, 0, At, B0); PG8_MMA(0, 1, At, B1); PG8_BAR; PG8_SCHED;
            PG8_LDA(At, 0, 1); PG8_STB(0, 0, b2); PG8_STB(0, 1, b2); PG8_STA(0, 0, a2, vs);
            PG8_WAIT_V(8); PG8_WAIT_L(0); PG8_BAR; PG8_MMA(1, 0, At, B0); PG8_MMA(1, 1, At, B1); PG8_BAR; PG8_SCHED;
            PG8_LDB(B0, 1, 0); PG8_LDB(B1, 1, 1); PG8_SCHED; PG8_LDA(At, 1, 0); PG8_STA(0, 1, a2, vs);
            PG8_WAIT_V(8); PG8_WAIT_L(0); PG8_BAR; PG8_MMA(0, 0, At, B0); PG8_MMA(0, 1, At, B1); PG8_BAR; PG8_SCHED;
            PG8_LDA(At, 1, 1); PG8_STB(1, 0, b3); PG8_STB(1, 1, b3); PG8_STA(1, 0, a3, vs);
            PG8_WAIT_V(8); PG8_WAIT_L(0); PG8_BAR; PG8_MMA(1, 0, At, B0); PG8_MMA(1, 1, At, B1); PG8_BAR; PG8_SCHED;
        }
        if (wr == 0) PG8_BAR;
        E(acc, cur, wr, wc, fr, fq);
        if (!has_next) break;
#pragma unroll
        for (int a = 0; a < 2; ++a)
#pragma unroll
            for (int b = 0; b < 2; ++b)
#pragma unroll
                for (int m = 0; m < 4; ++m)
#pragma unroll
                    for (int n = 0; n < 2; ++n) acc[a][b][m][n] = (f32x4){0.f, 0.f, 0.f, 0.f};
        cur = nxt; cA = nA; cB = nB; ++ui;
        if constexpr (GATHER) {
#pragma unroll
            for (int h = 0; h < 2; ++h)
#pragma unroll
                for (int i = 0; i < 2; ++i) voA[h][i] = vnA[h][i];
        }
        if (wr == 1) PG8_BAR;
    }
    PG8_WAIT_V(0);
    PG8_BAR;
#undef PG8_SA
#undef PG8_SB
#undef PG8_STAGE2
#undef PG8_STA
#undef PG8_STB
#undef PG8_LDA
#undef PG8_LDB
#undef PG8_MMA
#undef PG8_WAIT_V
#undef PG8_WAIT_L
#undef PG8_BAR
#undef PG8_SCHED
}

struct SchedStatic {
    const char* A; const char* B; int nM, nN, G, c; size_t astep, bstep;
    __device__ __forceinline__ bool next(int i, Unit& u) const {
        const long L = (long)i * G + c; if (L >= (long)nM * nN) return false;
        int pm, pn; tile_of((int)L, nM, nN, pm, pn);
        u.pm = pm; u.pn = pn; u.aux = 0; u.A = A + (size_t)pm * astep; u.B = B + (size_t)pn * bstep; return true;
    }
    __device__ __forceinline__ unsigned row_off(const Unit&, int) const { return 0u; }
};
struct SchedOut {
    const char* A0; const char* A1; const char* B0; const char* B1; int nM, nN, G, c; size_t astep, bstep;
    __device__ __forceinline__ bool next(int i, Unit& u) const {
        const long L = (long)(i >> 1) * G + c; if (L >= (long)nM * nN) return false;
        int pm, pn; tile_of((int)L, nM, nN, pm, pn);
        const int pass = i & 1;
        u.pm = pm; u.pn = pn; u.aux = pass; u.A = (pass ? A1 : A0) + (size_t)pm * astep; u.B = (pass ? B1 : B0) + (size_t)pn * bstep; return true;
    }
    __device__ __forceinline__ unsigned row_off(const Unit&, int) const { return 0u; }
};
struct SchedMoe {
    const char* A; const char* B; const LAS int* tb; const LAS int* cnt; const int* list; int npn_shift, G, c; size_t bstep_e, bstep_n, astep; bool gather;
    __device__ __forceinline__ bool next(int i, Unit& u) const {
        const int L = i * G + c; const int ntile = tb[16];
        if (L >= (ntile << npn_shift)) return false;
        const int ti = L >> npn_shift, pn = L & ((1 << npn_shift) - 1);
        int e = 0; while (ti >= tb[e + 1]) ++e;
        u.pm = ti; u.pn = pn; u.aux = e;
        u.A = gather ? A : A + (size_t)ti * astep;
        u.B = B + (size_t)e * bstep_e + (size_t)pn * bstep_n; return true;
    }
    __device__ __forceinline__ unsigned row_off(const Unit& u, int r) const {
        const int e = u.aux; int idx = (u.pm - tb[e]) * 256 + r; const int ce = cnt[e]; idx = idx < ce ? idx : ce - 1;
        const int tok = list[(size_t)e * TP + idx];
        return (unsigned)tok * (unsigned)(DM * 2);
    }
};

__device__ __forceinline__ u32x4 pack8(f32x4 v0, f32x4 v1) { u32x4 w; w.x = pk_bf16(v0[0], v0[1]); w.y = pk_bf16(v0[2], v0[3]); w.z = pk_bf16(v1[0], v1[1]); w.w = pk_bf16(v1[2], v1[3]); return w; }
__device__ __forceinline__ float logsig(float x) { return fminf(x, 0.f) - log1pf(__expf(-fabsf(x))); }
__device__ __forceinline__ float sigm(float x) { return 1.0f / (1.0f + __expf(-x)); }

struct EpiA1 {
    static constexpr bool PERM = true;
    bf16_t *Qf, *Kf, *Vf, *RAW; float* LF; const float* fbias;
    __device__ __forceinline__ void operator()(const Acc& acc, const Unit& u, int wr, int wc, int fr, int fq) const {
        const int pn = u.pn; bf16_t* base; int ldc, colt; float sc = 1.f;
        if (pn < 2) { base = Qf; ldc = 512; colt = pn * 256; sc = C2F; } else if (pn < 4) { base = Kf; ldc = 512; colt = (pn - 2) * 256; }
        else if (pn < 6) { base = Vf; ldc = 512; colt = (pn - 4) * 256; } else { base = RAW; ldc = 768; colt = (pn - 6) * 256; }
        const int row0 = u.pm * 256 + wr * 64 + fr, col0 = colt + wc * 32 + 8 * fq;
#pragma unroll
        for (int ai = 0; ai < 2; ++ai)
#pragma unroll
            for (int m = 0; m < 4; ++m) { bf16_t* rowp = base + (size_t)(row0 + ai * 128 + m * 16) * ldc + col0;
#pragma unroll
                for (int bj = 0; bj < 2; ++bj) *(u32x4*)(rowp + bj * 128) = pack8(acc[ai][bj][m][0] * sc, acc[ai][bj][m][1] * sc); }
        if (pn == 8 && wc == 1 && fq == 0) {
            const f32x4 b0 = *(const f32x4*)fbias, b1 = *(const f32x4*)(fbias + 4);
#pragma unroll
            for (int ai = 0; ai < 2; ++ai)
#pragma unroll
                for (int m = 0; m < 4; ++m) { const int row = row0 + ai * 128 + m * 16; const f32x4 a = acc[ai][1][m][0] + b0, b = acc[ai][1][m][1] + b1;
                    f32x4 o0, o1;
#pragma unroll
                    for (int j = 0; j < 4; ++j) { o0[j] = logsig(a[j]); o1[j] = logsig(b[j]); }
                    *(f32x4*)(LF + (size_t)row * 8) = o0; *(f32x4*)(LF + (size_t)row * 8 + 4) = o1; }
        }
    }
};
struct EpiA2 {
    static constexpr bool PERM = true;
    bf16_t* G;
    __device__ __forceinline__ void operator()(const Acc& acc, const Unit& u, int wr, int wc, int fr, int fq) const {
        const int row0 = u.pm * 256 + wr * 64 + fr, col0 = u.pn * 256 + wc * 32 + 8 * fq;
#pragma unroll
        for (int ai = 0; ai < 2; ++ai)
#pragma unroll
            for (int m = 0; m < 4; ++m) { bf16_t* rowp = G + (size_t)(row0 + ai * 128 + m * 16) * 2048 + col0;
#pragma unroll
                for (int bj = 0; bj < 2; ++bj) { f32x4 a = acc[ai][bj][m][0], b = acc[ai][bj][m][1];
#pragma unroll
                    for (int j = 0; j < 4; ++j) { a[j] = sigm(a[j]); b[j] = sigm(b[j]); }
                    *(u32x4*)(rowp + bj * 128) = pack8(a, b); } }
    }
};
struct EpiQup {
    static constexpr bool PERM = false;
    bf16_t* Qm; const float* cosT; const float* sinT;
    __device__ __forceinline__ void operator()(const Acc& acc, const Unit& u, int wr, int wc, int fr, int fq) const {
        const int row0 = u.pm * 256 + wr * 64 + fr;
#pragma unroll
        for (int ai = 0; ai < 2; ++ai)
#pragma unroll
            for (int m = 0; m < 4; ++m) { const int row = row0 + ai * 128 + m * 16; const int pos = row % LSEQ;
#pragma unroll
                for (int bj = 0; bj < 2; ++bj) { const int Gi = u.pn * 8 + bj * 4 + wc; f32x4 x0 = acc[ai][bj][m][0], x1 = acc[ai][bj][m][1];
                    if (Gi % 3 == 2) { const f32x4 cs = *(const f32x4*)(cosT + pos * 16 + 4 * fq), sn = *(const f32x4*)(sinT + pos * 16 + 4 * fq);
                        const f32x4 y0 = x0 * cs - x1 * sn, y1 = x1 * cs + x0 * sn; x0 = y0; x1 = y1; }
                    x0 = x0 * C2M; x1 = x1 * C2M;
                    bf16_t* p = Qm + (size_t)row * 768 + Gi * 32 + 4 * fq;
                    u32x2 w0, w1; w0.x = pk_bf16(x0[0], x0[1]); w0.y = pk_bf16(x0[2], x0[3]); w1.x = pk_bf16(x1[0], x1[1]); w1.y = pk_bf16(x1[2], x1[3]);
                    *(u32x2*)p = w0; *(u32x2*)(p + 16) = w1; } }
    }
};
struct EpiKV {
    static constexpr bool PERM = true;
    bf16_t *Km, *Vm;
    __device__ __forceinline__ void operator()(const Acc& acc, const Unit& u, int wr, int wc, int fr, int fq) const {
        const int row0 = u.pm * 256 + wr * 64 + fr;
#pragma unroll
        for (int ai = 0; ai < 2; ++ai)
#pragma unroll
            for (int m = 0; m < 4; ++m) { const int row = row0 + ai * 128 + m * 16;
#pragma unroll
                for (int bj = 0; bj < 2; ++bj) { const int n = u.pn * 256 + bj * 128 + wc * 32 + 8 * fq; const u32x4 w = pack8(acc[ai][bj][m][0], acc[ai][bj][m][1]);
                    if (u.pn < 2) *(u32x4*)(Km + (size_t)row * 768 + 96 * (n >> 6) + (n & 63)) = w;
                    else *(u32x4*)(Vm + (size_t)row * 512 + (n - 512)) = w; } }
    }
};
struct EpiOut {
    static constexpr bool PERM = true;
    const bf16_t* G; bf16_t* Mg;
    __device__ __forceinline__ void operator()(const Acc& acc, const Unit& u, int wr, int wc, int fr, int fq) const {
        const int row0 = u.pm * 256 + wr * 64 + fr, col0 = u.pn * 256 + wc * 32 + 8 * fq; const int pass = u.aux;
#pragma unroll
        for (int ai = 0; ai < 2; ++ai)
#pragma unroll
            for (int m = 0; m < 4; ++m) { const int row = row0 + ai * 128 + m * 16;
#pragma unroll
                for (int bj = 0; bj < 2; ++bj) { const int col = col0 + bj * 128;
                    const u32x4 g = *(const u32x4*)(G + (size_t)row * 2048 + pass * 1024 + col);
                    f32x4 a = acc[ai][bj][m][0], b = acc[ai][bj][m][1];
                    a[0] *= bf_lo(g.x); a[1] *= bf_hi(g.x); a[2] *= bf_lo(g.y); a[3] *= bf_hi(g.y); b[0] *= bf_lo(g.z); b[1] *= bf_hi(g.z); b[2] *= bf_lo(g.w); b[3] *= bf_hi(g.w);
                    bf16_t* mp = Mg + (size_t)row * 1024 + col;
                    if (pass) { const u32x4 p = *(const u32x4*)mp;
                        a[0] += bf_lo(p.x); a[1] += bf_hi(p.x); a[2] += bf_lo(p.y); a[3] += bf_hi(p.y); b[0] += bf_lo(p.z); b[1] += bf_hi(p.z); b[2] += bf_lo(p.w); b[3] += bf_hi(p.w); }
                    *(u32x4*)mp = pack8(a, b); } }
    }
};
struct EpiF {
    static constexpr bool PERM = false;
    const bf16_t* H; float* Z;
    __device__ __forceinline__ void operator()(const Acc& acc, const Unit& u, int wr, int wc, int fr, int fq) const {
        const int row0 = u.pm * 256 + wr * 64 + fr, col0 = u.pn * 256 + wc * 32 + 4 * fq;
#pragma unroll
        for (int ai = 0; ai < 2; ++ai)
#pragma unroll
            for (int m = 0; m < 4; ++m) { const size_t off = (size_t)(row0 + ai * 128 + m * 16) * 1024 + col0;
#pragma unroll
                for (int bj = 0; bj < 2; ++bj)
#pragma unroll
                    for (int n = 0; n < 2; ++n) { const u32x2 hv = *(const u32x2*)(H + off + bj * 128 + n * 16); f32x4 o = acc[ai][bj][m][n];
                        o[0] += ALPHA * bf_lo(hv.x); o[1] += ALPHA * bf_hi(hv.x); o[2] += ALPHA * bf_lo(hv.y); o[3] += ALPHA * bf_hi(hv.y);
                        *(f32x4*)(Z + off + bj * 128 + n * 16) = o; } }
    }
};
struct EpiM1 {
    static constexpr bool PERM = false;
    bf16_t* Hid;
    __device__ __forceinline__ void operator()(const Acc& acc, const Unit& u, int wr, int wc, int fr, int fq) const {
        const int row0 = u.pm * 256 + wr * 64 + fr, hc0 = u.pn * 128 + wc * 16 + 4 * fq;
#pragma unroll
        for (int ai = 0; ai < 2; ++ai)
#pragma unroll
            for (int m = 0; m < 4; ++m) { bf16_t* rowp = Hid + (size_t)(row0 + ai * 128 + m * 16) * 256 + hc0;
#pragma unroll
                for (int bj = 0; bj < 2; ++bj) { const f32x4 g = acc[ai][bj][m][0], up = acc[ai][bj][m][1]; f32x4 o;
#pragma unroll
                    for (int j = 0; j < 4; ++j) o[j] = g[j] * sigm(g[j]) * up[j];
                    u32x2 w; w.x = pk_bf16(o[0], o[1]); w.y = pk_bf16(o[2], o[3]); *(u32x2*)(rowp + bj * 64) = w; } }
    }
};
struct EpiM2 {
    static constexpr bool PERM = true;
    bf16_t* Ys;
    __device__ __forceinline__ void operator()(const Acc& acc, const Unit& u, int wr, int wc, int fr, int fq) const {
        const int row0 = u.pm * 256 + wr * 64 + fr, col0 = u.pn * 256 + wc * 32 + 8 * fq;
#pragma unroll
        for (int ai = 0; ai < 2; ++ai)
#pragma unroll
            for (int m = 0; m < 4; ++m) { bf16_t* rowp = Ys + (size_t)(row0 + ai * 128 + m * 16) * 1024 + col0;
#pragma unroll
                for (int bj = 0; bj < 2; ++bj) *(u32x4*)(rowp + bj * 128) = pack8(acc[ai][bj][m][0], acc[ai][bj][m][1]); }
    }
};
}

__device__ __forceinline__ int crow(int r, int hi) { return (r & 3) + 8 * (r >> 2) + 4 * hi; }
typedef short v4i16_t __attribute__((ext_vector_type(4)));
__device__ __forceinline__ s16x4 vtr(const LAS char* p) { return __builtin_bit_cast(s16x4, __builtin_amdgcn_ds_read_tr16_b64_v4i16((LAS v4i16_t*)p)); }
__device__ __forceinline__ float swapmax(float m) { auto rr = __builtin_amdgcn_permlane32_swap(__float_as_uint(m), __float_as_uint(m), false, false); return fmaxf(__uint_as_float(rr[0]), __uint_as_float(rr[1])); }
__device__ __forceinline__ float swapsum(float m) { auto rr = __builtin_amdgcn_permlane32_swap(__float_as_uint(m), __float_as_uint(m), false, false); return __uint_as_float(rr[0]) + __uint_as_float(rr[1]); }

template <int DK, bool FOX>
__device__ __forceinline__ void attn_unit(LAS char* lds, const bf16_t* Q, int ldq, const bf16_t* Kp, int ldk, const bf16_t* Vp, int ldv, bf16_t* O, int ldo,
                                          const float* cs, int b, int q0, int nvalid) {
    constexpr int NS = DK / 16, KB = 64 * DK * 2, BUF = KB + 8192 + 256;
    int tid_l = threadIdx.x; asm volatile("" : "+v"(tid_l));
    const int tid = tid_l, lane = tid & 63, r32 = lane & 31, hi = lane >> 5; const int wid = __builtin_amdgcn_readfirstlane(tid >> 6);
    const size_t rowbase = (size_t)b * LSEQ;
    const int qpos = q0 + 32 * wid + r32;
    const bool wave_on = (32 * wid) < nvalid;
    bf16x8 qf[NS];
#pragma unroll
    for (int s = 0; s < NS; ++s) qf[s] = *(const bf16x8*)(Q + (rowbase + qpos) * ldq + 16 * s + 8 * hi);
    float csq = 0.f; if (FOX) csq = cs[qpos];
    const int NT = (q0 + nvalid + 63) >> 6;
    const int skv = tid >> 3, sch = tid & 7;
    const bf16_t* kg = Kp + (rowbase + skv) * ldk + 8 * sch;
    const bf16_t* vg = Vp + (rowbase + skv) * ldv + 8 * sch;
    const int kdst = sch * 1024 + ((skv ^ sch) << 4);
    const int vdst = KB + ((sch >> 2) * 8 + (skv >> 3)) * 512 + (skv & 7) * 64 + (sch & 3) * 16;
    const int skv2 = tid >> 2, sch2 = 8 + (tid & 3);
    const bf16_t* kg2 = Kp + (rowbase + (skv2 & 63)) * ldk + 8 * sch2;
    const int kdst2 = sch2 * 1024 + (((skv2 & 63) ^ (sch2 & 7)) << 4);
    u32x4 kr0, kr1 = {0u, 0u, 0u, 0u}, vr0; f32x4 cr = {0.f, 0.f, 0.f, 0.f};
#define ATT_LOAD(t) do { kr0 = *(const u32x4*)(kg + (size_t)(t) * 64 * ldk); vr0 = *(const u32x4*)(vg + (size_t)(t) * 64 * ldv); \
        if (DK == 96 && tid < 256) kr1 = *(const u32x4*)(kg2 + (size_t)(t) * 64 * ldk); \
        if (FOX && tid < 16) cr = *(const f32x4*)(cs + (t) * 64 + 4 * tid); } while (0)
#define ATT_STORE(bufp) do { *(LAS u32x4*)((bufp) + kdst) = kr0; *(LAS u32x4*)((bufp) + vdst) = vr0; \
        if (DK == 96 && tid < 256) *(LAS u32x4*)((bufp) + kdst2) = kr1; \
        if (FOX && tid < 16) *(LAS f32x4*)((bufp) + KB + 8192 + 16 * tid) = cr; } while (0)
    ATT_LOAD(0);
    ATT_STORE(lds);
    __syncthreads();
    float mrun = -INFINITY, lrun = 0.f;
    f32x16 o0 = {}, o1 = {};
    const int vlane = ((lane >> 4) & 1) * 32 + (lane & 3) * 8 + (4 * hi + ((lane & 15) >> 2)) * 64;
    for (int t = 0; t < NT; ++t) {
        LAS char* cb = lds + (t & 1) * BUF; LAS char* nb = lds + ((t + 1) & 1) * BUF;
        const bool more = (t + 1 < NT);
        if (more) ATT_LOAD(t + 1);
        const bool active = wave_on && (64 * t <= q0 + 32 * wid + 31);
        if (active) {
            f32x16 p0 = {}, p1 = {};
#pragma unroll
            for (int s = 0; s < NS; ++s) {
                const int c = 2 * s + hi;
                const bf16x8 a0 = *(const LAS bf16x8*)(cb + c * 1024 + ((r32 ^ (c & 7)) << 4));
                const bf16x8 a1 = *(const LAS bf16x8*)(cb + c * 1024 + (((r32 + 32) ^ (c & 7)) << 4));
                p0 = __builtin_amdgcn_mfma_f32_32x32x16_bf16(a0, qf[s], p0, 0, 0, 0);
                p1 = __builtin_amdgcn_mfma_f32_32x32x16_bf16(a1, qf[s], p1, 0, 0, 0);
            }
            if (FOX) {
                const LAS float* cl = (const LAS float*)(cb + KB + 8192);
#pragma unroll
                for (int g = 0; g < 4; ++g) { const f32x4 c0 = *(const LAS f32x4*)(cl + 8 * g + 4 * hi), c1 = *(const LAS f32x4*)(cl + 32 + 8 * g + 4 * hi);
#pragma unroll
                    for (int j = 0; j < 4; ++j) { p0[4 * g + j] += csq - c0[j]; p1[4 * g + j] += csq - c1[j]; } }
            }
            if (64 * t + 63 > q0 + 32 * wid) {
                const int kb = 64 * t + 4 * hi;
#pragma unroll
                for (int r = 0; r < 16; ++r) { const int kv = kb + (r & 3) + 8 * (r >> 2); if (kv > qpos) p0[r] = -INFINITY; if (kv + 32 > qpos) p1[r] = -INFINITY; }
            }
            float mt = fmaxf(p0[0], p1[0]);
#pragma unroll
            for (int r = 1; r < 16; ++r) mt = fmaxf(mt, fmaxf(p0[r], p1[r]));
            mt = swapmax(mt);
            const float mnew = fmaxf(mrun, mt);
            const float alpha = __builtin_amdgcn_exp2f(mrun - mnew);
            mrun = mnew;
            float ls = 0.f;
#pragma unroll
            for (int r = 0; r < 16; ++r) { p0[r] = __builtin_amdgcn_exp2f(p0[r] - mnew); p1[r] = __builtin_amdgcn_exp2f(p1[r] - mnew); ls += p0[r] + p1[r]; }
            lrun = lrun * alpha + ls;
#pragma unroll
            for (int r = 0; r < 16; ++r) { o0[r] *= alpha; o1[r] *= alpha; }
            bf16x8 pb[4];
#pragma unroll
            for (int s = 0; s < 2; ++s) {
                u32x4 w; w.x = pk_bf16(p0[8 * s], p0[8 * s + 1]); w.y = pk_bf16(p0[8 * s + 2], p0[8 * s + 3]); w.z = pk_bf16(p0[8 * s + 4], p0[8 * s + 5]); w.w = pk_bf16(p0[8 * s + 6], p0[8 * s + 7]);
                pb[s] = __builtin_bit_cast(bf16x8, w);
                u32x4 w2; w2.x = pk_bf16(p1[8 * s], p1[8 * s + 1]); w2.y = pk_bf16(p1[8 * s + 2], p1[8 * s + 3]); w2.z = pk_bf16(p1[8 * s + 4], p1[8 * s + 5]); w2.w = pk_bf16(p1[8 * s + 6], p1[8 * s + 7]);
                pb[2 + s] = __builtin_bit_cast(bf16x8, w2);
            }
            const LAS char* vb = cb + KB + vlane;
#pragma unroll
            for (int ks = 0; ks < 4; ++ks) {
                const s16x4 l0 = vtr(vb + ks * 1024), h0 = vtr(vb + ks * 1024 + 512);
                const s16x4 l1 = vtr(vb + 4096 + ks * 1024), h1 = vtr(vb + 4096 + ks * 1024 + 512);
                const bf16x8 a0 = (bf16x8){l0[0], l0[1], l0[2], l0[3], h0[0], h0[1], h0[2], h0[3]};
                const bf16x8 a1 = (bf16x8){l1[0], l1[1], l1[2], l1[3], h1[0], h1[1], h1[2], h1[3]};
                o0 = __builtin_amdgcn_mfma_f32_32x32x16_bf16(a0, pb[ks], o0, 0, 0, 0);
                o1 = __builtin_amdgcn_mfma_f32_32x32x16_bf16(a1, pb[ks], o1, 0, 0, 0);
            }
        }
        if (more) ATT_STORE(nb);
        __syncthreads();
    }
#undef ATT_LOAD
#undef ATT_STORE
    if (wave_on) {
        const float lt = swapsum(lrun);
        const float inv = 1.0f / lt;
        if (32 * wid + r32 < nvalid) {
            bf16_t* op = O + (rowbase + qpos) * ldo;
#pragma unroll
            for (int g = 0; g < 4; ++g) {
                u32x2 w0, w1;
                w0.x = pk_bf16(o0[4 * g] * inv, o0[4 * g + 1] * inv); w0.y = pk_bf16(o0[4 * g + 2] * inv, o0[4 * g + 3] * inv);
                w1.x = pk_bf16(o1[4 * g] * inv, o1[4 * g + 1] * inv); w1.y = pk_bf16(o1[4 * g + 2] * inv, o1[4 * g + 3] * inv);
                *(u32x2*)(op + 8 * g + 4 * hi) = w0; *(u32x2*)(op + 32 + 8 * g + 4 * hi) = w1;
            }
        }
    }
}

struct Args { const float* in[22]; float* out; unsigned char* ws; };
struct Frame {
    LAS unsigned char* lds; volatile LAS unsigned* MISC; unsigned* ctl;
    int tid, lane, wave, vcu, G;
};

__device__ __forceinline__ void tr_item(const float* colp, int ld, const float* kscale, bf16_t* dst, int K, int n0, int k0, LAS float* scr, int lane) {
#pragma unroll 8
    for (int i = 0; i < 32; ++i) { const int kk = 2 * i + (lane >> 5); float v = colp ? colp[(size_t)(k0 + kk) * ld] : 0.f; if (kscale) v *= kscale[k0 + kk]; scr[kk * 33 + (lane & 31)] = v; }
    LDS_WAIT(); asm volatile("" ::: "memory");
    const int c = lane & 7;
#pragma unroll
    for (int j = 0; j < 4; ++j) { const int n = (lane >> 3) + 8 * j; const LAS float* s = scr + (8 * c) * 33 + n;
        u32x4 o; o.x = pk_bf16(s[0 * 33], s[1 * 33]); o.y = pk_bf16(s[2 * 33], s[3 * 33]); o.z = pk_bf16(s[4 * 33], s[5 * 33]); o.w = pk_bf16(s[6 * 33], s[7 * 33]);
        *(u32x4*)(dst + (size_t)(n0 + n) * K + k0 + 8 * c) = o; }
    LDS_WAIT(); asm volatile("" ::: "memory");
}
constexpr int ITEMS_PER_LAYER = 9616;
__device__ __forceinline__ void convert_item(const Args& a, bf16_t* W, int l, int r, LAS float* scr, int lane) {
    const int w = lane & 31;
    if (r < 1152) { const int kb = r / 72, nb = r % 72, n = nb * 32 + w; int col;
        if (n < 1536) col = n; else { const int j = n - 1536; col = j < 384 ? 1544 + j : j < 640 ? 1928 + (j - 384) : j < 672 ? 2184 + (j - 640) : j < 680 ? 1536 + (j - 672) : -1; }
        const float* src = a.in[4] + (size_t)l * 1024 * 4264;
        tr_item(col >= 0 ? src + col : nullptr, 4264, nullptr, W + W_BT1, 1024, nb * 32, kb * 64, scr, lane); return; }
    r -= 1152;
    if (r < 1024) { const int kb = r / 64, nb = r % 64, n = nb * 32 + w; const float* src = a.in[4] + (size_t)l * 1024 * 4264;
        tr_item(src + 2216 + n, 4264, nullptr, W + W_BT2, 1024, nb * 32, kb * 64, scr, lane); return; }
    r -= 1024;
    if (r < 256) { const int kb = r / 32, nb = r % 32, n = nb * 32 + w; tr_item(a.in[6] + (size_t)l * 512 * 1024 + n, 1024, nullptr, W + W_FOXO, 512, nb * 32, kb * 64, scr, lane); return; }
    r -= 256;
    if (r < 256) { const int kb = r / 32, nb = r % 32, n = nb * 32 + w; tr_item(a.in[11] + (size_t)l * 512 * 1024 + n, 1024, nullptr, W + W_MLAO, 512, nb * 32, kb * 64, scr, lane); return; }
    r -= 256;
    if (r < 144) { const int kb = r / 24, nb = r % 24, n = nb * 32 + w; tr_item(a.in[8] + (size_t)l * 384 * 768 + n, 768, a.in[7] + l * 384, W + W_UQ, 384, nb * 32, kb * 64, scr, lane); return; }
    r -= 144;
    if (r < 128) { const int kb = r / 32, nb = r % 32, n = nb * 32 + w; const int col = n < 512 ? (n >> 6) * 128 + (n & 63) : ((n - 512) >> 6) * 128 + 64 + (n & 63);
        tr_item(a.in[10] + (size_t)l * 256 * 1024 + col, 1024, a.in[9] + l * 256, W + W_UKV, 256, nb * 32, kb * 64, scr, lane); return; }
    r -= 128;
    if (r < 512) { const int kb = r / 32, nb = r % 32, n = nb * 32 + w; tr_item(a.in[12] + (size_t)l * 1024 * 1024 + n, 1024, nullptr, W + W_OUT, 1024, nb * 32, kb * 64, scr, lane); return; }
    r -= 512;
    if (r < 4096) { const int e = r / 256, rr = r % 256, kb = rr / 16, nb = rr % 16;
        const float* src = (w < 16 ? a.in[17] : a.in[18]) + ((size_t)(l * 16 + e) * 1024) * 256 + 16 * nb + (w & 15);
        tr_item(src, 256, nullptr, W + W_MOE1 + (size_t)e * 512 * 1024, 1024, nb * 32, kb * 64, scr, lane); return; }
    r -= 4096;
    { const int e = r / 128, rr = r % 128, kb = rr / 32, nb = rr % 32, n = nb * 32 + w;
        tr_item(a.in[19] + ((size_t)(l * 16 + e) * 256) * 1024 + n, 1024, nullptr, W + W_MOE2 + (size_t)e * 1024 * 256, 256, nb * 32, kb * 64, scr, lane); }
}

__device__ __forceinline__ void ln16(f32x4 (&v)[4], const float* g, const float* bta, int lane) {
    float s = 0.f;
#pragma unroll
    for (int j = 0; j < 4; ++j) s += (v[j][0] + v[j][1]) + (v[j][2] + v[j][3]);
    const float mean = wave_sum(s) * (1.f / DM); float s2 = 0.f;
#pragma unroll
    for (int j = 0; j < 4; ++j) { v[j] = v[j] - mean; s2 += (v[j][0] * v[j][0] + v[j][1] * v[j][1]) + (v[j][2] * v[j][2] + v[j][3] * v[j][3]); }
    const float rstd = 1.0f / sqrtf(wave_sum(s2) * (1.f / DM) + 1e-5f);
#pragma unroll
    for (int j = 0; j < 4; ++j) { const f32x4 gg = *(const f32x4*)(g + 4 * lane + 256 * j), bb = *(const f32x4*)(bta + 4 * lane + 256 * j); v[j] = v[j] * rstd * gg + bb; }
}
__device__ __forceinline__ void store_row_bf16(bf16_t* orow, const f32x4 (&v)[4], int lane) {
#pragma unroll
    for (int j = 0; j < 4; ++j) { u32x2 w; w.x = pk_bf16(v[j][0], v[j][1]); w.y = pk_bf16(v[j][2], v[j][3]); *(u32x2*)(orow + 4 * lane + 256 * j) = w; }
}

__device__ const double ROPE_INV_REV[16] = {0.15915494309189535, 0.08949940160889101, 0.050329212104487035, 0.0283021958306234, 0.015915494309189534, 0.008949940160889102,
    0.005032921210448704, 0.00283021958306234, 0.0015915494309189536, 0.0008949940160889102, 0.0005032921210448703, 0.00028302195830623395, 0.00015915494309189535,
    8.949940160889102e-05, 5.0329212104487035e-05, 2.8302195830623396e-05};

__global__ void __launch_bounds__(512, 2) fwd_kernel(Args args) {
    extern __shared__ __attribute__((aligned(16))) unsigned char lds_raw[];
    Frame F;
    F.lds = (LAS unsigned char*)lds_raw;
    F.MISC = (volatile LAS unsigned*)(F.lds + MISC_OFF);
    F.tid = threadIdx.x; F.lane = F.tid & 63; F.wave = __builtin_amdgcn_readfirstlane(F.tid >> 6);
    F.G = gridDim.x; { const int bx = blockIdx.x; F.vcu = (F.G % 8 == 0) ? (bx % 8) * (F.G / 8) + bx / 8 : bx; }
    unsigned char* ws = args.ws;
    F.ctl = (unsigned*)(ws + WS_CTL);
    for (int u = F.tid; u < (LDS_BYTES - MISC_OFF) / 4; u += 512) ((LAS unsigned*)(F.lds + MISC_OFF))[u] = 0u;
    __syncthreads();
    XcdBarrier bar = xcd_barrier_post(F.ctl + CW_BAR, F.MISC);
    const int NGW = F.G * 8;
#define PHASE_IDS int tid = threadIdx.x; asm volatile("" : "+v"(tid)); const int lane = tid & 63; const int wave = __builtin_amdgcn_readfirstlane(tid >> 6); const int gw = F.vcu * 8 + wave; (void)lane; (void)gw;

#define PHASE_PTRS unsigned char* wsl = args.ws; asm volatile("" : "+s"(wsl)); \
    float* ropeC = (float*)(wsl + WS_ROPE); float* ropeS = ropeC + LSEQ * 16; float* LFp = (float*)(wsl + WS_LF); float* CSp = (float*)(wsl + WS_CS); \
    unsigned* TOK = (unsigned*)(wsl + WS_TOK); int* LIST = (int*)(wsl + WS_LIST); bf16_t* Wall = (bf16_t*)(wsl + WS_W); bf16_t* HB = (bf16_t*)(wsl + WS_H); unsigned char* X = wsl + WS_X; \
    bf16_t *Qf = (bf16_t*)(X + X_QF), *Kf = (bf16_t*)(X + X_KF), *Vf = (bf16_t*)(X + X_VF), *RAW = (bf16_t*)(X + X_RAW), *Qm = (bf16_t*)(X + X_QM), *Km = (bf16_t*)(X + X_KM), \
           *Vm = (bf16_t*)(X + X_VM), *Om = (bf16_t*)(X + X_OM), *GATES = (bf16_t*)(X + X_GATES), *MERGED = (bf16_t*)(X + X_MERGED), *H1 = (bf16_t*)(X + X_H1), \
           *HID = (bf16_t*)(X + X_HID), *YS = (bf16_t*)(X + X_YS); float* Zb = (float*)(X + X_Z); unsigned* ctl = (unsigned*)(wsl + WS_CTL); \
    (void)ropeC; (void)ropeS; (void)LFp; (void)CSp; (void)TOK; (void)LIST; (void)Wall; (void)HB; (void)Qf; (void)Kf; (void)Vf; (void)RAW; (void)Qm; (void)Km; (void)Vm; (void)Om; (void)GATES; (void)MERGED; (void)H1; (void)HID; (void)YS; (void)Zb; (void)ctl;

    {
        PHASE_IDS
        PHASE_PTRS
        LAS float* scr = (LAS float*)(F.lds + wave * 16384);
        for (int it = gw; it < 2 * ITEMS_PER_LAYER; it += NGW) { const int l = it / ITEMS_PER_LAYER, r = it % ITEMS_PER_LAYER; convert_item(args, Wall + (size_t)l * W_LAYER, l, r, scr, lane); }
        for (int row = gw; row < TP; row += NGW) {
            bf16_t* orow = HB + (size_t)row * DM;
            if (row >= T) { *(u32x4*)(orow + 8 * lane) = (u32x4){0u, 0u, 0u, 0u}; *(u32x4*)(orow + 512 + 8 * lane) = (u32x4){0u, 0u, 0u, 0u}; continue; }
            const int b = row / LSEQ, p = row % LSEQ;
            const float* src = p < NMETA ? args.in[1] + (size_t)p * DM : args.in[0] + ((size_t)b * SEQ + (p - NMETA)) * DM;
            f32x4 v[4];
#pragma unroll
            for (int j = 0; j < 4; ++j) v[j] = *(const f32x4*)(src + 4 * lane + 256 * j);
            ln16(v, args.in[2], args.in[3], lane);
            store_row_bf16(orow, v, lane);
        }
        for (int idx = blockIdx.x * 512 + tid; idx < LSEQ * 16; idx += F.G * 512) {
            const int p = idx >> 4, i = idx & 15; double x = (double)p * ROPE_INV_REV[i]; x -= floor(x); const float xr = (float)x;
            ropeC[idx] = __builtin_amdgcn_cosf(xr); ropeS[idx] = __builtin_amdgcn_sinf(xr);
        }
    }
    xcd_barrier(bar);

    for (int l = 0; l < 2; ++l) {
        {
            PHASE_PTRS const bf16_t* W = Wall + (size_t)l * W_LAYER;
            pg8::SchedStatic S{(const char*)HB, (const char*)(W + W_BT1), NPANEL, 9, F.G, (int)blockIdx.x, (size_t)256 * DM * 2, (size_t)256 * DM * 2};
            pg8::EpiA1 E{Qf, Kf, Vf, RAW, LFp, args.in[5] + l * 8};
            pg8::gemm_phase<pg8::EpiA1, pg8::SchedStatic, false>(F.lds, 1024, 1024, 1024, S, E);
        }
        xcd_barrier(bar);
        {
            PHASE_IDS
            PHASE_PTRS
            if (blockIdx.x < 64 && wave == 0) {
                const int bb = blockIdx.x >> 3, hh = blockIdx.x & 7; float carry = 0.f;
                for (int i0 = 0; i0 < 65; i0 += 13) {
                    float v[13];
#pragma unroll
                    for (int k = 0; k < 13; ++k) { const int p = 64 * (i0 + k) + lane; v[k] = p < LSEQ ? LFp[((size_t)bb * LSEQ + p) * 8 + hh] : 0.f; }
#pragma unroll
                    for (int k = 0; k < 13; ++k) { float x = v[k];
#pragma unroll
                        for (int d = 1; d < 64; d <<= 1) { const float y = __shfl_up(x, d); if (lane >= d) x += y; }
                        x += carry; carry = __shfl(x, 63);
                        CSp[(size_t)blockIdx.x * CSP + 64 * (i0 + k) + lane] = x * LOG2E; }
                }
            }
            for (int row = gw; row < TP; row += NGW) {
                bf16_t* raw = RAW + (size_t)row * 768; const int pos = row % LSEQ;
                {
                    u32x4 q = {0u, 0u, 0u, 0u}; if (lane < 48) q = *(const u32x4*)(raw + 8 * lane);
                    float f[8] = {bf_lo(q.x), bf_hi(q.x), bf_lo(q.y), bf_hi(q.y), bf_lo(q.z), bf_hi(q.z), bf_lo(q.w), bf_hi(q.w)};
                    float ss = 0.f;
#pragma unroll
                    for (int j = 0; j < 8; ++j) ss += f[j] * f[j];
                    const float r = 1.0f / sqrtf(wave_sum(ss) * (1.f / 384.f) + 1e-6f);
                    if (lane < 48) { u32x4 o; o.x = pk_bf16(f[0] * r, f[1] * r); o.y = pk_bf16(f[2] * r, f[3] * r); o.z = pk_bf16(f[4] * r, f[5] * r); o.w = pk_bf16(f[6] * r, f[7] * r); *(u32x4*)(raw + 8 * lane) = o; }
                }
                {
                    u32x4 q = {0u, 0u, 0u, 0u}; if (lane < 32) q = *(const u32x4*)(raw + 384 + 8 * lane);
                    float f[8] = {bf_lo(q.x), bf_hi(q.x), bf_lo(q.y), bf_hi(q.y), bf_lo(q.z), bf_hi(q.z), bf_lo(q.w), bf_hi(q.w)};
                    float ss = 0.f;
#pragma unroll
                    for (int j = 0; j < 8; ++j) ss += f[j] * f[j];
                    const float r = 1.0f / sqrtf(wave_sum(ss) * (1.f / 256.f) + 1e-6f);
                    if (lane < 32) { u32x4 o; o.x = pk_bf16(f[0] * r, f[1] * r); o.y = pk_bf16(f[2] * r, f[3] * r); o.z = pk_bf16(f[4] * r, f[5] * r); o.w = pk_bf16(f[6] * r, f[7] * r); *(u32x4*)(raw + 384 + 8 * lane) = o; }
                }
                if (lane < 4) {
                    const u32x2 a = *(const u32x2*)(raw + 640 + 4 * lane), c = *(const u32x2*)(raw + 656 + 4 * lane);
                    const f32x4 x1 = {bf_lo(a.x), bf_hi(a.x), bf_lo(a.y), bf_hi(a.y)}, x2 = {bf_lo(c.x), bf_hi(c.x), bf_lo(c.y), bf_hi(c.y)};
                    const f32x4 cs = *(const f32x4*)(ropeC + pos * 16 + 4 * lane), sn = *(const f32x4*)(ropeS + pos * 16 + 4 * lane);
                    const f32x4 y1 = x1 * cs - x2 * sn, y2 = x2 * cs + x1 * sn;
                    u32x2 w1, w2; w1.x = pk_bf16(y1[0], y1[1]); w1.y = pk_bf16(y1[2], y1[3]); w2.x = pk_bf16(y2[0], y2[1]); w2.y = pk_bf16(y2[2], y2[3]);
                    bf16_t* kp = Km + (size_t)row * 768 + 64 + 4 * lane;
#pragma unroll
                    for (int h = 0; h < 8; ++h) { *(u32x2*)(kp + 96 * h) = w1; *(u32x2*)(kp + 96 * h + 16) = w2; }
                }
            }
        }
        xcd_barrier(bar);
        {
            PHASE_PTRS const bf16_t* W = Wall + (size_t)l * W_LAYER;
            pg8::SchedStatic S{(const char*)RAW, (const char*)(W + W_UQ), NPANEL, 3, F.G, (int)blockIdx.x, (size_t)256 * 768 * 2, (size_t)256 * 384 * 2};
            pg8::EpiQup E{Qm, ropeC, ropeS};
            pg8::gemm_phase<pg8::EpiQup, pg8::SchedStatic, false>(F.lds, 384, 768, 384, S, E);
        }
        {
            PHASE_PTRS const bf16_t* W = Wall + (size_t)l * W_LAYER;
            pg8::SchedStatic S{(const char*)(RAW + 384), (const char*)(W + W_UKV), NPANEL, 4, F.G, (int)blockIdx.x, (size_t)256 * 768 * 2, (size_t)256 * 256 * 2};
            pg8::EpiKV E{Km, Vm};
            pg8::gemm_phase<pg8::EpiKV, pg8::SchedStatic, false>(F.lds, 256, 768, 256, S, E);
        }
        xcd_barrier(bar);
        {
            PHASE_IDS
            PHASE_PTRS
            unsigned* qc = ctl + CW_QCTR + 64 * (l * 2);
            for (;;) {
                if (tid == 0) F.MISC[4] = __hip_atomic_fetch_add(qc, 1u, RLX_AGENT);
                __syncthreads();
                const int id = (int)F.MISC[4];
                __syncthreads();
                if (id >= 17 * 64) break;
                const int j = 16 - id / 64, bh = id % 64, b = bh >> 3, h = bh & 7;
                const int q0 = j == 0 ? 0 : 16 + 256 * (j - 1), nvalid = j == 0 ? 16 : 256;
                attn_unit<96, false>((LAS char*)F.lds, Qm + 96 * h, 768, Km + 96 * h, 768, Vm + 64 * h, 512, Om + 64 * h, 512, nullptr, b, q0, nvalid);
            }
            qc += 64;
            for (;;) {
                if (tid == 0) F.MISC[4] = __hip_atomic_fetch_add(qc, 1u, RLX_AGENT);
                __syncthreads();
                const int id = (int)F.MISC[4];
                __syncthreads();
                if (id >= 17 * 64) break;
                const int j = 16 - id / 64, bh = id % 64, b = bh >> 3, h = bh & 7;
                const int q0 = j == 0 ? 0 : 16 + 256 * (j - 1), nvalid = j == 0 ? 16 : 256;
                attn_unit<64, true>((LAS char*)F.lds, Qf + 64 * h, 512, Kf + 64 * h, 512, Vf + 64 * h, 512, Qf + 64 * h, 512, CSp + (size_t)bh * CSP, b, q0, nvalid);
            }
        }
        xcd_barrier(bar);
        {
            PHASE_PTRS const bf16_t* W = Wall + (size_t)l * W_LAYER;
            pg8::SchedStatic S{(const char*)HB, (const char*)(W + W_BT2), NPANEL, 8, F.G, (int)blockIdx.x, (size_t)256 * DM * 2, (size_t)256 * DM * 2};
            pg8::EpiA2 E{GATES};
            pg8::gemm_phase<pg8::EpiA2, pg8::SchedStatic, false>(F.lds, 1024, 1024, 1024, S, E);
        }
        xcd_barrier(bar);
        {
            PHASE_PTRS const bf16_t* W = Wall + (size_t)l * W_LAYER;
            pg8::SchedOut S{(const char*)Qf, (const char*)Om, (const char*)(W + W_FOXO), (const char*)(W + W_MLAO), NPANEL, 4, F.G, (int)blockIdx.x, (size_t)256 * 512 * 2, (size_t)256 * 512 * 2};
            pg8::EpiOut E{GATES, MERGED};
            pg8::gemm_phase<pg8::EpiOut, pg8::SchedOut, false>(F.lds, 512, 512, 512, S, E);
        }
        xcd_barrier(bar);
        {
            PHASE_PTRS const bf16_t* W = Wall + (size_t)l * W_LAYER;
            pg8::SchedStatic S{(const char*)MERGED, (const char*)(W + W_OUT), NPANEL, 4, F.G, (int)blockIdx.x, (size_t)256 * DM * 2, (size_t)256 * DM * 2};
            pg8::EpiF E{HB, Zb};
            pg8::gemm_phase<pg8::EpiF, pg8::SchedStatic, false>(F.lds, 1024, 1024, 1024, S, E);
        }
        xcd_barrier(bar);
        {
            PHASE_IDS
            PHASE_PTRS
            LAS float* rwT = (LAS float*)F.lds;
            LAS int* lcnt = (LAS int*)(F.lds + 65536);
            LAS int* gbase = lcnt + 16;
            LAS int* tE = lcnt + 64;
            LAS int* tP = tE + 272;
            LAS float* tG = (LAS float*)(tP + 272);
            const float* rw = args.in[15];
            for (int i = tid; i < 16384; i += 512) { const int col = i >> 4, e = i & 15; rwT[e * 1024 + col] = rw[i]; }
            if (tid < 16) lcnt[tid] = 0;
            __syncthreads();
            const int r0 = blockIdx.x * 129, nrows = (r0 + 129 <= T) ? 129 : (T > r0 ? T - r0 : 0);
            const float* rb = args.in[16];
            for (int lr = wave; lr < nrows; lr += 8) {
                const int row = r0 + lr;
                f32x4 v[4];
#pragma unroll
                for (int j = 0; j < 4; ++j) v[j] = *(const f32x4*)(Zb + (size_t)row * DM + 4 * lane + 256 * j);
                ln16(v, args.in[13] + l * DM, args.in[14] + l * DM, lane);
                store_row_bf16(H1 + (size_t)row * DM, v, lane);
                float s[16];
#pragma unroll
                for (int e = 0; e < 16; ++e) { float a = 0.f;
#pragma unroll
                    for (int j = 0; j < 4; ++j) { const f32x4 wv = *(const LAS f32x4*)(rwT + e * 1024 + 4 * lane + 256 * j); a += (v[j][0] * wv[0] + v[j][1] * wv[1]) + (v[j][2] * wv[2] + v[j][3] * wv[3]); }
                    s[e] = a; }
#pragma unroll
                for (int e = 0; e < 16; ++e) s[e] = wave_sum(s[e]);
                float sc[16], bi[16];
#pragma unroll
                for (int e = 0; e < 16; ++e) { sc[e] = 1.0f / (1.0f + expf(-s[e])); bi[e] = sc[e] + rb[e]; }
                int gsel = 0; float gbest = -INFINITY;
#pragma unroll
                for (int g = 0; g < 4; ++g) { float m1 = bi[4 * g], m2 = -INFINITY;
#pragma unroll
                    for (int k = 1; k < 4; ++k) { const float x = bi[4 * g + k]; if (x > m1) { m2 = m1; m1 = x; } else if (x > m2) m2 = x; }
                    const float gs = m1 + m2; if (gs > gbest) { gbest = gs; gsel = g; } }
                float b4[4], s4[4];
#pragma unroll
                for (int k = 0; k < 4; ++k) { b4[k] = gsel == 0 ? bi[k] : gsel == 1 ? bi[4 + k] : gsel == 2 ? bi[8 + k] : bi[12 + k]; s4[k] = gsel == 0 ? sc[k] : gsel == 1 ? sc[4 + k] : gsel == 2 ? sc[8 + k] : sc[12 + k]; }
                int i1 = 0;
#pragma unroll
                for (int k = 1; k < 4; ++k) if (b4[k] > b4[i1 == 0 ? 0 : i1 == 1 ? 1 : i1 == 2 ? 2 : 3]) i1 = k;
                int i2 = -1; float bb2 = -INFINITY;
#pragma unroll
                for (int k = 0; k < 4; ++k) if (k != i1 && b4[k] > bb2) { bb2 = b4[k]; i2 = k; }
                const float sa = i1 == 0 ? s4[0] : i1 == 1 ? s4[1] : i1 == 2 ? s4[2] : s4[3], sb = i2 == 0 ? s4[0] : i2 == 1 ? s4[1] : i2 == 2 ? s4[2] : s4[3];
                const float inv = 1.0f / (sa + sb);
                if (lane == 0) {
                    const int e0 = gsel * 4 + i1, e1 = gsel * 4 + i2;
                    tE[2 * lr] = e0; tE[2 * lr + 1] = e1;
                    tP[2 * lr] = atomicAdd((int*)&lcnt[e0], 1); tP[2 * lr + 1] = atomicAdd((int*)&lcnt[e1], 1);
                    tG[2 * lr] = sa * inv; tG[2 * lr + 1] = sb * inv;
                }
            }
            __syncthreads();
            if (tid < 16) gbase[tid] = (int)__hip_atomic_fetch_add(ctl + CW_ECNT + 64 * (l * 16 + tid), (unsigned)lcnt[tid], RLX_AGENT);
            __syncthreads();
            if (tid < nrows) {
                const int row = r0 + tid; const int e0 = tE[2 * tid], e1 = tE[2 * tid + 1];
                const int p0 = gbase[e0] + tP[2 * tid], p1 = gbase[e1] + tP[2 * tid + 1];
                LIST[(size_t)e0 * TP + p0] = row; LIST[(size_t)e1 * TP + p1] = row;
                u32x4 w0; w0.x = (unsigned)e0; w0.y = (unsigned)p0; w0.z = (unsigned)e1; w0.w = (unsigned)p1;
                *(u32x4*)(TOK + (size_t)row * 8) = w0;
                u32x2 w1; w1.x = __float_as_uint(tG[2 * tid]); w1.y = __float_as_uint(tG[2 * tid + 1]);
                *(u32x2*)(TOK + (size_t)row * 8 + 4) = w1;
            }
        }
        xcd_barrier(bar);
        LAS int* tb = (LAS int*)(F.lds + MISC_OFF) + 16; LAS int* ecnt = (LAS int*)(F.lds + MISC_OFF) + 64;
        if (threadIdx.x == 0) { int acc = 0; for (int e = 0; e < 16; ++e) { const int c = (int)__hip_atomic_load(F.ctl + CW_ECNT + 64 * (l * 16 + e), RLX_AGENT); ecnt[e] = c; tb[e] = acc; acc += (c + 255) >> 8; } tb[16] = acc; }
        __syncthreads();
        {
            PHASE_PTRS const bf16_t* W = Wall + (size_t)l * W_LAYER;
            pg8::SchedMoe S{(const char*)H1, (const char*)(W + W_MOE1), tb, ecnt, LIST, 1, F.G, (int)blockIdx.x, (size_t)512 * 1024 * 2, (size_t)256 * 1024 * 2, 0, true};
            pg8::EpiM1 E{HID};
            pg8::gemm_phase<pg8::EpiM1, pg8::SchedMoe, true>(F.lds, 1024, 1024, 1024, S, E);
        }
        xcd_barrier(bar);
        {
            PHASE_PTRS const bf16_t* W = Wall + (size_t)l * W_LAYER;
            pg8::SchedMoe S{(const char*)HID, (const char*)(W + W_MOE2), tb, ecnt, LIST, 2, F.G, (int)blockIdx.x, (size_t)1024 * 256 * 2, (size_t)256 * 256 * 2, (size_t)256 * 256 * 2, false};
            pg8::EpiM2 E{YS};
            pg8::gemm_phase<pg8::EpiM2, pg8::SchedMoe, false>(F.lds, 256, 256, 256, S, E);
        }
        xcd_barrier(bar);
        {
            PHASE_IDS
            PHASE_PTRS
            for (int row = gw; row < T; row += NGW) {
                const u32x4 w0 = *(const u32x4*)(TOK + (size_t)row * 8); const u32x2 w1 = *(const u32x2*)(TOK + (size_t)row * 8 + 4);
                const int e0 = (int)w0.x, p0 = (int)w0.y, e1 = (int)w0.z, p1 = (int)w0.w; const float g0 = __uint_as_float(w1.x), g1 = __uint_as_float(w1.y);
                const size_t s0 = (size_t)tb[e0] * 256 + p0, s1 = (size_t)tb[e1] * 256 + p1;
                f32x4 v[4];
#pragma unroll
                for (int j = 0; j < 4; ++j) {
                    const u32x2 hv = *(const u32x2*)(H1 + (size_t)row * DM + 4 * lane + 256 * j), a = *(const u32x2*)(YS + s0 * DM + 4 * lane + 256 * j), c = *(const u32x2*)(YS + s1 * DM + 4 * lane + 256 * j);
                    v[j][0] = ALPHA * bf_lo(hv.x) + g0 * bf_lo(a.x) + g1 * bf_lo(c.x); v[j][1] = ALPHA * bf_hi(hv.x) + g0 * bf_hi(a.x) + g1 * bf_hi(c.x);
                    v[j][2] = ALPHA * bf_lo(hv.y) + g0 * bf_lo(a.y) + g1 * bf_lo(c.y); v[j][3] = ALPHA * bf_hi(hv.y) + g0 * bf_hi(a.y) + g1 * bf_hi(c.y);
                }
                ln16(v, args.in[20] + l * DM, args.in[21] + l * DM, lane);
                if (l == 0) store_row_bf16(HB + (size_t)row * DM, v, lane);
                else { const int b = row / LSEQ, p = row % LSEQ;
                    if (p >= NMETA) { float* orow = args.out + ((size_t)b * SEQ + (p - NMETA)) * DM;
#pragma unroll
                        for (int j = 0; j < 4; ++j) *(f32x4*)(orow + 4 * lane + 256 * j) = v[j]; } }
            }
        }
        if (l == 0) xcd_barrier(bar);
    }
}

extern "C" void kernel_launch(void* const* d_in, const int* in_sizes, int n_in, void* d_out, int out_size, void* d_ws, size_t ws_size, hipStream_t stream) {
    static int grid = 0;
    if (grid == 0) {
        if (n_in != 22 || ws_size < WS_END) { fprintf(stderr, "kernel_launch: need 22 inputs and %zu bytes of workspace (got %d, %zu)\n", (size_t)WS_END, n_in, ws_size); grid = -1; return; }
        int dev = 0, cus = 0, per_cu = 0;
        if (hipGetDevice(&dev) != hipSuccess || hipDeviceGetAttribute(&cus, hipDeviceAttributeMultiprocessorCount, dev) != hipSuccess) { grid = -1; return; }
        if (hipFuncSetAttribute((const void*)fwd_kernel, hipFuncAttributeMaxDynamicSharedMemorySize, LDS_BYTES) != hipSuccess) { fprintf(stderr, "kernel_launch: hipFuncSetAttribute failed\n"); grid = -1; return; }
        if (hipOccupancyMaxActiveBlocksPerMultiprocessor(&per_cu, (const void*)fwd_kernel, 512, LDS_BYTES) != hipSuccess || per_cu < 1) { fprintf(stderr, "kernel_launch: occupancy query says %d\n", per_cu); }
        (void)hipGetLastError();
        grid = cus;
    }
    if (grid < 0) return;
    if (hipMemsetAsync((char*)d_ws + WS_CTL, 0, CTL_BYTES, stream) != hipSuccess) return;
    Args a{};
    for (int i = 0; i < 22; ++i) a.in[i] = (const float*)d_in[i];
    a.out = (float*)d_out; a.ws = (unsigned char*)d_ws;
    hipLaunchKernelGGL(fwd_kernel, dim3(grid), dim3(512), LDS_BYTES, stream, a);
}
```

```cpp
#include <hip/hip_runtime.h>
#include <cstdio>
#include <cstdint>

#ifndef REP_GEMM
#define REP_GEMM 1
#endif
#ifndef REP_MLA
#define REP_MLA 1
#endif
#ifndef REP_FOX
#define REP_FOX 1
#endif
#ifndef REP_J
#define REP_J 1
#endif
#ifndef REP_THIN
#define REP_THIN 1
#endif
#define LAS __attribute__((address_space(3)))
typedef unsigned short bf16_t;
typedef short bf16x8 __attribute__((ext_vector_type(8)));
typedef short s16x4 __attribute__((ext_vector_type(4)));
typedef float f32x4 __attribute__((ext_vector_type(4)));
typedef float f32x2_t __attribute__((ext_vector_type(2)));
typedef __bf16 bf16x2_t __attribute__((ext_vector_type(2)));
typedef float f32x16 __attribute__((ext_vector_type(16)));
typedef unsigned u32x4 __attribute__((ext_vector_type(4)));
typedef unsigned u32x2 __attribute__((ext_vector_type(2)));

constexpr int NB = 8, SEQ = 4096, NMETA = 16, LSEQ = 4112, T = NB * LSEQ  , TP = 33024  , DM = 1024;
constexpr int NPANEL = TP / 256;
constexpr int NEXP = 16;
constexpr float ALPHA = 1.41421356237309515f;
constexpr float LOG2E = 1.4426950408889634f;
constexpr float C2F = 0.125f * LOG2E;
constexpr float C2M = 0.14724444602590310f;
constexpr int CSP = 4160;

constexpr size_t MiB = 1ull << 20;
constexpr size_t WS_CTL = 0, CTL_BYTES = 1 * MiB;
constexpr size_t WS_ROPE = 1 * MiB;
constexpr size_t WS_LF = 2 * MiB;
constexpr size_t WS_CS = 4 * MiB;
constexpr size_t WS_TOK = 6 * MiB;
constexpr size_t WS_LIST = 8 * MiB;
constexpr size_t WS_W = 12 * MiB;
constexpr size_t WS_H = 88 * MiB;
constexpr size_t WS_X = 153 * MiB;
constexpr size_t S512 = (size_t)TP * 512 * 2, S768 = (size_t)TP * 768 * 2, S1024 = (size_t)TP * 1024 * 2;
constexpr size_t X_QF = 0, X_KF = S512, X_VF = 2 * S512, X_RAW = 3 * S512, X_QM = 3 * S512 + S768, X_KM = 3 * S512 + 2 * S768,
                 X_VM = 3 * S512 + 3 * S768, X_OM = 4 * S512 + 3 * S768, X_OF = 5 * S512 + 3 * S768, X_END = 6 * S512 + 3 * S768;
constexpr size_t X_GATES = X_KF;
constexpr size_t X_MERGED = X_KM;
constexpr size_t X_Z = X_KF;
constexpr size_t X_H1 = X_KM;
constexpr size_t X_HID = X_QF;
constexpr size_t X_YS = 36 * MiB;
constexpr int NSLOT_TILES = 273, NSLOT = NSLOT_TILES * 256;
constexpr size_t WS_END = WS_X + X_END;
static_assert(X_GATES + (size_t)TP * 2048 * 2 <= X_KM, "gates");
static_assert(X_MERGED + S1024 <= X_OM, "merged");
static_assert(X_HID + (size_t)NSLOT * 256 * 2 <= X_YS, "hid");
static_assert(X_YS + (size_t)NSLOT * 1024 * 2 <= X_KM, "ys");
static_assert(WS_W + 2ull * 19693568ull * 2ull <= WS_H, "weights");
static_assert(WS_H + S1024 <= WS_X, "h");
constexpr size_t W_BT1 = 0, W_BT2 = W_BT1 + 2304ull * 1024, W_FOXO = W_BT2 + 2048ull * 1024, W_MLAO = W_FOXO + 1024ull * 512,
                 W_UQ = W_MLAO + 1024ull * 512, W_UKV = W_UQ + 768ull * 384, W_OUT = W_UKV + 1024ull * 256, W_MOE1 = W_OUT + 1024ull * 1024,
                 W_MOE2 = W_MOE1 + 16ull * 512 * 1024, W_LAYER = W_MOE2 + 16ull * 1024 * 256;
static_assert(W_LAYER == 19693568ull, "weights per layer");
constexpr int CW_BAR = 4096;
constexpr int CW_QCTR = 8192;
constexpr int CW_ECNT = 12288;

constexpr int RING_BYTES = 131072;
constexpr int MISC_OFF = RING_BYTES;
constexpr int LDS_BYTES = 147456;

__device__ __forceinline__ unsigned pk_bf16(float lo, float hi) { f32x2_t v = {lo, hi}; bf16x2_t b = __builtin_convertvector(v, bf16x2_t); return __builtin_bit_cast(unsigned, b); }
__device__ __forceinline__ float bf_lo(unsigned u) { return __uint_as_float(u << 16); }
__device__ __forceinline__ float bf_hi(unsigned u) { return __uint_as_float(u & 0xffff0000u); }
__device__ __forceinline__ float wave_sum(float v) {
#pragma unroll
    for (int o = 1; o < 64; o <<= 1) v += __shfl_xor(v, o);
    return v;
}
#define LDS_WAIT() asm volatile("s_waitcnt lgkmcnt(0)" ::: "memory")
#define RLX_AGENT __ATOMIC_RELAXED, __HIP_MEMORY_SCOPE_AGENT

#define XB_TMO      128
#define XB_XCNT(j)  (256  + 64 * (j))
#define XB_XSUB(j)  (1280 + 64 * (j))
#define XB_XGEN(j)  (2304 + 64 * (j))
#define XB_TOP      3328
#define XB_TOPGEN   3392
#define XCD_BAR_WORDS 3456
#define XB_SPIN_CAP (1u << 20)
__device__ __forceinline__ unsigned xb_ld(unsigned* p)              { return __hip_atomic_load(p, __ATOMIC_RELAXED, __HIP_MEMORY_SCOPE_AGENT); }
__device__ __forceinline__ unsigned xb_add(unsigned* p, unsigned v) { return __hip_atomic_fetch_add(p, v, __ATOMIC_RELAXED, __HIP_MEMORY_SCOPE_AGENT); }
__device__ __forceinline__ unsigned xb_xcc_id() { return (unsigned)__builtin_amdgcn_s_getreg((3 << 11) | 20) & 0xFu; }
#define XB_SPIN(cond, bar) do { unsigned _sp = 0; while (cond) { __builtin_amdgcn_s_sleep(1); \
    if ((++_sp & 255u) == 0u) { if (xb_ld(&(bar)[XB_TMO])) break; if (_sp > XB_SPIN_CAP) { atomicAdd(&(bar)[XB_TMO], 1u); break; } } } } while (0)
struct XcdBarrier { unsigned* bar; unsigned x; volatile LAS unsigned* st; };
__device__ __forceinline__ XcdBarrier xcd_barrier_post(unsigned* bar, volatile LAS unsigned* st) {
    XcdBarrier b; b.bar = bar; b.x = xb_xcc_id(); b.st = st;
    if (threadIdx.x == 0) (void)xb_add(&bar[XB_XCNT(b.x)], 1u);
    return b;
}
__device__ __forceinline__ void xcd_barrier_complete(unsigned* bar, unsigned x, unsigned& nloc, unsigned& nx) {
    const unsigned G = gridDim.x * gridDim.y * gridDim.z;
    unsigned sum, cnt, mine, sp = 0u;
    for (;;) {
        sum = 0u; cnt = 0u; mine = 0u;
#pragma unroll
        for (unsigned j = 0; j < 16; ++j) { const unsigned c = xb_ld(&bar[XB_XCNT(j)]); sum += c; cnt += (c > 0u) ? 1u : 0u; mine = (j == x) ? c : mine; }
        if (sum == G) break;
        __builtin_amdgcn_s_sleep(1);
        if ((++sp & 255u) == 0u) { if (xb_ld(&bar[XB_TMO])) break; if (sp > XB_SPIN_CAP) { atomicAdd(&bar[XB_TMO], 1u); break; } }
    }
    nloc = mine > 0u ? mine : 1u; nx = cnt > 0u ? cnt : 1u;
}
__device__ __forceinline__ void xcd_barrier(const XcdBarrier& b) {
    asm volatile("s_waitcnt vmcnt(0)" ::: "memory");
    __syncthreads();
    if (threadIdx.x == 0) {
        unsigned* bar = b.bar; unsigned bx = b.x; asm volatile("" : "+s"(bar), "+s"(bx));
        __builtin_amdgcn_s_waitcnt(0);
        unsigned nloc = b.st[0], nx = b.st[1];
        if (nloc == 0u) { xcd_barrier_complete(bar, bx, nloc, nx); b.st[0] = nloc; b.st[1] = nx; }
        const unsigned old = xb_add(&bar[XB_XSUB(bx)], 1u);
        const unsigned gen = old / nloc;
        if (old + 1u == (gen + 1u) * nloc) {
            __builtin_amdgcn_fence(__ATOMIC_RELEASE, "agent");
            asm volatile("s_waitcnt vmcnt(0)" ::: "memory");
            const unsigned og = xb_add(&bar[XB_TOP], 1u);
            const unsigned tg = og / nx;
            if (og + 1u == (tg + 1u) * nx) xb_add(&bar[XB_TOPGEN], 1u);
            else XB_SPIN(xb_ld(&bar[XB_TOPGEN]) == tg, bar);
            __builtin_amdgcn_fence(__ATOMIC_ACQUIRE, "agent");
            xb_add(&bar[XB_XGEN(bx)], 1u);
            asm volatile("s_waitcnt vmcnt(0)" ::: "memory");
        } else {
            XB_SPIN(xb_ld(&bar[XB_XGEN(bx)]) == gen, bar);
            __builtin_amdgcn_fence(__ATOMIC_ACQUIRE, "agent");
            asm volatile("s_waitcnt vmcnt(0)" ::: "memory");
        }
    }
    __syncthreads();
}

namespace pg8 {
constexpr int BM = 256, BK = 64, HALF = 128, HTB = HALF * BK * 2, STAGE_BYTES = 8 * HTB;
__device__ __forceinline__ int lds_byte(int r, int c) { const int st = (r >> 4) * 2 + (c >> 5), rr = r & 15, cc = c & 31, ob = rr * 64 + cc * 2; return st * 1024 + (ob ^ (((ob >> 9) & 1) << 5)); }
__device__ __forceinline__ void stage_rc(int b, int& R, int& C) { const int st = b / 1024, sb = b % 1024, swz = sb ^ (((sb >> 9) & 1) << 5); R = (st >> 1) * 16 + swz / 64; C = (st & 1) * 32 + (swz % 64) / 2; }
__device__ __forceinline__ int perm32(int rho) { const int n = rho >> 4, i = rho & 15; return 8 * (i >> 2) + 4 * n + (i & 3); }
struct Unit { const char* A; const char* B; int pm, pn, aux; };
typedef f32x4 Acc[2][2][4][2];

__device__ __forceinline__ void tile_of(int L, int nM, int nN, int& pm, int& pn) {
    const int nwg = nM * nN; int wgid = L;
    { const int q = nwg / 8, r = nwg % 8, xcd = wgid % 8, off = wgid / 8; wgid = (xcd < r ? xcd * (q + 1) : r * (q + 1) + (xcd - r) * q) + off; }
    const int nig = 8 * nN, gid = wgid / nig, fm = gid * 8, gsz = (nM - fm) < 8 ? (nM - fm) : 8;
    pm = fm + ((wgid % nig) % gsz); pn = (wgid % nig) / gsz;
}

template <class Epi, class Sched, bool GATHER>
__device__ __forceinline__ void gemm_phase(LAS unsigned char* lds, const int K, const int lda, const int ldb, const Sched& S, const Epi& E) {
    int tid_l = threadIdx.x; asm volatile("" : "+v"(tid_l));
    const int tid = tid_l, wid = __builtin_amdgcn_readfirstlane(tid >> 6), lane = tid & 63, wr = wid >> 2, wc = wid & 3, fr = lane & 15, fq = lane >> 4;
    int nt = K / BK; asm volatile("" : "+s"(nt));
    unsigned voA[2][2], voB[2]; int Rr[2], Cc[2];
#pragma unroll
    for (int i = 0; i < 2; ++i) { int R, C; stage_rc(tid * 16 + i * 8192, R, C); const int Rb = Epi::PERM ? ((R & ~31) + perm32(R & 31)) : R;
        Rr[i] = R; Cc[i] = C; voA[0][i] = (unsigned)(R * lda + C) * 2u; voA[1][i] = (unsigned)((R + HALF) * lda + C) * 2u; voB[i] = (unsigned)(Rb * ldb + C) * 2u; }
    const size_t kstep = (size_t)(BK * 2);
    const size_t hstepB = (size_t)HALF * ldb * 2;
    const unsigned ldsw = (unsigned)wid * 1024u;
    const int aoff = lds_byte(wr * 64 + fr, fq * 8), boff = lds_byte(wc * 32 + fr, fq * 8);
#define PG8_SA(b, h) (((b) * 2 + (h)) * HTB)
#define PG8_SB(b, h) ((4 + (b) * 2 + (h)) * HTB)
#define PG8_STAGE2(bufoff, gbase, o0, o1) do { \
        __builtin_amdgcn_global_load_lds((const unsigned*)((const char*)(gbase) + (o0)), (LAS unsigned*)(lds + (bufoff) + ldsw), 16, 0, 0); \
        __builtin_amdgcn_global_load_lds((const unsigned*)((const char*)(gbase) + (o1)), (LAS unsigned*)(lds + (bufoff) + ldsw + 8192), 16, 0, 0); } while (0)
#define PG8_STA(b, h, gbase, VO) PG8_STAGE2(PG8_SA(b, h), gbase, (VO)[h][0], (VO)[h][1])
#define PG8_STB(b, h, gbase) PG8_STAGE2(PG8_SB(b, h), (gbase) + (h) * hstepB, voB[0], voB[1])
#define PG8_LDA(dst, b, h) do { _Pragma("unroll") for (int m = 0; m < 4; ++m) _Pragma("unroll") for (int k = 0; k < 2; ++k) dst[m][k] = *(const LAS bf16x8*)(lds + PG8_SA(b, h) + aoff + m * 2048 + k * 1024); } while (0)
#define PG8_LDB(dst, b, h) do { _Pragma("unroll") for (int n = 0; n < 2; ++n) _Pragma("unroll") for (int k = 0; k < 2; ++k) dst[n][k] = *(const LAS bf16x8*)(lds + PG8_SB(b, h) + boff + n * 2048 + k * 1024); } while (0)
#define PG8_MMA(ai, bj, At, Bt) do { __builtin_amdgcn_s_setprio(1); _Pragma("unroll") for (int m = 0; m < 4; ++m) _Pragma("unroll") for (int n = 0; n < 2; ++n) _Pragma("unroll") for (int k = 0; k < 2; ++k) \
        acc[ai][bj][m][n] = __builtin_amdgcn_mfma_f32_16x16x32_bf16(Bt[n][k], At[m][k], acc[ai][bj][m][n], 0, 0, 0); __builtin_amdgcn_s_setprio(0); } while (0)
#define PG8_WAIT_V(n) asm volatile("s_waitcnt vmcnt(" #n ")" ::: "memory")
#define PG8_WAIT_L(n) asm volatile("s_waitcnt lgkmcnt(" #n ")" ::: "memory")
#define PG8_BAR __builtin_amdgcn_s_barrier()
#define PG8_SCHED __builtin_amdgcn_sched_barrier(0)
    Unit cur, nxt; int ui = 0;
    if (!S.next(0, cur)) return;
    Acc acc;
#pragma unroll
    for (int a = 0; a < 2; ++a)
#pragma unroll
        for (int b = 0; b < 2; ++b)
#pragma unroll
            for (int m = 0; m < 4; ++m)
#pragma unroll
                for (int n = 0; n < 2; ++n) acc[a][b][m][n] = (f32x4){0.f, 0.f, 0.f, 0.f};
    bf16x8 At[4][2], B0[2][2], B1[2][2];
    const char* cA = cur.A; const char* cB = cur.B;
    if constexpr (GATHER) {
#pragma unroll
        for (int h = 0; h < 2; ++h)
#pragma unroll
            for (int i = 0; i < 2; ++i) voA[h][i] = S.row_off(cur, Rr[i] + h * HALF) + (unsigned)Cc[i] * 2u;
    }
    PG8_STB(0, 0, cB); PG8_STB(0, 1, cB); PG8_STA(0, 0, cA, voA); PG8_STA(0, 1, cA, voA);
    if (wr == 1) PG8_BAR;
    PG8_WAIT_V(2); PG8_BAR;
    PG8_STB(1, 0, cB + kstep); PG8_STA(1, 0, cA + kstep, voA); PG8_STB(1, 1, cB + kstep);
    PG8_WAIT_V(6); PG8_BAR;
    for (;;) {
        const bool has_next = S.next(ui + 1, nxt);
        const char* nA = has_next ? nxt.A : cA; const char* nB = has_next ? nxt.B : cB;
        unsigned vnA[2][2];
        if constexpr (GATHER) {
#pragma unroll
            for (int h = 0; h < 2; ++h)
#pragma unroll
                for (int i = 0; i < 2; ++i) vnA[h][i] = has_next ? (S.row_off(nxt, Rr[i] + h * HALF) + (unsigned)Cc[i] * 2u) : voA[h][i];
        }
        for (int t = 0; t < nt; t += 2) {
            const bool last = (t == nt - 2);
            const char* a1 = cA + (size_t)(t + 1) * kstep;
            const char* a2 = last ? nA : cA + (size_t)(t + 2) * kstep; const char* b2 = last ? nB : cB + (size_t)(t + 2) * kstep;
            const char* a3 = a2 + kstep; const char* b3 = b2 + kstep;
            unsigned vs[2][2];
#pragma unroll
            for (int h = 0; h < 2; ++h)
#pragma unroll
                for (int i = 0; i < 2; ++i) { if constexpr (GATHER) vs[h][i] = last ? vnA[h][i] : voA[h][i]; else vs[h][i] = voA[h][i]; }
            PG8_LDB(B0, 0, 0); PG8_LDB(B1, 0, 1); PG8_SCHED; PG8_LDA(At, 0, 0); PG8_STA(1, 1, a1, voA);
            PG8_WAIT_V(8); PG8_WAIT_L(0); PG8_BAR; PG8_MMA(0, 0, At, B0); PG8_MMA(0, 1, At, B1); PG8_BAR; PG8_SCHED;
            PG8_LDA(At, 0, 1); PG8_STB(0, 0, b2); PG8_STB(0, 1, b2); PG8_STA(0, 0, a2, vs);
            PG8_WAIT_V(8); PG8_WAIT_L(0); PG8_BAR; PG8_MMA(1, 0, At, B0); PG8_MMA(1, 1, At, B1); PG8_BAR; PG8_SCHED;
            PG8_LDB(B0, 1, 0); PG8_LDB(B1, 1, 1); PG8_SCHED; PG8_LDA(At, 1, 0); PG8_STA(0, 1, a2, vs);
            PG8_WAIT_V(8); PG8_WAIT_L(0); PG8_BAR; PG8_MMA(0, 0, At, B0); PG8_MMA(0, 1, At, B1); PG8_BAR; PG8_SCHED;
            PG8_LDA(At, 1, 1); PG8_STB(1, 0, b3); PG8_STB(1, 1, b3); PG8_STA(1, 0, a3, vs);
            PG8_WAIT_V(8); PG8_WAIT_L(0); PG8_BAR; PG8_MMA(1, 0, At, B0); PG8_MMA(1, 1, At, B1); PG8_BAR; PG8_SCHED;
        }
        if (wr == 0) PG8_BAR;
        E(acc, cur, wr, wc, fr, fq);
        if (!has_next) break;
#pragma unroll
        for (int a = 0; a < 2; ++a)
#pragma unroll
            for (int b = 0; b < 2; ++b)
#pragma unroll
                for (int m = 0; m < 4; ++m)
#pragma unroll
                    for (int n = 0; n < 2; ++n) acc[a][b][m][n] = (f32x4){0.f, 0.f, 0.f, 0.f};
        cur = nxt; cA = nA; cB = nB; ++ui;
        if constexpr (GATHER) {
#pragma unroll
            for (int h = 0; h < 2; ++h)
#pragma unroll
                for (int i = 0; i < 2; ++i) voA[h][i] = vnA[h][i];
        }
        if (wr == 1) PG8_BAR;
    }
    PG8_WAIT_V(0);
    PG8_BAR;
#undef PG8_SA
#undef PG8_SB
#undef PG8_STAGE2
#undef PG8_STA
#undef PG8_STB
#undef PG8_LDA
#undef PG8_LDB
#undef PG8_MMA
#undef PG8_WAIT_V
#undef PG8_WAIT_L
#undef PG8_BAR
#undef PG8_SCHED
}

struct SchedStatic {
    const char* A; const char* B; int nM, nN, G, c; size_t astep, bstep;
    __device__ __forceinline__ bool next(int i, Unit& u) const {
        const long L = (long)i * G + c; if (L >= (long)nM * nN) return false;
        int pm, pn; tile_of((int)L, nM, nN, pm, pn);
        u.pm = pm; u.pn = pn; u.aux = 0; u.A = A + (size_t)pm * astep; u.B = B + (size_t)pn * bstep; return true;
    }
    __device__ __forceinline__ unsigned row_off(const Unit&, int) const { return 0u; }
};
struct SchedOut {
    const char* A0; const char* A1; const char* B0; const char* B1; int nM, nN, G, c; size_t astep, bstep;
    __device__ __forceinline__ bool next(int i, Unit& u) const {
        const long L = (long)(i >> 1) * G + c; if (L >= (long)nM * nN) return false;
        int pm, pn; tile_of((int)L, nM, nN, pm, pn);
        const int pass = i & 1;
        u.pm = pm; u.pn = pn; u.aux = pass; u.A = (pass ? A1 : A0) + (size_t)pm * astep; u.B = (pass ? B1 : B0) + (size_t)pn * bstep; return true;
    }
    __device__ __forceinline__ unsigned row_off(const Unit&, int) const { return 0u; }
};
struct SchedMoe {
    const char* A; const char* B; const LAS int* tb; const LAS int* cnt; const int* list; int npn_shift, G, c; size_t bstep_e, bstep_n, astep; bool gather;
    __device__ __forceinline__ bool next(int i, Unit& u) const {
        const int L = i * G + c; const int ntile = tb[16];
        if (L >= (ntile << npn_shift)) return false;
        const int ti = L >> npn_shift, pn = L & ((1 << npn_shift) - 1);
        int e = 0; while (ti >= tb[e + 1]) ++e;
        u.pm = ti; u.pn = pn; u.aux = e;
        u.A = gather ? A : A + (size_t)ti * astep;
        u.B = B + (size_t)e * bstep_e + (size_t)pn * bstep_n; return true;
    }
    __device__ __forceinline__ unsigned row_off(const Unit& u, int r) const {
        const int e = u.aux; int idx = (u.pm - tb[e]) * 256 + r; const int ce = cnt[e]; idx = idx < ce ? idx : ce - 1;
        const int tok = list[(size_t)e * TP + idx];
        return (unsigned)tok * (unsigned)(DM * 2);
    }
};

__device__ __forceinline__ u32x4 pack8(f32x4 v0, f32x4 v1) { u32x4 w; w.x = pk_bf16(v0[0], v0[1]); w.y = pk_bf16(v0[2], v0[3]); w.z = pk_bf16(v1[0], v1[1]); w.w = pk_bf16(v1[2], v1[3]); return w; }
__device__ __forceinline__ float logsig(float x) { return fminf(x, 0.f) - log1pf(__expf(-fabsf(x))); }
__device__ __forceinline__ float sigm(float x) { return 1.0f / (1.0f + __expf(-x)); }

struct EpiA1 {
    static constexpr bool PERM = true;
    bf16_t *Qf, *Kf, *Vf, *RAW; float* LF; const float* fbias;
    __device__ __forceinline__ void operator()(const Acc& acc, const Unit& u, int wr, int wc, int fr, int fq) const {
        const int pn = u.pn; bf16_t* base; int ldc, colt; float sc = 1.f;
        if (pn < 2) { base = Qf; ldc = 512; colt = pn * 256; sc = C2F; } else if (pn < 4) { base = Kf; ldc = 512; colt = (pn - 2) * 256; }
        else if (pn < 6) { base = Vf; ldc = 512; colt = (pn - 4) * 256; } else { base = RAW; ldc = 768; colt = (pn - 6) * 256; }
        const int row0 = u.pm * 256 + wr * 64 + fr, col0 = colt + wc * 32 + 8 * fq;
#pragma unroll
        for (int ai = 0; ai < 2; ++ai)
#pragma unroll
            for (int m = 0; m < 4; ++m) { bf16_t* rowp = base + (size_t)(row0 + ai * 128 + m * 16) * ldc + col0;
#pragma unroll
                for (int bj = 0; bj < 2; ++bj) *(u32x4*)(rowp + bj * 128) = pack8(acc[ai][bj][m][0] * sc, acc[ai][bj][m][1] * sc); }
        if (pn == 8 && wc == 1 && fq == 0) {
            const f32x4 b0 = *(const f32x4*)fbias, b1 = *(const f32x4*)(fbias + 4);
#pragma unroll
            for (int ai = 0; ai < 2; ++ai)
#pragma unroll
                for (int m = 0; m < 4; ++m) { const int row = row0 + ai * 128 + m * 16; const f32x4 a = acc[ai][1][m][0] + b0, b = acc[ai][1][m][1] + b1;
                    f32x4 o0, o1;
#pragma unroll
                    for (int j = 0; j < 4; ++j) { o0[j] = logsig(a[j]); o1[j] = logsig(b[j]); }
                    *(f32x4*)(LF + (size_t)row * 8) = o0; *(f32x4*)(LF + (size_t)row * 8 + 4) = o1; }
        }
    }
};
struct EpiA2 {
    static constexpr bool PERM = true;
    bf16_t* G;
    __device__ __forceinline__ void operator()(const Acc& acc, const Unit& u, int wr, int wc, int fr, int fq) const {
        const int row0 = u.pm * 256 + wr * 64 + fr, col0 = u.pn * 256 + wc * 32 + 8 * fq;
#pragma unroll
        for (int ai = 0; ai < 2; ++ai)
#pragma unroll
            for (int m = 0; m < 4; ++m) { bf16_t* rowp = G + (size_t)(row0 + ai * 128 + m * 16) * 2048 + col0;
#pragma unroll
                for (int bj = 0; bj < 2; ++bj) { f32x4 a = acc[ai][bj][m][0], b = acc[ai][bj][m][1];
#pragma unroll
                    for (int j = 0; j < 4; ++j) { a[j] = sigm(a[j]); b[j] = sigm(b[j]); }
                    *(u32x4*)(rowp + bj * 128) = pack8(a, b); } }
    }
};
struct EpiQup {
    static constexpr bool PERM = false;
    bf16_t* Qm; const float* cosT; const float* sinT;
    __device__ __forceinline__ void operator()(const Acc& acc, const Unit& u, int wr, int wc, int fr, int fq) const {
        const int row0 = u.pm * 256 + wr * 64 + fr;
#pragma unroll
        for (int ai = 0; ai < 2; ++ai)
#pragma unroll
            for (int m = 0; m < 4; ++m) { const int row = row0 + ai * 128 + m * 16; const int pos = row % LSEQ;
#pragma unroll
                for (int bj = 0; bj < 2; ++bj) { const int Gi = u.pn * 8 + bj * 4 + wc; f32x4 x0 = acc[ai][bj][m][0], x1 = acc[ai][bj][m][1];
                    if (Gi % 3 == 2) { const f32x4 cs = *(const f32x4*)(cosT + pos * 16 + 4 * fq), sn = *(const f32x4*)(sinT + pos * 16 + 4 * fq);
                        const f32x4 y0 = x0 * cs - x1 * sn, y1 = x1 * cs + x0 * sn; x0 = y0; x1 = y1; }
                    x0 = x0 * C2M; x1 = x1 * C2M;
                    bf16_t* p = Qm + (size_t)row * 768 + Gi * 32 + 4 * fq;
                    u32x2 w0, w1; w0.x = pk_bf16(x0[0], x0[1]); w0.y = pk_bf16(x0[2], x0[3]); w1.x = pk_bf16(x1[0], x1[1]); w1.y = pk_bf16(x1[2], x1[3]);
                    *(u32x2*)p = w0; *(u32x2*)(p + 16) = w1; } }
    }
};
struct EpiKV {
    static constexpr bool PERM = true;
    bf16_t *Km, *Vm;
    __device__ __forceinline__ void operator()(const Acc& acc, const Unit& u, int wr, int wc, int fr, int fq) const {
        const int row0 = u.pm * 256 + wr * 64 + fr;
#pragma unroll
        for (int ai = 0; ai < 2; ++ai)
#pragma unroll
            for (int m = 0; m < 4; ++m) { const int row = row0 + ai * 128 + m * 16;
#pragma unroll
                for (int bj = 0; bj < 2; ++bj) { const int n = u.pn * 256 + bj * 128 + wc * 32 + 8 * fq; const u32x4 w = pack8(acc[ai][bj][m][0], acc[ai][bj][m][1]);
                    if (u.pn < 2) *(u32x4*)(Km + (size_t)row * 768 + 96 * (n >> 6) + (n & 63)) = w;
                    else *(u32x4*)(Vm + (size_t)row * 512 + (n - 512)) = w; } }
    }
};
struct EpiOut {
    static constexpr bool PERM = true;
    const bf16_t* G; bf16_t* Mg;
    __device__ __forceinline__ void operator()(const Acc& acc, const Unit& u, int wr, int wc, int fr, int fq) const {
        const int row0 = u.pm * 256 + wr * 64 + fr, col0 = u.pn * 256 + wc * 32 + 8 * fq; const int pass = u.aux;
#pragma unroll
        for (int ai = 0; ai < 2; ++ai)
#pragma unroll
            for (int m = 0; m < 4; ++m) { const int row = row0 + ai * 128 + m * 16;
#pragma unroll
                for (int bj = 0; bj < 2; ++bj) { const int col = col0 + bj * 128;
                    const u32x4 g = *(const u32x4*)(G + (size_t)row * 2048 + pass * 1024 + col);
                    f32x4 a = acc[ai][bj][m][0], b = acc[ai][bj][m][1];
                    a[0] *= bf_lo(g.x); a[1] *= bf_hi(g.x); a[2] *= bf_lo(g.y); a[3] *= bf_hi(g.y); b[0] *= bf_lo(g.z); b[1] *= bf_hi(g.z); b[2] *= bf_lo(g.w); b[3] *= bf_hi(g.w);
                    bf16_t* mp = Mg + (size_t)row * 1024 + col;
                    if (pass) { const u32x4 p = *(const u32x4*)mp;
                        a[0] += bf_lo(p.x); a[1] += bf_hi(p.x); a[2] += bf_lo(p.y); a[3] += bf_hi(p.y); b[0] += bf_lo(p.z); b[1] += bf_hi(p.z); b[2] += bf_lo(p.w); b[3] += bf_hi(p.w); }
                    *(u32x4*)mp = pack8(a, b); } }
    }
};
struct EpiF {
    static constexpr bool PERM = false;
    const bf16_t* H; float* Z;
    __device__ __forceinline__ void operator()(const Acc& acc, const Unit& u, int wr, int wc, int fr, int fq) const {
        const int row0 = u.pm * 256 + wr * 64 + fr, col0 = u.pn * 256 + wc * 32 + 4 * fq;
#pragma unroll
        for (int ai = 0; ai < 2; ++ai)
#pragma unroll
            for (int m = 0; m < 4; ++m) { const size_t off = (size_t)(row0 + ai * 128 + m * 16) * 1024 + col0;
#pragma unroll
                for (int bj = 0; bj < 2; ++bj)
#pragma unroll
                    for (int n = 0; n < 2; ++n) { const u32x2 hv = *(const u32x2*)(H + off + bj * 128 + n * 16); f32x4 o = acc[ai][bj][m][n];
                        o[0] += ALPHA * bf_lo(hv.x); o[1] += ALPHA * bf_hi(hv.x); o[2] += ALPHA * bf_lo(hv.y); o[3] += ALPHA * bf_hi(hv.y);
                        *(f32x4*)(Z + off + bj * 128 + n * 16) = o; } }
    }
};
struct EpiM1 {
    static constexpr bool PERM = false;
    bf16_t* Hid;
    __device__ __forceinline__ void operator()(const Acc& acc, const Unit& u, int wr, int wc, int fr, int fq) const {
        const int row0 = u.pm * 256 + wr * 64 + fr, hc0 = u.pn * 128 + wc * 16 + 4 * fq;
#pragma unroll
        for (int ai = 0; ai < 2; ++ai)
#pragma unroll
            for (int m = 0; m < 4; ++m) { bf16_t* rowp = Hid + (size_t)(row0 + ai * 128 + m * 16) * 256 + hc0;
#pragma unroll
                for (int bj = 0; bj < 2; ++bj) { const f32x4 g = acc[ai][bj][m][0], up = acc[ai][bj][m][1]; f32x4 o;
#pragma unroll
                    for (int j = 0; j < 4; ++j) o[j] = g[j] * sigm(g[j]) * up[j];
                    u32x2 w; w.x = pk_bf16(o[0], o[1]); w.y = pk_bf16(o[2], o[3]); *(u32x2*)(rowp + bj * 64) = w; } }
    }
};
struct EpiM2 {
    static constexpr bool PERM = true;
    bf16_t* Ys;
    __device__ __forceinline__ void operator()(const Acc& acc, const Unit& u, int wr, int wc, int fr, int fq) const {
        const int row0 = u.pm * 256 + wr * 64 + fr, col0 = u.pn * 256 + wc * 32 + 8 * fq;
#pragma unroll
        for (int ai = 0; ai < 2; ++ai)
#pragma unroll
            for (int m = 0; m < 4; ++m) { bf16_t* rowp = Ys + (size_t)(row0 + ai * 128 + m * 16) * 1024 + col0;
#pragma unroll
                for (int bj = 0; bj < 2; ++bj) *(u32x4*)(rowp + bj * 128) = pack8(acc[ai][bj][m][0], acc[ai][bj][m][1]); }
    }
};
}

__device__ __forceinline__ int crow(int r, int hi) { return (r & 3) + 8 * (r >> 2) + 4 * hi; }
typedef short v4i16_t __attribute__((ext_vector_type(4)));
__device__ __forceinline__ s16x4 vtr(const LAS char* p) { return __builtin_bit_cast(s16x4, __builtin_amdgcn_ds_read_tr16_b64_v4i16((LAS v4i16_t*)p)); }
__device__ __forceinline__ float swapmax(float m) { auto rr = __builtin_amdgcn_permlane32_swap(__float_as_uint(m), __float_as_uint(m), false, false); return fmaxf(__uint_as_float(rr[0]), __uint_as_float(rr[1])); }
__device__ __forceinline__ float swapsum(float m) { auto rr = __builtin_amdgcn_permlane32_swap(__float_as_uint(m), __float_as_uint(m), false, false); return __uint_as_float(rr[0]) + __uint_as_float(rr[1]); }

template <int DK, bool FOX>
__device__ __forceinline__ void attn_unit(LAS char* lds, const bf16_t* Q, int ldq, const bf16_t* Kp, int ldk, const bf16_t* Vp, int ldv, bf16_t* O, int ldo,
                                          const float* cs, int b, int q0, int nvalid) {
    constexpr int NS = DK / 16, KB = 64 * DK * 2, BUF = KB + 8192 + 256;
    int tid_l = threadIdx.x; asm volatile("" : "+v"(tid_l));
    const int tid = tid_l, lane = tid & 63, r32 = lane & 31, hi = lane >> 5; const int wid = __builtin_amdgcn_readfirstlane(tid >> 6);
    const size_t rowbase = (size_t)b * LSEQ;
    const int qpos = q0 + 32 * wid + r32;
    const bool wave_on = (32 * wid) < nvalid;
    bf16x8 qf[NS];
#pragma unroll
    for (int s = 0; s < NS; ++s) qf[s] = *(const bf16x8*)(Q + (rowbase + qpos) * ldq + 16 * s + 8 * hi);
    float csq = 0.f; if (FOX) csq = cs[qpos];
    const int NT = (q0 + nvalid + 63) >> 6;
    const int skv = tid >> 3, sch = tid & 7;
    const bf16_t* kg = Kp + (rowbase + skv) * ldk + 8 * sch;
    const bf16_t* vg = Vp + (rowbase + skv) * ldv + 8 * sch;
    const int kdst = sch * 1024 + ((skv ^ sch) << 4);
    const int vdst = KB + ((sch >> 2) * 8 + (skv >> 3)) * 512 + (skv & 7) * 64 + (sch & 3) * 16;
    const int skv2 = tid >> 2, sch2 = 8 + (tid & 3);
    const bf16_t* kg2 = Kp + (rowbase + (skv2 & 63)) * ldk + 8 * sch2;
    const int kdst2 = sch2 * 1024 + (((skv2 & 63) ^ (sch2 & 7)) << 4);
    u32x4 kr0, kr1 = {0u, 0u, 0u, 0u}, vr0; f32x4 cr = {0.f, 0.f, 0.f, 0.f};
#define ATT_LOAD(t) do { kr0 = *(const u32x4*)(kg + (size_t)(t) * 64 * ldk); vr0 = *(const u32x4*)(vg + (size_t)(t) * 64 * ldv); \
        if (DK == 96 && tid < 256) kr1 = *(const u32x4*)(kg2 + (size_t)(t) * 64 * ldk); \
        if (FOX && tid < 16) cr = *(const f32x4*)(cs + (t) * 64 + 4 * tid); } while (0)
#define ATT_STORE(bufp) do { *(LAS u32x4*)((bufp) + kdst) = kr0; *(LAS u32x4*)((bufp) + vdst) = vr0; \
        if (DK == 96 && tid < 256) *(LAS u32x4*)((bufp) + kdst2) = kr1; \
        if (FOX && tid < 16) *(LAS f32x4*)((bufp) + KB + 8192 + 16 * tid) = cr; } while (0)
    ATT_LOAD(0);
    ATT_STORE(lds);
    __syncthreads();
    float mrun = -INFINITY, lrun = 0.f;
    f32x16 o0 = {}, o1 = {};
    const int vlane = ((lane >> 4) & 1) * 32 + (lane & 3) * 8 + (4 * hi + ((lane & 15) >> 2)) * 64;
    for (int t = 0; t < NT; ++t) {
        LAS char* cb = lds + (t & 1) * BUF; LAS char* nb = lds + ((t + 1) & 1) * BUF;
        const bool more = (t + 1 < NT);
        if (more) ATT_LOAD(t + 1);
        const bool active = wave_on && (64 * t <= q0 + 32 * wid + 31);
        if (active) {
            f32x16 p0 = {}, p1 = {};
#pragma unroll
            for (int s = 0; s < NS; ++s) {
                const int c = 2 * s + hi;
                const bf16x8 a0 = *(const LAS bf16x8*)(cb + c * 1024 + ((r32 ^ (c & 7)) << 4));
                const bf16x8 a1 = *(const LAS bf16x8*)(cb + c * 1024 + (((r32 + 32) ^ (c & 7)) << 4));
                p0 = __builtin_amdgcn_mfma_f32_32x32x16_bf16(a0, qf[s], p0, 0, 0, 0);
                p1 = __builtin_amdgcn_mfma_f32_32x32x16_bf16(a1, qf[s], p1, 0, 0, 0);
            }
            if (FOX) {
                const LAS float* cl = (const LAS float*)(cb + KB + 8192);
#pragma unroll
                for (int g = 0; g < 4; ++g) { const f32x4 c0 = *(const LAS f32x4*)(cl + 8 * g + 4 * hi), c1 = *(const LAS f32x4*)(cl + 32 + 8 * g + 4 * hi);
#pragma unroll
                    for (int j = 0; j < 4; ++j) { p0[4 * g + j] += csq - c0[j]; p1[4 * g + j] += csq - c1[j]; } }
            }
            if (64 * t + 63 > q0 + 32 * wid) {
                const int kb = 64 * t + 4 * hi;
#pragma unroll
                for (int r = 0; r < 16; ++r) { const int kv = kb + (r & 3) + 8 * (r >> 2); if (kv > qpos) p0[r] = -INFINITY; if (kv + 32 > qpos) p1[r] = -INFINITY; }
            }
            float mt = fmaxf(p0[0], p1[0]);
#pragma unroll
            for (int r = 1; r < 16; ++r) mt = fmaxf(mt, fmaxf(p0[r], p1[r]));
            mt = swapmax(mt);
            const float mnew = fmaxf(mrun, mt);
            const float alpha = __builtin_amdgcn_exp2f(mrun - mnew);
            mrun = mnew;
            float ls = 0.f;
#pragma unroll
            for (int r = 0; r < 16; ++r) { p0[r] = __builtin_amdgcn_exp2f(p0[r] - mnew); p1[r] = __builtin_amdgcn_exp2f(p1[r] - mnew); ls += p0[r] + p1[r]; }
            lrun = lrun * alpha + ls;
#pragma unroll
            for (int r = 0; r < 16; ++r) { o0[r] *= alpha; o1[r] *= alpha; }
            bf16x8 pb[4];
#pragma unroll
            for (int s = 0; s < 2; ++s) {
                u32x4 w; w.x = pk_bf16(p0[8 * s], p0[8 * s + 1]); w.y = pk_bf16(p0[8 * s + 2], p0[8 * s + 3]); w.z = pk_bf16(p0[8 * s + 4], p0[8 * s + 5]); w.w = pk_bf16(p0[8 * s + 6], p0[8 * s + 7]);
                pb[s] = __builtin_bit_cast(bf16x8, w);
                u32x4 w2; w2.x = pk_bf16(p1[8 * s], p1[8 * s + 1]); w2.y = pk_bf16(p1[8 * s + 2], p1[8 * s + 3]); w2.z = pk_bf16(p1[8 * s + 4], p1[8 * s + 5]); w2.w = pk_bf16(p1[8 * s + 6], p1[8 * s + 7]);
                pb[2 + s] = __builtin_bit_cast(bf16x8, w2);
            }
            const LAS char* vb = cb + KB + vlane;
#pragma unroll
            for (int ks = 0; ks < 4; ++ks) {
                const s16x4 l0 = vtr(vb + ks * 1024), h0 = vtr(vb + ks * 1024 + 512);
                const s16x4 l1 = vtr(vb + 4096 + ks * 1024), h1 = vtr(vb + 4096 + ks * 1024 + 512);
                const bf16x8 a0 = (bf16x8){l0[0], l0[1], l0[2], l0[3], h0[0], h0[1], h0[2], h0[3]};
                const bf16x8 a1 = (bf16x8){l1[0], l1[1], l1[2], l1[3], h1[0], h1[1], h1[2], h1[3]};
                o0 = __builtin_amdgcn_mfma_f32_32x32x16_bf16(a0, pb[ks], o0, 0, 0, 0);
                o1 = __builtin_amdgcn_mfma_f32_32x32x16_bf16(a1, pb[ks], o1, 0, 0, 0);
            }
        }
        if (more) ATT_STORE(nb);
        __syncthreads();
    }
#undef ATT_LOAD
#undef ATT_STORE
    if (wave_on) {
        const float lt = swapsum(lrun);
        const float inv = 1.0f / lt;
        if (32 * wid + r32 < nvalid) {
            bf16_t* op = O + (rowbase + qpos) * ldo;
#pragma unroll
            for (int g = 0; g < 4; ++g) {
                u32x2 w0, w1;
                w0.x = pk_bf16(o0[4 * g] * inv, o0[4 * g + 1] * inv); w0.y = pk_bf16(o0[4 * g + 2] * inv, o0[4 * g + 3] * inv);
                w1.x = pk_bf16(o1[4 * g] * inv, o1[4 * g + 1] * inv); w1.y = pk_bf16(o1[4 * g + 2] * inv, o1[4 * g + 3] * inv);
                *(u32x2*)(op + 8 * g + 4 * hi) = w0; *(u32x2*)(op + 32 + 8 * g + 4 * hi) = w1;
            }
        }
    }
}

struct Args { const float* in[22]; float* out; unsigned char* ws; };
struct Frame {
    LAS unsigned char* lds; volatile LAS unsigned* MISC; unsigned* ctl;
    int tid, lane, wave, vcu, G;
};

__device__ __forceinline__ void tr_item(const float* colp, int ld, const float* kscale, bf16_t* dst, int K, int n0, int k0, LAS float* scr, int lane) {
#pragma unroll
    for (int i = 0; i < 32; ++i) { const int kk = 2 * i + (lane >> 5); float v = colp ? colp[(size_t)(k0 + kk) * ld] : 0.f; if (kscale) v *= kscale[k0 + kk]; scr[kk * 33 + (lane & 31)] = v; }
    LDS_WAIT(); asm volatile("" ::: "memory");
    const int c = lane & 7;
#pragma unroll
    for (int j = 0; j < 4; ++j) { const int n = (lane >> 3) + 8 * j; const LAS float* s = scr + (8 * c) * 33 + n;
        u32x4 o; o.x = pk_bf16(s[0 * 33], s[1 * 33]); o.y = pk_bf16(s[2 * 33], s[3 * 33]); o.z = pk_bf16(s[4 * 33], s[5 * 33]); o.w = pk_bf16(s[6 * 33], s[7 * 33]);
        *(u32x4*)(dst + (size_t)(n0 + n) * K + k0 + 8 * c) = o; }
    LDS_WAIT(); asm volatile("" ::: "memory");
}
constexpr int ITEMS_PER_LAYER = 9616;
__device__ __forceinline__ void convert_item(const Args& a, bf16_t* W, int l, int r, LAS float* scr, int lane) {
    const int w = lane & 31;
    if (r < 1152) { const int kb = r / 72, nb = r % 72, n = nb * 32 + w; int col;
        if (n < 1536) col = n; else { const int j = n - 1536; col = j < 384 ? 1544 + j : j < 640 ? 1928 + (j - 384) : j < 672 ? 2184 + (j - 640) : j < 680 ? 1536 + (j - 672) : -1; }
        const float* src = a.in[4] + (size_t)l * 1024 * 4264;
        tr_item(col >= 0 ? src + col : nullptr, 4264, nullptr, W + W_BT1, 1024, nb * 32, kb * 64, scr, lane); return; }
    r -= 1152;
    if (r < 1024) { const int kb = r / 64, nb = r % 64, n = nb * 32 + w; const float* src = a.in[4] + (size_t)l * 1024 * 4264;
        tr_item(src + 2216 + n, 4264, nullptr, W + W_BT2, 1024, nb * 32, kb * 64, scr, lane); return; }
    r -= 1024;
    if (r < 256) { const int kb = r / 32, nb = r % 32, n = nb * 32 + w; tr_item(a.in[6] + (size_t)l * 512 * 1024 + n, 1024, nullptr, W + W_FOXO, 512, nb * 32, kb * 64, scr, lane); return; }
    r -= 256;
    if (r < 256) { const int kb = r / 32, nb = r % 32, n = nb * 32 + w; tr_item(a.in[11] + (size_t)l * 512 * 1024 + n, 1024, nullptr, W + W_MLAO, 512, nb * 32, kb * 64, scr, lane); return; }
    r -= 256;
    if (r < 144) { const int kb = r / 24, nb = r % 24, n = nb * 32 + w; tr_item(a.in[8] + (size_t)l * 384 * 768 + n, 768, a.in[7] + l * 384, W + W_UQ, 384, nb * 32, kb * 64, scr, lane); return; }
    r -= 144;
    if (r < 128) { const int kb = r / 32, nb = r % 32, n = nb * 32 + w; const int col = n < 512 ? (n >> 6) * 128 + (n & 63) : ((n - 512) >> 6) * 128 + 64 + (n & 63);
        tr_item(a.in[10] + (size_t)l * 256 * 1024 + col, 1024, a.in[9] + l * 256, W + W_UKV, 256, nb * 32, kb * 64, scr, lane); return; }
    r -= 128;
    if (r < 512) { const int kb = r / 32, nb = r % 32, n = nb * 32 + w; tr_item(a.in[12] + (size_t)l * 1024 * 1024 + n, 1024, nullptr, W + W_OUT, 1024, nb * 32, kb * 64, scr, lane); return; }
    r -= 512;
    if (r < 4096) { const int e = r / 256, rr = r % 256, kb = rr / 16, nb = rr % 16;
        const float* src = (w < 16 ? a.in[17] : a.in[18]) + ((size_t)(l * 16 + e) * 1024) * 256 + 16 * nb + (w & 15);
        tr_item(src, 256, nullptr, W + W_MOE1 + (size_t)e * 512 * 1024, 1024, nb * 32, kb * 64, scr, lane); return; }
    r -= 4096;
    { const int e = r / 128, rr = r % 128, kb = rr / 32, nb = rr % 32, n = nb * 32 + w;
        tr_item(a.in[19] + ((size_t)(l * 16 + e) * 256) * 1024 + n, 1024, nullptr, W + W_MOE2 + (size_t)e * 1024 * 256, 256, nb * 32, kb * 64, scr, lane); }
}

__device__ __forceinline__ void ln16(f32x4 (&v)[4], const float* g, const float* bta, int lane) {
    float s = 0.f;
#pragma unroll
    for (int j = 0; j < 4; ++j) s += (v[j][0] + v[j][1]) + (v[j][2] + v[j][3]);
    const float mean = wave_sum(s) * (1.f / DM); float s2 = 0.f;
#pragma unroll
    for (int j = 0; j < 4; ++j) { v[j] = v[j] - mean; s2 += (v[j][0] * v[j][0] + v[j][1] * v[j][1]) + (v[j][2] * v[j][2] + v[j][3] * v[j][3]); }
    const float rstd = 1.0f / sqrtf(wave_sum(s2) * (1.f / DM) + 1e-5f);
#pragma unroll
    for (int j = 0; j < 4; ++j) { const f32x4 gg = *(const f32x4*)(g + 4 * lane + 256 * j), bb = *(const f32x4*)(bta + 4 * lane + 256 * j); v[j] = v[j] * rstd * gg + bb; }
}
template <int R>
__device__ __forceinline__ void ln16xR(f32x4 (&v)[R][4], const float* g, const float* bta, int lane) {
    float s[R];
#pragma unroll
    for (int k = 0; k < R; ++k) { s[k] = 0.f;
#pragma unroll
        for (int j = 0; j < 4; ++j) s[k] += (v[k][j][0] + v[k][j][1]) + (v[k][j][2] + v[k][j][3]); }
#pragma unroll
    for (int o = 1; o < 64; o <<= 1) {
#pragma unroll
        for (int k = 0; k < R; ++k) s[k] += __shfl_xor(s[k], o); }
    float s2[R];
#pragma unroll
    for (int k = 0; k < R; ++k) { const float mean = s[k] * (1.f / DM); s2[k] = 0.f;
#pragma unroll
        for (int j = 0; j < 4; ++j) { v[k][j] = v[k][j] - mean; s2[k] += (v[k][j][0] * v[k][j][0] + v[k][j][1] * v[k][j][1]) + (v[k][j][2] * v[k][j][2] + v[k][j][3] * v[k][j][3]); } }
#pragma unroll
    for (int o = 1; o < 64; o <<= 1) {
#pragma unroll
        for (int k = 0; k < R; ++k) s2[k] += __shfl_xor(s2[k], o); }
#pragma unroll
    for (int j = 0; j < 4; ++j) { const f32x4 gg = *(const f32x4*)(g + 4 * lane + 256 * j), bb = *(const f32x4*)(bta + 4 * lane + 256 * j);
#pragma unroll
        for (int k = 0; k < R; ++k) { const float rstd = 1.0f / sqrtf(s2[k] * (1.f / DM) + 1e-5f); v[k][j] = v[k][j] * rstd * gg + bb; } }
}
__device__ __forceinline__ void store_row_bf16(bf16_t* orow, const f32x4 (&v)[4], int lane) {
#pragma unroll
    for (int j = 0; j < 4; ++j) { u32x2 w; w.x = pk_bf16(v[j][0], v[j][1]); w.y = pk_bf16(v[j][2], v[j][3]); *(u32x2*)(orow + 4 * lane + 256 * j) = w; }
}

__device__ const double ROPE_INV_REV[16] = {0.15915494309189535, 0.08949940160889101, 0.050329212104487035, 0.0283021958306234, 0.015915494309189534, 0.008949940160889102,
    0.005032921210448704, 0.00283021958306234, 0.0015915494309189536, 0.0008949940160889102, 0.0005032921210448703, 0.00028302195830623395, 0.00015915494309189535,
    8.949940160889102e-05, 5.0329212104487035e-05, 2.8302195830623396e-05};

__global__ void __launch_bounds__(512, 2) fwd_kernel(Args args) {
    extern __shared__ __attribute__((aligned(16))) unsigned char lds_raw[];
    Frame F;
    F.lds = (LAS unsigned char*)lds_raw;
    F.MISC = (volatile LAS unsigned*)(F.lds + MISC_OFF);
    F.tid = threadIdx.x; F.lane = F.tid & 63; F.wave = __builtin_amdgcn_readfirstlane(F.tid >> 6);
    F.G = gridDim.x; { const int bx = blockIdx.x; F.vcu = (F.G % 8 == 0) ? (bx % 8) * (F.G / 8) + bx / 8 : bx; }
    unsigned char* ws = args.ws;
    F.ctl = (unsigned*)(ws + WS_CTL);
    for (int u = F.tid; u < (LDS_BYTES - MISC_OFF) / 4; u += 512) ((LAS unsigned*)(F.lds + MISC_OFF))[u] = 0u;
    __syncthreads();
    XcdBarrier bar = xcd_barrier_post(F.ctl + CW_BAR, F.MISC);
    const int NGW = F.G * 8;
#define PHASE_IDS int tid = threadIdx.x; asm volatile("" : "+v"(tid)); const int lane = tid & 63; const int wave = __builtin_amdgcn_readfirstlane(tid >> 6); const int gw = F.vcu * 8 + wave; (void)lane; (void)gw;

#define PHASE_PTRS unsigned char* wsl = args.ws; asm volatile("" : "+s"(wsl)); \
    float* ropeC = (float*)(wsl + WS_ROPE); float* ropeS = ropeC + LSEQ * 16; float* LFp = (float*)(wsl + WS_LF); float* CSp = (float*)(wsl + WS_CS); \
    unsigned* TOK = (unsigned*)(wsl + WS_TOK); int* LIST = (int*)(wsl + WS_LIST); bf16_t* Wall = (bf16_t*)(wsl + WS_W); bf16_t* HB = (bf16_t*)(wsl + WS_H); unsigned char* X = wsl + WS_X; \
    bf16_t *Qf = (bf16_t*)(X + X_QF), *Kf = (bf16_t*)(X + X_KF), *Vf = (bf16_t*)(X + X_VF), *RAW = (bf16_t*)(X + X_RAW), *Qm = (bf16_t*)(X + X_QM), *Km = (bf16_t*)(X + X_KM), \
           *Vm = (bf16_t*)(X + X_VM), *Om = (bf16_t*)(X + X_OM), *Of = (bf16_t*)(X + X_OF), *GATES = (bf16_t*)(X + X_GATES), *MERGED = (bf16_t*)(X + X_MERGED), *H1 = (bf16_t*)(X + X_H1), \
           *HID = (bf16_t*)(X + X_HID), *YS = (bf16_t*)(X + X_YS); float* Zb = (float*)(X + X_Z); unsigned* ctl = (unsigned*)(wsl + WS_CTL); \
    (void)ropeC; (void)ropeS; (void)LFp; (void)CSp; (void)TOK; (void)LIST; (void)Wall; (void)HB; (void)Qf; (void)Kf; (void)Vf; (void)RAW; (void)Qm; (void)Km; (void)Vm; (void)Om; (void)Of; (void)GATES; (void)MERGED; (void)H1; (void)HID; (void)YS; (void)Zb; (void)ctl;

    {
        PHASE_IDS
        PHASE_PTRS
        LAS float* scr = (LAS float*)(F.lds + wave * 16384);
        for (int it = gw; it < 2 * ITEMS_PER_LAYER; it += NGW) { const int l = it / ITEMS_PER_LAYER, r = it % ITEMS_PER_LAYER; convert_item(args, Wall + (size_t)l * W_LAYER, l, r, scr, lane); }
        for (int r4 = gw * 4; r4 < TP; r4 += NGW * 4) {
            if (r4 >= T) {
#pragma unroll
                for (int k = 0; k < 4; ++k) { bf16_t* orow = HB + (size_t)(r4 + k) * DM; *(u32x4*)(orow + 8 * lane) = (u32x4){0u, 0u, 0u, 0u}; *(u32x4*)(orow + 512 + 8 * lane) = (u32x4){0u, 0u, 0u, 0u}; }
                continue; }
            f32x4 v[4][4];
#pragma unroll
            for (int k = 0; k < 4; ++k) { const int row = r4 + k; const int b = row / LSEQ, p = row % LSEQ;
                const float* src = p < NMETA ? args.in[1] + (size_t)p * DM : args.in[0] + ((size_t)b * SEQ + (p - NMETA)) * DM;
#pragma unroll
                for (int j = 0; j < 4; ++j) v[k][j] = *(const f32x4*)(src + 4 * lane + 256 * j); }
            ln16xR<4>(v, args.in[2], args.in[3], lane);
#pragma unroll
            for (int k = 0; k < 4; ++k) store_row_bf16(HB + (size_t)(r4 + k) * DM, v[k], lane);
        }
        for (int idx = blockIdx.x * 512 + tid; idx < LSEQ * 16; idx += F.G * 512) {
            const int p = idx >> 4, i = idx & 15; double x = (double)p * ROPE_INV_REV[i]; x -= floor(x); const float xr = (float)x;
            ropeC[idx] = __builtin_amdgcn_cosf(xr); ropeS[idx] = __builtin_amdgcn_sinf(xr);
        }
    }
    xcd_barrier(bar);

    for (int l = 0; l < 2; ++l) {
        for (int rep_ = 0; rep_ < REP_GEMM; ++rep_) {
        {
            PHASE_PTRS const bf16_t* W = Wall + (size_t)l * W_LAYER;
            pg8::SchedStatic S{(const char*)HB, (const char*)(W + W_BT1), NPANEL, 9, F.G, (int)blockIdx.x, (size_t)256 * DM * 2, (size_t)256 * DM * 2};
            pg8::EpiA1 E{Qf, Kf, Vf, RAW, LFp, args.in[5] + l * 8};
            pg8::gemm_phase<pg8::EpiA1, pg8::SchedStatic, false>(F.lds, 1024, 1024, 1024, S, E);
        }
        xcd_barrier(bar);
        }
        for (int rep_ = 0; rep_ < REP_THIN; ++rep_) {
        {
            PHASE_IDS
            PHASE_PTRS
            if (blockIdx.x < 64 && wave == 0) {
                const int bb = blockIdx.x >> 3, hh = blockIdx.x & 7; float carry = 0.f;
                for (int i0 = 0; i0 < 65; i0 += 13) {
                    float v[13];
#pragma unroll
                    for (int k = 0; k < 13; ++k) { const int p = 64 * (i0 + k) + lane; v[k] = p < LSEQ ? LFp[((size_t)bb * LSEQ + p) * 8 + hh] : 0.f; }
#pragma unroll
                    for (int k = 0; k < 13; ++k) { float x = v[k];
#pragma unroll
                        for (int d = 1; d < 64; d <<= 1) { const float y = __shfl_up(x, d); if (lane >= d) x += y; }
                        x += carry; carry = __shfl(x, 63);
                        CSp[(size_t)blockIdx.x * CSP + 64 * (i0 + k) + lane] = x * LOG2E; }
                }
            }
            for (int r4 = gw * 4; r4 < TP; r4 += NGW * 4) {
                u32x4 q[4], kv[4]; u32x2 ka[4], kc[4];
#pragma unroll
                for (int k = 0; k < 4; ++k) { const bf16_t* raw = RAW + (size_t)(r4 + k) * 768;
                    q[k] = (u32x4){0u, 0u, 0u, 0u}; kv[k] = (u32x4){0u, 0u, 0u, 0u}; ka[k] = (u32x2){0u, 0u}; kc[k] = (u32x2){0u, 0u};
                    if (lane < 48) q[k] = *(const u32x4*)(raw + 8 * lane);
                    if (lane < 32) kv[k] = *(const u32x4*)(raw + 384 + 8 * lane);
                    if (lane < 4) { ka[k] = *(const u32x2*)(raw + 640 + 4 * lane); kc[k] = *(const u32x2*)(raw + 656 + 4 * lane); } }
                float fq_[4][8], fk_[4][8], sq[4], sk[4];
#pragma unroll
                for (int k = 0; k < 4; ++k) {
                    fq_[k][0] = bf_lo(q[k].x); fq_[k][1] = bf_hi(q[k].x); fq_[k][2] = bf_lo(q[k].y); fq_[k][3] = bf_hi(q[k].y); fq_[k][4] = bf_lo(q[k].z); fq_[k][5] = bf_hi(q[k].z); fq_[k][6] = bf_lo(q[k].w); fq_[k][7] = bf_hi(q[k].w);
                    fk_[k][0] = bf_lo(kv[k].x); fk_[k][1] = bf_hi(kv[k].x); fk_[k][2] = bf_lo(kv[k].y); fk_[k][3] = bf_hi(kv[k].y); fk_[k][4] = bf_lo(kv[k].z); fk_[k][5] = bf_hi(kv[k].z); fk_[k][6] = bf_lo(kv[k].w); fk_[k][7] = bf_hi(kv[k].w);
                    sq[k] = 0.f; sk[k] = 0.f;
#pragma unroll
                    for (int j = 0; j < 8; ++j) { sq[k] += fq_[k][j] * fq_[k][j]; sk[k] += fk_[k][j] * fk_[k][j]; } }
#pragma unroll
                for (int o = 1; o < 64; o <<= 1) {
#pragma unroll
                    for (int k = 0; k < 4; ++k) { sq[k] += __shfl_xor(sq[k], o); sk[k] += __shfl_xor(sk[k], o); } }
#pragma unroll
                for (int k = 0; k < 4; ++k) { bf16_t* raw = RAW + (size_t)(r4 + k) * 768; const int pos = (r4 + k) % LSEQ;
                    const float rq = 1.0f / sqrtf(sq[k] * (1.f / 384.f) + 1e-6f), rk = 1.0f / sqrtf(sk[k] * (1.f / 256.f) + 1e-6f);
                    if (lane < 48) { u32x4 o; o.x = pk_bf16(fq_[k][0] * rq, fq_[k][1] * rq); o.y = pk_bf16(fq_[k][2] * rq, fq_[k][3] * rq); o.z = pk_bf16(fq_[k][4] * rq, fq_[k][5] * rq); o.w = pk_bf16(fq_[k][6] * rq, fq_[k][7] * rq); *(u32x4*)(raw + 8 * lane) = o; }
                    if (lane < 32) { u32x4 o; o.x = pk_bf16(fk_[k][0] * rk, fk_[k][1] * rk); o.y = pk_bf16(fk_[k][2] * rk, fk_[k][3] * rk); o.z = pk_bf16(fk_[k][4] * rk, fk_[k][5] * rk); o.w = pk_bf16(fk_[k][6] * rk, fk_[k][7] * rk); *(u32x4*)(raw + 384 + 8 * lane) = o; }
                    if (lane < 4) {
                        const u32x2 a = ka[k], c = kc[k];
                        const f32x4 x1 = {bf_lo(a.x), bf_hi(a.x), bf_lo(a.y), bf_hi(a.y)}, x2 = {bf_lo(c.x), bf_hi(c.x), bf_lo(c.y), bf_hi(c.y)};
                        const f32x4 cs = *(const f32x4*)(ropeC + pos * 16 + 4 * lane), sn = *(const f32x4*)(ropeS + pos * 16 + 4 * lane);
                        const f32x4 y1 = x1 * cs - x2 * sn, y2 = x2 * cs + x1 * sn;
                        u32x2 w1, w2; w1.x = pk_bf16(y1[0], y1[1]); w1.y = pk_bf16(y1[2], y1[3]); w2.x = pk_bf16(y2[0], y2[1]); w2.y = pk_bf16(y2[2], y2[3]);
                        bf16_t* kp = Km + (size_t)(r4 + k) * 768 + 64 + 4 * lane;
#pragma unroll
                        for (int h = 0; h < 8; ++h) { *(u32x2*)(kp + 96 * h) = w1; *(u32x2*)(kp + 96 * h + 16) = w2; }
                    } }
            }
        }
        xcd_barrier(bar);
        }
        for (int rep_ = 0; rep_ < REP_GEMM; ++rep_) {
        {
            PHASE_PTRS const bf16_t* W = Wall + (size_t)l * W_LAYER;
            pg8::SchedStatic S{(const char*)RAW, (const char*)(W + W_UQ), NPANEL, 3, F.G, (int)blockIdx.x, (size_t)256 * 768 * 2, (size_t)256 * 384 * 2};
            pg8::EpiQup E{Qm, ropeC, ropeS};
            pg8::gemm_phase<pg8::EpiQup, pg8::SchedStatic, false>(F.lds, 384, 768, 384, S, E);
        }
        {
            PHASE_PTRS const bf16_t* W = Wall + (size_t)l * W_LAYER;
            pg8::SchedStatic S{(const char*)(RAW + 384), (const char*)(W + W_UKV), NPANEL, 4, F.G, (int)blockIdx.x, (size_t)256 * 768 * 2, (size_t)256 * 256 * 2};
            pg8::EpiKV E{Km, Vm};
            pg8::gemm_phase<pg8::EpiKV, pg8::SchedStatic, false>(F.lds, 256, 768, 256, S, E);
        }
        xcd_barrier(bar);
        }
        {
            PHASE_IDS
            PHASE_PTRS
            unsigned* qc = ctl + CW_QCTR + 64 * (l * 2);
            for (int rep_ = 0; rep_ < REP_MLA; ++rep_) { if (rep_) qc = ctl + CW_QCTR + 64 * (8 + l);
            for (;;) {
                if (tid == 0) F.MISC[4] = __hip_atomic_fetch_add(qc, 1u, RLX_AGENT);
                __syncthreads();
                const int id = (int)F.MISC[4];
                __syncthreads();
                if (id >= 17 * 64) break;
                const int j = 16 - id / 64, bh = id % 64, b = bh >> 3, h = bh & 7;
                const int q0 = j == 0 ? 0 : 16 + 256 * (j - 1), nvalid = j == 0 ? 16 : 256;
                attn_unit<96, false>((LAS char*)F.lds, Qm + 96 * h, 768, Km + 96 * h, 768, Vm + 64 * h, 512, Om + 64 * h, 512, nullptr, b, q0, nvalid);
            }
            }
            qc = ctl + CW_QCTR + 64 * (l * 2 + 1);
            for (int rep_ = 0; rep_ < REP_FOX; ++rep_) { if (rep_) qc = ctl + CW_QCTR + 64 * (12 + l);
            for (;;) {
                if (tid == 0) F.MISC[4] = __hip_atomic_fetch_add(qc, 1u, RLX_AGENT);
                __syncthreads();
                const int id = (int)F.MISC[4];
                __syncthreads();
                if (id >= 17 * 64) break;
                const int j = 16 - id / 64, bh = id % 64, b = bh >> 3, h = bh & 7;
                const int q0 = j == 0 ? 0 : 16 + 256 * (j - 1), nvalid = j == 0 ? 16 : 256;
                attn_unit<64, true>((LAS char*)F.lds, Qf + 64 * h, 512, Kf + 64 * h, 512, Vf + 64 * h, 512, Of + 64 * h, 512, CSp + (size_t)bh * CSP, b, q0, nvalid);
            }
            }
        }
        xcd_barrier(bar);
        for (int rep_ = 0; rep_ < REP_GEMM; ++rep_) {
        {
            PHASE_PTRS const bf16_t* W = Wall + (size_t)l * W_LAYER;
            pg8::SchedStatic S{(const char*)HB, (const char*)(W + W_BT2), NPANEL, 8, F.G, (int)blockIdx.x, (size_t)256 * DM * 2, (size_t)256 * DM * 2};
            pg8::EpiA2 E{GATES};
            pg8::gemm_phase<pg8::EpiA2, pg8::SchedStatic, false>(F.lds, 1024, 1024, 1024, S, E);
        }
        xcd_barrier(bar);
        }
        for (int rep_ = 0; rep_ < REP_GEMM; ++rep_) {
        {
            PHASE_PTRS const bf16_t* W = Wall + (size_t)l * W_LAYER;
            pg8::SchedOut S{(const char*)Of, (const char*)Om, (const char*)(W + W_FOXO), (const char*)(W + W_MLAO), NPANEL, 4, F.G, (int)blockIdx.x, (size_t)256 * 512 * 2, (size_t)256 * 512 * 2};
            pg8::EpiOut E{GATES, MERGED};
            pg8::gemm_phase<pg8::EpiOut, pg8::SchedOut, false>(F.lds, 512, 512, 512, S, E);
        }
        xcd_barrier(bar);
        }
        for (int rep_ = 0; rep_ < REP_GEMM; ++rep_) {
        {
            PHASE_PTRS const bf16_t* W = Wall + (size_t)l * W_LAYER;
            pg8::SchedStatic S{(const char*)MERGED, (const char*)(W + W_OUT), NPANEL, 4, F.G, (int)blockIdx.x, (size_t)256 * DM * 2, (size_t)256 * DM * 2};
            pg8::EpiF E{HB, Zb};
            pg8::gemm_phase<pg8::EpiF, pg8::SchedStatic, false>(F.lds, 1024, 1024, 1024, S, E);
        }
        xcd_barrier(bar);
        }
        {
            PHASE_IDS
            PHASE_PTRS
            LAS float* rwT = (LAS float*)F.lds;
            LAS int* lcnt = (LAS int*)(F.lds + 65536);
            LAS int* gbase = lcnt + 16;
            LAS int* tE = lcnt + 64;
            LAS int* tP = tE + 272;
            LAS float* tG = (LAS float*)(tP + 272);
            const float* rw = args.in[15];
            for (int i = tid; i < 16384; i += 512) { const int col = i >> 4, e = i & 15; rwT[e * 1024 + col] = rw[i]; }
            if (tid < 16) lcnt[tid] = 0;
            __syncthreads();
            const int r0 = blockIdx.x * 129, nrows = (r0 + 129 <= T) ? 129 : (T > r0 ? T - r0 : 0);
            const float* rb = args.in[16];
            for (int g4 = wave * 4; g4 < nrows; g4 += 32) {
                f32x4 v[4][4];
#pragma unroll
                for (int k = 0; k < 4; ++k) { const int lr = (g4 + k < nrows) ? g4 + k : nrows - 1; const int row = r0 + lr;
#pragma unroll
                    for (int j = 0; j < 4; ++j) v[k][j] = *(const f32x4*)(Zb + (size_t)row * DM + 4 * lane + 256 * j); }
                ln16xR<4>(v, args.in[13] + l * DM, args.in[14] + l * DM, lane);
#pragma unroll
                for (int k = 0; k < 4; ++k) if (g4 + k < nrows) store_row_bf16(H1 + (size_t)(r0 + g4 + k) * DM, v[k], lane);
                float s[4][16];
#pragma unroll
                for (int e = 0; e < 16; ++e) {
                    f32x4 wv[4];
#pragma unroll
                    for (int j = 0; j < 4; ++j) wv[j] = *(const LAS f32x4*)(rwT + e * 1024 + 4 * lane + 256 * j);
#pragma unroll
                    for (int k = 0; k < 4; ++k) { float a = 0.f;
#pragma unroll
                        for (int j = 0; j < 4; ++j) a += (v[k][j][0] * wv[j][0] + v[k][j][1] * wv[j][1]) + (v[k][j][2] * wv[j][2] + v[k][j][3] * wv[j][3]);
                        s[k][e] = a; }
                }
#pragma unroll
                for (int k = 0; k < 4; ++k) {
#pragma unroll
                    for (int i = 0; i < 8; ++i) { const bool up = (lane & 32) != 0; const float mine = up ? s[k][i + 8] : s[k][i], oth = up ? s[k][i] : s[k][i + 8]; s[k][i] = mine + __shfl_xor(oth, 32); }
#pragma unroll
                    for (int i = 0; i < 4; ++i) { const bool up = (lane & 16) != 0; const float mine = up ? s[k][i + 4] : s[k][i], oth = up ? s[k][i] : s[k][i + 4]; s[k][i] = mine + __shfl_xor(oth, 16); }
#pragma unroll
                    for (int i = 0; i < 2; ++i) { const bool up = (lane & 8) != 0; const float mine = up ? s[k][i + 2] : s[k][i], oth = up ? s[k][i] : s[k][i + 2]; s[k][i] = mine + __shfl_xor(oth, 8); }
                    { const bool up = (lane & 4) != 0; const float mine = up ? s[k][1] : s[k][0], oth = up ? s[k][0] : s[k][1]; s[k][0] = mine + __shfl_xor(oth, 4); }
                    s[k][0] += __shfl_xor(s[k][0], 2); s[k][0] += __shfl_xor(s[k][0], 1);
                }
#pragma unroll
                for (int k = 0; k < 4; ++k) {
                    float lg[16];
#pragma unroll
                    for (int e = 0; e < 16; ++e) lg[e] = __int_as_float(__builtin_amdgcn_readlane(__float_as_int(s[k][0]), 4 * e));
                    float sc[16], bi[16];
#pragma unroll
                    for (int e = 0; e < 16; ++e) { sc[e] = 1.0f / (1.0f + expf(-lg[e])); bi[e] = sc[e] + rb[e]; }
                    int gsel = 0; float gbest = -INFINITY;
#pragma unroll
                    for (int g = 0; g < 4; ++g) { float m1 = bi[4 * g], m2 = -INFINITY;
#pragma unroll
                        for (int kk = 1; kk < 4; ++kk) { const float x = bi[4 * g + kk]; if (x > m1) { m2 = m1; m1 = x; } else if (x > m2) m2 = x; }
                        const float gs = m1 + m2; if (gs > gbest) { gbest = gs; gsel = g; } }
                    float b4[4], s4[4];
#pragma unroll
                    for (int kk = 0; kk < 4; ++kk) { b4[kk] = gsel == 0 ? bi[kk] : gsel == 1 ? bi[4 + kk] : gsel == 2 ? bi[8 + kk] : bi[12 + kk]; s4[kk] = gsel == 0 ? sc[kk] : gsel == 1 ? sc[4 + kk] : gsel == 2 ? sc[8 + kk] : sc[12 + kk]; }
                    int i1 = 0; float bb1 = b4[0], ss1 = s4[0];
#pragma unroll
                    for (int kk = 1; kk < 4; ++kk) if (b4[kk] > bb1) { bb1 = b4[kk]; ss1 = s4[kk]; i1 = kk; }
                    int i2 = -1; float bb2 = -INFINITY, ss2 = 0.f;
#pragma unroll
                    for (int kk = 0; kk < 4; ++kk) if (kk != i1 && b4[kk] > bb2) { bb2 = b4[kk]; ss2 = s4[kk]; i2 = kk; }
                    const float inv = 1.0f / (ss1 + ss2);
                    if (lane == 0 && g4 + k < nrows) {
                        const int lr = g4 + k; const int e0 = gsel * 4 + i1, e1 = gsel * 4 + i2;
                        tE[2 * lr] = e0; tE[2 * lr + 1] = e1;
                        tP[2 * lr] = atomicAdd((int*)&lcnt[e0], 1); tP[2 * lr + 1] = atomicAdd((int*)&lcnt[e1], 1);
                        tG[2 * lr] = ss1 * inv; tG[2 * lr + 1] = ss2 * inv;
                    }
                }
            }
            __syncthreads();
            if (tid < 16) gbase[tid] = (int)__hip_atomic_fetch_add(ctl + CW_ECNT + 64 * (l * 16 + tid), (unsigned)lcnt[tid], RLX_AGENT);
            __syncthreads();
            if (tid < nrows) {
                const int row = r0 + tid; const int e0 = tE[2 * tid], e1 = tE[2 * tid + 1];
                const int p0 = gbase[e0] + tP[2 * tid], p1 = gbase[e1] + tP[2 * tid + 1];
                LIST[(size_t)e0 * TP + p0] = row; LIST[(size_t)e1 * TP + p1] = row;
                u32x4 w0; w0.x = (unsigned)e0; w0.y = (unsigned)p0; w0.z = (unsigned)e1; w0.w = (unsigned)p1;
                *(u32x4*)(TOK + (size_t)row * 8) = w0;
                u32x2 w1; w1.x = __float_as_uint(tG[2 * tid]); w1.y = __float_as_uint(tG[2 * tid + 1]);
                *(u32x2*)(TOK + (size_t)row * 8 + 4) = w1;
            }
        }
        xcd_barrier(bar);
        LAS int* tb = (LAS int*)(F.lds + MISC_OFF) + 16; LAS int* ecnt = (LAS int*)(F.lds + MISC_OFF) + 64;
        if (threadIdx.x == 0) { int acc = 0; for (int e = 0; e < 16; ++e) { const int c = (int)__hip_atomic_load(F.ctl + CW_ECNT + 64 * (l * 16 + e), RLX_AGENT); ecnt[e] = c; tb[e] = acc; acc += (c + 255) >> 8; } tb[16] = acc; }
        __syncthreads();
        for (int rep_ = 0; rep_ < REP_GEMM; ++rep_) {
        {
            PHASE_PTRS const bf16_t* W = Wall + (size_t)l * W_LAYER;
            pg8::SchedMoe S{(const char*)H1, (const char*)(W + W_MOE1), tb, ecnt, LIST, 1, F.G, (int)blockIdx.x, (size_t)512 * 1024 * 2, (size_t)256 * 1024 * 2, 0, true};
            pg8::EpiM1 E{HID};
            pg8::gemm_phase<pg8::EpiM1, pg8::SchedMoe, true>(F.lds, 1024, 1024, 1024, S, E);
        }
        xcd_barrier(bar);
        }
        for (int rep_ = 0; rep_ < REP_GEMM; ++rep_) {
        {
            PHASE_PTRS const bf16_t* W = Wall + (size_t)l * W_LAYER;
            pg8::SchedMoe S{(const char*)HID, (const char*)(W + W_MOE2), tb, ecnt, LIST, 2, F.G, (int)blockIdx.x, (size_t)1024 * 256 * 2, (size_t)256 * 256 * 2, (size_t)256 * 256 * 2, false};
            pg8::EpiM2 E{YS};
            pg8::gemm_phase<pg8::EpiM2, pg8::SchedMoe, false>(F.lds, 256, 256, 256, S, E);
        }
        xcd_barrier(bar);
        }
        {
            PHASE_IDS
            PHASE_PTRS
            for (int rep_ = 0; rep_ < REP_J; ++rep_)
            for (int r4 = gw * 4; r4 < T; r4 += NGW * 4) {
                u32x4 w0[4]; u32x2 w1[4];
#pragma unroll
                for (int k = 0; k < 4; ++k) { w0[k] = *(const u32x4*)(TOK + (size_t)(r4 + k) * 8); w1[k] = *(const u32x2*)(TOK + (size_t)(r4 + k) * 8 + 4); }
                u32x2 hv[4][4], ya[4][4], yc[4][4];
#pragma unroll
                for (int k = 0; k < 4; ++k) {
                    const size_t s0 = (size_t)tb[(int)w0[k].x] * 256 + (int)w0[k].y, s1 = (size_t)tb[(int)w0[k].z] * 256 + (int)w0[k].w;
#pragma unroll
                    for (int j = 0; j < 4; ++j) { hv[k][j] = *(const u32x2*)(H1 + (size_t)(r4 + k) * DM + 4 * lane + 256 * j); ya[k][j] = *(const u32x2*)(YS + s0 * DM + 4 * lane + 256 * j); yc[k][j] = *(const u32x2*)(YS + s1 * DM + 4 * lane + 256 * j); } }
                f32x4 v[4][4];
#pragma unroll
                for (int k = 0; k < 4; ++k) { const float g0 = __uint_as_float(w1[k].x), g1 = __uint_as_float(w1[k].y);
#pragma unroll
                    for (int j = 0; j < 4; ++j) {
                        v[k][j][0] = ALPHA * bf_lo(hv[k][j].x) + g0 * bf_lo(ya[k][j].x) + g1 * bf_lo(yc[k][j].x); v[k][j][1] = ALPHA * bf_hi(hv[k][j].x) + g0 * bf_hi(ya[k][j].x) + g1 * bf_hi(yc[k][j].x);
                        v[k][j][2] = ALPHA * bf_lo(hv[k][j].y) + g0 * bf_lo(ya[k][j].y) + g1 * bf_lo(yc[k][j].y); v[k][j][3] = ALPHA * bf_hi(hv[k][j].y) + g0 * bf_hi(ya[k][j].y) + g1 * bf_hi(yc[k][j].y); } }
                ln16xR<4>(v, args.in[20] + l * DM, args.in[21] + l * DM, lane);
#pragma unroll
                for (int k = 0; k < 4; ++k) { const int row = r4 + k;
                    if (l == 0) store_row_bf16(HB + (size_t)row * DM, v[k], lane);
                    else { const int b = row / LSEQ, p = row % LSEQ;
                        if (p >= NMETA) { float* orow = args.out + ((size_t)b * SEQ + (p - NMETA)) * DM;
#pragma unroll
                            for (int j = 0; j < 4; ++j) *(f32x4*)(orow + 4 * lane + 256 * j) = v[k][j]; } } }
            }
        }
        if (l == 0) xcd_barrier(bar);
    }
}

extern "C" void kernel_launch(void* const* d_in, const int* in_sizes, int n_in, void* d_out, int out_size, void* d_ws, size_t ws_size, hipStream_t stream) {
    static int grid = 0;
    if (grid == 0) {
        if (n_in != 22 || ws_size < WS_END) { fprintf(stderr, "kernel_launch: need 22 inputs and %zu bytes of workspace (got %d, %zu)\n", (size_t)WS_END, n_in, ws_size); grid = -1; return; }
        int dev = 0, cus = 0, per_cu = 0;
        if (hipGetDevice(&dev) != hipSuccess || hipDeviceGetAttribute(&cus, hipDeviceAttributeMultiprocessorCount, dev) != hipSuccess) { grid = -1; return; }
        if (hipFuncSetAttribute((const void*)fwd_kernel, hipFuncAttributeMaxDynamicSharedMemorySize, LDS_BYTES) != hipSuccess) { fprintf(stderr, "kernel_launch: hipFuncSetAttribute failed\n"); grid = -1; return; }
        if (hipOccupancyMaxActiveBlocksPerMultiprocessor(&per_cu, (const void*)fwd_kernel, 512, LDS_BYTES) != hipSuccess || per_cu < 1) { fprintf(stderr, "kernel_launch: occupancy query says %d\n", per_cu); }
        (void)hipGetLastError();
        grid = cus;
    }
    if (grid < 0) return;
    if (hipMemsetAsync((char*)d_ws + WS_CTL, 0, CTL_BYTES, stream) != hipSuccess) return;
    Args a{};
    for (int i = 0; i < 22; ++i) a.in[i] = (const float*)d_in[i];
    a.out = (float*)d_out; a.ws = (unsigned char*)d_ws;
    hipLaunchKernelGGL(fwd_kernel, dim3(grid), dim3(512), LDS_BYTES, stream, a);
}
```

```cpp
#include <hip/hip_runtime.h>
#include <cstdio>
#include <cstdint>

#ifndef REP_GEMM
#define REP_GEMM 1
#endif
#ifndef REP_MLA
#define REP_MLA 1
#endif
#ifndef REP_FOX
#define REP_FOX 1
#endif
#ifndef REP_J
#define REP_J 1
#endif
#ifndef REP_THIN
#define REP_THIN 1
#endif
#define LAS __attribute__((address_space(3)))
typedef unsigned short bf16_t;
typedef short bf16x8 __attribute__((ext_vector_type(8)));
typedef short s16x4 __attribute__((ext_vector_type(4)));
typedef float f32x4 __attribute__((ext_vector_type(4)));
typedef float f32x2_t __attribute__((ext_vector_type(2)));
typedef __bf16 bf16x2_t __attribute__((ext_vector_type(2)));
typedef float f32x16 __attribute__((ext_vector_type(16)));
typedef unsigned u32x4 __attribute__((ext_vector_type(4)));
typedef unsigned u32x2 __attribute__((ext_vector_type(2)));

constexpr int NB = 8, SEQ = 4096, NMETA = 16, LSEQ = 4112, T = NB * LSEQ  , TP = 33024  , DM = 1024;
constexpr int NPANEL = TP / 256;
constexpr int NEXP = 16;
constexpr float ALPHA = 1.41421356237309515f;
constexpr float LOG2E = 1.4426950408889634f;
constexpr float C2F = 0.125f * LOG2E;
constexpr float C2M = 0.14724444602590310f;
constexpr int CSP = 4160;

constexpr size_t MiB = 1ull << 20;
constexpr size_t WS_CTL = 0, CTL_BYTES = 1 * MiB;
constexpr size_t WS_ROPE = 1 * MiB;
constexpr size_t WS_LF = 2 * MiB;
constexpr size_t WS_CS = 4 * MiB;
constexpr size_t WS_TOK = 6 * MiB;
constexpr size_t WS_LIST = 8 * MiB;
constexpr size_t WS_W = 12 * MiB;
constexpr size_t WS_H = 88 * MiB;
constexpr size_t WS_X = 153 * MiB;
constexpr size_t S512 = (size_t)TP * 512 * 2, S768 = (size_t)TP * 768 * 2, S1024 = (size_t)TP * 1024 * 2;
constexpr size_t X_QF = 0, X_KF = S512, X_VF = 2 * S512, X_RAW = 3 * S512, X_QM = 3 * S512 + S768, X_KM = 3 * S512 + 2 * S768,
                 X_VM = 3 * S512 + 3 * S768, X_OM = 4 * S512 + 3 * S768, X_OF = 5 * S512 + 3 * S768, X_END = 6 * S512 + 3 * S768;
constexpr size_t X_GATES = X_KF;
constexpr size_t X_MERGED = X_KM;
constexpr size_t X_Z = X_KF;
constexpr size_t X_H1 = X_KM;
constexpr size_t X_HID = X_QF;
constexpr size_t X_YS = 36 * MiB;
constexpr int NSLOT_TILES = 273, NSLOT = NSLOT_TILES * 256;
constexpr size_t WS_END = WS_X + X_END;
static_assert(X_GATES + (size_t)TP * 2048 * 2 <= X_KM, "gates");
static_assert(X_MERGED + S1024 <= X_OM, "merged");
static_assert(X_HID + (size_t)NSLOT * 256 * 2 <= X_YS, "hid");
static_assert(X_YS + (size_t)NSLOT * 1024 * 2 <= X_KM, "ys");
static_assert(WS_W + 2ull * 19693568ull * 2ull <= WS_H, "weights");
static_assert(WS_H + S1024 <= WS_X, "h");
constexpr size_t W_BT1 = 0, W_BT2 = W_BT1 + 2304ull * 1024, W_FOXO = W_BT2 + 2048ull * 1024, W_MLAO = W_FOXO + 1024ull * 512,
                 W_UQ = W_MLAO + 1024ull * 512, W_UKV = W_UQ + 768ull * 384, W_OUT = W_UKV + 1024ull * 256, W_MOE1 = W_OUT + 1024ull * 1024,
                 W_MOE2 = W_MOE1 + 16ull * 512 * 1024, W_LAYER = W_MOE2 + 16ull * 1024 * 256;
static_assert(W_LAYER == 19693568ull, "weights per layer");
constexpr int CW_BAR = 4096;
constexpr int CW_QCTR = 8192;
constexpr int CW_ECNT = 16384;

constexpr int RING_BYTES = 131072;
constexpr int MISC_OFF = RING_BYTES;
constexpr int LDS_BYTES = 147456;

__device__ __forceinline__ unsigned pk_bf16(float lo, float hi) { f32x2_t v = {lo, hi}; bf16x2_t b = __builtin_convertvector(v, bf16x2_t); return __builtin_bit_cast(unsigned, b); }
__device__ __forceinline__ float bf_lo(unsigned u) { return __uint_as_float(u << 16); }
__device__ __forceinline__ float bf_hi(unsigned u) { return __uint_as_float(u & 0xffff0000u); }
__device__ __forceinline__ float wave_sum(float v) {
#pragma unroll
    for (int o = 1; o < 64; o <<= 1) v += __shfl_xor(v, o);
    return v;
}
#define LDS_WAIT() asm volatile("s_waitcnt lgkmcnt(0)" ::: "memory")
#define RLX_AGENT __ATOMIC_RELAXED, __HIP_MEMORY_SCOPE_AGENT

#define XB_TMO      128
#define XB_XCNT(j)  (256  + 64 * (j))
#define XB_XSUB(j)  (1280 + 64 * (j))
#define XB_XGEN(j)  (2304 + 64 * (j))
#define XB_TOP      3328
#define XB_TOPGEN   3392
#define XCD_BAR_WORDS 3456
#define XB_SPIN_CAP (1u << 20)
__device__ __forceinline__ unsigned xb_ld(unsigned* p)              { return __hip_atomic_load(p, __ATOMIC_RELAXED, __HIP_MEMORY_SCOPE_AGENT); }
__device__ __forceinline__ unsigned xb_add(unsigned* p, unsigned v) { return __hip_atomic_fetch_add(p, v, __ATOMIC_RELAXED, __HIP_MEMORY_SCOPE_AGENT); }
__device__ __forceinline__ unsigned xb_xcc_id() { return (unsigned)__builtin_amdgcn_s_getreg((3 << 11) | 20) & 0xFu; }
#define XB_SPIN(cond, bar) do { unsigned _sp = 0; while (cond) { __builtin_amdgcn_s_sleep(1); \
    if ((++_sp & 255u) == 0u) { if (xb_ld(&(bar)[XB_TMO])) break; if (_sp > XB_SPIN_CAP) { atomicAdd(&(bar)[XB_TMO], 1u); break; } } } } while (0)
struct XcdBarrier { unsigned* bar; unsigned x; volatile LAS unsigned* st; };
__device__ __forceinline__ XcdBarrier xcd_barrier_post(unsigned* bar, volatile LAS unsigned* st) {
    XcdBarrier b; b.bar = bar; b.x = xb_xcc_id(); b.st = st;
    if (threadIdx.x == 0) (void)xb_add(&bar[XB_XCNT(b.x)], 1u);
    return b;
}
__device__ __forceinline__ void xcd_barrier_complete(unsigned* bar, unsigned x, unsigned& nloc, unsigned& nx) {
    const unsigned G = gridDim.x * gridDim.y * gridDim.z;
    unsigned sum, cnt, mine, sp = 0u;
    for (;;) {
        sum = 0u; cnt = 0u; mine = 0u;
#pragma unroll
        for (unsigned j = 0; j < 16; ++j) { const unsigned c = xb_ld(&bar[XB_XCNT(j)]); sum += c; cnt += (c > 0u) ? 1u : 0u; mine = (j == x) ? c : mine; }
        if (sum == G) break;
        __builtin_amdgcn_s_sleep(1);
        if ((++sp & 255u) == 0u) { if (xb_ld(&bar[XB_TMO])) break; if (sp > XB_SPIN_CAP) { atomicAdd(&bar[XB_TMO], 1u); break; } }
    }
    nloc = mine > 0u ? mine : 1u; nx = cnt > 0u ? cnt : 1u;
}
__device__ __forceinline__ void xcd_barrier(const XcdBarrier& b) {
    asm volatile("s_waitcnt vmcnt(0)" ::: "memory");
    __syncthreads();
    if (threadIdx.x == 0) {
        unsigned* bar = b.bar; unsigned bx = b.x; asm volatile("" : "+s"(bar), "+s"(bx));
        __builtin_amdgcn_s_waitcnt(0);
        unsigned nloc = b.st[0], nx = b.st[1];
        if (nloc == 0u) { xcd_barrier_complete(bar, bx, nloc, nx); b.st[0] = nloc; b.st[1] = nx; }
        const unsigned old = xb_add(&bar[XB_XSUB(bx)], 1u);
        const unsigned gen = old / nloc;
        if (old + 1u == (gen + 1u) * nloc) {
            __builtin_amdgcn_fence(__ATOMIC_RELEASE, "agent");
            asm volatile("s_waitcnt vmcnt(0)" ::: "memory");
            const unsigned og = xb_add(&bar[XB_TOP], 1u);
            const unsigned tg = og / nx;
            if (og + 1u == (tg + 1u) * nx) xb_add(&bar[XB_TOPGEN], 1u);
            else XB_SPIN(xb_ld(&bar[XB_TOPGEN]) == tg, bar);
            __builtin_amdgcn_fence(__ATOMIC_ACQUIRE, "agent");
            xb_add(&bar[XB_XGEN(bx)], 1u);
            asm volatile("s_waitcnt vmcnt(0)" ::: "memory");
        } else {
            XB_SPIN(xb_ld(&bar[XB_XGEN(bx)]) == gen, bar);
            __builtin_amdgcn_fence(__ATOMIC_ACQUIRE, "agent");
            asm volatile("s_waitcnt vmcnt(0)" ::: "memory");
        }
    }
    __syncthreads();
}

namespace pg8 {
constexpr int BM = 256, BK = 64, HALF = 128, HTB = HALF * BK * 2, STAGE_BYTES = 8 * HTB;
__device__ __forceinline__ int lds_byte(int r, int c) { const int st = (r >> 4) * 2 + (c >> 5), rr = r & 15, cc = c & 31, ob = rr * 64 + cc * 2; return st * 1024 + (ob ^ (((ob >> 9) & 1) << 5)); }
__device__ __forceinline__ void stage_rc(int b, int& R, int& C) { const int st = b / 1024, sb = b % 1024, swz = sb ^ (((sb >> 9) & 1) << 5); R = (st >> 1) * 16 + swz / 64; C = (st & 1) * 32 + (swz % 64) / 2; }
__device__ __forceinline__ int perm32(int rho) { const int n = rho >> 4, i = rho & 15; return 8 * (i >> 2) + 4 * n + (i & 3); }
struct Unit { const char* A; const char* B; int pm, pn, aux; };
typedef f32x4 Acc[2][2][4][2];

__device__ __forceinline__ void tile_of(int L, int nM, int nN, int& pm, int& pn) {
    const int nwg = nM * nN; int wgid = L;
    { const int q = nwg / 8, r = nwg % 8, xcd = wgid % 8, off = wgid / 8; wgid = (xcd < r ? xcd * (q + 1) : r * (q + 1) + (xcd - r) * q) + off; }
    const int nig = 8 * nN, gid = wgid / nig, fm = gid * 8, gsz = (nM - fm) < 8 ? (nM - fm) : 8;
    pm = fm + ((wgid % nig) % gsz); pn = (wgid % nig) / gsz;
}

template <class Epi, class Sched, bool GATHER>
__device__ __forceinline__ void gemm_phase(LAS unsigned char* lds, const int K, const int lda, const int ldb, const Sched& S, const Epi& E) {
    int tid_l = threadIdx.x; asm volatile("" : "+v"(tid_l));
    const int tid = tid_l, wid = __builtin_amdgcn_readfirstlane(tid >> 6), lane = tid & 63, wr = wid >> 2, wc = wid & 3, fr = lane & 15, fq = lane >> 4;
    int nt = K / BK; asm volatile("" : "+s"(nt));
    unsigned voA[2][2], voB[2]; int Rr[2], Cc[2];
#pragma unroll
    for (int i = 0; i < 2; ++i) { int R, C; stage_rc(tid * 16 + i * 8192, R, C); const int Rb = Epi::PERM ? ((R & ~31) + perm32(R & 31)) : R;
        Rr[i] = R; Cc[i] = C; voA[0][i] = (unsigned)(R * lda + C) * 2u; voA[1][i] = (unsigned)((R + HALF) * lda + C) * 2u; voB[i] = (unsigned)(Rb * ldb + C) * 2u; }
    const size_t kstep = (size_t)(BK * 2);
    const size_t hstepB = (size_t)HALF * ldb * 2;
    const unsigned ldsw = (unsigned)wid * 1024u;
    const int aoff = lds_byte(wr * 64 + fr, fq * 8), boff = lds_byte(wc * 32 + fr, fq * 8);
#define PG8_SA(b, h) (((b) * 2 + (h)) * HTB)
#define PG8_SB(b, h) ((4 + (b) * 2 + (h)) * HTB)
#define PG8_STAGE2(bufoff, gbase, o0, o1) do { \
        __builtin_amdgcn_global_load_lds((const unsigned*)((const char*)(gbase) + (o0)), (LAS unsigned*)(lds + (bufoff) + ldsw), 16, 0, 0); \
        __builtin_amdgcn_global_load_lds((const unsigned*)((const char*)(gbase) + (o1)), (LAS unsigned*)(lds + (bufoff) + ldsw + 8192), 16, 0, 0); } while (0)
#define PG8_STA(b, h, gbase, VO) PG8_STAGE2(PG8_SA(b, h), gbase, (VO)[h][0], (VO)[h][1])
#define PG8_STB(b, h, gbase) PG8_STAGE2(PG8_SB(b, h), (gbase) + (h) * hstepB, voB[0], voB[1])
#define PG8_LDA(dst, b, h) do { _Pragma("unroll") for (int m = 0; m < 4; ++m) _Pragma("unroll") for (int k = 0; k < 2; ++k) dst[m][k] = *(const LAS bf16x8*)(lds + PG8_SA(b, h) + aoff + m * 2048 + k * 1024); } while (0)
#define PG8_LDB(dst, b, h) do { _Pragma("unroll") for (int n = 0; n < 2; ++n) _Pragma("unroll") for (int k = 0; k < 2; ++k) dst[n][k] = *(const LAS bf16x8*)(lds + PG8_SB(b, h) + boff + n * 2048 + k * 1024); } while (0)
#define PG8_MMA(ai, bj, At, Bt) do { __builtin_amdgcn_s_setprio(1); _Pragma("unroll") for (int m = 0; m < 4; ++m) _Pragma("unroll") for (int n = 0; n < 2; ++n) _Pragma("unroll") for (int k = 0; k < 2; ++k) \
        acc[ai][bj][m][n] = __builtin_amdgcn_mfma_f32_16x16x32_bf16(Bt[n][k], At[m][k], acc[ai][bj][m][n], 0, 0, 0); __builtin_amdgcn_s_setprio(0); } while (0)
#define PG8_WAIT_V(n) asm volatile("s_waitcnt vmcnt(" #n ")" ::: "memory")
#define PG8_WAIT_L(n) asm volatile("s_waitcnt lgkmcnt(" #n ")" ::: "memory")
#define PG8_BAR __builtin_amdgcn_s_barrier()
#define PG8_SCHED __builtin_amdgcn_sched_barrier(0)
    Unit cur, nxt; int ui = 0;
    if (!S.next(0, cur)) return;
    Acc acc;
#pragma unroll
    for (int a = 0; a < 2; ++a)
#pragma unroll
        for (int b = 0; b < 2; ++b)
#pragma unroll
            for (int m = 0; m < 4; ++m)
#pragma unroll
                for (int n = 0; n < 2; ++n) acc[a][b][m][n] = (f32x4){0.f, 0.f, 0.f, 0.f};
    bf16x8 At[4][2], B0[2][2], B1[2][2];
    const char* cA = cur.A; const char* cB = cur.B;
    if constexpr (GATHER) {
#pragma unroll
        for (int h = 0; h < 2; ++h)
#pragma unroll
            for (int i = 0; i < 2; ++i) voA[h][i] = S.row_off(cur, Rr[i] + h * HALF) + (unsigned)Cc[i] * 2u;
    }
    PG8_STB(0, 0, cB); PG8_STB(0, 1, cB); PG8_STA(0, 0, cA, voA); PG8_STA(0, 1, cA, voA);
    if (wr == 1) PG8_BAR;
    PG8_WAIT_V(2); PG8_BAR;
    PG8_STB(1, 0, cB + kstep); PG8_STA(1, 0, cA + kstep, voA); PG8_STB(1, 1, cB + kstep);
    PG8_WAIT_V(6); PG8_BAR;
    for (;;) {
        const bool has_next = S.next(ui + 1, nxt);
        const char* nA = has_next ? nxt.A : cA; const char* nB = has_next ? nxt.B : cB;
        unsigned vnA[2][2];
        if constexpr (GATHER) {
#pragma unroll
            for (int h = 0; h < 2; ++h)
#pragma unroll
                for (int i = 0; i < 2; ++i) vnA[h][i] = has_next ? (S.row_off(nxt, Rr[i] + h * HALF) + (unsigned)Cc[i] * 2u) : voA[h][i];
        }
        for (int t = 0; t < nt; t += 2) {
            const bool last = (t == nt - 2);
            const char* a1 = cA + (size_t)(t + 1) * kstep;
            const char* a2 = last ? nA : cA + (size_t)(t + 2) * kstep; const char* b2 = last ? nB : cB + (size_t)(t + 2) * kstep;
            const char* a3 = a2 + kstep; const char* b3 = b2 + kstep;
            unsigned vs[2][2];
#pragma unroll
            for (int h = 0; h < 2; ++h)
#pragma unroll
                for (int i = 0; i < 2; ++i) { if constexpr (GATHER) vs[h][i] = last ? vnA[h][i] : voA[h][i]; else vs[h][i] = voA[h][i]; }
            PG8_LDB(B0, 0, 0); PG8_LDB(B1, 0, 1); PG8_SCHED; PG8_LDA(At, 0, 0); PG8_STA(1, 1, a1, voA);
            PG8_WAIT_V(8); PG8_WAIT_L(0); PG8_BAR; PG8_MMA(0, 0, At, B0); PG8_MMA(0, 1, At, B1); PG8_BAR; PG8_SCHED;
            PG8_LDA(At, 0, 1); PG8_STB(0, 0, b2); PG8_STB(0, 1, b2); PG8_STA(0, 0, a2, vs);
            PG8_WAIT_V(8); PG8_WAIT_L(0); PG8_BAR; PG8_MMA(1, 0, At, B0); PG8_MMA(1, 1, At, B1); PG8_BAR; PG8_SCHED;
            PG8_LDB(B0, 1, 0); PG8_LDB(B1, 1, 1); PG8_SCHED; PG8_LDA(At, 1, 0); PG8_STA(0, 1, a2, vs);
            PG8_WAIT_V(8); PG8_WAIT_L(0); PG8_BAR; PG8_MMA(0, 0, At, B0); PG8_MMA(0, 1, At, B1); PG8_BAR; PG8_SCHED;
            PG8_LDA(At, 1, 1); PG8_STB(1, 0, b3); PG8_STB(1, 1, b3); PG8_STA(1, 0, a3, vs);
            PG8_WAIT_V(8); PG8_WAIT_L(0); PG8_BAR; PG8_MMA(1, 0, At, B0); PG8_MMA(1, 1, At, B1); PG8_BAR; PG8_SCHED;
        }
        if (wr == 0) PG8_BAR;
        E(acc, cur, wr, wc, fr, fq);
        if (!has_next) break;
#pragma unroll
        for (int a = 0; a < 2; ++a)
#pragma unroll
            for (int b = 0; b < 2; ++b)
#pragma unroll
                for (int m = 0; m < 4; ++m)
#pragma unroll
                    for (int n = 0; n < 2; ++n) acc[a][b][m][n] = (f32x4){0.f, 0.f, 0.f, 0.f};
        cur = nxt; cA = nA; cB = nB; ++ui;
        if constexpr (GATHER) {
#pragma unroll
            for (int h = 0; h < 2; ++h)
#pragma unroll
                for (int i = 0; i < 2; ++i) voA[h][i] = vnA[h][i];
        }
        if (wr == 1) PG8_BAR;
    }
    PG8_WAIT_V(0);
    PG8_BAR;
#undef PG8_SA
#undef PG8_SB
#undef PG8_STAGE2
#undef PG8_STA
#undef PG8_STB
#undef PG8_LDA
#undef PG8_LDB
#undef PG8_MMA
#undef PG8_WAIT_V
#undef PG8_WAIT_L
#undef PG8_BAR
#undef PG8_SCHED
}

struct SchedStatic {
    const char* A; const char* B; int nM, nN, G, c; size_t astep, bstep;
    __device__ __forceinline__ bool next(int i, Unit& u) const {
        const long L = (long)i * G + c; if (L >= (long)nM * nN) return false;
        int pm, pn; tile_of((int)L, nM, nN, pm, pn);
        u.pm = pm; u.pn = pn; u.aux = 0; u.A = A + (size_t)pm * astep; u.B = B + (size_t)pn * bstep; return true;
    }
    __device__ __forceinline__ unsigned row_off(const Unit&, int) const { return 0u; }
};
struct SchedOut {
    const char* A0; const char* A1; const char* B0; const char* B1; int nM, nN, G, c; size_t astep, bstep;
    __device__ __forceinline__ bool next(int i, Unit& u) const {
        const long L = (long)(i >> 1) * G + c; if (L >= (long)nM * nN) return false;
        int pm, pn; tile_of((int)L, nM, nN, pm, pn);
        const int pass = i & 1;
        u.pm = pm; u.pn = pn; u.aux = pass; u.A = (pass ? A1 : A0) + (size_t)pm * astep; u.B = (pass ? B1 : B0) + (size_t)pn * bstep; return true;
    }
    __device__ __forceinline__ unsigned row_off(const Unit&, int) const { return 0u; }
};
struct SchedMoe {
    const char* A; const char* B; const LAS int* tb; const LAS int* cnt; const int* list; int npn_shift, G, c; size_t bstep_e, bstep_n, astep; bool gather;
    __device__ __forceinline__ bool next(int i, Unit& u) const {
        const int L = i * G + c; const int ntile = tb[16];
        if (L >= (ntile << npn_shift)) return false;
        const int ti = L >> npn_shift, pn = L & ((1 << npn_shift) - 1);
        int e = 0; while (ti >= tb[e + 1]) ++e;
        u.pm = ti; u.pn = pn; u.aux = e;
        u.A = gather ? A : A + (size_t)ti * astep;
        u.B = B + (size_t)e * bstep_e + (size_t)pn * bstep_n; return true;
    }
    __device__ __forceinline__ unsigned row_off(const Unit& u, int r) const {
        const int e = u.aux; int idx = (u.pm - tb[e]) * 256 + r; const int ce = cnt[e]; idx = idx < ce ? idx : ce - 1;
        const int tok = list[(size_t)e * TP + idx];
        return (unsigned)tok * (unsigned)(DM * 2);
    }
};

__device__ __forceinline__ u32x4 pack8(f32x4 v0, f32x4 v1) { u32x4 w; w.x = pk_bf16(v0[0], v0[1]); w.y = pk_bf16(v0[2], v0[3]); w.z = pk_bf16(v1[0], v1[1]); w.w = pk_bf16(v1[2], v1[3]); return w; }
__device__ __forceinline__ float logsig(float x) { return fminf(x, 0.f) - log1pf(__expf(-fabsf(x))); }
__device__ __forceinline__ float sigm(float x) { return 1.0f / (1.0f + __expf(-x)); }

struct EpiA1 {
    static constexpr bool PERM = true;
    bf16_t *Qf, *Kf, *Vf, *RAW; float* LF; const float* fbias;
    __device__ __forceinline__ void operator()(const Acc& acc, const Unit& u, int wr, int wc, int fr, int fq) const {
        const int pn = u.pn; bf16_t* base; int ldc, colt; float sc = 1.f;
        if (pn < 2) { base = Qf; ldc = 512; colt = pn * 256; sc = C2F; } else if (pn < 4) { base = Kf; ldc = 512; colt = (pn - 2) * 256; }
        else if (pn < 6) { base = Vf; ldc = 512; colt = (pn - 4) * 256; } else { base = RAW; ldc = 768; colt = (pn - 6) * 256; }
        const int row0 = u.pm * 256 + wr * 64 + fr, col0 = colt + wc * 32 + 8 * fq;
#pragma unroll
        for (int ai = 0; ai < 2; ++ai)
#pragma unroll
            for (int m = 0; m < 4; ++m) { bf16_t* rowp = base + (size_t)(row0 + ai * 128 + m * 16) * ldc + col0;
#pragma unroll
                for (int bj = 0; bj < 2; ++bj) *(u32x4*)(rowp + bj * 128) = pack8(acc[ai][bj][m][0] * sc, acc[ai][bj][m][1] * sc); }
        if (pn == 8 && wc == 1 && fq == 0) {
            const f32x4 b0 = *(const f32x4*)fbias, b1 = *(const f32x4*)(fbias + 4);
#pragma unroll
            for (int ai = 0; ai < 2; ++ai)
#pragma unroll
                for (int m = 0; m < 4; ++m) { const int row = row0 + ai * 128 + m * 16; const f32x4 a = acc[ai][1][m][0] + b0, b = acc[ai][1][m][1] + b1;
                    f32x4 o0, o1;
#pragma unroll
                    for (int j = 0; j < 4; ++j) { o0[j] = logsig(a[j]); o1[j] = logsig(b[j]); }
                    *(f32x4*)(LF + (size_t)row * 8) = o0; *(f32x4*)(LF + (size_t)row * 8 + 4) = o1; }
        }
    }
};
struct EpiA2 {
    static constexpr bool PERM = true;
    bf16_t* G;
    __device__ __forceinline__ void operator()(const Acc& acc, const Unit& u, int wr, int wc, int fr, int fq) const {
        const int row0 = u.pm * 256 + wr * 64 + fr, col0 = u.pn * 256 + wc * 32 + 8 * fq;
#pragma unroll
        for (int ai = 0; ai < 2; ++ai)
#pragma unroll
            for (int m = 0; m < 4; ++m) { bf16_t* rowp = G + (size_t)(row0 + ai * 128 + m * 16) * 2048 + col0;
#pragma unroll
                for (int bj = 0; bj < 2; ++bj) { f32x4 a = acc[ai][bj][m][0], b = acc[ai][bj][m][1];
#pragma unroll
                    for (int j = 0; j < 4; ++j) { a[j] = sigm(a[j]); b[j] = sigm(b[j]); }
                    *(u32x4*)(rowp + bj * 128) = pack8(a, b); } }
    }
};
struct EpiQup {
    static constexpr bool PERM = false;
    bf16_t* Qm; const float* cosT; const float* sinT;
    __device__ __forceinline__ void operator()(const Acc& acc, const Unit& u, int wr, int wc, int fr, int fq) const {
        const int row0 = u.pm * 256 + wr * 64 + fr;
#pragma unroll
        for (int ai = 0; ai < 2; ++ai)
#pragma unroll
            for (int m = 0; m < 4; ++m) { const int row = row0 + ai * 128 + m * 16; const int pos = row % LSEQ;
#pragma unroll
                for (int bj = 0; bj < 2; ++bj) { const int Gi = u.pn * 8 + bj * 4 + wc; f32x4 x0 = acc[ai][bj][m][0], x1 = acc[ai][bj][m][1];
                    if (Gi % 3 == 2) { const f32x4 cs = *(const f32x4*)(cosT + pos * 16 + 4 * fq), sn = *(const f32x4*)(sinT + pos * 16 + 4 * fq);
                        const f32x4 y0 = x0 * cs - x1 * sn, y1 = x1 * cs + x0 * sn; x0 = y0; x1 = y1; }
                    x0 = x0 * C2M; x1 = x1 * C2M;
                    bf16_t* p = Qm + (size_t)row * 768 + Gi * 32 + 4 * fq;
                    u32x2 w0, w1; w0.x = pk_bf16(x0[0], x0[1]); w0.y = pk_bf16(x0[2], x0[3]); w1.x = pk_bf16(x1[0], x1[1]); w1.y = pk_bf16(x1[2], x1[3]);
                    *(u32x2*)p = w0; *(u32x2*)(p + 16) = w1; } }
    }
};
struct EpiKV {
    static constexpr bool PERM = true;
    bf16_t *Km, *Vm;
    __device__ __forceinline__ void operator()(const Acc& acc, const Unit& u, int wr, int wc, int fr, int fq) const {
        const int row0 = u.pm * 256 + wr * 64 + fr;
#pragma unroll
        for (int ai = 0; ai < 2; ++ai)
#pragma unroll
            for (int m = 0; m < 4; ++m) { const int row = row0 + ai * 128 + m * 16;
#pragma unroll
                for (int bj = 0; bj < 2; ++bj) { const int n = u.pn * 256 + bj * 128 + wc * 32 + 8 * fq; const u32x4 w = pack8(acc[ai][bj][m][0], acc[ai][bj][m][1]);
                    if (u.pn < 2) *(u32x4*)(Km + (size_t)row * 768 + 96 * (n >> 6) + (n & 63)) = w;
                    else *(u32x4*)(Vm + (size_t)row * 512 + (n - 512)) = w; } }
    }
};
struct EpiOut {
    static constexpr bool PERM = true;
    const bf16_t* G; bf16_t* Mg;
    __device__ __forceinline__ void operator()(const Acc& acc, const Unit& u, int wr, int wc, int fr, int fq) const {
        const int row0 = u.pm * 256 + wr * 64 + fr, col0 = u.pn * 256 + wc * 32 + 8 * fq; const int pass = u.aux;
#pragma unroll
        for (int ai = 0; ai < 2; ++ai)
#pragma unroll
            for (int m = 0; m < 4; ++m) { const int row = row0 + ai * 128 + m * 16;
#pragma unroll
                for (int bj = 0; bj < 2; ++bj) { const int col = col0 + bj * 128;
                    const u32x4 g = *(const u32x4*)(G + (size_t)row * 2048 + pass * 1024 + col);
                    f32x4 a = acc[ai][bj][m][0], b = acc[ai][bj][m][1];
                    a[0] *= bf_lo(g.x); a[1] *= bf_hi(g.x); a[2] *= bf_lo(g.y); a[3] *= bf_hi(g.y); b[0] *= bf_lo(g.z); b[1] *= bf_hi(g.z); b[2] *= bf_lo(g.w); b[3] *= bf_hi(g.w);
                    bf16_t* mp = Mg + (size_t)row * 1024 + col;
                    if (pass) { const u32x4 p = *(const u32x4*)mp;
                        a[0] += bf_lo(p.x); a[1] += bf_hi(p.x); a[2] += bf_lo(p.y); a[3] += bf_hi(p.y); b[0] += bf_lo(p.z); b[1] += bf_hi(p.z); b[2] += bf_lo(p.w); b[3] += bf_hi(p.w); }
                    *(u32x4*)mp = pack8(a, b); } }
    }
};
struct EpiF {
    static constexpr bool PERM = false;
    const bf16_t* H; float* Z;
    __device__ __forceinline__ void operator()(const Acc& acc, const Unit& u, int wr, int wc, int fr, int fq) const {
        const int row0 = u.pm * 256 + wr * 64 + fr, col0 = u.pn * 256 + wc * 32 + 4 * fq;
#pragma unroll
        for (int ai = 0; ai < 2; ++ai)
#pragma unroll
            for (int m = 0; m < 4; ++m) { const size_t off = (size_t)(row0 + ai * 128 + m * 16) * 1024 + col0;
#pragma unroll
                for (int bj = 0; bj < 2; ++bj)
#pragma unroll
                    for (int n = 0; n < 2; ++n) { const u32x2 hv = *(const u32x2*)(H + off + bj * 128 + n * 16); f32x4 o = acc[ai][bj][m][n];
                        o[0] += ALPHA * bf_lo(hv.x); o[1] += ALPHA * bf_hi(hv.x); o[2] += ALPHA * bf_lo(hv.y); o[3] += ALPHA * bf_hi(hv.y);
                        *(f32x4*)(Z + off + bj * 128 + n * 16) = o; } }
    }
};
struct EpiM1 {
    static constexpr bool PERM = false;
    bf16_t* Hid;
    __device__ __forceinline__ void operator()(const Acc& acc, const Unit& u, int wr, int wc, int fr, int fq) const {
        const int row0 = u.pm * 256 + wr * 64 + fr, hc0 = u.pn * 128 + wc * 16 + 4 * fq;
#pragma unroll
        for (int ai = 0; ai < 2; ++ai)
#pragma unroll
            for (int m = 0; m < 4; ++m) { bf16_t* rowp = Hid + (size_t)(row0 + ai * 128 + m * 16) * 256 + hc0;
#pragma unroll
                for (int bj = 0; bj < 2; ++bj) { const f32x4 g = acc[ai][bj][m][0], up = acc[ai][bj][m][1]; f32x4 o;
#pragma unroll
                    for (int j = 0; j < 4; ++j) o[j] = g[j] * sigm(g[j]) * up[j];
                    u32x2 w; w.x = pk_bf16(o[0], o[1]); w.y = pk_bf16(o[2], o[3]); *(u32x2*)(rowp + bj * 64) = w; } }
    }
};
struct EpiM2 {
    static constexpr bool PERM = true;
    bf16_t* Ys;
    __device__ __forceinline__ void operator()(const Acc& acc, const Unit& u, int wr, int wc, int fr, int fq) const {
        const int row0 = u.pm * 256 + wr * 64 + fr, col0 = u.pn * 256 + wc * 32 + 8 * fq;
#pragma unroll
        for (int ai = 0; ai < 2; ++ai)
#pragma unroll
            for (int m = 0; m < 4; ++m) { bf16_t* rowp = Ys + (size_t)(row0 + ai * 128 + m * 16) * 1024 + col0;
#pragma unroll
                for (int bj = 0; bj < 2; ++bj) *(u32x4*)(rowp + bj * 128) = pack8(acc[ai][bj][m][0], acc[ai][bj][m][1]); }
    }
};
}

__device__ __forceinline__ int crow(int r, int hi) { return (r & 3) + 8 * (r >> 2) + 4 * hi; }
typedef short v4i16_t __attribute__((ext_vector_type(4)));
__device__ __forceinline__ s16x4 vtr(const LAS char* p) { return __builtin_bit_cast(s16x4, __builtin_amdgcn_ds_read_tr16_b64_v4i16((LAS v4i16_t*)p)); }
__device__ __forceinline__ float swapmax(float m) { auto rr = __builtin_amdgcn_permlane32_swap(__float_as_uint(m), __float_as_uint(m), false, false); return fmaxf(__uint_as_float(rr[0]), __uint_as_float(rr[1])); }
__device__ __forceinline__ float swapsum(float m) { auto rr = __builtin_amdgcn_permlane32_swap(__float_as_uint(m), __float_as_uint(m), false, false); return __uint_as_float(rr[0]) + __uint_as_float(rr[1]); }

template <int DK, bool FOX>
__device__ __forceinline__ void attn_unit(LAS char* lds, const bf16_t* Q, int ldq, const bf16_t* Kp, int ldk, const bf16_t* Vp, int ldv, bf16_t* O, int ldo,
                                          const float* cs, int b, int q0, int nvalid) {
    constexpr int NS = DK / 16, KB = 64 * DK * 2, BUF = KB + 8192 + 256;
    int tid_l = threadIdx.x; asm volatile("" : "+v"(tid_l));
    const int tid = tid_l, lane = tid & 63, r32 = lane & 31, hi = lane >> 5; const int wid = __builtin_amdgcn_readfirstlane(tid >> 6);
    const size_t rowbase = (size_t)b * LSEQ;
    const int qpos = q0 + 32 * wid + r32;
    const bool wave_on = (32 * wid) < nvalid;
    bf16x8 qf[NS];
#pragma unroll
    for (int s = 0; s < NS; ++s) qf[s] = *(const bf16x8*)(Q + (rowbase + qpos) * ldq + 16 * s + 8 * hi);
    float csq = 0.f; if (FOX) csq = cs[qpos];
    const int NT = (q0 + nvalid + 63) >> 6;
    const int skv = tid >> 3, sch = tid & 7;
    const bf16_t* kg = Kp + (rowbase + skv) * ldk + 8 * sch;
    const bf16_t* vg = Vp + (rowbase + skv) * ldv + 8 * sch;
    const int kdst = sch * 1024 + ((skv ^ sch) << 4);
    const int vdst = KB + ((sch >> 2) * 8 + (skv >> 3)) * 512 + (skv & 7) * 64 + (sch & 3) * 16;
    const int skv2 = tid >> 2, sch2 = 8 + (tid & 3);
    const bf16_t* kg2 = Kp + (rowbase + (skv2 & 63)) * ldk + 8 * sch2;
    const int kdst2 = sch2 * 1024 + (((skv2 & 63) ^ (sch2 & 7)) << 4);
    u32x4 kr0, kr1 = {0u, 0u, 0u, 0u}, vr0; f32x4 cr = {0.f, 0.f, 0.f, 0.f};
#define ATT_LOAD(t) do { kr0 = *(const u32x4*)(kg + (size_t)(t) * 64 * ldk); vr0 = *(const u32x4*)(vg + (size_t)(t) * 64 * ldv); \
        if (DK == 96 && tid < 256) kr1 = *(const u32x4*)(kg2 + (size_t)(t) * 64 * ldk); \
        if (FOX && tid < 16) cr = *(const f32x4*)(cs + (t) * 64 + 4 * tid); } while (0)
#define ATT_STORE(bufp) do { *(LAS u32x4*)((bufp) + kdst) = kr0; *(LAS u32x4*)((bufp) + vdst) = vr0; \
        if (DK == 96 && tid < 256) *(LAS u32x4*)((bufp) + kdst2) = kr1; \
        if (FOX && tid < 16) *(LAS f32x4*)((bufp) + KB + 8192 + 16 * tid) = cr; } while (0)
    ATT_LOAD(0);
    ATT_STORE(lds);
    __syncthreads();
    float mrun = -INFINITY, lrun = 0.f;
    f32x16 o0 = {}, o1 = {};
    const int vlane = ((lane >> 4) & 1) * 32 + (lane & 3) * 8 + (4 * hi + ((lane & 15) >> 2)) * 64;
    for (int t = 0; t < NT; ++t) {
        LAS char* cb = lds + (t & 1) * BUF; LAS char* nb = lds + ((t + 1) & 1) * BUF;
        const bool more = (t + 1 < NT);
        if (more) ATT_LOAD(t + 1);
        const bool active = wave_on && (64 * t <= q0 + 32 * wid + 31);
        if (active) {
            f32x16 p0 = {}, p1 = {};
#pragma unroll
            for (int s = 0; s < NS; ++s) {
                const int c = 2 * s + hi;
                const bf16x8 a0 = *(const LAS bf16x8*)(cb + c * 1024 + ((r32 ^ (c & 7)) << 4));
                const bf16x8 a1 = *(const LAS bf16x8*)(cb + c * 1024 + (((r32 + 32) ^ (c & 7)) << 4));
                p0 = __builtin_amdgcn_mfma_f32_32x32x16_bf16(a0, qf[s], p0, 0, 0, 0);
                p1 = __builtin_amdgcn_mfma_f32_32x32x16_bf16(a1, qf[s], p1, 0, 0, 0);
            }
            if (FOX) {
                const LAS float* cl = (const LAS float*)(cb + KB + 8192);
#pragma unroll
                for (int g = 0; g < 4; ++g) { const f32x4 c0 = *(const LAS f32x4*)(cl + 8 * g + 4 * hi), c1 = *(const LAS f32x4*)(cl + 32 + 8 * g + 4 * hi);
#pragma unroll
                    for (int j = 0; j < 4; ++j) { p0[4 * g + j] += csq - c0[j]; p1[4 * g + j] += csq - c1[j]; } }
            }
            if (64 * t + 63 > q0 + 32 * wid) {
                const int kb = 64 * t + 4 * hi;
#pragma unroll
                for (int r = 0; r < 16; ++r) { const int kv = kb + (r & 3) + 8 * (r >> 2); if (kv > qpos) p0[r] = -INFINITY; if (kv + 32 > qpos) p1[r] = -INFINITY; }
            }
            float mt = fmaxf(p0[0], p1[0]);
#pragma unroll
            for (int r = 1; r < 16; ++r) mt = fmaxf(mt, fmaxf(p0[r], p1[r]));
            mt = swapmax(mt);
            const float mnew = fmaxf(mrun, mt);
            const float alpha = __builtin_amdgcn_exp2f(mrun - mnew);
            mrun = mnew;
            float ls = 0.f;
#pragma unroll
            for (int r = 0; r < 16; ++r) { p0[r] = __builtin_amdgcn_exp2f(p0[r] - mnew); p1[r] = __builtin_amdgcn_exp2f(p1[r] - mnew); ls += p0[r] + p1[r]; }
            lrun = lrun * alpha + ls;
#pragma unroll
            for (int r = 0; r < 16; ++r) { o0[r] *= alpha; o1[r] *= alpha; }
            bf16x8 pb[4];
#pragma unroll
            for (int s = 0; s < 2; ++s) {
                u32x4 w; w.x = pk_bf16(p0[8 * s], p0[8 * s + 1]); w.y = pk_bf16(p0[8 * s + 2], p0[8 * s + 3]); w.z = pk_bf16(p0[8 * s + 4], p0[8 * s + 5]); w.w = pk_bf16(p0[8 * s + 6], p0[8 * s + 7]);
                pb[s] = __builtin_bit_cast(bf16x8, w);
                u32x4 w2; w2.x = pk_bf16(p1[8 * s], p1[8 * s + 1]); w2.y = pk_bf16(p1[8 * s + 2], p1[8 * s + 3]); w2.z = pk_bf16(p1[8 * s + 4], p1[8 * s + 5]); w2.w = pk_bf16(p1[8 * s + 6], p1[8 * s + 7]);
                pb[2 + s] = __builtin_bit_cast(bf16x8, w2);
            }
            const LAS char* vb = cb + KB + vlane;
#pragma unroll
            for (int ks = 0; ks < 4; ++ks) {
                const s16x4 l0 = vtr(vb + ks * 1024), h0 = vtr(vb + ks * 1024 + 512);
                const s16x4 l1 = vtr(vb + 4096 + ks * 1024), h1 = vtr(vb + 4096 + ks * 1024 + 512);
                const bf16x8 a0 = (bf16x8){l0[0], l0[1], l0[2], l0[3], h0[0], h0[1], h0[2], h0[3]};
                const bf16x8 a1 = (bf16x8){l1[0], l1[1], l1[2], l1[3], h1[0], h1[1], h1[2], h1[3]};
                o0 = __builtin_amdgcn_mfma_f32_32x32x16_bf16(a0, pb[ks], o0, 0, 0, 0);
                o1 = __builtin_amdgcn_mfma_f32_32x32x16_bf16(a1, pb[ks], o1, 0, 0, 0);
            }
        }
        if (more) ATT_STORE(nb);
        __syncthreads();
    }
#undef ATT_LOAD
#undef ATT_STORE
    if (wave_on) {
        const float lt = swapsum(lrun);
        const float inv = 1.0f / lt;
        if (32 * wid + r32 < nvalid) {
            bf16_t* op = O + (rowbase + qpos) * ldo;
#pragma unroll
            for (int g = 0; g < 4; ++g) {
                u32x2 w0, w1;
                w0.x = pk_bf16(o0[4 * g] * inv, o0[4 * g + 1] * inv); w0.y = pk_bf16(o0[4 * g + 2] * inv, o0[4 * g + 3] * inv);
                w1.x = pk_bf16(o1[4 * g] * inv, o1[4 * g + 1] * inv); w1.y = pk_bf16(o1[4 * g + 2] * inv, o1[4 * g + 3] * inv);
                *(u32x2*)(op + 8 * g + 4 * hi) = w0; *(u32x2*)(op + 32 + 8 * g + 4 * hi) = w1;
            }
        }
    }
}

template <int DK, bool FOX>
__device__ __forceinline__ void attn_unit2(LAS char* lds, const bf16_t* Q, int ldq, const bf16_t* Kp, int ldk, const bf16_t* Vp, int ldv, bf16_t* O, int ldo,
                                           const float* cs, int b, int j, int tau_min) {
    constexpr int NS = DK / 16, KB = 64 * DK * 2, SB = KB + 8192 + 256;
    constexpr float THR = 8.0f;
    int tid_l = threadIdx.x; asm volatile("" : "+v"(tid_l));
    const int tid = tid_l, lane = tid & 63, r32 = lane & 31, hi = lane >> 5; const int wid = __builtin_amdgcn_readfirstlane(tid >> 6);
    const size_t rowbase = (size_t)b * LSEQ;
    const int qp0 = (j == 0) ? 0 : 16 + 256 * (j - 1) + 32 * wid;
    const int qpos = qp0 + r32;
    const bool wave_on = (j > 0) || (wid == 0);
    const int tdiag = (j == 0) ? 0 : 4 * (j - 1) + 1 + (wid >> 1);
    const int qin = (j == 0) ? r32 : 32 * (wid & 1) + r32;
    const int NT = 4 * j + 1;
    bf16x8 qf[NS];
#pragma unroll
    for (int s = 0; s < NS; ++s) qf[s] = *(const bf16x8*)(Q + (rowbase + qpos) * ldq + 16 * s + 8 * hi);
    float csq = 0.f; if (FOX) csq = cs[qpos];
    const bf16_t* kg = Kp + (rowbase + lane) * ldk + 8 * wid;
    const bf16_t* kg2 = Kp + (rowbase + lane) * ldk + 8 * (8 + (wid & 3));
    const bf16_t* vg = Vp + (rowbase + 16 * (wid & 3) + 8 * (lane >> 5) + ((lane >> 2) & 7)) * ldv + 32 * (wid >> 2) + 8 * (lane & 3);
    const int nops = 2 + ((DK == 96) ? (wid < 4 ? 1 : 0) : (FOX ? (wid == 4 ? 1 : 0) : 0));
#define ATT_ISSUE(t, slot) do { const int ts_ = ((t) == 0) ? 0 : 64 * (t) - 48; LAS char* sb_ = lds + (slot) * SB; \
        __builtin_amdgcn_global_load_lds((const unsigned*)(kg + (size_t)ts_ * ldk), (LAS unsigned*)(sb_ + wid * 1024), 16, 0, 0); \
        __builtin_amdgcn_global_load_lds((const unsigned*)(vg + (size_t)ts_ * ldv), (LAS unsigned*)(sb_ + KB + (wid >> 2) * 4096 + (wid & 3) * 1024), 16, 0, 0); \
        if (DK == 96) { if (wid < 4) __builtin_amdgcn_global_load_lds((const unsigned*)(kg2 + (size_t)ts_ * ldk), (LAS unsigned*)(sb_ + (8 + wid) * 1024), 16, 0, 0); } \
        else if (FOX) { if (wid == 4) { if (lane < 16) __builtin_amdgcn_global_load_lds((const unsigned*)(cs + ts_ + 4 * lane), (LAS unsigned*)(sb_ + KB + 8192), 16, 0, 0); } } } while (0)
    int t = NT - 1;
    int slot = 0;
    ATT_ISSUE(t, 0);
    if (t - 1 >= tau_min) ATT_ISSUE(t - 1, 1);
    float mhat = 0.f, lrun = 0.f;
    f32x16 o0 = {}, o1 = {};
    const int vlane = ((lane >> 4) & 1) * 32 + (lane & 3) * 8 + (4 * hi + ((lane & 15) >> 2)) * 64;
    bool started = false;
    for (; t >= tau_min; --t) {
        if (t - 1 >= tau_min) { if (nops == 3) asm volatile("s_waitcnt vmcnt(3)" ::: "memory"); else asm volatile("s_waitcnt vmcnt(2)" ::: "memory"); }
        else asm volatile("s_waitcnt vmcnt(0)" ::: "memory");
        __builtin_amdgcn_s_barrier(); asm volatile("" ::: "memory");
        { const int s2 = (slot >= 1) ? slot - 1 : 2;
          if (t - 2 >= tau_min) ATT_ISSUE(t - 2, s2); }
        const LAS char* cb = lds + slot * SB;
        if (wave_on && t <= tdiag) {
            f32x16 p0, p1;
            if (FOX) {
                const LAS float* cl = (const LAS float*)(cb + KB + 8192); const float base = csq - mhat;
#pragma unroll
                for (int g = 0; g < 4; ++g) { const f32x4 c0 = *(const LAS f32x4*)(cl + 8 * g + 4 * hi), c1 = *(const LAS f32x4*)(cl + 32 + 8 * g + 4 * hi);
#pragma unroll
                    for (int jj = 0; jj < 4; ++jj) { p0[4 * g + jj] = base - c0[jj]; p1[4 * g + jj] = base - c1[jj]; } }
            } else {
                const float nm = -mhat;
#pragma unroll
                for (int r = 0; r < 16; ++r) { p0[r] = nm; p1[r] = nm; }
            }
#pragma unroll
            for (int s = 0; s < NS; ++s) {
                const int c = 2 * s + hi;
                const bf16x8 a0 = *(const LAS bf16x8*)(cb + c * 1024 + r32 * 16);
                const bf16x8 a1 = *(const LAS bf16x8*)(cb + c * 1024 + 512 + r32 * 16);
                p0 = __builtin_amdgcn_mfma_f32_32x32x16_bf16(a0, qf[s], p0, 0, 0, 0);
                p1 = __builtin_amdgcn_mfma_f32_32x32x16_bf16(a1, qf[s], p1, 0, 0, 0);
            }
            if (t == tdiag) {
#pragma unroll
                for (int r = 0; r < 16; ++r) { const int kv = 4 * hi + (r & 3) + 8 * (r >> 2); if (kv > qin) p0[r] = -INFINITY; if (kv + 32 > qin) p1[r] = -INFINITY; }
            }
            if (t == 0) {
#pragma unroll
                for (int r = 0; r < 16; ++r) { const int kv = 4 * hi + (r & 3) + 8 * (r >> 2); if (kv >= 16) p0[r] = -INFINITY; p1[r] = -INFINITY; }
            }
            float mt = fmaxf(p0[0], p1[0]);
#pragma unroll
            for (int r = 1; r < 16; ++r) mt = fmaxf(mt, fmaxf(p0[r], p1[r]));
            mt = swapmax(mt);
            if (!started) {
                started = true; mhat = mt;
#pragma unroll
                for (int r = 0; r < 16; ++r) { p0[r] -= mt; p1[r] -= mt; }
            } else if (__any(mt > THR)) {
                const float dl = fmaxf(mt, 0.f); mhat += dl; const float f = __builtin_amdgcn_exp2f(-dl); lrun *= f;
#pragma unroll
                for (int r = 0; r < 16; ++r) { p0[r] -= dl; p1[r] -= dl; o0[r] *= f; o1[r] *= f; }
            }
            float ls = 0.f;
#pragma unroll
            for (int r = 0; r < 16; ++r) { p0[r] = __builtin_amdgcn_exp2f(p0[r]); p1[r] = __builtin_amdgcn_exp2f(p1[r]); ls += p0[r] + p1[r]; }
            lrun += ls;
            bf16x8 pb[4];
#pragma unroll
            for (int s = 0; s < 2; ++s) {
                u32x4 w; w.x = pk_bf16(p0[8 * s], p0[8 * s + 1]); w.y = pk_bf16(p0[8 * s + 2], p0[8 * s + 3]); w.z = pk_bf16(p0[8 * s + 4], p0[8 * s + 5]); w.w = pk_bf16(p0[8 * s + 6], p0[8 * s + 7]);
                pb[s] = __builtin_bit_cast(bf16x8, w);
                u32x4 w2; w2.x = pk_bf16(p1[8 * s], p1[8 * s + 1]); w2.y = pk_bf16(p1[8 * s + 2], p1[8 * s + 3]); w2.z = pk_bf16(p1[8 * s + 4], p1[8 * s + 5]); w2.w = pk_bf16(p1[8 * s + 6], p1[8 * s + 7]);
                pb[2 + s] = __builtin_bit_cast(bf16x8, w2);
            }
            const LAS char* vb = cb + KB + vlane;
#pragma unroll
            for (int ks = 0; ks < 4; ++ks) {
                const s16x4 l0 = vtr(vb + ks * 1024), h0 = vtr(vb + ks * 1024 + 512);
                const s16x4 l1 = vtr(vb + 4096 + ks * 1024), h1 = vtr(vb + 4096 + ks * 1024 + 512);
                const bf16x8 a0 = (bf16x8){l0[0], l0[1], l0[2], l0[3], h0[0], h0[1], h0[2], h0[3]};
                const bf16x8 a1 = (bf16x8){l1[0], l1[1], l1[2], l1[3], h1[0], h1[1], h1[2], h1[3]};
                o0 = __builtin_amdgcn_mfma_f32_32x32x16_bf16(a0, pb[ks], o0, 0, 0, 0);
                o1 = __builtin_amdgcn_mfma_f32_32x32x16_bf16(a1, pb[ks], o1, 0, 0, 0);
            }
        }
        slot = (slot == 2) ? 0 : slot + 1;
    }
#undef ATT_ISSUE
    if (wave_on) {
        const float lt = swapsum(lrun);
        const float inv = 1.0f / lt;
        if (j > 0 || r32 < 16) {
            bf16_t* op = O + (rowbase + qpos) * ldo;
#pragma unroll
            for (int g = 0; g < 4; ++g) {
                u32x2 w0, w1;
                w0.x = pk_bf16(o0[4 * g] * inv, o0[4 * g + 1] * inv); w0.y = pk_bf16(o0[4 * g + 2] * inv, o0[4 * g + 3] * inv);
                w1.x = pk_bf16(o1[4 * g] * inv, o1[4 * g + 1] * inv); w1.y = pk_bf16(o1[4 * g + 2] * inv, o1[4 * g + 3] * inv);
                *(u32x2*)(op + 8 * g + 4 * hi) = w0; *(u32x2*)(op + 32 + 8 * g + 4 * hi) = w1;
            }
        }
    }
    asm volatile("s_waitcnt lgkmcnt(0)" ::: "memory");
    __builtin_amdgcn_s_barrier(); asm volatile("" ::: "memory");
}

struct Args { const float* in[22]; float* out; unsigned char* ws; };
struct Frame {
    LAS unsigned char* lds; volatile LAS unsigned* MISC; unsigned* ctl;
    int tid, lane, wave, vcu, G;
};

__device__ __forceinline__ void tr_item(const float* colp, int ld, const float* kscale, bf16_t* dst, int K, int n0, int k0, LAS float* scr, int lane) {
#pragma unroll
    for (int i = 0; i < 32; ++i) { const int kk = 2 * i + (lane >> 5); float v = colp ? colp[(size_t)(k0 + kk) * ld] : 0.f; if (kscale) v *= kscale[k0 + kk]; scr[kk * 33 + (lane & 31)] = v; }
    LDS_WAIT(); asm volatile("" ::: "memory");
    const int c = lane & 7;
#pragma unroll
    for (int j = 0; j < 4; ++j) { const int n = (lane >> 3) + 8 * j; const LAS float* s = scr + (8 * c) * 33 + n;
        u32x4 o; o.x = pk_bf16(s[0 * 33], s[1 * 33]); o.y = pk_bf16(s[2 * 33], s[3 * 33]); o.z = pk_bf16(s[4 * 33], s[5 * 33]); o.w = pk_bf16(s[6 * 33], s[7 * 33]);
        *(u32x4*)(dst + (size_t)(n0 + n) * K + k0 + 8 * c) = o; }
    LDS_WAIT(); asm volatile("" ::: "memory");
}
constexpr int ITEMS_PER_LAYER = 9616;
__device__ __forceinline__ void convert_item(const Args& a, bf16_t* W, int l, int r, LAS float* scr, int lane) {
    const int w = lane & 31;
    if (r < 1152) { const int kb = r / 72, nb = r % 72, n = nb * 32 + w; int col;
        if (n < 1536) col = n; else { const int j = n - 1536; col = j < 384 ? 1544 + j : j < 640 ? 1928 + (j - 384) : j < 672 ? 2184 + (j - 640) : j < 680 ? 1536 + (j - 672) : -1; }
        const float* src = a.in[4] + (size_t)l * 1024 * 4264;
        tr_item(col >= 0 ? src + col : nullptr, 4264, nullptr, W + W_BT1, 1024, nb * 32, kb * 64, scr, lane); return; }
    r -= 1152;
    if (r < 1024) { const int kb = r / 64, nb = r % 64, n = nb * 32 + w; const float* src = a.in[4] + (size_t)l * 1024 * 4264;
        tr_item(src + 2216 + n, 4264, nullptr, W + W_BT2, 1024, nb * 32, kb * 64, scr, lane); return; }
    r -= 1024;
    if (r < 256) { const int kb = r / 32, nb = r % 32, n = nb * 32 + w; tr_item(a.in[6] + (size_t)l * 512 * 1024 + n, 1024, nullptr, W + W_FOXO, 512, nb * 32, kb * 64, scr, lane); return; }
    r -= 256;
    if (r < 256) { const int kb = r / 32, nb = r % 32, n = nb * 32 + w; tr_item(a.in[11] + (size_t)l * 512 * 1024 + n, 1024, nullptr, W + W_MLAO, 512, nb * 32, kb * 64, scr, lane); return; }
    r -= 256;
    if (r < 144) { const int kb = r / 24, nb = r % 24, n = nb * 32 + w; tr_item(a.in[8] + (size_t)l * 384 * 768 + n, 768, a.in[7] + l * 384, W + W_UQ, 384, nb * 32, kb * 64, scr, lane); return; }
    r -= 144;
    if (r < 128) { const int kb = r / 32, nb = r % 32, n = nb * 32 + w; const int col = n < 512 ? (n >> 6) * 128 + (n & 63) : ((n - 512) >> 6) * 128 + 64 + (n & 63);
        tr_item(a.in[10] + (size_t)l * 256 * 1024 + col, 1024, a.in[9] + l * 256, W + W_UKV, 256, nb * 32, kb * 64, scr, lane); return; }
    r -= 128;
    if (r < 512) { const int kb = r / 32, nb = r % 32, n = nb * 32 + w; tr_item(a.in[12] + (size_t)l * 1024 * 1024 + n, 1024, nullptr, W + W_OUT, 1024, nb * 32, kb * 64, scr, lane); return; }
    r -= 512;
    if (r < 4096) { const int e = r / 256, rr = r % 256, kb = rr / 16, nb = rr % 16;
        const float* src = (w < 16 ? a.in[17] : a.in[18]) + ((size_t)(l * 16 + e) * 1024) * 256 + 16 * nb + (w & 15);
        tr_item(src, 256, nullptr, W + W_MOE1 + (size_t)e * 512 * 1024, 1024, nb * 32, kb * 64, scr, lane); return; }
    r -= 4096;
    { const int e = r / 128, rr = r % 128, kb = rr / 32, nb = rr % 32, n = nb * 32 + w;
        tr_item(a.in[19] + ((size_t)(l * 16 + e) * 256) * 1024 + n, 1024, nullptr, W + W_MOE2 + (size_t)e * 1024 * 256, 256, nb * 32, kb * 64, scr, lane); }
}

__device__ __forceinline__ void ln16(f32x4 (&v)[4], const float* g, const float* bta, int lane) {
    float s = 0.f;
#pragma unroll
    for (int j = 0; j < 4; ++j) s += (v[j][0] + v[j][1]) + (v[j][2] + v[j][3]);
    const float mean = wave_sum(s) * (1.f / DM); float s2 = 0.f;
#pragma unroll
    for (int j = 0; j < 4; ++j) { v[j] = v[j] - mean; s2 += (v[j][0] * v[j][0] + v[j][1] * v[j][1]) + (v[j][2] * v[j][2] + v[j][3] * v[j][3]); }
    const float rstd = 1.0f / sqrtf(wave_sum(s2) * (1.f / DM) + 1e-5f);
#pragma unroll
    for (int j = 0; j < 4; ++j) { const f32x4 gg = *(const f32x4*)(g + 4 * lane + 256 * j), bb = *(const f32x4*)(bta + 4 * lane + 256 * j); v[j] = v[j] * rstd * gg + bb; }
}
template <int R>
__device__ __forceinline__ void ln16xR(f32x4 (&v)[R][4], const float* g, const float* bta, int lane) {
    float s[R];
#pragma unroll
    for (int k = 0; k < R; ++k) { s[k] = 0.f;
#pragma unroll
        for (int j = 0; j < 4; ++j) s[k] += (v[k][j][0] + v[k][j][1]) + (v[k][j][2] + v[k][j][3]); }
#pragma unroll
    for (int o = 1; o < 64; o <<= 1) {
#pragma unroll
        for (int k = 0; k < R; ++k) s[k] += __shfl_xor(s[k], o); }
    float s2[R];
#pragma unroll
    for (int k = 0; k < R; ++k) { const float mean = s[k] * (1.f / DM); s2[k] = 0.f;
#pragma unroll
        for (int j = 0; j < 4; ++j) { v[k][j] = v[k][j] - mean; s2[k] += (v[k][j][0] * v[k][j][0] + v[k][j][1] * v[k][j][1]) + (v[k][j][2] * v[k][j][2] + v[k][j][3] * v[k][j][3]); } }
#pragma unroll
    for (int o = 1; o < 64; o <<= 1) {
#pragma unroll
        for (int k = 0; k < R; ++k) s2[k] += __shfl_xor(s2[k], o); }
#pragma unroll
    for (int j = 0; j < 4; ++j) { const f32x4 gg = *(const f32x4*)(g + 4 * lane + 256 * j), bb = *(const f32x4*)(bta + 4 * lane + 256 * j);
#pragma unroll
        for (int k = 0; k < R; ++k) { const float rstd = 1.0f / sqrtf(s2[k] * (1.f / DM) + 1e-5f); v[k][j] = v[k][j] * rstd * gg + bb; } }
}
__device__ __forceinline__ void store_row_bf16(bf16_t* orow, const f32x4 (&v)[4], int lane) {
#pragma unroll
    for (int j = 0; j < 4; ++j) { u32x2 w; w.x = pk_bf16(v[j][0], v[j][1]); w.y = pk_bf16(v[j][2], v[j][3]); *(u32x2*)(orow + 4 * lane + 256 * j) = w; }
}

__device__ const double ROPE_INV_REV[16] = {0.15915494309189535, 0.08949940160889101, 0.050329212104487035, 0.0283021958306234, 0.015915494309189534, 0.008949940160889102,
    0.005032921210448704, 0.00283021958306234, 0.0015915494309189536, 0.0008949940160889102, 0.0005032921210448703, 0.00028302195830623395, 0.00015915494309189535,
    8.949940160889102e-05, 5.0329212104487035e-05, 2.8302195830623396e-05};

__global__ void __launch_bounds__(512, 2) fwd_kernel(Args args) {
    extern __shared__ __attribute__((aligned(16))) unsigned char lds_raw[];
    Frame F;
    F.lds = (LAS unsigned char*)lds_raw;
    F.MISC = (volatile LAS unsigned*)(F.lds + MISC_OFF);
    F.tid = threadIdx.x; F.lane = F.tid & 63; F.wave = __builtin_amdgcn_readfirstlane(F.tid >> 6);
    F.G = gridDim.x; { const int bx = blockIdx.x; F.vcu = (F.G % 8 == 0) ? (bx % 8) * (F.G / 8) + bx / 8 : bx; }
    unsigned char* ws = args.ws;
    F.ctl = (unsigned*)(ws + WS_CTL);
    for (int u = F.tid; u < (LDS_BYTES - MISC_OFF) / 4; u += 512) ((LAS unsigned*)(F.lds + MISC_OFF))[u] = 0u;
    __syncthreads();
    XcdBarrier bar = xcd_barrier_post(F.ctl + CW_BAR, F.MISC);
    const int NGW = F.G * 8;
#define PHASE_IDS int tid = threadIdx.x; asm volatile("" : "+v"(tid)); const int lane = tid & 63; const int wave = __builtin_amdgcn_readfirstlane(tid >> 6); const int gw = F.vcu * 8 + wave; (void)lane; (void)gw;

#define PHASE_PTRS unsigned char* wsl = args.ws; asm volatile("" : "+s"(wsl)); \
    float* ropeC = (float*)(wsl + WS_ROPE); float* ropeS = ropeC + LSEQ * 16; float* LFp = (float*)(wsl + WS_LF); float* CSp = (float*)(wsl + WS_CS); \
    unsigned* TOK = (unsigned*)(wsl + WS_TOK); int* LIST = (int*)(wsl + WS_LIST); bf16_t* Wall = (bf16_t*)(wsl + WS_W); bf16_t* HB = (bf16_t*)(wsl + WS_H); unsigned char* X = wsl + WS_X; \
    bf16_t *Qf = (bf16_t*)(X + X_QF), *Kf = (bf16_t*)(X + X_KF), *Vf = (bf16_t*)(X + X_VF), *RAW = (bf16_t*)(X + X_RAW), *Qm = (bf16_t*)(X + X_QM), *Km = (bf16_t*)(X + X_KM), \
           *Vm = (bf16_t*)(X + X_VM), *Om = (bf16_t*)(X + X_OM), *Of = (bf16_t*)(X + X_OF), *GATES = (bf16_t*)(X + X_GATES), *MERGED = (bf16_t*)(X + X_MERGED), *H1 = (bf16_t*)(X + X_H1), \
           *HID = (bf16_t*)(X + X_HID), *YS = (bf16_t*)(X + X_YS); float* Zb = (float*)(X + X_Z); unsigned* ctl = (unsigned*)(wsl + WS_CTL); \
    (void)ropeC; (void)ropeS; (void)LFp; (void)CSp; (void)TOK; (void)LIST; (void)Wall; (void)HB; (void)Qf; (void)Kf; (void)Vf; (void)RAW; (void)Qm; (void)Km; (void)Vm; (void)Om; (void)Of; (void)GATES; (void)MERGED; (void)H1; (void)HID; (void)YS; (void)Zb; (void)ctl;

    {
        PHASE_IDS
        PHASE_PTRS
        LAS float* scr = (LAS float*)(F.lds + wave * 16384);
        for (int it = gw; it < 2 * ITEMS_PER_LAYER; it += NGW) { const int l = it / ITEMS_PER_LAYER, r = it % ITEMS_PER_LAYER; convert_item(args, Wall + (size_t)l * W_LAYER, l, r, scr, lane); }
        for (int r4 = gw * 4; r4 < TP; r4 += NGW * 4) {
            if (r4 >= T) {
#pragma unroll
                for (int k = 0; k < 4; ++k) { bf16_t* orow = HB + (size_t)(r4 + k) * DM; *(u32x4*)(orow + 8 * lane) = (u32x4){0u, 0u, 0u, 0u}; *(u32x4*)(orow + 512 + 8 * lane) = (u32x4){0u, 0u, 0u, 0u}; }
                continue; }
            f32x4 v[4][4];
#pragma unroll
            for (int k = 0; k < 4; ++k) { const int row = r4 + k; const int b = row / LSEQ, p = row % LSEQ;
                const float* src = p < NMETA ? args.in[1] + (size_t)p * DM : args.in[0] + ((size_t)b * SEQ + (p - NMETA)) * DM;
#pragma unroll
                for (int j = 0; j < 4; ++j) v[k][j] = *(const f32x4*)(src + 4 * lane + 256 * j); }
            ln16xR<4>(v, args.in[2], args.in[3], lane);
#pragma unroll
            for (int k = 0; k < 4; ++k) store_row_bf16(HB + (size_t)(r4 + k) * DM, v[k], lane);
        }
        for (int idx = blockIdx.x * 512 + tid; idx < LSEQ * 16; idx += F.G * 512) {
            const int p = idx >> 4, i = idx & 15; double x = (double)p * ROPE_INV_REV[i]; x -= floor(x); const float xr = (float)x;
            ropeC[idx] = __builtin_amdgcn_cosf(xr); ropeS[idx] = __builtin_amdgcn_sinf(xr);
        }
    }
    xcd_barrier(bar);

    for (int l = 0; l < 2; ++l) {
        for (int rep_ = 0; rep_ < REP_GEMM; ++rep_) {
        {
            PHASE_PTRS const bf16_t* W = Wall + (size_t)l * W_LAYER;
            pg8::SchedStatic S{(const char*)HB, (const char*)(W + W_BT1), NPANEL, 9, F.G, (int)blockIdx.x, (size_t)256 * DM * 2, (size_t)256 * DM * 2};
            pg8::EpiA1 E{Qf, Kf, Vf, RAW, LFp, args.in[5] + l * 8};
            pg8::gemm_phase<pg8::EpiA1, pg8::SchedStatic, false>(F.lds, 1024, 1024, 1024, S, E);
        }
        xcd_barrier(bar);
        }
        for (int rep_ = 0; rep_ < REP_THIN; ++rep_) {
        {
            PHASE_IDS
            PHASE_PTRS
            if (blockIdx.x < 64 && wave == 0) {
                const int bb = blockIdx.x >> 3, hh = blockIdx.x & 7; float carry = 0.f;
                for (int i0 = 0; i0 < 65; i0 += 13) {
                    float v[13];
#pragma unroll
                    for (int k = 0; k < 13; ++k) { const int p = 64 * (i0 + k) + lane; v[k] = p < LSEQ ? LFp[((size_t)bb * LSEQ + p) * 8 + hh] : 0.f; }
#pragma unroll
                    for (int k = 0; k < 13; ++k) { float x = v[k];
#pragma unroll
                        for (int d = 1; d < 64; d <<= 1) { const float y = __shfl_up(x, d); if (lane >= d) x += y; }
                        x += carry; carry = __shfl(x, 63);
                        CSp[(size_t)blockIdx.x * CSP + 64 * (i0 + k) + lane] = x * LOG2E; }
                }
            }
            for (int r4 = gw * 4; r4 < TP; r4 += NGW * 4) {
                u32x4 q[4], kv[4]; u32x2 ka[4], kc[4];
#pragma unroll
                for (int k = 0; k < 4; ++k) { const bf16_t* raw = RAW + (size_t)(r4 + k) * 768;
                    q[k] = (u32x4){0u, 0u, 0u, 0u}; kv[k] = (u32x4){0u, 0u, 0u, 0u}; ka[k] = (u32x2){0u, 0u}; kc[k] = (u32x2){0u, 0u};
                    if (lane < 48) q[k] = *(const u32x4*)(raw + 8 * lane);
                    if (lane < 32) kv[k] = *(const u32x4*)(raw + 384 + 8 * lane);
                    if (lane < 4) { ka[k] = *(const u32x2*)(raw + 640 + 4 * lane); kc[k] = *(const u32x2*)(raw + 656 + 4 * lane); } }
                float fq_[4][8], fk_[4][8], sq[4], sk[4];
#pragma unroll
                for (int k = 0; k < 4; ++k) {
                    fq_[k][0] = bf_lo(q[k].x); fq_[k][1] = bf_hi(q[k].x); fq_[k][2] = bf_lo(q[k].y); fq_[k][3] = bf_hi(q[k].y); fq_[k][4] = bf_lo(q[k].z); fq_[k][5] = bf_hi(q[k].z); fq_[k][6] = bf_lo(q[k].w); fq_[k][7] = bf_hi(q[k].w);
                    fk_[k][0] = bf_lo(kv[k].x); fk_[k][1] = bf_hi(kv[k].x); fk_[k][2] = bf_lo(kv[k].y); fk_[k][3] = bf_hi(kv[k].y); fk_[k][4] = bf_lo(kv[k].z); fk_[k][5] = bf_hi(kv[k].z); fk_[k][6] = bf_lo(kv[k].w); fk_[k][7] = bf_hi(kv[k].w);
                    sq[k] = 0.f; sk[k] = 0.f;
#pragma unroll
                    for (int j = 0; j < 8; ++j) { sq[k] += fq_[k][j] * fq_[k][j]; sk[k] += fk_[k][j] * fk_[k][j]; } }
#pragma unroll
                for (int o = 1; o < 64; o <<= 1) {
#pragma unroll
                    for (int k = 0; k < 4; ++k) { sq[k] += __shfl_xor(sq[k], o); sk[k] += __shfl_xor(sk[k], o); } }
#pragma unroll
                for (int k = 0; k < 4; ++k) { bf16_t* raw = RAW + (size_t)(r4 + k) * 768; const int pos = (r4 + k) % LSEQ;
                    const float rq = 1.0f / sqrtf(sq[k] * (1.f / 384.f) + 1e-6f), rk = 1.0f / sqrtf(sk[k] * (1.f / 256.f) + 1e-6f);
                    if (lane < 48) { u32x4 o; o.x = pk_bf16(fq_[k][0] * rq, fq_[k][1] * rq); o.y = pk_bf16(fq_[k][2] * rq, fq_[k][3] * rq); o.z = pk_bf16(fq_[k][4] * rq, fq_[k][5] * rq); o.w = pk_bf16(fq_[k][6] * rq, fq_[k][7] * rq); *(u32x4*)(raw + 8 * lane) = o; }
                    if (lane < 32) { u32x4 o; o.x = pk_bf16(fk_[k][0] * rk, fk_[k][1] * rk); o.y = pk_bf16(fk_[k][2] * rk, fk_[k][3] * rk); o.z = pk_bf16(fk_[k][4] * rk, fk_[k][5] * rk); o.w = pk_bf16(fk_[k][6] * rk, fk_[k][7] * rk); *(u32x4*)(raw + 384 + 8 * lane) = o; }
                    if (lane < 4) {
                        const u32x2 a = ka[k], c = kc[k];
                        const f32x4 x1 = {bf_lo(a.x), bf_hi(a.x), bf_lo(a.y), bf_hi(a.y)}, x2 = {bf_lo(c.x), bf_hi(c.x), bf_lo(c.y), bf_hi(c.y)};
                        const f32x4 cs = *(const f32x4*)(ropeC + pos * 16 + 4 * lane), sn = *(const f32x4*)(ropeS + pos * 16 + 4 * lane);
                        const f32x4 y1 = x1 * cs - x2 * sn, y2 = x2 * cs + x1 * sn;
                        u32x2 w1, w2; w1.x = pk_bf16(y1[0], y1[1]); w1.y = pk_bf16(y1[2], y1[3]); w2.x = pk_bf16(y2[0], y2[1]); w2.y = pk_bf16(y2[2], y2[3]);
                        bf16_t* kp = Km + (size_t)(r4 + k) * 768 + 64 + 4 * lane;
#pragma unroll
                        for (int h = 0; h < 8; ++h) { *(u32x2*)(kp + 96 * h) = w1; *(u32x2*)(kp + 96 * h + 16) = w2; }
                    } }
            }
        }
        xcd_barrier(bar);
        }
        for (int rep_ = 0; rep_ < REP_GEMM; ++rep_) {
        {
            PHASE_PTRS const bf16_t* W = Wall + (size_t)l * W_LAYER;
            pg8::SchedStatic S{(const char*)RAW, (const char*)(W + W_UQ), NPANEL, 3, F.G, (int)blockIdx.x, (size_t)256 * 768 * 2, (size_t)256 * 384 * 2};
            pg8::EpiQup E{Qm, ropeC, ropeS};
            pg8::gemm_phase<pg8::EpiQup, pg8::SchedStatic, false>(F.lds, 384, 768, 384, S, E);
        }
        {
            PHASE_PTRS const bf16_t* W = Wall + (size_t)l * W_LAYER;
            pg8::SchedStatic S{(const char*)(RAW + 384), (const char*)(W + W_UKV), NPANEL, 4, F.G, (int)blockIdx.x, (size_t)256 * 768 * 2, (size_t)256 * 256 * 2};
            pg8::EpiKV E{Km, Vm};
            pg8::gemm_phase<pg8::EpiKV, pg8::SchedStatic, false>(F.lds, 256, 768, 256, S, E);
        }
        xcd_barrier(bar);
        }
        {
            PHASE_IDS
            PHASE_PTRS
            const int myx = (int)(xb_xcc_id() & 7u);
            for (int rep_ = 0; rep_ < REP_MLA; ++rep_)
            for (int xo = 0; xo < 8; ++xo) { const int x = (myx + xo) & 7; unsigned* qc = ctl + CW_QCTR + 64 * ((rep_ * 4 + l * 2) * 8 + x);
                for (;;) {
                    if (tid == 0) F.MISC[4] = __hip_atomic_fetch_add(qc, 1u, RLX_AGENT);
                    __syncthreads();
                    const int id = (int)F.MISC[4];
                    __syncthreads();
                    if (id >= 136) break;
                    const int g = id / 34, i = id % 34, j = 16 - (i >> 1), h = 2 * g + (i & 1), b = x;
                    attn_unit2<96, false>((LAS char*)F.lds, Qm + 96 * h, 768, Km + 96 * h, 768, Vm + 64 * h, 512, Om + 64 * h, 512, nullptr, b, j, 0);
                } }
            for (int rep_ = 0; rep_ < REP_FOX; ++rep_)
            for (int xo = 0; xo < 8; ++xo) { const int x = (myx + xo) & 7; unsigned* qc = ctl + CW_QCTR + 64 * ((rep_ * 4 + l * 2 + 1) * 8 + x);
                for (;;) {
                    if (tid == 0) F.MISC[4] = __hip_atomic_fetch_add(qc, 1u, RLX_AGENT);
                    __syncthreads();
                    const int id = (int)F.MISC[4];
                    __syncthreads();
                    if (id >= 136) break;
                    const int g = id / 34, i = id % 34, j = 16 - (i >> 1), h = 2 * g + (i & 1), b = x;
                    attn_unit2<64, true>((LAS char*)F.lds, Qf + 64 * h, 512, Kf + 64 * h, 512, Vf + 64 * h, 512, Of + 64 * h, 512, CSp + (size_t)(b * 8 + h) * CSP, b, j, 0);
                } }
        }
        xcd_barrier(bar);
        for (int rep_ = 0; rep_ < REP_GEMM; ++rep_) {
        {
            PHASE_PTRS const bf16_t* W = Wall + (size_t)l * W_LAYER;
            pg8::SchedStatic S{(const char*)HB, (const char*)(W + W_BT2), NPANEL, 8, F.G, (int)blockIdx.x, (size_t)256 * DM * 2, (size_t)256 * DM * 2};
            pg8::EpiA2 E{GATES};
            pg8::gemm_phase<pg8::EpiA2, pg8::SchedStatic, false>(F.lds, 1024, 1024, 1024, S, E);
        }
        xcd_barrier(bar);
        }
        for (int rep_ = 0; rep_ < REP_GEMM; ++rep_) {
        {
            PHASE_PTRS const bf16_t* W = Wall + (size_t)l * W_LAYER;
            pg8::SchedOut S{(const char*)Of, (const char*)Om, (const char*)(W + W_FOXO), (const char*)(W + W_MLAO), NPANEL, 4, F.G, (int)blockIdx.x, (size_t)256 * 512 * 2, (size_t)256 * 512 * 2};
            pg8::EpiOut E{GATES, MERGED};
            pg8::gemm_phase<pg8::EpiOut, pg8::SchedOut, false>(F.lds, 512, 512, 512, S, E);
        }
        xcd_barrier(bar);
        }
        for (int rep_ = 0; rep_ < REP_GEMM; ++rep_) {
        {
            PHASE_PTRS const bf16_t* W = Wall + (size_t)l * W_LAYER;
            pg8::SchedStatic S{(const char*)MERGED, (const char*)(W + W_OUT), NPANEL, 4, F.G, (int)blockIdx.x, (size_t)256 * DM * 2, (size_t)256 * DM * 2};
            pg8::EpiF E{HB, Zb};
            pg8::gemm_phase<pg8::EpiF, pg8::SchedStatic, false>(F.lds, 1024, 1024, 1024, S, E);
        }
        xcd_barrier(bar);
        }
        {
            PHASE_IDS
            PHASE_PTRS
            LAS float* rwT = (LAS float*)F.lds;
            LAS int* lcnt = (LAS int*)(F.lds + 65536);
            LAS int* gbase = lcnt + 16;
            LAS int* tE = lcnt + 64;
            LAS int* tP = tE + 272;
            LAS float* tG = (LAS float*)(tP + 272);
            const float* rw = args.in[15];
            for (int i = tid; i < 16384; i += 512) { const int col = i >> 4, e = i & 15; rwT[e * 1024 + col] = rw[i]; }
            if (tid < 16) lcnt[tid] = 0;
            __syncthreads();
            const int r0 = blockIdx.x * 129, nrows = (r0 + 129 <= T) ? 129 : (T > r0 ? T - r0 : 0);
            const float* rb = args.in[16];
            for (int g4 = wave * 4; g4 < nrows; g4 += 32) {
                f32x4 v[4][4];
#pragma unroll
                for (int k = 0; k < 4; ++k) { const int lr = (g4 + k < nrows) ? g4 + k : nrows - 1; const int row = r0 + lr;
#pragma unroll
                    for (int j = 0; j < 4; ++j) v[k][j] = *(const f32x4*)(Zb + (size_t)row * DM + 4 * lane + 256 * j); }
                ln16xR<4>(v, args.in[13] + l * DM, args.in[14] + l * DM, lane);
#pragma unroll
                for (int k = 0; k < 4; ++k) if (g4 + k < nrows) store_row_bf16(H1 + (size_t)(r0 + g4 + k) * DM, v[k], lane);
                float s[4][16];
#pragma unroll
                for (int e = 0; e < 16; ++e) {
                    f32x4 wv[4];
#pragma unroll
                    for (int j = 0; j < 4; ++j) wv[j] = *(const LAS f32x4*)(rwT + e * 1024 + 4 * lane + 256 * j);
#pragma unroll
                    for (int k = 0; k < 4; ++k) { float a = 0.f;
#pragma unroll
                        for (int j = 0; j < 4; ++j) a += (v[k][j][0] * wv[j][0] + v[k][j][1] * wv[j][1]) + (v[k][j][2] * wv[j][2] + v[k][j][3] * wv[j][3]);
                        s[k][e] = a; }
                }
#pragma unroll
                for (int k = 0; k < 4; ++k) {
#pragma unroll
                    for (int i = 0; i < 8; ++i) { const bool up = (lane & 32) != 0; const float mine = up ? s[k][i + 8] : s[k][i], oth = up ? s[k][i] : s[k][i + 8]; s[k][i] = mine + __shfl_xor(oth, 32); }
#pragma unroll
                    for (int i = 0; i < 4; ++i) { const bool up = (lane & 16) != 0; const float mine = up ? s[k][i + 4] : s[k][i], oth = up ? s[k][i] : s[k][i + 4]; s[k][i] = mine + __shfl_xor(oth, 16); }
#pragma unroll
                    for (int i = 0; i < 2; ++i) { const bool up = (lane & 8) != 0; const float mine = up ? s[k][i + 2] : s[k][i], oth = up ? s[k][i] : s[k][i + 2]; s[k][i] = mine + __shfl_xor(oth, 8); }
                    { const bool up = (lane & 4) != 0; const float mine = up ? s[k][1] : s[k][0], oth = up ? s[k][0] : s[k][1]; s[k][0] = mine + __shfl_xor(oth, 4); }
                    s[k][0] += __shfl_xor(s[k][0], 2); s[k][0] += __shfl_xor(s[k][0], 1);
                }
#pragma unroll
                for (int k = 0; k < 4; ++k) {
                    float lg[16];
#pragma unroll
                    for (int e = 0; e < 16; ++e) lg[e] = __int_as_float(__builtin_amdgcn_readlane(__float_as_int(s[k][0]), 4 * e));
                    float sc[16], bi[16];
#pragma unroll
                    for (int e = 0; e < 16; ++e) { sc[e] = 1.0f / (1.0f + expf(-lg[e])); bi[e] = sc[e] + rb[e]; }
                    int gsel = 0; float gbest = -INFINITY;
#pragma unroll
                    for (int g = 0; g < 4; ++g) { float m1 = bi[4 * g], m2 = -INFINITY;
#pragma unroll
                        for (int kk = 1; kk < 4; ++kk) { const float x = bi[4 * g + kk]; if (x > m1) { m2 = m1; m1 = x; } else if (x > m2) m2 = x; }
                        const float gs = m1 + m2; if (gs > gbest) { gbest = gs; gsel = g; } }
                    float b4[4], s4[4];
#pragma unroll
                    for (int kk = 0; kk < 4; ++kk) { b4[kk] = gsel == 0 ? bi[kk] : gsel == 1 ? bi[4 + kk] : gsel == 2 ? bi[8 + kk] : bi[12 + kk]; s4[kk] = gsel == 0 ? sc[kk] : gsel == 1 ? sc[4 + kk] : gsel == 2 ? sc[8 + kk] : sc[12 + kk]; }
                    int i1 = 0; float bb1 = b4[0], ss1 = s4[0];
#pragma unroll
                    for (int kk = 1; kk < 4; ++kk) if (b4[kk] > bb1) { bb1 = b4[kk]; ss1 = s4[kk]; i1 = kk; }
                    int i2 = -1; float bb2 = -INFINITY, ss2 = 0.f;
#pragma unroll
                    for (int kk = 0; kk < 4; ++kk) if (kk != i1 && b4[kk] > bb2) { bb2 = b4[kk]; ss2 = s4[kk]; i2 = kk; }
                    const float inv = 1.0f / (ss1 + ss2);
                    if (lane == 0 && g4 + k < nrows) {
                        const int lr = g4 + k; const int e0 = gsel * 4 + i1, e1 = gsel * 4 + i2;
                        tE[2 * lr] = e0; tE[2 * lr + 1] = e1;
                        tP[2 * lr] = atomicAdd((int*)&lcnt[e0], 1); tP[2 * lr + 1] = atomicAdd((int*)&lcnt[e1], 1);
                        tG[2 * lr] = ss1 * inv; tG[2 * lr + 1] = ss2 * inv;
                    }
                }
            }
            __syncthreads();
            if (tid < 16) gbase[tid] = (int)__hip_atomic_fetch_add(ctl + CW_ECNT + 64 * (l * 16 + tid), (unsigned)lcnt[tid], RLX_AGENT);
            __syncthreads();
            if (tid < nrows) {
                const int row = r0 + tid; const int e0 = tE[2 * tid], e1 = tE[2 * tid + 1];
                const int p0 = gbase[e0] + tP[2 * tid], p1 = gbase[e1] + tP[2 * tid + 1];
                LIST[(size_t)e0 * TP + p0] = row; LIST[(size_t)e1 * TP + p1] = row;
                u32x4 w0; w0.x = (unsigned)e0; w0.y = (unsigned)p0; w0.z = (unsigned)e1; w0.w = (unsigned)p1;
                *(u32x4*)(TOK + (size_t)row * 8) = w0;
                u32x2 w1; w1.x = __float_as_uint(tG[2 * tid]); w1.y = __float_as_uint(tG[2 * tid + 1]);
                *(u32x2*)(TOK + (size_t)row * 8 + 4) = w1;
            }
        }
        xcd_barrier(bar);
        LAS int* tb = (LAS int*)(F.lds + MISC_OFF) + 16; LAS int* ecnt = (LAS int*)(F.lds + MISC_OFF) + 64;
        if (threadIdx.x == 0) { int acc = 0; for (int e = 0; e < 16; ++e) { const int c = (int)__hip_atomic_load(F.ctl + CW_ECNT + 64 * (l * 16 + e), RLX_AGENT); ecnt[e] = c; tb[e] = acc; acc += (c + 255) >> 8; } tb[16] = acc; }
        __syncthreads();
        for (int rep_ = 0; rep_ < REP_GEMM; ++rep_) {
        {
            PHASE_PTRS const bf16_t* W = Wall + (size_t)l * W_LAYER;
            pg8::SchedMoe S{(const char*)H1, (const char*)(W + W_MOE1), tb, ecnt, LIST, 1, F.G, (int)blockIdx.x, (size_t)512 * 1024 * 2, (size_t)256 * 1024 * 2, 0, true};
            pg8::EpiM1 E{HID};
            pg8::gemm_phase<pg8::EpiM1, pg8::SchedMoe, true>(F.lds, 1024, 1024, 1024, S, E);
        }
        xcd_barrier(bar);
        }
        for (int rep_ = 0; rep_ < REP_GEMM; ++rep_) {
        {
            PHASE_PTRS const bf16_t* W = Wall + (size_t)l * W_LAYER;
            pg8::SchedMoe S{(const char*)HID, (const char*)(W + W_MOE2), tb, ecnt, LIST, 2, F.G, (int)blockIdx.x, (size_t)1024 * 256 * 2, (size_t)256 * 256 * 2, (size_t)256 * 256 * 2, false};
            pg8::EpiM2 E{YS};
            pg8::gemm_phase<pg8::EpiM2, pg8::SchedMoe, false>(F.lds, 256, 256, 256, S, E);
        }
        xcd_barrier(bar);
        }
        {
            PHASE_IDS
            PHASE_PTRS
            for (int rep_ = 0; rep_ < REP_J; ++rep_)
            for (int r4 = gw * 4; r4 < T; r4 += NGW * 4) {
                u32x4 w0[4]; u32x2 w1[4];
#pragma unroll
                for (int k = 0; k < 4; ++k) { w0[k] = *(const u32x4*)(TOK + (size_t)(r4 + k) * 8); w1[k] = *(const u32x2*)(TOK + (size_t)(r4 + k) * 8 + 4); }
                u32x2 hv[4][4], ya[4][4], yc[4][4];
#pragma unroll
                for (int k = 0; k < 4; ++k) {
                    const size_t s0 = (size_t)tb[(int)w0[k].x] * 256 + (int)w0[k].y, s1 = (size_t)tb[(int)w0[k].z] * 256 + (int)w0[k].w;
#pragma unroll
                    for (int j = 0; j < 4; ++j) { hv[k][j] = *(const u32x2*)(H1 + (size_t)(r4 + k) * DM + 4 * lane + 256 * j); ya[k][j] = *(const u32x2*)(YS + s0 * DM + 4 * lane + 256 * j); yc[k][j] = *(const u32x2*)(YS + s1 * DM + 4 * lane + 256 * j); } }
                f32x4 v[4][4];
#pragma unroll
                for (int k = 0; k < 4; ++k) { const float g0 = __uint_as_float(w1[k].x), g1 = __uint_as_float(w1[k].y);
#pragma unroll
                    for (int j = 0; j < 4; ++j) {
                        v[k][j][0] = ALPHA * bf_lo(hv[k][j].x) + g0 * bf_lo(ya[k][j].x) + g1 * bf_lo(yc[k][j].x); v[k][j][1] = ALPHA * bf_hi(hv[k][j].x) + g0 * bf_hi(ya[k][j].x) + g1 * bf_hi(yc[k][j].x);
                        v[k][j][2] = ALPHA * bf_lo(hv[k][j].y) + g0 * bf_lo(ya[k][j].y) + g1 * bf_lo(yc[k][j].y); v[k][j][3] = ALPHA * bf_hi(hv[k][j].y) + g0 * bf_hi(ya[k][j].y) + g1 * bf_hi(yc[k][j].y); } }
                ln16xR<4>(v, args.in[20] + l * DM, args.in[21] + l * DM, lane);
#pragma unroll
                for (int k = 0; k < 4; ++k) { const int row = r4 + k;
                    if (l == 0) store_row_bf16(HB + (size_t)row * DM, v[k], lane);
                    else { const int b = row / LSEQ, p = row % LSEQ;
                        if (p >= NMETA) { float* orow = args.out + ((size_t)b * SEQ + (p - NMETA)) * DM;
#pragma unroll
                            for (int j = 0; j < 4; ++j) *(f32x4*)(orow + 4 * lane + 256 * j) = v[k][j]; } } }
            }
        }
        if (l == 0) xcd_barrier(bar);
    }
}

extern "C" void kernel_launch(void* const* d_in, const int* in_sizes, int n_in, void* d_out, int out_size, void* d_ws, size_t ws_size, hipStream_t stream) {
    static int grid = 0;
    if (grid == 0) {
        if (n_in != 22 || ws_size < WS_END) { fprintf(stderr, "kernel_launch: need 22 inputs and %zu bytes of workspace (got %d, %zu)\n", (size_t)WS_END, n_in, ws_size); grid = -1; return; }
        int dev = 0, cus = 0, per_cu = 0;
        if (hipGetDevice(&dev) != hipSuccess || hipDeviceGetAttribute(&cus, hipDeviceAttributeMultiprocessorCount, dev) != hipSuccess) { grid = -1; return; }
        if (hipFuncSetAttribute((const void*)fwd_kernel, hipFuncAttributeMaxDynamicSharedMemorySize, LDS_BYTES) != hipSuccess) { fprintf(stderr, "kernel_launch: hipFuncSetAttribute failed\n"); grid = -1; return; }
        if (hipOccupancyMaxActiveBlocksPerMultiprocessor(&per_cu, (const void*)fwd_kernel, 512, LDS_BYTES) != hipSuccess || per_cu < 1) { fprintf(stderr, "kernel_launch: occupancy query says %d\n", per_cu); }
        (void)hipGetLastError();
        grid = cus;
    }
    if (grid < 0) return;
    if (hipMemsetAsync((char*)d_ws + WS_CTL, 0, CTL_BYTES, stream) != hipSuccess) return;
    Args a{};
    for (int i = 0; i < 22; ++i) a.in[i] = (const float*)d_in[i];
    a.out = (float*)d_out; a.ws = (unsigned char*)d_ws;
    hipLaunchKernelGGL(fwd_kernel, dim3(grid), dim3(512), LDS_BYTES, stream, a);
}
```

```cpp
#include <hip/hip_runtime.h>
#include <cstdio>
#include <cstdint>

#ifndef REP_GEMM
#define REP_GEMM 1
#endif
#ifndef REP_MLA
#define REP_MLA 1
#endif
#ifndef REP2_MODE
#define REP2_MODE 0
#endif
#ifndef REP_FOX
#define REP_FOX 1
#endif
#ifndef REP_J
#define REP_J 1
#endif
#ifndef REP_THIN
#define REP_THIN 1
#endif
#define LAS __attribute__((address_space(3)))
typedef unsigned short bf16_t;
typedef short bf16x8 __attribute__((ext_vector_type(8)));
typedef short s16x4 __attribute__((ext_vector_type(4)));
typedef float f32x4 __attribute__((ext_vector_type(4)));
typedef float f32x2_t __attribute__((ext_vector_type(2)));
typedef __bf16 bf16x2_t __attribute__((ext_vector_type(2)));
typedef float f32x16 __attribute__((ext_vector_type(16)));
typedef unsigned u32x4 __attribute__((ext_vector_type(4)));
typedef unsigned u32x2 __attribute__((ext_vector_type(2)));

constexpr int NB = 8, SEQ = 4096, NMETA = 16, LSEQ = 4112, T = NB * LSEQ  , TP = 33024  , DM = 1024;
constexpr int NPANEL = TP / 256;
constexpr int NEXP = 16;
constexpr float ALPHA = 1.41421356237309515f;
constexpr float LOG2E = 1.4426950408889634f;
constexpr float C2F = 0.125f * LOG2E;
constexpr float C2M = 0.14724444602590310f;
constexpr int CSP = 4160;

constexpr size_t MiB = 1ull << 20;
constexpr size_t WS_CTL = 0, CTL_BYTES = 1 * MiB;
constexpr size_t WS_ROPE = 1 * MiB;
constexpr size_t WS_LF = 2 * MiB;
constexpr size_t WS_CS = 4 * MiB;
constexpr size_t WS_TOK = 6 * MiB;
constexpr size_t WS_LIST = 8 * MiB;
constexpr size_t WS_W = 12 * MiB;
constexpr size_t WS_H = 88 * MiB;
constexpr size_t WS_X = 153 * MiB;
constexpr size_t S512 = (size_t)TP * 512 * 2, S768 = (size_t)TP * 768 * 2, S1024 = (size_t)TP * 1024 * 2;
constexpr size_t X_QF = 0, X_KF = S512, X_VF = 2 * S512, X_RAW = 3 * S512, X_QM = 3 * S512 + S768, X_KM = 3 * S512 + 2 * S768,
                 X_VM = 3 * S512 + 3 * S768, X_OM = 4 * S512 + 3 * S768, X_OF = 5 * S512 + 3 * S768, X_END = 6 * S512 + 3 * S768;
constexpr size_t X_GATES = X_KF;
constexpr size_t X_MERGED = X_KM;
constexpr size_t X_Z = X_KF;
constexpr size_t X_H1 = X_KM;
constexpr size_t X_HID = X_QF;
constexpr size_t X_YS = 36 * MiB;
constexpr int NSLOT_TILES = 273, NSLOT = NSLOT_TILES * 256;
constexpr size_t WS_END = WS_X + X_END;
static_assert(X_GATES + (size_t)TP * 2048 * 2 <= X_KM, "gates");
static_assert(X_MERGED + S1024 <= X_OM, "merged");
static_assert(X_HID + (size_t)NSLOT * 256 * 2 <= X_YS, "hid");
static_assert(X_YS + (size_t)NSLOT * 1024 * 2 <= X_KM, "ys");
static_assert(WS_W + 2ull * 19693568ull * 2ull <= WS_H, "weights");
static_assert(WS_H + S1024 <= WS_X, "h");
constexpr size_t W_BT1 = 0, W_BT2 = W_BT1 + 2304ull * 1024, W_FOXO = W_BT2 + 2048ull * 1024, W_MLAO = W_FOXO + 1024ull * 512,
                 W_UQ = W_MLAO + 1024ull * 512, W_UKV = W_UQ + 768ull * 384, W_OUT = W_UKV + 1024ull * 256, W_MOE1 = W_OUT + 1024ull * 1024,
                 W_MOE2 = W_MOE1 + 16ull * 512 * 1024, W_LAYER = W_MOE2 + 16ull * 1024 * 256;
static_assert(W_LAYER == 19693568ull, "weights per layer");
constexpr int CW_BAR = 4096;
constexpr int CW_QCTR = 8192;
constexpr int CW_ECNT = 16384;
constexpr int CW_QKMAX = 20480;

constexpr int RING_BYTES = 131072;
constexpr int MISC_OFF = RING_BYTES;
constexpr int LDS_BYTES = 147456;

__device__ __forceinline__ unsigned pk_bf16(float lo, float hi) { f32x2_t v = {lo, hi}; bf16x2_t b = __builtin_convertvector(v, bf16x2_t); return __builtin_bit_cast(unsigned, b); }
__device__ __forceinline__ float bf_lo(unsigned u) { return __uint_as_float(u << 16); }
__device__ __forceinline__ float bf_hi(unsigned u) { return __uint_as_float(u & 0xffff0000u); }
__device__ __forceinline__ float wave_sum(float v) {
#pragma unroll
    for (int o = 1; o < 64; o <<= 1) v += __shfl_xor(v, o);
    return v;
}
#define LDS_WAIT() asm volatile("s_waitcnt lgkmcnt(0)" ::: "memory")
#define RLX_AGENT __ATOMIC_RELAXED, __HIP_MEMORY_SCOPE_AGENT

#define XB_TMO      128
#define XB_XCNT(j)  (256  + 64 * (j))
#define XB_XSUB(j)  (1280 + 64 * (j))
#define XB_XGEN(j)  (2304 + 64 * (j))
#define XB_TOP      3328
#define XB_TOPGEN   3392
#define XCD_BAR_WORDS 3456
#define XB_SPIN_CAP (1u << 20)
__device__ __forceinline__ unsigned xb_ld(unsigned* p)              { return __hip_atomic_load(p, __ATOMIC_RELAXED, __HIP_MEMORY_SCOPE_AGENT); }
__device__ __forceinline__ unsigned xb_add(unsigned* p, unsigned v) { return __hip_atomic_fetch_add(p, v, __ATOMIC_RELAXED, __HIP_MEMORY_SCOPE_AGENT); }
__device__ __forceinline__ unsigned xb_xcc_id() { return (unsigned)__builtin_amdgcn_s_getreg((3 << 11) | 20) & 0xFu; }
#define XB_SPIN(cond, bar) do { unsigned _sp = 0; while (cond) { __builtin_amdgcn_s_sleep(1); \
    if ((++_sp & 255u) == 0u) { if (xb_ld(&(bar)[XB_TMO])) break; if (_sp > XB_SPIN_CAP) { atomicAdd(&(bar)[XB_TMO], 1u); break; } } } } while (0)
struct XcdBarrier { unsigned* bar; unsigned x; volatile LAS unsigned* st; };
__device__ __forceinline__ XcdBarrier xcd_barrier_post(unsigned* bar, volatile LAS unsigned* st) {
    XcdBarrier b; b.bar = bar; b.x = xb_xcc_id(); b.st = st;
    if (threadIdx.x == 0) (void)xb_add(&bar[XB_XCNT(b.x)], 1u);
    return b;
}
__device__ __forceinline__ void xcd_barrier_complete(unsigned* bar, unsigned x, unsigned& nloc, unsigned& nx) {
    const unsigned G = gridDim.x * gridDim.y * gridDim.z;
    unsigned sum, cnt, mine, sp = 0u;
    for (;;) {
        sum = 0u; cnt = 0u; mine = 0u;
#pragma unroll
        for (unsigned j = 0; j < 16; ++j) { const unsigned c = xb_ld(&bar[XB_XCNT(j)]); sum += c; cnt += (c > 0u) ? 1u : 0u; mine = (j == x) ? c : mine; }
        if (sum == G) break;
        __builtin_amdgcn_s_sleep(1);
        if ((++sp & 255u) == 0u) { if (xb_ld(&bar[XB_TMO])) break; if (sp > XB_SPIN_CAP) { atomicAdd(&bar[XB_TMO], 1u); break; } }
    }
    nloc = mine > 0u ? mine : 1u; nx = cnt > 0u ? cnt : 1u;
}
__device__ __forceinline__ void xcd_barrier(const XcdBarrier& b) {
    asm volatile("s_waitcnt vmcnt(0)" ::: "memory");
    __syncthreads();
    if (threadIdx.x == 0) {
        unsigned* bar = b.bar; unsigned bx = b.x; asm volatile("" : "+s"(bar), "+s"(bx));
        __builtin_amdgcn_s_waitcnt(0);
        unsigned nloc = b.st[0], nx = b.st[1];
        if (nloc == 0u) { xcd_barrier_complete(bar, bx, nloc, nx); b.st[0] = nloc; b.st[1] = nx; }
        const unsigned old = xb_add(&bar[XB_XSUB(bx)], 1u);
        const unsigned gen = old / nloc;
        if (old + 1u == (gen + 1u) * nloc) {
            __builtin_amdgcn_fence(__ATOMIC_RELEASE, "agent");
            asm volatile("s_waitcnt vmcnt(0)" ::: "memory");
            const unsigned og = xb_add(&bar[XB_TOP], 1u);
            const unsigned tg = og / nx;
            if (og + 1u == (tg + 1u) * nx) xb_add(&bar[XB_TOPGEN], 1u);
            else XB_SPIN(xb_ld(&bar[XB_TOPGEN]) == tg, bar);
            __builtin_amdgcn_fence(__ATOMIC_ACQUIRE, "agent");
            xb_add(&bar[XB_XGEN(bx)], 1u);
            asm volatile("s_waitcnt vmcnt(0)" ::: "memory");
        } else {
            XB_SPIN(xb_ld(&bar[XB_XGEN(bx)]) == gen, bar);
            __builtin_amdgcn_fence(__ATOMIC_ACQUIRE, "agent");
            asm volatile("s_waitcnt vmcnt(0)" ::: "memory");
        }
    }
    __syncthreads();
}

namespace pg8 {
constexpr int BM = 256, BK = 64, HALF = 128, HTB = HALF * BK * 2, STAGE_BYTES = 8 * HTB;
__device__ __forceinline__ int lds_byte(int r, int c) { const int st = (r >> 4) * 2 + (c >> 5), rr = r & 15, cc = c & 31, ob = rr * 64 + cc * 2; return st * 1024 + (ob ^ (((ob >> 9) & 1) << 5)); }
__device__ __forceinline__ void stage_rc(int b, int& R, int& C) { const int st = b / 1024, sb = b % 1024, swz = sb ^ (((sb >> 9) & 1) << 5); R = (st >> 1) * 16 + swz / 64; C = (st & 1) * 32 + (swz % 64) / 2; }
__device__ __forceinline__ int perm32(int rho) { const int n = rho >> 4, i = rho & 15; return 8 * (i >> 2) + 4 * n + (i & 3); }
struct Unit { const char* A; const char* B; int pm, pn, aux; };
typedef f32x4 Acc[2][2][4][2];

__device__ __forceinline__ void tile_of(int L, int nM, int nN, int& pm, int& pn) {
    const int nwg = nM * nN; int wgid = L;
    { const int q = nwg / 8, r = nwg % 8, xcd = wgid % 8, off = wgid / 8; wgid = (xcd < r ? xcd * (q + 1) : r * (q + 1) + (xcd - r) * q) + off; }
    const int nig = 8 * nN, gid = wgid / nig, fm = gid * 8, gsz = (nM - fm) < 8 ? (nM - fm) : 8;
    pm = fm + ((wgid % nig) % gsz); pn = (wgid % nig) / gsz;
}

template <class Epi, class Sched, bool GATHER>
__device__ __forceinline__ void gemm_phase(LAS unsigned char* lds, const int K, const int lda, const int ldb, const Sched& S, const Epi& E) {
    int tid_l = threadIdx.x; asm volatile("" : "+v"(tid_l));
    const int tid = tid_l, wid = __builtin_amdgcn_readfirstlane(tid >> 6), lane = tid & 63, wr = wid >> 2, wc = wid & 3, fr = lane & 15, fq = lane >> 4;
    int nt = K / BK; asm volatile("" : "+s"(nt));
    unsigned voA[2][2], voB[2]; int Rr[2], Cc[2];
#pragma unroll
    for (int i = 0; i < 2; ++i) { int R, C; stage_rc(tid * 16 + i * 8192, R, C); const int Rb = Epi::PERM ? ((R & ~31) + perm32(R & 31)) : R;
        Rr[i] = R; Cc[i] = C; voA[0][i] = (unsigned)(R * lda + C) * 2u; voA[1][i] = (unsigned)((R + HALF) * lda + C) * 2u; voB[i] = (unsigned)(Rb * ldb + C) * 2u; }
    const size_t kstep = (size_t)(BK * 2);
    const size_t hstepB = (size_t)HALF * ldb * 2;
    const unsigned ldsw = (unsigned)wid * 1024u;
    const int aoff = lds_byte(wr * 64 + fr, fq * 8), boff = lds_byte(wc * 32 + fr, fq * 8);
#define PG8_SA(b, h) (((b) * 2 + (h)) * HTB)
#define PG8_SB(b, h) ((4 + (b) * 2 + (h)) * HTB)
#define PG8_STAGE2(bufoff, gbase, o0, o1) do { \
        __builtin_amdgcn_global_load_lds((const unsigned*)((const char*)(gbase) + (o0)), (LAS unsigned*)(lds + (bufoff) + ldsw), 16, 0, 0); \
        __builtin_amdgcn_global_load_lds((const unsigned*)((const char*)(gbase) + (o1)), (LAS unsigned*)(lds + (bufoff) + ldsw + 8192), 16, 0, 0); } while (0)
#define PG8_STA(b, h, gbase, VO) PG8_STAGE2(PG8_SA(b, h), gbase, (VO)[h][0], (VO)[h][1])
#define PG8_STB(b, h, gbase) PG8_STAGE2(PG8_SB(b, h), (gbase) + (h) * hstepB, voB[0], voB[1])
#define PG8_LDA(dst, b, h) do { _Pragma("unroll") for (int m = 0; m < 4; ++m) _Pragma("unroll") for (int k = 0; k < 2; ++k) dst[m][k] = *(const LAS bf16x8*)(lds + PG8_SA(b, h) + aoff + m * 2048 + k * 1024); } while (0)
#define PG8_LDB(dst, b, h) do { _Pragma("unroll") for (int n = 0; n < 2; ++n) _Pragma("unroll") for (int k = 0; k < 2; ++k) dst[n][k] = *(const LAS bf16x8*)(lds + PG8_SB(b, h) + boff + n * 2048 + k * 1024); } while (0)
#define PG8_MMA(ai, bj, At, Bt) do { __builtin_amdgcn_s_setprio(1); _Pragma("unroll") for (int m = 0; m < 4; ++m) _Pragma("unroll") for (int n = 0; n < 2; ++n) _Pragma("unroll") for (int k = 0; k < 2; ++k) \
        acc[ai][bj][m][n] = __builtin_amdgcn_mfma_f32_16x16x32_bf16(Bt[n][k], At[m][k], acc[ai][bj][m][n], 0, 0, 0); __builtin_amdgcn_s_setprio(0); } while (0)
#define PG8_WAIT_V(n) asm volatile("s_waitcnt vmcnt(" #n ")" ::: "memory")
#define PG8_WAIT_L(n) asm volatile("s_waitcnt lgkmcnt(" #n ")" ::: "memory")
#define PG8_BAR __builtin_amdgcn_s_barrier()
#define PG8_SCHED __builtin_amdgcn_sched_barrier(0)
    Unit cur, nxt; int ui = 0;
    if (!S.next(0, cur)) return;
    Acc acc;
#pragma unroll
    for (int a = 0; a < 2; ++a)
#pragma unroll
        for (int b = 0; b < 2; ++b)
#pragma unroll
            for (int m = 0; m < 4; ++m)
#pragma unroll
                for (int n = 0; n < 2; ++n) acc[a][b][m][n] = (f32x4){0.f, 0.f, 0.f, 0.f};
    bf16x8 At[4][2], B0[2][2], B1[2][2];
    const char* cA = cur.A; const char* cB = cur.B;
    if constexpr (GATHER) {
#pragma unroll
        for (int h = 0; h < 2; ++h)
#pragma unroll
            for (int i = 0; i < 2; ++i) voA[h][i] = S.row_off(cur, Rr[i] + h * HALF) + (unsigned)Cc[i] * 2u;
    }
    PG8_STB(0, 0, cB); PG8_STB(0, 1, cB); PG8_STA(0, 0, cA, voA); PG8_STA(0, 1, cA, voA);
    if (wr == 1) PG8_BAR;
    PG8_WAIT_V(2); PG8_BAR;
    PG8_STB(1, 0, cB + kstep); PG8_STA(1, 0, cA + kstep, voA); PG8_STB(1, 1, cB + kstep);
    PG8_WAIT_V(6); PG8_BAR;
    for (;;) {
        const bool has_next = S.next(ui + 1, nxt);
        const char* nA = has_next ? nxt.A : cA; const char* nB = has_next ? nxt.B : cB;
        unsigned vnA[2][2];
        if constexpr (GATHER) {
#pragma unroll
            for (int h = 0; h < 2; ++h)
#pragma unroll
                for (int i = 0; i < 2; ++i) vnA[h][i] = has_next ? (S.row_off(nxt, Rr[i] + h * HALF) + (unsigned)Cc[i] * 2u) : voA[h][i];
        }
        for (int t = 0; t < nt; t += 2) {
            const bool last = (t == nt - 2);
            const char* a1 = cA + (size_t)(t + 1) * kstep;
            const char* a2 = last ? nA : cA + (size_t)(t + 2) * kstep; const char* b2 = last ? nB : cB + (size_t)(t + 2) * kstep;
            const char* a3 = a2 + kstep; const char* b3 = b2 + kstep;
            unsigned vs[2][2];
#pragma unroll
            for (int h = 0; h < 2; ++h)
#pragma unroll
                for (int i = 0; i < 2; ++i) { if constexpr (GATHER) vs[h][i] = last ? vnA[h][i] : voA[h][i]; else vs[h][i] = voA[h][i]; }
            PG8_LDB(B0, 0, 0); PG8_LDB(B1, 0, 1); PG8_SCHED; PG8_LDA(At, 0, 0); PG8_STA(1, 1, a1, voA);
            PG8_WAIT_V(8); PG8_WAIT_L(0); PG8_BAR; PG8_MMA(0, 0, At, B0); PG8_MMA(0, 1, At, B1); PG8_BAR; PG8_SCHED;
            PG8_LDA(At, 0, 1); PG8_STB(0, 0, b2); PG8_STB(0, 1, b2); PG8_STA(0, 0, a2, vs);
            PG8_WAIT_V(8); PG8_WAIT_L(0); PG8_BAR; PG8_MMA(1, 0, At, B0); PG8_MMA(1, 1, At, B1); PG8_BAR; PG8_SCHED;
            PG8_LDB(B0, 1, 0); PG8_LDB(B1, 1, 1); PG8_SCHED; PG8_LDA(At, 1, 0); PG8_STA(0, 1, a2, vs);
            PG8_WAIT_V(8); PG8_WAIT_L(0); PG8_BAR; PG8_MMA(0, 0, At, B0); PG8_MMA(0, 1, At, B1); PG8_BAR; PG8_SCHED;
            PG8_LDA(At, 1, 1); PG8_STB(1, 0, b3); PG8_STB(1, 1, b3); PG8_STA(1, 0, a3, vs);
            PG8_WAIT_V(8); PG8_WAIT_L(0); PG8_BAR; PG8_MMA(1, 0, At, B0); PG8_MMA(1, 1, At, B1); PG8_BAR; PG8_SCHED;
        }
        if (wr == 0) PG8_BAR;
        E(acc, cur, wr, wc, fr, fq);
        if (!has_next) break;
#pragma unroll
        for (int a = 0; a < 2; ++a)
#pragma unroll
            for (int b = 0; b < 2; ++b)
#pragma unroll
                for (int m = 0; m < 4; ++m)
#pragma unroll
                    for (int n = 0; n < 2; ++n) acc[a][b][m][n] = (f32x4){0.f, 0.f, 0.f, 0.f};
        cur = nxt; cA = nA; cB = nB; ++ui;
        if constexpr (GATHER) {
#pragma unroll
            for (int h = 0; h < 2; ++h)
#pragma unroll
                for (int i = 0; i < 2; ++i) voA[h][i] = vnA[h][i];
        }
        if (wr == 1) PG8_BAR;
    }
    PG8_WAIT_V(0);
    PG8_BAR;
#undef PG8_SA
#undef PG8_SB
#undef PG8_STAGE2
#undef PG8_STA
#undef PG8_STB
#undef PG8_LDA
#undef PG8_LDB
#undef PG8_MMA
#undef PG8_WAIT_V
#undef PG8_WAIT_L
#undef PG8_BAR
#undef PG8_SCHED
}

struct SchedStatic {
    const char* A; const char* B; int nM, nN, G, c; size_t astep, bstep;
    __device__ __forceinline__ bool next(int i, Unit& u) const {
        const long L = (long)i * G + c; if (L >= (long)nM * nN) return false;
        int pm, pn; tile_of((int)L, nM, nN, pm, pn);
        u.pm = pm; u.pn = pn; u.aux = 0; u.A = A + (size_t)pm * astep; u.B = B + (size_t)pn * bstep; return true;
    }
    __device__ __forceinline__ unsigned row_off(const Unit&, int) const { return 0u; }
};
struct SchedOut {
    const char* A0; const char* A1; const char* B0; const char* B1; int nM, nN, G, c; size_t astep, bstep;
    __device__ __forceinline__ bool next(int i, Unit& u) const {
        const long L = (long)(i >> 1) * G + c; if (L >= (long)nM * nN) return false;
        int pm, pn; tile_of((int)L, nM, nN, pm, pn);
        const int pass = i & 1;
        u.pm = pm; u.pn = pn; u.aux = pass; u.A = (pass ? A1 : A0) + (size_t)pm * astep; u.B = (pass ? B1 : B0) + (size_t)pn * bstep; return true;
    }
    __device__ __forceinline__ unsigned row_off(const Unit&, int) const { return 0u; }
};
struct SchedMoe {
    const char* A; const char* B; const LAS int* tb; const LAS int* cnt; const int* list; int npn_shift, G, c; size_t bstep_e, bstep_n, astep; bool gather;
    __device__ __forceinline__ bool next(int i, Unit& u) const {
        const int L = i * G + c; const int ntile = tb[16];
        if (L >= (ntile << npn_shift)) return false;
        const int ti = L >> npn_shift, pn = L & ((1 << npn_shift) - 1);
        int e = 0; while (ti >= tb[e + 1]) ++e;
        u.pm = ti; u.pn = pn; u.aux = e;
        u.A = gather ? A : A + (size_t)ti * astep;
        u.B = B + (size_t)e * bstep_e + (size_t)pn * bstep_n; return true;
    }
    __device__ __forceinline__ unsigned row_off(const Unit& u, int r) const {
        const int e = u.aux; int idx = (u.pm - tb[e]) * 256 + r; const int ce = cnt[e]; idx = idx < ce ? idx : ce - 1;
        const int tok = list[(size_t)e * TP + idx];
        return (unsigned)tok * (unsigned)(DM * 2);
    }
};

__device__ __forceinline__ u32x4 pack8(f32x4 v0, f32x4 v1) { u32x4 w; w.x = pk_bf16(v0[0], v0[1]); w.y = pk_bf16(v0[2], v0[3]); w.z = pk_bf16(v1[0], v1[1]); w.w = pk_bf16(v1[2], v1[3]); return w; }
__device__ __forceinline__ float logsig(float x) { return fminf(x, 0.f) - log1pf(__expf(-fabsf(x))); }
__device__ __forceinline__ float sigm(float x) { return 1.0f / (1.0f + __expf(-x)); }

struct EpiA1 {
    static constexpr bool PERM = true;
    bf16_t *Qf, *Kf, *Vf, *RAW; float* LF; const float* fbias;
    __device__ __forceinline__ void operator()(const Acc& acc, const Unit& u, int wr, int wc, int fr, int fq) const {
        const int pn = u.pn; bf16_t* base; int ldc, colt; float sc = 1.f;
        if (pn < 2) { base = Qf; ldc = 512; colt = pn * 256; sc = C2F; } else if (pn < 4) { base = Kf; ldc = 512; colt = (pn - 2) * 256; }
        else if (pn < 6) { base = Vf; ldc = 512; colt = (pn - 4) * 256; } else { base = RAW; ldc = 768; colt = (pn - 6) * 256; }
        const int row0 = u.pm * 256 + wr * 64 + fr, col0 = colt + wc * 32 + 8 * fq;
#pragma unroll
        for (int ai = 0; ai < 2; ++ai)
#pragma unroll
            for (int m = 0; m < 4; ++m) { bf16_t* rowp = base + (size_t)(row0 + ai * 128 + m * 16) * ldc + col0;
#pragma unroll
                for (int bj = 0; bj < 2; ++bj) *(u32x4*)(rowp + bj * 128) = pack8(acc[ai][bj][m][0] * sc, acc[ai][bj][m][1] * sc); }
        if (pn == 8 && wc == 1 && fq == 0) {
            const f32x4 b0 = *(const f32x4*)fbias, b1 = *(const f32x4*)(fbias + 4);
#pragma unroll
            for (int ai = 0; ai < 2; ++ai)
#pragma unroll
                for (int m = 0; m < 4; ++m) { const int row = row0 + ai * 128 + m * 16; const f32x4 a = acc[ai][1][m][0] + b0, b = acc[ai][1][m][1] + b1;
                    f32x4 o0, o1;
#pragma unroll
                    for (int j = 0; j < 4; ++j) { o0[j] = logsig(a[j]); o1[j] = logsig(b[j]); }
                    *(f32x4*)(LF + (size_t)row * 8) = o0; *(f32x4*)(LF + (size_t)row * 8 + 4) = o1; }
        }
    }
};
struct EpiA2 {
    static constexpr bool PERM = true;
    bf16_t* G;
    __device__ __forceinline__ void operator()(const Acc& acc, const Unit& u, int wr, int wc, int fr, int fq) const {
        const int row0 = u.pm * 256 + wr * 64 + fr, col0 = u.pn * 256 + wc * 32 + 8 * fq;
#pragma unroll
        for (int ai = 0; ai < 2; ++ai)
#pragma unroll
            for (int m = 0; m < 4; ++m) { bf16_t* rowp = G + (size_t)(row0 + ai * 128 + m * 16) * 2048 + col0;
#pragma unroll
                for (int bj = 0; bj < 2; ++bj) { f32x4 a = acc[ai][bj][m][0], b = acc[ai][bj][m][1];
#pragma unroll
                    for (int j = 0; j < 4; ++j) { a[j] = sigm(a[j]); b[j] = sigm(b[j]); }
                    *(u32x4*)(rowp + bj * 128) = pack8(a, b); } }
    }
};
struct EpiQup {
    static constexpr bool PERM = false;
    bf16_t* Qm; const float* cosT; const float* sinT;
    __device__ __forceinline__ void operator()(const Acc& acc, const Unit& u, int wr, int wc, int fr, int fq) const {
        const int row0 = u.pm * 256 + wr * 64 + fr;
#pragma unroll
        for (int ai = 0; ai < 2; ++ai)
#pragma unroll
            for (int m = 0; m < 4; ++m) { const int row = row0 + ai * 128 + m * 16; const int pos = row % LSEQ;
#pragma unroll
                for (int bj = 0; bj < 2; ++bj) { const int Gi = u.pn * 8 + bj * 4 + wc; f32x4 x0 = acc[ai][bj][m][0], x1 = acc[ai][bj][m][1];
                    if (Gi % 3 == 2) { const f32x4 cs = *(const f32x4*)(cosT + pos * 16 + 4 * fq), sn = *(const f32x4*)(sinT + pos * 16 + 4 * fq);
                        const f32x4 y0 = x0 * cs - x1 * sn, y1 = x1 * cs + x0 * sn; x0 = y0; x1 = y1; }
                    x0 = x0 * C2M; x1 = x1 * C2M;
                    bf16_t* p = Qm + (size_t)row * 768 + Gi * 32 + 4 * fq;
                    u32x2 w0, w1; w0.x = pk_bf16(x0[0], x0[1]); w0.y = pk_bf16(x0[2], x0[3]); w1.x = pk_bf16(x1[0], x1[1]); w1.y = pk_bf16(x1[2], x1[3]);
                    *(u32x2*)p = w0; *(u32x2*)(p + 16) = w1; } }
    }
};
struct EpiKV {
    static constexpr bool PERM = true;
    bf16_t *Km, *Vm;
    __device__ __forceinline__ void operator()(const Acc& acc, const Unit& u, int wr, int wc, int fr, int fq) const {
        const int row0 = u.pm * 256 + wr * 64 + fr;
#pragma unroll
        for (int ai = 0; ai < 2; ++ai)
#pragma unroll
            for (int m = 0; m < 4; ++m) { const int row = row0 + ai * 128 + m * 16;
#pragma unroll
                for (int bj = 0; bj < 2; ++bj) { const int n = u.pn * 256 + bj * 128 + wc * 32 + 8 * fq; const u32x4 w = pack8(acc[ai][bj][m][0], acc[ai][bj][m][1]);
                    if (u.pn < 2) *(u32x4*)(Km + (size_t)row * 768 + 96 * (n >> 6) + (n & 63)) = w;
                    else *(u32x4*)(Vm + (size_t)row * 512 + (n - 512)) = w; } }
    }
};
struct EpiOut {
    static constexpr bool PERM = true;
    const bf16_t* G; bf16_t* Mg;
    __device__ __forceinline__ void operator()(const Acc& acc, const Unit& u, int wr, int wc, int fr, int fq) const {
        const int row0 = u.pm * 256 + wr * 64 + fr, col0 = u.pn * 256 + wc * 32 + 8 * fq; const int pass = u.aux;
#pragma unroll
        for (int ai = 0; ai < 2; ++ai)
#pragma unroll
            for (int m = 0; m < 4; ++m) { const int row = row0 + ai * 128 + m * 16;
#pragma unroll
                for (int bj = 0; bj < 2; ++bj) { const int col = col0 + bj * 128;
                    const u32x4 g = *(const u32x4*)(G + (size_t)row * 2048 + pass * 1024 + col);
                    f32x4 a = acc[ai][bj][m][0], b = acc[ai][bj][m][1];
                    a[0] *= bf_lo(g.x); a[1] *= bf_hi(g.x); a[2] *= bf_lo(g.y); a[3] *= bf_hi(g.y); b[0] *= bf_lo(g.z); b[1] *= bf_hi(g.z); b[2] *= bf_lo(g.w); b[3] *= bf_hi(g.w);
                    bf16_t* mp = Mg + (size_t)row * 1024 + col;
                    if (pass) { const u32x4 p = *(const u32x4*)mp;
                        a[0] += bf_lo(p.x); a[1] += bf_hi(p.x); a[2] += bf_lo(p.y); a[3] += bf_hi(p.y); b[0] += bf_lo(p.z); b[1] += bf_hi(p.z); b[2] += bf_lo(p.w); b[3] += bf_hi(p.w); }
                    *(u32x4*)mp = pack8(a, b); } }
    }
};
struct EpiF {
    static constexpr bool PERM = false;
    const bf16_t* H; float* Z;
    __device__ __forceinline__ void operator()(const Acc& acc, const Unit& u, int wr, int wc, int fr, int fq) const {
        const int row0 = u.pm * 256 + wr * 64 + fr, col0 = u.pn * 256 + wc * 32 + 4 * fq;
#pragma unroll
        for (int ai = 0; ai < 2; ++ai)
#pragma unroll
            for (int m = 0; m < 4; ++m) { const size_t off = (size_t)(row0 + ai * 128 + m * 16) * 1024 + col0;
#pragma unroll
                for (int bj = 0; bj < 2; ++bj)
#pragma unroll
                    for (int n = 0; n < 2; ++n) { const u32x2 hv = *(const u32x2*)(H + off + bj * 128 + n * 16); f32x4 o = acc[ai][bj][m][n];
                        o[0] += ALPHA * bf_lo(hv.x); o[1] += ALPHA * bf_hi(hv.x); o[2] += ALPHA * bf_lo(hv.y); o[3] += ALPHA * bf_hi(hv.y);
                        *(f32x4*)(Z + off + bj * 128 + n * 16) = o; } }
    }
};
struct EpiM1 {
    static constexpr bool PERM = false;
    bf16_t* Hid;
    __device__ __forceinline__ void operator()(const Acc& acc, const Unit& u, int wr, int wc, int fr, int fq) const {
        const int row0 = u.pm * 256 + wr * 64 + fr, hc0 = u.pn * 128 + wc * 16 + 4 * fq;
#pragma unroll
        for (int ai = 0; ai < 2; ++ai)
#pragma unroll
            for (int m = 0; m < 4; ++m) { bf16_t* rowp = Hid + (size_t)(row0 + ai * 128 + m * 16) * 256 + hc0;
#pragma unroll
                for (int bj = 0; bj < 2; ++bj) { const f32x4 g = acc[ai][bj][m][0], up = acc[ai][bj][m][1]; f32x4 o;
#pragma unroll
                    for (int j = 0; j < 4; ++j) o[j] = g[j] * sigm(g[j]) * up[j];
                    u32x2 w; w.x = pk_bf16(o[0], o[1]); w.y = pk_bf16(o[2], o[3]); *(u32x2*)(rowp + bj * 64) = w; } }
    }
};
struct EpiM2 {
    static constexpr bool PERM = true;
    bf16_t* Ys;
    __device__ __forceinline__ void operator()(const Acc& acc, const Unit& u, int wr, int wc, int fr, int fq) const {
        const int row0 = u.pm * 256 + wr * 64 + fr, col0 = u.pn * 256 + wc * 32 + 8 * fq;
#pragma unroll
        for (int ai = 0; ai < 2; ++ai)
#pragma unroll
            for (int m = 0; m < 4; ++m) { bf16_t* rowp = Ys + (size_t)(row0 + ai * 128 + m * 16) * 1024 + col0;
#pragma unroll
                for (int bj = 0; bj < 2; ++bj) *(u32x4*)(rowp + bj * 128) = pack8(acc[ai][bj][m][0], acc[ai][bj][m][1]); }
    }
};
}

__device__ __forceinline__ int crow(int r, int hi) { return (r & 3) + 8 * (r >> 2) + 4 * hi; }
typedef short v4i16_t __attribute__((ext_vector_type(4)));
__device__ __forceinline__ s16x4 vtr(const LAS char* p) { return __builtin_bit_cast(s16x4, __builtin_amdgcn_ds_read_tr16_b64_v4i16((LAS v4i16_t*)p)); }
__device__ __forceinline__ float swapmax(float m) { auto rr = __builtin_amdgcn_permlane32_swap(__float_as_uint(m), __float_as_uint(m), false, false); return fmaxf(__uint_as_float(rr[0]), __uint_as_float(rr[1])); }
__device__ __forceinline__ float swapsum(float m) { auto rr = __builtin_amdgcn_permlane32_swap(__float_as_uint(m), __float_as_uint(m), false, false); return __uint_as_float(rr[0]) + __uint_as_float(rr[1]); }

template <int DK, bool FOX>
__device__ __forceinline__ void attn_unit(LAS char* lds, const bf16_t* Q, int ldq, const bf16_t* Kp, int ldk, const bf16_t* Vp, int ldv, bf16_t* O, int ldo,
                                          const float* cs, int b, int q0, int nvalid) {
    constexpr int NS = DK / 16, KB = 64 * DK * 2, BUF = KB + 8192 + 256;
    int tid_l = threadIdx.x; asm volatile("" : "+v"(tid_l));
    const int tid = tid_l, lane = tid & 63, r32 = lane & 31, hi = lane >> 5; const int wid = __builtin_amdgcn_readfirstlane(tid >> 6);
    const size_t rowbase = (size_t)b * LSEQ;
    const int qpos = q0 + 32 * wid + r32;
    const bool wave_on = (32 * wid) < nvalid;
    bf16x8 qf[NS];
#pragma unroll
    for (int s = 0; s < NS; ++s) qf[s] = *(const bf16x8*)(Q + (rowbase + qpos) * ldq + 16 * s + 8 * hi);
    float csq = 0.f; if (FOX) csq = cs[qpos];
    const int NT = (q0 + nvalid + 63) >> 6;
    const int skv = tid >> 3, sch = tid & 7;
    const bf16_t* kg = Kp + (rowbase + skv) * ldk + 8 * sch;
    const bf16_t* vg = Vp + (rowbase + skv) * ldv + 8 * sch;
    const int kdst = sch * 1024 + ((skv ^ sch) << 4);
    const int vdst = KB + ((sch >> 2) * 8 + (skv >> 3)) * 512 + (skv & 7) * 64 + (sch & 3) * 16;
    const int skv2 = tid >> 2, sch2 = 8 + (tid & 3);
    const bf16_t* kg2 = Kp + (rowbase + (skv2 & 63)) * ldk + 8 * sch2;
    const int kdst2 = sch2 * 1024 + (((skv2 & 63) ^ (sch2 & 7)) << 4);
    u32x4 kr0, kr1 = {0u, 0u, 0u, 0u}, vr0; f32x4 cr = {0.f, 0.f, 0.f, 0.f};
#define ATT_LOAD(t) do { kr0 = *(const u32x4*)(kg + (size_t)(t) * 64 * ldk); vr0 = *(const u32x4*)(vg + (size_t)(t) * 64 * ldv); \
        if (DK == 96 && tid < 256) kr1 = *(const u32x4*)(kg2 + (size_t)(t) * 64 * ldk); \
        if (FOX && tid < 16) cr = *(const f32x4*)(cs + (t) * 64 + 4 * tid); } while (0)
#define ATT_STORE(bufp) do { *(LAS u32x4*)((bufp) + kdst) = kr0; *(LAS u32x4*)((bufp) + vdst) = vr0; \
        if (DK == 96 && tid < 256) *(LAS u32x4*)((bufp) + kdst2) = kr1; \
        if (FOX && tid < 16) *(LAS f32x4*)((bufp) + KB + 8192 + 16 * tid) = cr; } while (0)
    ATT_LOAD(0);
    ATT_STORE(lds);
    __syncthreads();
    float mrun = -INFINITY, lrun = 0.f;
    f32x16 o0 = {}, o1 = {};
    const int vlane = ((lane >> 4) & 1) * 32 + (lane & 3) * 8 + (4 * hi + ((lane & 15) >> 2)) * 64;
    for (int t = 0; t < NT; ++t) {
        LAS char* cb = lds + (t & 1) * BUF; LAS char* nb = lds + ((t + 1) & 1) * BUF;
        const bool more = (t + 1 < NT);
        if (more) ATT_LOAD(t + 1);
        const bool active = wave_on && (64 * t <= q0 + 32 * wid + 31);
        if (active) {
            f32x16 p0 = {}, p1 = {};
#pragma unroll
            for (int s = 0; s < NS; ++s) {
                const int c = 2 * s + hi;
                const bf16x8 a0 = *(const LAS bf16x8*)(cb + c * 1024 + ((r32 ^ (c & 7)) << 4));
                const bf16x8 a1 = *(const LAS bf16x8*)(cb + c * 1024 + (((r32 + 32) ^ (c & 7)) << 4));
                p0 = __builtin_amdgcn_mfma_f32_32x32x16_bf16(a0, qf[s], p0, 0, 0, 0);
                p1 = __builtin_amdgcn_mfma_f32_32x32x16_bf16(a1, qf[s], p1, 0, 0, 0);
            }
            if (FOX) {
                const LAS float* cl = (const LAS float*)(cb + KB + 8192);
#pragma unroll
                for (int g = 0; g < 4; ++g) { const f32x4 c0 = *(const LAS f32x4*)(cl + 8 * g + 4 * hi), c1 = *(const LAS f32x4*)(cl + 32 + 8 * g + 4 * hi);
#pragma unroll
                    for (int j = 0; j < 4; ++j) { p0[4 * g + j] += csq - c0[j]; p1[4 * g + j] += csq - c1[j]; } }
            }
            if (64 * t + 63 > q0 + 32 * wid) {
                const int kb = 64 * t + 4 * hi;
#pragma unroll
                for (int r = 0; r < 16; ++r) { const int kv = kb + (r & 3) + 8 * (r >> 2); if (kv > qpos) p0[r] = -INFINITY; if (kv + 32 > qpos) p1[r] = -INFINITY; }
            }
            float mt = fmaxf(p0[0], p1[0]);
#pragma unroll
            for (int r = 1; r < 16; ++r) mt = fmaxf(mt, fmaxf(p0[r], p1[r]));
            mt = swapmax(mt);
            const float mnew = fmaxf(mrun, mt);
            const float alpha = __builtin_amdgcn_exp2f(mrun - mnew);
            mrun = mnew;
            float ls = 0.f;
#pragma unroll
            for (int r = 0; r < 16; ++r) { p0[r] = __builtin_amdgcn_exp2f(p0[r] - mnew); p1[r] = __builtin_amdgcn_exp2f(p1[r] - mnew); ls += p0[r] + p1[r]; }
            lrun = lrun * alpha + ls;
#pragma unroll
            for (int r = 0; r < 16; ++r) { o0[r] *= alpha; o1[r] *= alpha; }
            bf16x8 pb[4];
#pragma unroll
            for (int s = 0; s < 2; ++s) {
                u32x4 w; w.x = pk_bf16(p0[8 * s], p0[8 * s + 1]); w.y = pk_bf16(p0[8 * s + 2], p0[8 * s + 3]); w.z = pk_bf16(p0[8 * s + 4], p0[8 * s + 5]); w.w = pk_bf16(p0[8 * s + 6], p0[8 * s + 7]);
                pb[s] = __builtin_bit_cast(bf16x8, w);
                u32x4 w2; w2.x = pk_bf16(p1[8 * s], p1[8 * s + 1]); w2.y = pk_bf16(p1[8 * s + 2], p1[8 * s + 3]); w2.z = pk_bf16(p1[8 * s + 4], p1[8 * s + 5]); w2.w = pk_bf16(p1[8 * s + 6], p1[8 * s + 7]);
                pb[2 + s] = __builtin_bit_cast(bf16x8, w2);
            }
            const LAS char* vb = cb + KB + vlane;
#pragma unroll
            for (int ks = 0; ks < 4; ++ks) {
                const s16x4 l0 = vtr(vb + ks * 1024), h0 = vtr(vb + ks * 1024 + 512);
                const s16x4 l1 = vtr(vb + 4096 + ks * 1024), h1 = vtr(vb + 4096 + ks * 1024 + 512);
                const bf16x8 a0 = (bf16x8){l0[0], l0[1], l0[2], l0[3], h0[0], h0[1], h0[2], h0[3]};
                const bf16x8 a1 = (bf16x8){l1[0], l1[1], l1[2], l1[3], h1[0], h1[1], h1[2], h1[3]};
                o0 = __builtin_amdgcn_mfma_f32_32x32x16_bf16(a0, pb[ks], o0, 0, 0, 0);
                o1 = __builtin_amdgcn_mfma_f32_32x32x16_bf16(a1, pb[ks], o1, 0, 0, 0);
            }
        }
        if (more) ATT_STORE(nb);
        __syncthreads();
    }
#undef ATT_LOAD
#undef ATT_STORE
    if (wave_on) {
        const float lt = swapsum(lrun);
        const float inv = 1.0f / lt;
        if (32 * wid + r32 < nvalid) {
            bf16_t* op = O + (rowbase + qpos) * ldo;
#pragma unroll
            for (int g = 0; g < 4; ++g) {
                u32x2 w0, w1;
                w0.x = pk_bf16(o0[4 * g] * inv, o0[4 * g + 1] * inv); w0.y = pk_bf16(o0[4 * g + 2] * inv, o0[4 * g + 3] * inv);
                w1.x = pk_bf16(o1[4 * g] * inv, o1[4 * g + 1] * inv); w1.y = pk_bf16(o1[4 * g + 2] * inv, o1[4 * g + 3] * inv);
                *(u32x2*)(op + 8 * g + 4 * hi) = w0; *(u32x2*)(op + 32 + 8 * g + 4 * hi) = w1;
            }
        }
    }
}

template <int DK, bool FOX, int MODE = 0>
__device__ __forceinline__ void attn_unit2(LAS char* lds, const bf16_t* Q, int ldq, const bf16_t* Kp, int ldk, const bf16_t* Vp, int ldv, bf16_t* O, int ldo,
                                           const float* cs, int b, int j, int tau_min) {
    constexpr int NS = DK / 16, KB = 64 * DK * 2, SB = KB + 8192 + 256;
    constexpr float THR = 8.0f;
    int tid_l = threadIdx.x; asm volatile("" : "+v"(tid_l));
    const int tid = tid_l, lane = tid & 63, r32 = lane & 31, hi = lane >> 5; const int wid = __builtin_amdgcn_readfirstlane(tid >> 6);
    const size_t rowbase = (size_t)b * LSEQ;
    const int qp0 = (j == 0) ? 0 : 16 + 256 * (j - 1) + 32 * wid;
    const int qpos = qp0 + r32;
    const bool wave_on = (j > 0) || (wid == 0);
    const int tdiag = (j == 0) ? 0 : 4 * (j - 1) + 1 + (wid >> 1);
    const int qin = (j == 0) ? r32 : 32 * (wid & 1) + r32;
    const int NT = 4 * j + 1;
    bf16x8 qf[NS];
#pragma unroll
    for (int s = 0; s < NS; ++s) qf[s] = *(const bf16x8*)(Q + (rowbase + qpos) * ldq + 16 * s + 8 * hi);
    float csq = 0.f; if (FOX) csq = cs[qpos];
    const bf16_t* kg = Kp + (rowbase + lane) * ldk + 8 * wid;
    const bf16_t* kg2 = Kp + (rowbase + lane) * ldk + 8 * (8 + (wid & 3));
    const bf16_t* vg = Vp + (rowbase + 16 * (wid & 3) + 8 * (lane >> 5) + ((lane >> 2) & 7)) * ldv + 32 * (wid >> 2) + 8 * (lane & 3);
    const int nops = 2 + ((DK == 96) ? (wid < 4 ? 1 : 0) : (FOX ? (wid == 4 ? 1 : 0) : 0));
#define ATT_ISSUE(t, slot) do { const int ts_ = ((t) == 0) ? 0 : 64 * (t) - 48; LAS char* sb_ = lds + (slot) * SB; \
        __builtin_amdgcn_global_load_lds((const unsigned*)(kg + (size_t)ts_ * ldk), (LAS unsigned*)(sb_ + wid * 1024), 16, 0, 0); \
        __builtin_amdgcn_global_load_lds((const unsigned*)(vg + (size_t)ts_ * ldv), (LAS unsigned*)(sb_ + KB + (wid >> 2) * 4096 + (wid & 3) * 1024), 16, 0, 0); \
        if (DK == 96) { if (wid < 4) __builtin_amdgcn_global_load_lds((const unsigned*)(kg2 + (size_t)ts_ * ldk), (LAS unsigned*)(sb_ + (8 + wid) * 1024), 16, 0, 0); } \
        else if (FOX) { if (wid == 4) { if (lane < 16) __builtin_amdgcn_global_load_lds((const unsigned*)(cs + ts_ + 4 * lane), (LAS unsigned*)(sb_ + KB + 8192), 16, 0, 0); } } } while (0)
    int t = NT - 1;
    int slot = 0;
    if (MODE != 2) { ATT_ISSUE(t, 0);
    if (t - 1 >= tau_min) ATT_ISSUE(t - 1, 1); }
    float mhat = 0.f, lrun = 0.f;
    f32x16 o0 = {}, o1 = {};
    const int vlane = ((lane >> 4) & 1) * 32 + (lane & 3) * 8 + (4 * hi + ((lane & 15) >> 2)) * 64;
    bool started = false;
    for (; t >= tau_min; --t) {
        if (MODE != 2) { if (t - 1 >= tau_min) { if (nops == 3) asm volatile("s_waitcnt vmcnt(3)" ::: "memory"); else asm volatile("s_waitcnt vmcnt(2)" ::: "memory"); }
        else asm volatile("s_waitcnt vmcnt(0)" ::: "memory"); }
        __builtin_amdgcn_s_barrier(); asm volatile("" ::: "memory");
        { const int s2 = (slot >= 1) ? slot - 1 : 2;
          if (MODE != 2) { if (t - 2 >= tau_min) ATT_ISSUE(t - 2, s2); } }
        const LAS char* cb = lds + slot * SB;
        if (MODE != 1 && wave_on && t <= tdiag) {
            f32x16 p0, p1;
            if (FOX) {
                const LAS float* cl = (const LAS float*)(cb + KB + 8192); const float base = csq - mhat;
#pragma unroll
                for (int g = 0; g < 4; ++g) { const f32x4 c0 = *(const LAS f32x4*)(cl + 8 * g + 4 * hi), c1 = *(const LAS f32x4*)(cl + 32 + 8 * g + 4 * hi);
#pragma unroll
                    for (int jj = 0; jj < 4; ++jj) { p0[4 * g + jj] = base - c0[jj]; p1[4 * g + jj] = base - c1[jj]; } }
            } else {
                const float nm = -mhat;
#pragma unroll
                for (int r = 0; r < 16; ++r) { p0[r] = nm; p1[r] = nm; }
            }
            bf16x8 ka[NS][2];
#pragma unroll
            for (int s = 0; s < NS; ++s) { const int c = 2 * s + hi; ka[s][0] = *(const LAS bf16x8*)(cb + c * 1024 + r32 * 16); ka[s][1] = *(const LAS bf16x8*)(cb + c * 1024 + 512 + r32 * 16); }
            __builtin_amdgcn_sched_barrier(0);
#pragma unroll
            for (int s = 0; s < NS; ++s) { p0 = __builtin_amdgcn_mfma_f32_32x32x16_bf16(ka[s][0], qf[s], p0, 0, 0, 0); p1 = __builtin_amdgcn_mfma_f32_32x32x16_bf16(ka[s][1], qf[s], p1, 0, 0, 0); }
            __builtin_amdgcn_sched_barrier(0);
            const LAS char* vb = cb + KB + vlane;
            s16x4 vl0[4], vh0[4], vl1[4], vh1[4];
#pragma unroll
            for (int ks = 0; ks < 4; ++ks) { vl0[ks] = vtr(vb + ks * 1024); vh0[ks] = vtr(vb + ks * 1024 + 512); vl1[ks] = vtr(vb + 4096 + ks * 1024); vh1[ks] = vtr(vb + 4096 + ks * 1024 + 512); }
            __builtin_amdgcn_sched_barrier(0);
            if (t == tdiag) {
#pragma unroll
                for (int r = 0; r < 16; ++r) { const int kv = 4 * hi + (r & 3) + 8 * (r >> 2); if (kv > qin) p0[r] = -INFINITY; if (kv + 32 > qin) p1[r] = -INFINITY; }
            }
            if (t == 0) {
#pragma unroll
                for (int r = 0; r < 16; ++r) { const int kv = 4 * hi + (r & 3) + 8 * (r >> 2); if (kv >= 16) p0[r] = -INFINITY; p1[r] = -INFINITY; }
            }
            float mt = fmaxf(p0[0], p1[0]);
#pragma unroll
            for (int r = 1; r < 16; ++r) mt = fmaxf(mt, fmaxf(p0[r], p1[r]));
            mt = swapmax(mt);
            if (!started) {
                started = true; mhat = mt;
#pragma unroll
                for (int r = 0; r < 16; ++r) { p0[r] -= mt; p1[r] -= mt; }
            } else if (__any(mt > THR)) {
                const float dl = fmaxf(mt, 0.f); mhat += dl; const float f = __builtin_amdgcn_exp2f(-dl); lrun *= f;
#pragma unroll
                for (int r = 0; r < 16; ++r) { p0[r] -= dl; p1[r] -= dl; o0[r] *= f; o1[r] *= f; }
            }
            float ls = 0.f;
#pragma unroll
            for (int r = 0; r < 16; ++r) { p0[r] = __builtin_amdgcn_exp2f(p0[r]); p1[r] = __builtin_amdgcn_exp2f(p1[r]); ls += p0[r] + p1[r]; }
            lrun += ls;
            bf16x8 pb[4];
#pragma unroll
            for (int s = 0; s < 2; ++s) {
                u32x4 w; w.x = pk_bf16(p0[8 * s], p0[8 * s + 1]); w.y = pk_bf16(p0[8 * s + 2], p0[8 * s + 3]); w.z = pk_bf16(p0[8 * s + 4], p0[8 * s + 5]); w.w = pk_bf16(p0[8 * s + 6], p0[8 * s + 7]);
                pb[s] = __builtin_bit_cast(bf16x8, w);
                u32x4 w2; w2.x = pk_bf16(p1[8 * s], p1[8 * s + 1]); w2.y = pk_bf16(p1[8 * s + 2], p1[8 * s + 3]); w2.z = pk_bf16(p1[8 * s + 4], p1[8 * s + 5]); w2.w = pk_bf16(p1[8 * s + 6], p1[8 * s + 7]);
                pb[2 + s] = __builtin_bit_cast(bf16x8, w2);
            }
            __builtin_amdgcn_sched_barrier(0);
#pragma unroll
            for (int ks = 0; ks < 4; ++ks) {
                const bf16x8 a0 = (bf16x8){vl0[ks][0], vl0[ks][1], vl0[ks][2], vl0[ks][3], vh0[ks][0], vh0[ks][1], vh0[ks][2], vh0[ks][3]};
                const bf16x8 a1 = (bf16x8){vl1[ks][0], vl1[ks][1], vl1[ks][2], vl1[ks][3], vh1[ks][0], vh1[ks][1], vh1[ks][2], vh1[ks][3]};
                o0 = __builtin_amdgcn_mfma_f32_32x32x16_bf16(a0, pb[ks], o0, 0, 0, 0);
                o1 = __builtin_amdgcn_mfma_f32_32x32x16_bf16(a1, pb[ks], o1, 0, 0, 0);
            }
        }
        slot = (slot == 2) ? 0 : slot + 1;
    }
#undef ATT_ISSUE
    if (MODE != 1 && wave_on) {
        const float lt = swapsum(lrun);
        const float inv = 1.0f / lt;
        if (j > 0 || r32 < 16) {
            bf16_t* op = O + (rowbase + qpos) * ldo;
#pragma unroll
            for (int g = 0; g < 4; ++g) {
                u32x2 w0, w1;
                w0.x = pk_bf16(o0[4 * g] * inv, o0[4 * g + 1] * inv); w0.y = pk_bf16(o0[4 * g + 2] * inv, o0[4 * g + 3] * inv);
                w1.x = pk_bf16(o1[4 * g] * inv, o1[4 * g + 1] * inv); w1.y = pk_bf16(o1[4 * g + 2] * inv, o1[4 * g + 3] * inv);
                *(u32x2*)(op + 8 * g + 4 * hi) = w0; *(u32x2*)(op + 32 + 8 * g + 4 * hi) = w1;
            }
        }
    }
    asm volatile("s_waitcnt lgkmcnt(0)" ::: "memory");
    __builtin_amdgcn_s_barrier(); asm volatile("" ::: "memory");
}

struct Args { const float* in[22]; float* out; unsigned char* ws; };
struct Frame {
    LAS unsigned char* lds; volatile LAS unsigned* MISC; unsigned* ctl;
    int tid, lane, wave, vcu, G;
};

__device__ __forceinline__ void tr_item(const float* colp, int ld, const float* kscale, bf16_t* dst, int K, int n0, int k0, LAS float* scr, int lane) {
#pragma unroll
    for (int i = 0; i < 32; ++i) { const int kk = 2 * i + (lane >> 5); float v = colp ? colp[(size_t)(k0 + kk) * ld] : 0.f; if (kscale) v *= kscale[k0 + kk]; scr[kk * 33 + (lane & 31)] = v; }
    LDS_WAIT(); asm volatile("" ::: "memory");
    const int c = lane & 7;
#pragma unroll
    for (int j = 0; j < 4; ++j) { const int n = (lane >> 3) + 8 * j; const LAS float* s = scr + (8 * c) * 33 + n;
        u32x4 o; o.x = pk_bf16(s[0 * 33], s[1 * 33]); o.y = pk_bf16(s[2 * 33], s[3 * 33]); o.z = pk_bf16(s[4 * 33], s[5 * 33]); o.w = pk_bf16(s[6 * 33], s[7 * 33]);
        *(u32x4*)(dst + (size_t)(n0 + n) * K + k0 + 8 * c) = o; }
    LDS_WAIT(); asm volatile("" ::: "memory");
}
constexpr int ITEMS_PER_LAYER = 9616;
__device__ __forceinline__ void convert_item(const Args& a, bf16_t* W, int l, int r, LAS float* scr, int lane) {
    const int w = lane & 31;
    if (r < 1152) { const int kb = r / 72, nb = r % 72, n = nb * 32 + w; int col;
        if (n < 1536) col = n; else { const int j = n - 1536; col = j < 384 ? 1544 + j : j < 640 ? 1928 + (j - 384) : j < 672 ? 2184 + (j - 640) : j < 680 ? 1536 + (j - 672) : -1; }
        const float* src = a.in[4] + (size_t)l * 1024 * 4264;
        tr_item(col >= 0 ? src + col : nullptr, 4264, nullptr, W + W_BT1, 1024, nb * 32, kb * 64, scr, lane); return; }
    r -= 1152;
    if (r < 1024) { const int kb = r / 64, nb = r % 64, n = nb * 32 + w; const float* src = a.in[4] + (size_t)l * 1024 * 4264;
        tr_item(src + 2216 + n, 4264, nullptr, W + W_BT2, 1024, nb * 32, kb * 64, scr, lane); return; }
    r -= 1024;
    if (r < 256) { const int kb = r / 32, nb = r % 32, n = nb * 32 + w; tr_item(a.in[6] + (size_t)l * 512 * 1024 + n, 1024, nullptr, W + W_FOXO, 512, nb * 32, kb * 64, scr, lane); return; }
    r -= 256;
    if (r < 256) { const int kb = r / 32, nb = r % 32, n = nb * 32 + w; tr_item(a.in[11] + (size_t)l * 512 * 1024 + n, 1024, nullptr, W + W_MLAO, 512, nb * 32, kb * 64, scr, lane); return; }
    r -= 256;
    if (r < 144) { const int kb = r / 24, nb = r % 24, n = nb * 32 + w; tr_item(a.in[8] + (size_t)l * 384 * 768 + n, 768, a.in[7] + l * 384, W + W_UQ, 384, nb * 32, kb * 64, scr, lane); return; }
    r -= 144;
    if (r < 128) { const int kb = r / 32, nb = r % 32, n = nb * 32 + w; const int col = n < 512 ? (n >> 6) * 128 + (n & 63) : ((n - 512) >> 6) * 128 + 64 + (n & 63);
        tr_item(a.in[10] + (size_t)l * 256 * 1024 + col, 1024, a.in[9] + l * 256, W + W_UKV, 256, nb * 32, kb * 64, scr, lane); return; }
    r -= 128;
    if (r < 512) { const int kb = r / 32, nb = r % 32, n = nb * 32 + w; tr_item(a.in[12] + (size_t)l * 1024 * 1024 + n, 1024, nullptr, W + W_OUT, 1024, nb * 32, kb * 64, scr, lane); return; }
    r -= 512;
    if (r < 4096) { const int e = r / 256, rr = r % 256, kb = rr / 16, nb = rr % 16;
        const float* src = (w < 16 ? a.in[17] : a.in[18]) + ((size_t)(l * 16 + e) * 1024) * 256 + 16 * nb + (w & 15);
        tr_item(src, 256, nullptr, W + W_MOE1 + (size_t)e * 512 * 1024, 1024, nb * 32, kb * 64, scr, lane); return; }
    r -= 4096;
    { const int e = r / 128, rr = r % 128, kb = rr / 32, nb = rr % 32, n = nb * 32 + w;
        tr_item(a.in[19] + ((size_t)(l * 16 + e) * 256) * 1024 + n, 1024, nullptr, W + W_MOE2 + (size_t)e * 1024 * 256, 256, nb * 32, kb * 64, scr, lane); }
}

__device__ __forceinline__ void ln16(f32x4 (&v)[4], const float* g, const float* bta, int lane) {
    float s = 0.f;
#pragma unroll
    for (int j = 0; j < 4; ++j) s += (v[j][0] + v[j][1]) + (v[j][2] + v[j][3]);
    const float mean = wave_sum(s) * (1.f / DM); float s2 = 0.f;
#pragma unroll
    for (int j = 0; j < 4; ++j) { v[j] = v[j] - mean; s2 += (v[j][0] * v[j][0] + v[j][1] * v[j][1]) + (v[j][2] * v[j][2] + v[j][3] * v[j][3]); }
    const float rstd = 1.0f / sqrtf(wave_sum(s2) * (1.f / DM) + 1e-5f);
#pragma unroll
    for (int j = 0; j < 4; ++j) { const f32x4 gg = *(const f32x4*)(g + 4 * lane + 256 * j), bb = *(const f32x4*)(bta + 4 * lane + 256 * j); v[j] = v[j] * rstd * gg + bb; }
}
template <int R>
__device__ __forceinline__ void ln16xR(f32x4 (&v)[R][4], const float* g, const float* bta, int lane) {
    float s[R];
#pragma unroll
    for (int k = 0; k < R; ++k) { s[k] = 0.f;
#pragma unroll
        for (int j = 0; j < 4; ++j) s[k] += (v[k][j][0] + v[k][j][1]) + (v[k][j][2] + v[k][j][3]); }
#pragma unroll
    for (int o = 1; o < 64; o <<= 1) {
#pragma unroll
        for (int k = 0; k < R; ++k) s[k] += __shfl_xor(s[k], o); }
    float s2[R];
#pragma unroll
    for (int k = 0; k < R; ++k) { const float mean = s[k] * (1.f / DM); s2[k] = 0.f;
#pragma unroll
        for (int j = 0; j < 4; ++j) { v[k][j] = v[k][j] - mean; s2[k] += (v[k][j][0] * v[k][j][0] + v[k][j][1] * v[k][j][1]) + (v[k][j][2] * v[k][j][2] + v[k][j][3] * v[k][j][3]); } }
#pragma unroll
    for (int o = 1; o < 64; o <<= 1) {
#pragma unroll
        for (int k = 0; k < R; ++k) s2[k] += __shfl_xor(s2[k], o); }
#pragma unroll
    for (int j = 0; j < 4; ++j) { const f32x4 gg = *(const f32x4*)(g + 4 * lane + 256 * j), bb = *(const f32x4*)(bta + 4 * lane + 256 * j);
#pragma unroll
        for (int k = 0; k < R; ++k) { const float rstd = 1.0f / sqrtf(s2[k] * (1.f / DM) + 1e-5f); v[k][j] = v[k][j] * rstd * gg + bb; } }
}
__device__ __forceinline__ void store_row_bf16(bf16_t* orow, const f32x4 (&v)[4], int lane) {
#pragma unroll
    for (int j = 0; j < 4; ++j) { u32x2 w; w.x = pk_bf16(v[j][0], v[j][1]); w.y = pk_bf16(v[j][2], v[j][3]); *(u32x2*)(orow + 4 * lane + 256 * j) = w; }
}

__device__ const double ROPE_INV_REV[16] = {0.15915494309189535, 0.08949940160889101, 0.050329212104487035, 0.0283021958306234, 0.015915494309189534, 0.008949940160889102,
    0.005032921210448704, 0.00283021958306234, 0.0015915494309189536, 0.0008949940160889102, 0.0005032921210448703, 0.00028302195830623395, 0.00015915494309189535,
    8.949940160889102e-05, 5.0329212104487035e-05, 2.8302195830623396e-05};

__global__ void __launch_bounds__(512, 2) fwd_kernel(Args args) {
    extern __shared__ __attribute__((aligned(16))) unsigned char lds_raw[];
    Frame F;
    F.lds = (LAS unsigned char*)lds_raw;
    F.MISC = (volatile LAS unsigned*)(F.lds + MISC_OFF);
    F.tid = threadIdx.x; F.lane = F.tid & 63; F.wave = __builtin_amdgcn_readfirstlane(F.tid >> 6);
    F.G = gridDim.x; { const int bx = blockIdx.x; F.vcu = (F.G % 8 == 0) ? (bx % 8) * (F.G / 8) + bx / 8 : bx; }
    unsigned char* ws = args.ws;
    F.ctl = (unsigned*)(ws + WS_CTL);
    for (int u = F.tid; u < (LDS_BYTES - MISC_OFF) / 4; u += 512) ((LAS unsigned*)(F.lds + MISC_OFF))[u] = 0u;
    __syncthreads();
    XcdBarrier bar = xcd_barrier_post(F.ctl + CW_BAR, F.MISC);
    const int NGW = F.G * 8;
#define PHASE_IDS int tid = threadIdx.x; asm volatile("" : "+v"(tid)); const int lane = tid & 63; const int wave = __builtin_amdgcn_readfirstlane(tid >> 6); const int gw = F.vcu * 8 + wave; (void)lane; (void)gw;

#define PHASE_PTRS unsigned char* wsl = args.ws; asm volatile("" : "+s"(wsl)); \
    float* ropeC = (float*)(wsl + WS_ROPE); float* ropeS = ropeC + LSEQ * 16; float* LFp = (float*)(wsl + WS_LF); float* CSp = (float*)(wsl + WS_CS); \
    unsigned* TOK = (unsigned*)(wsl + WS_TOK); int* LIST = (int*)(wsl + WS_LIST); bf16_t* Wall = (bf16_t*)(wsl + WS_W); bf16_t* HB = (bf16_t*)(wsl + WS_H); unsigned char* X = wsl + WS_X; \
    bf16_t *Qf = (bf16_t*)(X + X_QF), *Kf = (bf16_t*)(X + X_KF), *Vf = (bf16_t*)(X + X_VF), *RAW = (bf16_t*)(X + X_RAW), *Qm = (bf16_t*)(X + X_QM), *Km = (bf16_t*)(X + X_KM), \
           *Vm = (bf16_t*)(X + X_VM), *Om = (bf16_t*)(X + X_OM), *Of = (bf16_t*)(X + X_OF), *GATES = (bf16_t*)(X + X_GATES), *MERGED = (bf16_t*)(X + X_MERGED), *H1 = (bf16_t*)(X + X_H1), \
           *HID = (bf16_t*)(X + X_HID), *YS = (bf16_t*)(X + X_YS); float* Zb = (float*)(X + X_Z); unsigned* ctl = (unsigned*)(wsl + WS_CTL); \
    (void)ropeC; (void)ropeS; (void)LFp; (void)CSp; (void)TOK; (void)LIST; (void)Wall; (void)HB; (void)Qf; (void)Kf; (void)Vf; (void)RAW; (void)Qm; (void)Km; (void)Vm; (void)Om; (void)Of; (void)GATES; (void)MERGED; (void)H1; (void)HID; (void)YS; (void)Zb; (void)ctl;

    {
        PHASE_IDS
        PHASE_PTRS
        LAS float* scr = (LAS float*)(F.lds + wave * 16384);
        for (int it = gw; it < 2 * ITEMS_PER_LAYER; it += NGW) { const int l = it / ITEMS_PER_LAYER, r = it % ITEMS_PER_LAYER; convert_item(args, Wall + (size_t)l * W_LAYER, l, r, scr, lane); }
        for (int r4 = gw * 4; r4 < TP; r4 += NGW * 4) {
            if (r4 >= T) {
#pragma unroll
                for (int k = 0; k < 4; ++k) { bf16_t* orow = HB + (size_t)(r4 + k) * DM; *(u32x4*)(orow + 8 * lane) = (u32x4){0u, 0u, 0u, 0u}; *(u32x4*)(orow + 512 + 8 * lane) = (u32x4){0u, 0u, 0u, 0u}; }
                continue; }
            f32x4 v[4][4];
#pragma unroll
            for (int k = 0; k < 4; ++k) { const int row = r4 + k; const int b = row / LSEQ, p = row % LSEQ;
                const float* src = p < NMETA ? args.in[1] + (size_t)p * DM : args.in[0] + ((size_t)b * SEQ + (p - NMETA)) * DM;
#pragma unroll
                for (int j = 0; j < 4; ++j) v[k][j] = *(const f32x4*)(src + 4 * lane + 256 * j); }
            ln16xR<4>(v, args.in[2], args.in[3], lane);
#pragma unroll
            for (int k = 0; k < 4; ++k) store_row_bf16(HB + (size_t)(r4 + k) * DM, v[k], lane);
        }
        for (int idx = blockIdx.x * 512 + tid; idx < LSEQ * 16; idx += F.G * 512) {
            const int p = idx >> 4, i = idx & 15; double x = (double)p * ROPE_INV_REV[i]; x -= floor(x); const float xr = (float)x;
            ropeC[idx] = __builtin_amdgcn_cosf(xr); ropeS[idx] = __builtin_amdgcn_sinf(xr);
        }
    }
    xcd_barrier(bar);

    for (int l = 0; l < 2; ++l) {
        for (int rep_ = 0; rep_ < REP_GEMM; ++rep_) {
        {
            PHASE_PTRS const bf16_t* W = Wall + (size_t)l * W_LAYER;
            pg8::SchedStatic S{(const char*)HB, (const char*)(W + W_BT1), NPANEL, 9, F.G, (int)blockIdx.x, (size_t)256 * DM * 2, (size_t)256 * DM * 2};
            pg8::EpiA1 E{Qf, Kf, Vf, RAW, LFp, args.in[5] + l * 8};
            pg8::gemm_phase<pg8::EpiA1, pg8::SchedStatic, false>(F.lds, 1024, 1024, 1024, S, E);
        }
        xcd_barrier(bar);
        }
        for (int rep_ = 0; rep_ < REP_THIN; ++rep_) {
        {
            PHASE_IDS
            PHASE_PTRS
            if (blockIdx.x < 64 && wave == 0) {
                const int bb = blockIdx.x >> 3, hh = blockIdx.x & 7; float carry = 0.f;
                for (int i0 = 0; i0 < 65; i0 += 13) {
                    float v[13];
#pragma unroll
                    for (int k = 0; k < 13; ++k) { const int p = 64 * (i0 + k) + lane; v[k] = p < LSEQ ? LFp[((size_t)bb * LSEQ + p) * 8 + hh] : 0.f; }
#pragma unroll
                    for (int k = 0; k < 13; ++k) { float x = v[k];
#pragma unroll
                        for (int d = 1; d < 64; d <<= 1) { const float y = __shfl_up(x, d); if (lane >= d) x += y; }
                        x += carry; carry = __shfl(x, 63);
                        CSp[(size_t)blockIdx.x * CSP + 64 * (i0 + k) + lane] = x * LOG2E; }
                }
            }
            LAS unsigned* qkl = (LAS unsigned*)F.lds;
            if (tid < 128) qkl[tid] = 0u;
            __syncthreads();
            for (int r4 = gw * 4; r4 < T; r4 += NGW * 4) {
                u32x4 qv[4], kv2[4];
#pragma unroll
                for (int k = 0; k < 4; ++k) { qv[k] = *(const u32x4*)(Qf + (size_t)(r4 + k) * 512 + 8 * lane); kv2[k] = *(const u32x4*)(Kf + (size_t)(r4 + k) * 512 + 8 * lane); }
                float sq[4], sk[4];
#pragma unroll
                for (int k = 0; k < 4; ++k) {
                    const float a0 = bf_lo(qv[k].x), a1 = bf_hi(qv[k].x), a2 = bf_lo(qv[k].y), a3 = bf_hi(qv[k].y), a4 = bf_lo(qv[k].z), a5 = bf_hi(qv[k].z), a6 = bf_lo(qv[k].w), a7 = bf_hi(qv[k].w);
                    const float c0 = bf_lo(kv2[k].x), c1 = bf_hi(kv2[k].x), c2 = bf_lo(kv2[k].y), c3 = bf_hi(kv2[k].y), c4 = bf_lo(kv2[k].z), c5 = bf_hi(kv2[k].z), c6 = bf_lo(kv2[k].w), c7 = bf_hi(kv2[k].w);
                    sq[k] = (a0 * a0 + a1 * a1) + (a2 * a2 + a3 * a3) + (a4 * a4 + a5 * a5) + (a6 * a6 + a7 * a7);
                    sk[k] = (c0 * c0 + c1 * c1) + (c2 * c2 + c3 * c3) + (c4 * c4 + c5 * c5) + (c6 * c6 + c7 * c7); }
#pragma unroll
                for (int o = 1; o < 8; o <<= 1) {
#pragma unroll
                    for (int k = 0; k < 4; ++k) { sq[k] += __shfl_xor(sq[k], o); sk[k] += __shfl_xor(sk[k], o); } }
                if ((lane & 7) == 0) {
#pragma unroll
                    for (int k = 0; k < 4; ++k) { const int bh = ((r4 + k) / LSEQ) * 8 + (lane >> 3);
                        atomicMax((unsigned*)&qkl[2 * bh], __float_as_uint(sq[k])); atomicMax((unsigned*)&qkl[2 * bh + 1], __float_as_uint(sk[k])); } }
            }
            __syncthreads();
            if (tid < 128) { const unsigned v = qkl[tid]; if (v) __hip_atomic_fetch_max(ctl + CW_QKMAX + 128 * l + tid, v, RLX_AGENT); }
            for (int r4 = gw * 4; r4 < TP; r4 += NGW * 4) {
                u32x4 q[4], kv[4]; u32x2 ka[4], kc[4];
#pragma unroll
                for (int k = 0; k < 4; ++k) { const bf16_t* raw = RAW + (size_t)(r4 + k) * 768;
                    q[k] = (u32x4){0u, 0u, 0u, 0u}; kv[k] = (u32x4){0u, 0u, 0u, 0u}; ka[k] = (u32x2){0u, 0u}; kc[k] = (u32x2){0u, 0u};
                    if (lane < 48) q[k] = *(const u32x4*)(raw + 8 * lane);
                    if (lane < 32) kv[k] = *(const u32x4*)(raw + 384 + 8 * lane);
                    if (lane < 4) { ka[k] = *(const u32x2*)(raw + 640 + 4 * lane); kc[k] = *(const u32x2*)(raw + 656 + 4 * lane); } }
                float fq_[4][8], fk_[4][8], sq[4], sk[4];
#pragma unroll
                for (int k = 0; k < 4; ++k) {
                    fq_[k][0] = bf_lo(q[k].x); fq_[k][1] = bf_hi(q[k].x); fq_[k][2] = bf_lo(q[k].y); fq_[k][3] = bf_hi(q[k].y); fq_[k][4] = bf_lo(q[k].z); fq_[k][5] = bf_hi(q[k].z); fq_[k][6] = bf_lo(q[k].w); fq_[k][7] = bf_hi(q[k].w);
                    fk_[k][0] = bf_lo(kv[k].x); fk_[k][1] = bf_hi(kv[k].x); fk_[k][2] = bf_lo(kv[k].y); fk_[k][3] = bf_hi(kv[k].y); fk_[k][4] = bf_lo(kv[k].z); fk_[k][5] = bf_hi(kv[k].z); fk_[k][6] = bf_lo(kv[k].w); fk_[k][7] = bf_hi(kv[k].w);
                    sq[k] = 0.f; sk[k] = 0.f;
#pragma unroll
                    for (int j = 0; j < 8; ++j) { sq[k] += fq_[k][j] * fq_[k][j]; sk[k] += fk_[k][j] * fk_[k][j]; } }
#pragma unroll
                for (int o = 1; o < 64; o <<= 1) {
#pragma unroll
                    for (int k = 0; k < 4; ++k) { sq[k] += __shfl_xor(sq[k], o); sk[k] += __shfl_xor(sk[k], o); } }
#pragma unroll
                for (int k = 0; k < 4; ++k) { bf16_t* raw = RAW + (size_t)(r4 + k) * 768; const int pos = (r4 + k) % LSEQ;
                    const float rq = 1.0f / sqrtf(sq[k] * (1.f / 384.f) + 1e-6f), rk = 1.0f / sqrtf(sk[k] * (1.f / 256.f) + 1e-6f);
                    if (lane < 48) { u32x4 o; o.x = pk_bf16(fq_[k][0] * rq, fq_[k][1] * rq); o.y = pk_bf16(fq_[k][2] * rq, fq_[k][3] * rq); o.z = pk_bf16(fq_[k][4] * rq, fq_[k][5] * rq); o.w = pk_bf16(fq_[k][6] * rq, fq_[k][7] * rq); *(u32x4*)(raw + 8 * lane) = o; }
                    if (lane < 32) { u32x4 o; o.x = pk_bf16(fk_[k][0] * rk, fk_[k][1] * rk); o.y = pk_bf16(fk_[k][2] * rk, fk_[k][3] * rk); o.z = pk_bf16(fk_[k][4] * rk, fk_[k][5] * rk); o.w = pk_bf16(fk_[k][6] * rk, fk_[k][7] * rk); *(u32x4*)(raw + 384 + 8 * lane) = o; }
                    if (lane < 4) {
                        const u32x2 a = ka[k], c = kc[k];
                        const f32x4 x1 = {bf_lo(a.x), bf_hi(a.x), bf_lo(a.y), bf_hi(a.y)}, x2 = {bf_lo(c.x), bf_hi(c.x), bf_lo(c.y), bf_hi(c.y)};
                        const f32x4 cs = *(const f32x4*)(ropeC + pos * 16 + 4 * lane), sn = *(const f32x4*)(ropeS + pos * 16 + 4 * lane);
                        const f32x4 y1 = x1 * cs - x2 * sn, y2 = x2 * cs + x1 * sn;
                        u32x2 w1, w2; w1.x = pk_bf16(y1[0], y1[1]); w1.y = pk_bf16(y1[2], y1[3]); w2.x = pk_bf16(y2[0], y2[1]); w2.y = pk_bf16(y2[2], y2[3]);
                        bf16_t* kp = Km + (size_t)(r4 + k) * 768 + 64 + 4 * lane;
#pragma unroll
                        for (int h = 0; h < 8; ++h) { *(u32x2*)(kp + 96 * h) = w1; *(u32x2*)(kp + 96 * h + 16) = w2; }
                    } }
            }
        }
        xcd_barrier(bar);
        }
        for (int rep_ = 0; rep_ < REP_GEMM; ++rep_) {
        {
            PHASE_PTRS const bf16_t* W = Wall + (size_t)l * W_LAYER;
            pg8::SchedStatic S{(const char*)RAW, (const char*)(W + W_UQ), NPANEL, 3, F.G, (int)blockIdx.x, (size_t)256 * 768 * 2, (size_t)256 * 384 * 2};
            pg8::EpiQup E{Qm, ropeC, ropeS};
            pg8::gemm_phase<pg8::EpiQup, pg8::SchedStatic, false>(F.lds, 384, 768, 384, S, E);
        }
        {
            PHASE_PTRS const bf16_t* W = Wall + (size_t)l * W_LAYER;
            pg8::SchedStatic S{(const char*)(RAW + 384), (const char*)(W + W_UKV), NPANEL, 4, F.G, (int)blockIdx.x, (size_t)256 * 768 * 2, (size_t)256 * 256 * 2};
            pg8::EpiKV E{Km, Vm};
            pg8::gemm_phase<pg8::EpiKV, pg8::SchedStatic, false>(F.lds, 256, 768, 256, S, E);
        }
        xcd_barrier(bar);
        }
        {
            PHASE_IDS
            PHASE_PTRS
            const int myx = (int)(xb_xcc_id() & 7u);
            for (int rep_ = 0; rep_ < REP_MLA; ++rep_)
            for (int xo = 0; xo < 8; ++xo) { const int x = (myx + xo) & 7; unsigned* qc = ctl + CW_QCTR + 64 * ((rep_ * 4 + l * 2) * 8 + x);
                for (;;) {
                    if (tid == 0) F.MISC[4] = __hip_atomic_fetch_add(qc, 1u, RLX_AGENT);
                    __syncthreads();
                    const int id = (int)F.MISC[4];
                    __syncthreads();
                    if (id >= 136) break;
                    const int g = id / 34, i = id % 34, j = 16 - (i >> 1), h = 2 * g + (i & 1), b = x;
                    if (rep_ == 0) attn_unit2<96, false>((LAS char*)F.lds, Qm + 96 * h, 768, Km + 96 * h, 768, Vm + 64 * h, 512, Om + 64 * h, 512, nullptr, b, j, 0);
                    else attn_unit2<96, false, REP2_MODE>((LAS char*)F.lds, Qm + 96 * h, 768, Km + 96 * h, 768, Vm + 64 * h, 512, (bf16_t*)args.out + 64 * h, 512, nullptr, b, j, 0);
                } }
            for (int rep_ = 0; rep_ < REP_FOX; ++rep_)
            for (int xo = 0; xo < 8; ++xo) { const int x = (myx + xo) & 7; unsigned* qc = ctl + CW_QCTR + 64 * ((rep_ * 4 + l * 2 + 1) * 8 + x);
                for (;;) {
                    if (tid == 0) F.MISC[4] = __hip_atomic_fetch_add(qc, 1u, RLX_AGENT);
                    __syncthreads();
                    const int id = (int)F.MISC[4];
                    __syncthreads();
                    if (id >= 136) break;
                    const int g = id / 34, i = id % 34, j = 16 - (i >> 1), h = 2 * g + (i & 1), b = x;
                    int tmin = 0;
                    if (j > 0) {
                        const float* csr = CSp + (size_t)(b * 8 + h) * CSP;
                        const float q2 = __uint_as_float(__hip_atomic_load(ctl + CW_QKMAX + 128 * l + (b * 8 + h) * 2, RLX_AGENT)), k2 = __uint_as_float(__hip_atomic_load(ctl + CW_QKMAX + 128 * l + (b * 8 + h) * 2 + 1, RLX_AGENT));
                        const float qk = 2.0f * sqrtf(q2 * k2) * 1.0001f + 0.01f;
                        const float cq = csr[16 + 256 * (j - 1)];
                        const float ck = csr[lane == 0 ? 15 : 64 * lane + 15];
                        const bool ok = (qk + cq - ck) >= -100.0f;
                        const unsigned long long m = __ballot(ok);
                        tmin = m ? (int)__builtin_ctzll(m) : 64;
                        const int tfirst = 4 * (j - 1) + 1; tmin = tmin < tfirst ? tmin : tfirst;
                    }
                    tmin = __builtin_amdgcn_readfirstlane(tmin);
                    if (rep_ == 0) attn_unit2<64, true>((LAS char*)F.lds, Qf + 64 * h, 512, Kf + 64 * h, 512, Vf + 64 * h, 512, Of + 64 * h, 512, CSp + (size_t)(b * 8 + h) * CSP, b, j, tmin);
                    else attn_unit2<64, true, REP2_MODE>((LAS char*)F.lds, Qf + 64 * h, 512, Kf + 64 * h, 512, Vf + 64 * h, 512, (bf16_t*)args.out + 64 * h, 512, CSp + (size_t)(b * 8 + h) * CSP, b, j, 0);
                } }
        }
        xcd_barrier(bar);
        for (int rep_ = 0; rep_ < REP_GEMM; ++rep_) {
        {
            PHASE_PTRS const bf16_t* W = Wall + (size_t)l * W_LAYER;
            pg8::SchedStatic S{(const char*)HB, (const char*)(W + W_BT2), NPANEL, 8, F.G, (int)blockIdx.x, (size_t)256 * DM * 2, (size_t)256 * DM * 2};
            pg8::EpiA2 E{GATES};
            pg8::gemm_phase<pg8::EpiA2, pg8::SchedStatic, false>(F.lds, 1024, 1024, 1024, S, E);
        }
        xcd_barrier(bar);
        }
        for (int rep_ = 0; rep_ < REP_GEMM; ++rep_) {
        {
            PHASE_PTRS const bf16_t* W = Wall + (size_t)l * W_LAYER;
            pg8::SchedOut S{(const char*)Of, (const char*)Om, (const char*)(W + W_FOXO), (const char*)(W + W_MLAO), NPANEL, 4, F.G, (int)blockIdx.x, (size_t)256 * 512 * 2, (size_t)256 * 512 * 2};
            pg8::EpiOut E{GATES, MERGED};
            pg8::gemm_phase<pg8::EpiOut, pg8::SchedOut, false>(F.lds, 512, 512, 512, S, E);
        }
        xcd_barrier(bar);
        }
        for (int rep_ = 0; rep_ < REP_GEMM; ++rep_) {
        {
            PHASE_PTRS const bf16_t* W = Wall + (size_t)l * W_LAYER;
            pg8::SchedStatic S{(const char*)MERGED, (const char*)(W + W_OUT), NPANEL, 4, F.G, (int)blockIdx.x, (size_t)256 * DM * 2, (size_t)256 * DM * 2};
            pg8::EpiF E{HB, Zb};
            pg8::gemm_phase<pg8::EpiF, pg8::SchedStatic, false>(F.lds, 1024, 1024, 1024, S, E);
        }
        xcd_barrier(bar);
        }
        {
            PHASE_IDS
            PHASE_PTRS
            LAS float* rwT = (LAS float*)F.lds;
            LAS int* lcnt = (LAS int*)(F.lds + 65536);
            LAS int* gbase = lcnt + 16;
            LAS int* tE = lcnt + 64;
            LAS int* tP = tE + 272;
            LAS float* tG = (LAS float*)(tP + 272);
            const float* rw = args.in[15];
            for (int i = tid; i < 16384; i += 512) { const int col = i >> 4, e = i & 15; rwT[e * 1024 + col] = rw[i]; }
            if (tid < 16) lcnt[tid] = 0;
            __syncthreads();
            const int r0 = blockIdx.x * 129, nrows = (r0 + 129 <= T) ? 129 : (T > r0 ? T - r0 : 0);
            const float* rb = args.in[16];
            for (int g4 = wave * 4; g4 < nrows; g4 += 32) {
                f32x4 v[4][4];
#pragma unroll
                for (int k = 0; k < 4; ++k) { const int lr = (g4 + k < nrows) ? g4 + k : nrows - 1; const int row = r0 + lr;
#pragma unroll
                    for (int j = 0; j < 4; ++j) v[k][j] = *(const f32x4*)(Zb + (size_t)row * DM + 4 * lane + 256 * j); }
                ln16xR<4>(v, args.in[13] + l * DM, args.in[14] + l * DM, lane);
#pragma unroll
                for (int k = 0; k < 4; ++k) if (g4 + k < nrows) store_row_bf16(H1 + (size_t)(r0 + g4 + k) * DM, v[k], lane);
                float s[4][16];
#pragma unroll
                for (int e = 0; e < 16; ++e) {
                    f32x4 wv[4];
#pragma unroll
                    for (int j = 0; j < 4; ++j) wv[j] = *(const LAS f32x4*)(rwT + e * 1024 + 4 * lane + 256 * j);
#pragma unroll
                    for (int k = 0; k < 4; ++k) { float a = 0.f;
#pragma unroll
                        for (int j = 0; j < 4; ++j) a += (v[k][j][0] * wv[j][0] + v[k][j][1] * wv[j][1]) + (v[k][j][2] * wv[j][2] + v[k][j][3] * wv[j][3]);
                        s[k][e] = a; }
                }
#pragma unroll
                for (int k = 0; k < 4; ++k) {
#pragma unroll
                    for (int i = 0; i < 8; ++i) { const bool up = (lane & 32) != 0; const float mine = up ? s[k][i + 8] : s[k][i], oth = up ? s[k][i] : s[k][i + 8]; s[k][i] = mine + __shfl_xor(oth, 32); }
#pragma unroll
                    for (int i = 0; i < 4; ++i) { const bool up = (lane & 16) != 0; const float mine = up ? s[k][i + 4] : s[k][i], oth = up ? s[k][i] : s[k][i + 4]; s[k][i] = mine + __shfl_xor(oth, 16); }
#pragma unroll
                    for (int i = 0; i < 2; ++i) { const bool up = (lane & 8) != 0; const float mine = up ? s[k][i + 2] : s[k][i], oth = up ? s[k][i] : s[k][i + 2]; s[k][i] = mine + __shfl_xor(oth, 8); }
                    { const bool up = (lane & 4) != 0; const float mine = up ? s[k][1] : s[k][0], oth = up ? s[k][0] : s[k][1]; s[k][0] = mine + __shfl_xor(oth, 4); }
                    s[k][0] += __shfl_xor(s[k][0], 2); s[k][0] += __shfl_xor(s[k][0], 1);
                }
#pragma unroll
                for (int k = 0; k < 4; ++k) {
                    float lg[16];
#pragma unroll
                    for (int e = 0; e < 16; ++e) lg[e] = __int_as_float(__builtin_amdgcn_readlane(__float_as_int(s[k][0]), 4 * e));
                    float sc[16], bi[16];
#pragma unroll
                    for (int e = 0; e < 16; ++e) { sc[e] = 1.0f / (1.0f + expf(-lg[e])); bi[e] = sc[e] + rb[e]; }
                    int gsel = 0; float gbest = -INFINITY;
#pragma unroll
                    for (int g = 0; g < 4; ++g) { float m1 = bi[4 * g], m2 = -INFINITY;
#pragma unroll
                        for (int kk = 1; kk < 4; ++kk) { const float x = bi[4 * g + kk]; if (x > m1) { m2 = m1; m1 = x; } else if (x > m2) m2 = x; }
                        const float gs = m1 + m2; if (gs > gbest) { gbest = gs; gsel = g; } }
                    float b4[4], s4[4];
#pragma unroll
                    for (int kk = 0; kk < 4; ++kk) { b4[kk] = gsel == 0 ? bi[kk] : gsel == 1 ? bi[4 + kk] : gsel == 2 ? bi[8 + kk] : bi[12 + kk]; s4[kk] = gsel == 0 ? sc[kk] : gsel == 1 ? sc[4 + kk] : gsel == 2 ? sc[8 + kk] : sc[12 + kk]; }
                    int i1 = 0; float bb1 = b4[0], ss1 = s4[0];
#pragma unroll
                    for (int kk = 1; kk < 4; ++kk) if (b4[kk] > bb1) { bb1 = b4[kk]; ss1 = s4[kk]; i1 = kk; }
                    int i2 = -1; float bb2 = -INFINITY, ss2 = 0.f;
#pragma unroll
                    for (int kk = 0; kk < 4; ++kk) if (kk != i1 && b4[kk] > bb2) { bb2 = b4[kk]; ss2 = s4[kk]; i2 = kk; }
                    const float inv = 1.0f / (ss1 + ss2);
                    if (lane == 0 && g4 + k < nrows) {
                        const int lr = g4 + k; const int e0 = gsel * 4 + i1, e1 = gsel * 4 + i2;
                        tE[2 * lr] = e0; tE[2 * lr + 1] = e1;
                        tP[2 * lr] = atomicAdd((int*)&lcnt[e0], 1); tP[2 * lr + 1] = atomicAdd((int*)&lcnt[e1], 1);
                        tG[2 * lr] = ss1 * inv; tG[2 * lr + 1] = ss2 * inv;
                    }
                }
            }
            __syncthreads();
            if (tid < 16) gbase[tid] = (int)__hip_atomic_fetch_add(ctl + CW_ECNT + 64 * (l * 16 + tid), (unsigned)lcnt[tid], RLX_AGENT);
            __syncthreads();
            if (tid < nrows) {
                const int row = r0 + tid; const int e0 = tE[2 * tid], e1 = tE[2 * tid + 1];
                const int p0 = gbase[e0] + tP[2 * tid], p1 = gbase[e1] + tP[2 * tid + 1];
                LIST[(size_t)e0 * TP + p0] = row; LIST[(size_t)e1 * TP + p1] = row;
                u32x4 w0; w0.x = (unsigned)e0; w0.y = (unsigned)p0; w0.z = (unsigned)e1; w0.w = (unsigned)p1;
                *(u32x4*)(TOK + (size_t)row * 8) = w0;
                u32x2 w1; w1.x = __float_as_uint(tG[2 * tid]); w1.y = __float_as_uint(tG[2 * tid + 1]);
                *(u32x2*)(TOK + (size_t)row * 8 + 4) = w1;
            }
        }
        xcd_barrier(bar);
        LAS int* tb = (LAS int*)(F.lds + MISC_OFF) + 16; LAS int* ecnt = (LAS int*)(F.lds + MISC_OFF) + 64;
        if (threadIdx.x == 0) { int acc = 0; for (int e = 0; e < 16; ++e) { const int c = (int)__hip_atomic_load(F.ctl + CW_ECNT + 64 * (l * 16 + e), RLX_AGENT); ecnt[e] = c; tb[e] = acc; acc += (c + 255) >> 8; } tb[16] = acc; }
        __syncthreads();
        for (int rep_ = 0; rep_ < REP_GEMM; ++rep_) {
        {
            PHASE_PTRS const bf16_t* W = Wall + (size_t)l * W_LAYER;
            pg8::SchedMoe S{(const char*)H1, (const char*)(W + W_MOE1), tb, ecnt, LIST, 1, F.G, (int)blockIdx.x, (size_t)512 * 1024 * 2, (size_t)256 * 1024 * 2, 0, true};
            pg8::EpiM1 E{HID};
            pg8::gemm_phase<pg8::EpiM1, pg8::SchedMoe, true>(F.lds, 1024, 1024, 1024, S, E);
        }
        xcd_barrier(bar);
        }
        for (int rep_ = 0; rep_ < REP_GEMM; ++rep_) {
        {
            PHASE_PTRS const bf16_t* W = Wall + (size_t)l * W_LAYER;
            pg8::SchedMoe S{(const char*)HID, (const char*)(W + W_MOE2), tb, ecnt, LIST, 2, F.G, (int)blockIdx.x, (size_t)1024 * 256 * 2, (size_t)256 * 256 * 2, (size_t)256 * 256 * 2, false};
            pg8::EpiM2 E{YS};
            pg8::gemm_phase<pg8::EpiM2, pg8::SchedMoe, false>(F.lds, 256, 256, 256, S, E);
        }
        xcd_barrier(bar);
        }
        {
            PHASE_IDS
            PHASE_PTRS
            for (int rep_ = 0; rep_ < REP_J; ++rep_)
            for (int r4 = gw * 4; r4 < T; r4 += NGW * 4) {
                u32x4 w0[4]; u32x2 w1[4];
#pragma unroll
                for (int k = 0; k < 4; ++k) { w0[k] = *(const u32x4*)(TOK + (size_t)(r4 + k) * 8); w1[k] = *(const u32x2*)(TOK + (size_t)(r4 + k) * 8 + 4); }
                u32x2 hv[4][4], ya[4][4], yc[4][4];
#pragma unroll
                for (int k = 0; k < 4; ++k) {
                    const size_t s0 = (size_t)tb[(int)w0[k].x] * 256 + (int)w0[k].y, s1 = (size_t)tb[(int)w0[k].z] * 256 + (int)w0[k].w;
#pragma unroll
                    for (int j = 0; j < 4; ++j) { hv[k][j] = *(const u32x2*)(H1 + (size_t)(r4 + k) * DM + 4 * lane + 256 * j); ya[k][j] = *(const u32x2*)(YS + s0 * DM + 4 * lane + 256 * j); yc[k][j] = *(const u32x2*)(YS + s1 * DM + 4 * lane + 256 * j); } }
                f32x4 v[4][4];
#pragma unroll
                for (int k = 0; k < 4; ++k) { const float g0 = __uint_as_float(w1[k].x), g1 = __uint_as_float(w1[k].y);
#pragma unroll
                    for (int j = 0; j < 4; ++j) {
                        v[k][j][0] = ALPHA * bf_lo(hv[k][j].x) + g0 * bf_lo(ya[k][j].x) + g1 * bf_lo(yc[k][j].x); v[k][j][1] = ALPHA * bf_hi(hv[k][j].x) + g0 * bf_hi(ya[k][j].x) + g1 * bf_hi(yc[k][j].x);
                        v[k][j][2] = ALPHA * bf_lo(hv[k][j].y) + g0 * bf_lo(ya[k][j].y) + g1 * bf_lo(yc[k][j].y); v[k][j][3] = ALPHA * bf_hi(hv[k][j].y) + g0 * bf_hi(ya[k][j].y) + g1 * bf_hi(yc[k][j].y); } }
                ln16xR<4>(v, args.in[20] + l * DM, args.in[21] + l * DM, lane);
#pragma unroll
                for (int k = 0; k < 4; ++k) { const int row = r4 + k;
                    if (l == 0) store_row_bf16(HB + (size_t)row * DM, v[k], lane);
                    else { const int b = row / LSEQ, p = row % LSEQ;
                        if (p >= NMETA) { float* orow = args.out + ((size_t)b * SEQ + (p - NMETA)) * DM;
#pragma unroll
                            for (int j = 0; j < 4; ++j) *(f32x4*)(orow + 4 * lane + 256 * j) = v[k][j]; } } }
            }
        }
        if (l == 0) xcd_barrier(bar);
    }
}

extern "C" void kernel_launch(void* const* d_in, const int* in_sizes, int n_in, void* d_out, int out_size, void* d_ws, size_t ws_size, hipStream_t stream) {
    static int grid = 0;
    if (grid == 0) {
        if (n_in != 22 || ws_size < WS_END) { fprintf(stderr, "kernel_launch: need 22 inputs and %zu bytes of workspace (got %d, %zu)\n", (size_t)WS_END, n_in, ws_size); grid = -1; return; }
        int dev = 0, cus = 0, per_cu = 0;
        if (hipGetDevice(&dev) != hipSuccess || hipDeviceGetAttribute(&cus, hipDeviceAttributeMultiprocessorCount, dev) != hipSuccess) { grid = -1; return; }
        if (hipFuncSetAttribute((const void*)fwd_kernel, hipFuncAttributeMaxDynamicSharedMemorySize, LDS_BYTES) != hipSuccess) { fprintf(stderr, "kernel_launch: hipFuncSetAttribute failed\n"); grid = -1; return; }
        if (hipOccupancyMaxActiveBlocksPerMultiprocessor(&per_cu, (const void*)fwd_kernel, 512, LDS_BYTES) != hipSuccess || per_cu < 1) { fprintf(stderr, "kernel_launch: occupancy query says %d\n", per_cu); }
        (void)hipGetLastError();
        grid = cus;
    }
    if (grid < 0) return;
    if (hipMemsetAsync((char*)d_ws + WS_CTL, 0, CTL_BYTES, stream) != hipSuccess) return;
    Args a{};
    for (int i = 0; i < 22; ++i) a.in[i] = (const float*)d_in[i];
    a.out = (float*)d_out; a.ws = (unsigned char*)d_ws;
    hipLaunchKernelGGL(fwd_kernel, dim3(grid), dim3(512), LDS_BYTES, stream, a);
}
```

```cpp
#include <hip/hip_runtime.h>
#include <cstdio>
#include <cstdint>

#ifndef REP_GEMM
#define REP_GEMM 1
#endif
#ifndef REP_MLA
#define REP_MLA 1
#endif
#ifndef REP2_MODE
#define REP2_MODE 0
#endif
#ifndef REP_FOX
#define REP_FOX 1
#endif
#ifndef REP_J
#define REP_J 1
#endif
#ifndef REP_THIN
#define REP_THIN 1
#endif
#define LAS __attribute__((address_space(3)))
typedef unsigned short bf16_t;
typedef short bf16x8 __attribute__((ext_vector_type(8)));
typedef short s16x4 __attribute__((ext_vector_type(4)));
typedef float f32x4 __attribute__((ext_vector_type(4)));
typedef float f32x2_t __attribute__((ext_vector_type(2)));
typedef __bf16 bf16x2_t __attribute__((ext_vector_type(2)));
typedef float f32x16 __attribute__((ext_vector_type(16)));
typedef unsigned u32x4 __attribute__((ext_vector_type(4)));
typedef unsigned u32x2 __attribute__((ext_vector_type(2)));

constexpr int NB = 8, SEQ = 4096, NMETA = 16, LSEQ = 4112, T = NB * LSEQ  , TP = 33024  , DM = 1024;
constexpr int NPANEL = TP / 256;
constexpr int NEXP = 16;
constexpr float ALPHA = 1.41421356237309515f;
constexpr float LOG2E = 1.4426950408889634f;
constexpr float C2F = 0.125f * LOG2E;
constexpr float C2M = 0.14724444602590310f;
constexpr int CSP = 4160;

constexpr size_t MiB = 1ull << 20;
constexpr size_t WS_CTL = 0, CTL_BYTES = 1 * MiB;
constexpr size_t WS_ROPE = 1 * MiB;
constexpr size_t WS_RWT = 1 * MiB + 640 * 1024;
constexpr size_t WS_LF = 2 * MiB;
constexpr size_t WS_CS = 4 * MiB;
constexpr size_t WS_TOK = 6 * MiB;
constexpr size_t WS_LIST = 8 * MiB;
constexpr size_t WS_GALT = 11 * MiB;
constexpr size_t WS_W = 12 * MiB;
constexpr size_t WS_H = 88 * MiB;
constexpr size_t WS_X = 153 * MiB;
constexpr size_t S512 = (size_t)TP * 512 * 2, S768 = (size_t)TP * 768 * 2, S1024 = (size_t)TP * 1024 * 2;
constexpr size_t X_QF = 0, X_KF = S512, X_VF = 2 * S512, X_RAW = 3 * S512, X_QM = 3 * S512 + S768, X_KM = 3 * S512 + 2 * S768,
                 X_VM = 3 * S512 + 3 * S768, X_OM = 4 * S512 + 3 * S768, X_OF = 5 * S512 + 3 * S768, X_END = 6 * S512 + 3 * S768;
constexpr size_t X_GATES = X_KF;
constexpr size_t X_MERGED = X_KM;
constexpr size_t X_Z = X_KF;
constexpr size_t X_H1 = X_KM;
constexpr size_t X_HID = X_QF;
constexpr size_t X_YS = 36 * MiB;
constexpr int NSLOT_TILES = 273, NSLOT = NSLOT_TILES * 256;
constexpr size_t WS_END = WS_X + X_END;
static_assert(X_GATES + (size_t)TP * 2048 * 2 <= X_KM, "gates");
static_assert(X_MERGED + S1024 <= X_OM, "merged");
static_assert(X_HID + (size_t)NSLOT * 256 * 2 <= X_YS, "hid");
static_assert(X_YS + (size_t)NSLOT * 1024 * 2 <= X_KM, "ys");
static_assert(WS_W + 2ull * 19693568ull * 2ull <= WS_H, "weights");
static_assert(WS_H + S1024 <= WS_X, "h");
constexpr size_t W_BT1 = 0, W_BT2 = W_BT1 + 2304ull * 1024, W_FOXO = W_BT2 + 2048ull * 1024, W_MLAO = W_FOXO + 1024ull * 512,
                 W_UQ = W_MLAO + 1024ull * 512, W_UKV = W_UQ + 768ull * 384, W_OUT = W_UKV + 1024ull * 256, W_MOE1 = W_OUT + 1024ull * 1024,
                 W_MOE2 = W_MOE1 + 16ull * 512 * 1024, W_LAYER = W_MOE2 + 16ull * 1024 * 256;
static_assert(W_LAYER == 19693568ull, "weights per layer");
constexpr int CW_BAR = 4096;
constexpr int CW_QCTR = 8192;
constexpr int CW_ECNT = 16384;
constexpr int CW_QKMAX = 20480;

constexpr int RING_BYTES = 131072;
constexpr int MISC_OFF = RING_BYTES;
constexpr int LDS_BYTES = 147456;

__device__ __forceinline__ unsigned pk_bf16(float lo, float hi) { f32x2_t v = {lo, hi}; bf16x2_t b = __builtin_convertvector(v, bf16x2_t); return __builtin_bit_cast(unsigned, b); }
__device__ __forceinline__ float bf_lo(unsigned u) { return __uint_as_float(u << 16); }
__device__ __forceinline__ float bf_hi(unsigned u) { return __uint_as_float(u & 0xffff0000u); }
__device__ __forceinline__ float wave_sum(float v) {
#pragma unroll
    for (int o = 1; o < 64; o <<= 1) v += __shfl_xor(v, o);
    return v;
}
#define LDS_WAIT() asm volatile("s_waitcnt lgkmcnt(0)" ::: "memory")
#define RLX_AGENT __ATOMIC_RELAXED, __HIP_MEMORY_SCOPE_AGENT

#define XB_TMO      128
#define XB_XCNT(j)  (256  + 64 * (j))
#define XB_XSUB(j)  (1280 + 64 * (j))
#define XB_XGEN(j)  (2304 + 64 * (j))
#define XB_TOP      3328
#define XB_TOPGEN   3392
#define XCD_BAR_WORDS 3456
#define XB_SPIN_CAP (1u << 20)
__device__ __forceinline__ unsigned xb_ld(unsigned* p)              { return __hip_atomic_load(p, __ATOMIC_RELAXED, __HIP_MEMORY_SCOPE_AGENT); }
__device__ __forceinline__ unsigned xb_add(unsigned* p, unsigned v) { return __hip_atomic_fetch_add(p, v, __ATOMIC_RELAXED, __HIP_MEMORY_SCOPE_AGENT); }
__device__ __forceinline__ unsigned xb_xcc_id() { return (unsigned)__builtin_amdgcn_s_getreg((3 << 11) | 20) & 0xFu; }
#define XB_SPIN(cond, bar) do { unsigned _sp = 0; while (cond) { __builtin_amdgcn_s_sleep(1); \
    if ((++_sp & 255u) == 0u) { if (xb_ld(&(bar)[XB_TMO])) break; if (_sp > XB_SPIN_CAP) { atomicAdd(&(bar)[XB_TMO], 1u); break; } } } } while (0)
struct XcdBarrier { unsigned* bar; unsigned x; volatile LAS unsigned* st; };
__device__ __forceinline__ XcdBarrier xcd_barrier_post(unsigned* bar, volatile LAS unsigned* st) {
    XcdBarrier b; b.bar = bar; b.x = xb_xcc_id(); b.st = st;
    if (threadIdx.x == 0) (void)xb_add(&bar[XB_XCNT(b.x)], 1u);
    return b;
}
__device__ __forceinline__ void xcd_barrier_complete(unsigned* bar, unsigned x, unsigned& nloc, unsigned& nx) {
    const unsigned G = gridDim.x * gridDim.y * gridDim.z;
    unsigned sum, cnt, mine, sp = 0u;
    for (;;) {
        sum = 0u; cnt = 0u; mine = 0u;
#pragma unroll
        for (unsigned j = 0; j < 16; ++j) { const unsigned c = xb_ld(&bar[XB_XCNT(j)]); sum += c; cnt += (c > 0u) ? 1u : 0u; mine = (j == x) ? c : mine; }
        if (sum == G) break;
        __builtin_amdgcn_s_sleep(1);
        if ((++sp & 255u) == 0u) { if (xb_ld(&bar[XB_TMO])) break; if (sp > XB_SPIN_CAP) { atomicAdd(&bar[XB_TMO], 1u); break; } }
    }
    nloc = mine > 0u ? mine : 1u; nx = cnt > 0u ? cnt : 1u;
}
__device__ __forceinline__ void xcd_barrier(const XcdBarrier& b) {
    asm volatile("s_waitcnt vmcnt(0)" ::: "memory");
    __syncthreads();
    if (threadIdx.x == 0) {
        unsigned* bar = b.bar; unsigned bx = b.x; asm volatile("" : "+s"(bar), "+s"(bx));
        __builtin_amdgcn_s_waitcnt(0);
        unsigned nloc = b.st[0], nx = b.st[1];
        if (nloc == 0u) { xcd_barrier_complete(bar, bx, nloc, nx); b.st[0] = nloc; b.st[1] = nx; }
        const unsigned old = xb_add(&bar[XB_XSUB(bx)], 1u);
        const unsigned gen = old / nloc;
        if (old + 1u == (gen + 1u) * nloc) {
            __builtin_amdgcn_fence(__ATOMIC_RELEASE, "agent");
            asm volatile("s_waitcnt vmcnt(0)" ::: "memory");
            const unsigned og = xb_add(&bar[XB_TOP], 1u);
            const unsigned tg = og / nx;
            if (og + 1u == (tg + 1u) * nx) xb_add(&bar[XB_TOPGEN], 1u);
            else XB_SPIN(xb_ld(&bar[XB_TOPGEN]) == tg, bar);
            __builtin_amdgcn_fence(__ATOMIC_ACQUIRE, "agent");
            xb_add(&bar[XB_XGEN(bx)], 1u);
            asm volatile("s_waitcnt vmcnt(0)" ::: "memory");
        } else {
            XB_SPIN(xb_ld(&bar[XB_XGEN(bx)]) == gen, bar);
            __builtin_amdgcn_fence(__ATOMIC_ACQUIRE, "agent");
            asm volatile("s_waitcnt vmcnt(0)" ::: "memory");
        }
    }
    __syncthreads();
}

namespace pg8 {
constexpr int BM = 256, BK = 64, HALF = 128, HTB = HALF * BK * 2, STAGE_BYTES = 8 * HTB;
__device__ __forceinline__ int lds_byte(int r, int c) { const int st = (r >> 4) * 2 + (c >> 5), rr = r & 15, cc = c & 31, ob = rr * 64 + cc * 2; return st * 1024 + (ob ^ (((ob >> 9) & 1) << 5)); }
__device__ __forceinline__ void stage_rc(int b, int& R, int& C) { const int st = b / 1024, sb = b % 1024, swz = sb ^ (((sb >> 9) & 1) << 5); R = (st >> 1) * 16 + swz / 64; C = (st & 1) * 32 + (swz % 64) / 2; }
__device__ __forceinline__ int perm32(int rho) { const int n = rho >> 4, i = rho & 15; return 8 * (i >> 2) + 4 * n + (i & 3); }
struct Unit { const char* A; const char* B; int pm, pn, aux, half; };
typedef f32x4 Acc[2][2][4][2];

__device__ __forceinline__ void tile_of(int L, int nM, int nN, int& pm, int& pn) {
    const int nwg = nM * nN; int wgid = L;
    { const int q = nwg / 8, r = nwg % 8, xcd = wgid % 8, off = wgid / 8; wgid = (xcd < r ? xcd * (q + 1) : r * (q + 1) + (xcd - r) * q) + off; }
    const int nig = 8 * nN, gid = wgid / nig, fm = gid * 8, gsz = (nM - fm) < 8 ? (nM - fm) : 8;
    pm = fm + ((wgid % nig) % gsz); pn = (wgid % nig) / gsz;
}

template <class Epi, class Sched, bool GATHER>
__device__ __forceinline__ void gemm_phase(LAS unsigned char* lds, const int K, const int lda, const int ldb, const Sched& S, const Epi& E) {
    int tid_l = threadIdx.x; asm volatile("" : "+v"(tid_l));
    const int tid = tid_l, wid = __builtin_amdgcn_readfirstlane(tid >> 6), lane = tid & 63, wr = wid >> 2, wc = wid & 3, fr = lane & 15, fq = lane >> 4;
    int nt = K / BK; asm volatile("" : "+s"(nt));
    unsigned voA[2][2], voB[2]; int Rr[2], Cc[2];
#pragma unroll
    for (int i = 0; i < 2; ++i) { int R, C; stage_rc(tid * 16 + i * 8192, R, C); const int Rb = Epi::PERM ? ((R & ~31) + perm32(R & 31)) : R;
        Rr[i] = R; Cc[i] = C; voA[0][i] = (unsigned)(R * lda + C) * 2u; voA[1][i] = (unsigned)((R + HALF) * lda + C) * 2u; voB[i] = (unsigned)(Rb * ldb + C) * 2u; }
    const size_t kstep = (size_t)(BK * 2);
    const size_t hstepB = (size_t)HALF * ldb * 2, hstepA = (size_t)HALF * lda * 2;
    const unsigned ldsw = (unsigned)wid * 1024u;
    const int aoff = lds_byte(wr * 64 + fr, fq * 8), boff = lds_byte(wc * 32 + fr, fq * 8);
#define PG8_SA(b, h) (((b) * 2 + (h)) * HTB)
#define PG8_SB(b, h) ((4 + (b) * 2 + (h)) * HTB)
#define PG8_STAGE2(bufoff, gbase, o0, o1) do { \
        __builtin_amdgcn_global_load_lds((const unsigned*)((const char*)(gbase) + (o0)), (LAS unsigned*)(lds + (bufoff) + ldsw), 16, 0, 0); \
        __builtin_amdgcn_global_load_lds((const unsigned*)((const char*)(gbase) + (o1)), (LAS unsigned*)(lds + (bufoff) + ldsw + 8192), 16, 0, 0); } while (0)
#define PG8_STA(b, h, gbase, VO) do { if constexpr (GATHER) PG8_STAGE2(PG8_SA(b, h), gbase, (VO)[h][0], (VO)[h][1]); else PG8_STAGE2(PG8_SA(b, h), (gbase) + (h) * hstepA, (VO)[0][0], (VO)[0][1]); } while (0)
#define PG8_STB(b, h, gbase) PG8_STAGE2(PG8_SB(b, h), (gbase) + (h) * hstepB, voB[0], voB[1])
#define PG8_LDA(dst, b, h) do { _Pragma("unroll") for (int m = 0; m < 4; ++m) _Pragma("unroll") for (int k = 0; k < 2; ++k) dst[m][k] = *(const LAS bf16x8*)(lds + PG8_SA(b, h) + aoff + m * 2048 + k * 1024); } while (0)
#define PG8_LDB(dst, b, h) do { _Pragma("unroll") for (int n = 0; n < 2; ++n) _Pragma("unroll") for (int k = 0; k < 2; ++k) dst[n][k] = *(const LAS bf16x8*)(lds + PG8_SB(b, h) + boff + n * 2048 + k * 1024); } while (0)
#define PG8_MMA(ai, bj, At, Bt) do { __builtin_amdgcn_s_setprio(1); _Pragma("unroll") for (int m = 0; m < 4; ++m) _Pragma("unroll") for (int n = 0; n < 2; ++n) _Pragma("unroll") for (int k = 0; k < 2; ++k) \
        acc[ai][bj][m][n] = __builtin_amdgcn_mfma_f32_16x16x32_bf16(Bt[n][k], At[m][k], acc[ai][bj][m][n], 0, 0, 0); __builtin_amdgcn_s_setprio(0); } while (0)
#define PG8_WAIT_V(n) asm volatile("s_waitcnt vmcnt(" #n ")" ::: "memory")
#define PG8_WAIT_L(n) asm volatile("s_waitcnt lgkmcnt(" #n ")" ::: "memory")
#define PG8_BAR __builtin_amdgcn_s_barrier()
#define PG8_SCHED __builtin_amdgcn_sched_barrier(0)
    Unit cur, nxt; int ui = 0;
    if (!S.next(0, cur)) return;
    Acc acc;
#pragma unroll
    for (int a = 0; a < 2; ++a)
#pragma unroll
        for (int b = 0; b < 2; ++b)
#pragma unroll
            for (int m = 0; m < 4; ++m)
#pragma unroll
                for (int n = 0; n < 2; ++n) acc[a][b][m][n] = (f32x4){0.f, 0.f, 0.f, 0.f};
    bf16x8 At[4][2], B0[2][2], B1[2][2];
    const char* cA = cur.A; const char* cB = cur.B;
    if constexpr (GATHER) {
#pragma unroll
        for (int h = 0; h < 2; ++h)
#pragma unroll
            for (int i = 0; i < 2; ++i) voA[h][i] = S.row_off(cur, Rr[i] + h * HALF) + (unsigned)Cc[i] * 2u;
    }
    PG8_STB(0, 0, cB); PG8_STB(0, 1, cB); PG8_STA(0, 0, cA, voA); PG8_STA(0, 1, cA, voA);
    if (wr == 1) PG8_BAR;
    PG8_WAIT_V(2); PG8_BAR;
    PG8_STB(1, 0, cB + kstep); PG8_STA(1, 0, cA + kstep, voA); PG8_STB(1, 1, cB + kstep);
    PG8_WAIT_V(6); PG8_BAR;
    for (;;) {
        const bool has_next = S.next(ui + 1, nxt);
        const char* nA = has_next ? nxt.A : cA; const char* nB = has_next ? nxt.B : cB;
        unsigned vnA[2][2];
        if constexpr (GATHER) {
#pragma unroll
            for (int h = 0; h < 2; ++h)
#pragma unroll
                for (int i = 0; i < 2; ++i) vnA[h][i] = has_next ? (S.row_off(nxt, Rr[i] + h * HALF) + (unsigned)Cc[i] * 2u) : voA[h][i];
        }
        for (int t = 0; t < nt; t += 2) {
            const bool last = (t == nt - 2);
            const char* a1 = cA + (size_t)(t + 1) * kstep;
            const char* a2 = last ? nA : cA + (size_t)(t + 2) * kstep; const char* b2 = last ? nB : cB + (size_t)(t + 2) * kstep;
            const char* a3 = a2 + kstep; const char* b3 = b2 + kstep;
            unsigned vs[2][2];
#pragma unroll
            for (int h = 0; h < 2; ++h)
#pragma unroll
                for (int i = 0; i < 2; ++i) { if constexpr (GATHER) vs[h][i] = last ? vnA[h][i] : voA[h][i]; else vs[h][i] = voA[h][i]; }
            PG8_LDB(B0, 0, 0); PG8_LDB(B1, 0, 1); PG8_SCHED; PG8_LDA(At, 0, 0); PG8_STA(1, 1, a1, voA);
            PG8_WAIT_V(8); PG8_WAIT_L(0); PG8_BAR; PG8_MMA(0, 0, At, B0); PG8_MMA(0, 1, At, B1); PG8_BAR; PG8_SCHED;
            PG8_LDA(At, 0, 1); PG8_STB(0, 0, b2); PG8_STB(0, 1, b2); PG8_STA(0, 0, a2, vs);
            PG8_WAIT_V(8); PG8_WAIT_L(0); PG8_BAR; if (!cur.half) { PG8_MMA(1, 0, At, B0); PG8_MMA(1, 1, At, B1); } PG8_BAR; PG8_SCHED;
            PG8_LDB(B0, 1, 0); PG8_LDB(B1, 1, 1); PG8_SCHED; PG8_LDA(At, 1, 0); PG8_STA(0, 1, a2, vs);
            PG8_WAIT_V(8); PG8_WAIT_L(0); PG8_BAR; PG8_MMA(0, 0, At, B0); PG8_MMA(0, 1, At, B1); PG8_BAR; PG8_SCHED;
            PG8_LDA(At, 1, 1); PG8_STB(1, 0, b3); PG8_STB(1, 1, b3); PG8_STA(1, 0, a3, vs);
            PG8_WAIT_V(8); PG8_WAIT_L(0); PG8_BAR; if (!cur.half) { PG8_MMA(1, 0, At, B0); PG8_MMA(1, 1, At, B1); } PG8_BAR; PG8_SCHED;
        }
        if (wr == 0) PG8_BAR;
        E(acc, cur, wr, wc, fr, fq);
        if (!has_next) break;
#pragma unroll
        for (int a = 0; a < 2; ++a)
#pragma unroll
            for (int b = 0; b < 2; ++b)
#pragma unroll
                for (int m = 0; m < 4; ++m)
#pragma unroll
                    for (int n = 0; n < 2; ++n) acc[a][b][m][n] = (f32x4){0.f, 0.f, 0.f, 0.f};
        cur = nxt; cA = nA; cB = nB; ++ui;
        if constexpr (GATHER) {
#pragma unroll
            for (int h = 0; h < 2; ++h)
#pragma unroll
                for (int i = 0; i < 2; ++i) voA[h][i] = vnA[h][i];
        }
        if (wr == 1) PG8_BAR;
    }
    PG8_WAIT_V(0);
    PG8_BAR;
#undef PG8_SA
#undef PG8_SB
#undef PG8_STAGE2
#undef PG8_STA
#undef PG8_STB
#undef PG8_LDA
#undef PG8_LDB
#undef PG8_MMA
#undef PG8_WAIT_V
#undef PG8_WAIT_L
#undef PG8_BAR
#undef PG8_SCHED
}

struct SchedStatic {
    const char* A; const char* B; int nM, nN, G, c; size_t astep, bstep;
    __device__ __forceinline__ bool next(int i, Unit& u) const {
        const long L = (long)i * G + c; if (L >= (long)nM * nN) return false;
        int pm, pn; const int nfull = (nM - 1) * nN;
        if ((int)L < nfull) { tile_of((int)L, nM - 1, nN, pm, pn); u.half = 0; } else { pm = nM - 1; pn = (int)L - nfull; u.half = 1; }
        u.pm = pm; u.pn = pn; u.aux = 0; u.A = A + (size_t)pm * astep; u.B = B + (size_t)pn * bstep; return true;
    }
    __device__ __forceinline__ unsigned row_off(const Unit&, int) const { return 0u; }
};
struct SchedOut {
    const char* A0; const char* A1; const char* B0; const char* B1; int nM, nN, G, c; size_t astep, bstep;
    __device__ __forceinline__ bool next(int i, Unit& u) const {
        const long L = (long)(i >> 1) * G + c; if (L >= (long)nM * nN) return false;
        int pm, pn; const int nfull = (nM - 1) * nN;
        if ((int)L < nfull) { tile_of((int)L, nM - 1, nN, pm, pn); u.half = 0; } else { pm = nM - 1; pn = (int)L - nfull; u.half = 1; }
        const int pass = i & 1;
        u.pm = pm; u.pn = pn; u.aux = pass; u.A = (pass ? A1 : A0) + (size_t)pm * astep; u.B = (pass ? B1 : B0) + (size_t)pn * bstep; return true;
    }
    __device__ __forceinline__ unsigned row_off(const Unit&, int) const { return 0u; }
};
struct SchedMoe {
    const char* A; const char* B; const LAS int* tb; const LAS int* cnt; const int* list; int npn_shift, G, c; size_t bstep_e, bstep_n, astep; bool gather;
    __device__ __forceinline__ bool next(int i, Unit& u) const {
        const int L = i * G + c; const int ntile = tb[16];
        if (L >= (ntile << npn_shift)) return false;
        const int ti = L >> npn_shift, pn = L & ((1 << npn_shift) - 1);
        int e = 0; while (ti >= tb[e + 1]) ++e;
        u.pm = ti; u.pn = pn; u.aux = e; u.half = (cnt[e] - (ti - tb[e]) * 256) <= 128 ? 1 : 0;
        u.A = gather ? A : A + (size_t)ti * astep;
        u.B = B + (size_t)e * bstep_e + (size_t)pn * bstep_n; return true;
    }
    __device__ __forceinline__ unsigned row_off(const Unit& u, int r) const {
        const int e = u.aux; int idx = (u.pm - tb[e]) * 256 + r; const int ce = cnt[e]; idx = idx < ce ? idx : ce - 1;
        const int tok = list[(size_t)e * TP + idx];
        return (unsigned)tok * (unsigned)(DM * 2);
    }
};

__device__ __forceinline__ u32x4 pack8(f32x4 v0, f32x4 v1) { u32x4 w; w.x = pk_bf16(v0[0], v0[1]); w.y = pk_bf16(v0[2], v0[3]); w.z = pk_bf16(v1[0], v1[1]); w.w = pk_bf16(v1[2], v1[3]); return w; }
__device__ __forceinline__ float logsig(float x) { return fminf(x, 0.f) - log1pf(__expf(-fabsf(x))); }
__device__ __forceinline__ float sigm(float x) { return 1.0f / (1.0f + __expf(-x)); }

struct EpiA1 {
    static constexpr bool PERM = true;
    bf16_t *Qf, *Kf, *Vf, *RAW; float* LF; const float* fbias;
    __device__ __forceinline__ void operator()(const Acc& acc, const Unit& u, int wr, int wc, int fr, int fq) const {
        const int pn = u.pn; bf16_t* base; int ldc, colt; float sc = 1.f;
        if (pn < 2) { base = Qf; ldc = 512; colt = pn * 256; sc = C2F; } else if (pn < 4) { base = Kf; ldc = 512; colt = (pn - 2) * 256; }
        else if (pn < 6) { base = Vf; ldc = 512; colt = (pn - 4) * 256; } else { base = RAW; ldc = 768; colt = (pn - 6) * 256; }
        const int row0 = u.pm * 256 + wr * 64 + fr, col0 = colt + wc * 32 + 8 * fq;
#pragma unroll
        for (int ai = 0; ai < 2; ++ai)
#pragma unroll
            for (int m = 0; m < 4; ++m) { if (ai == 1 && u.half) continue; bf16_t* rowp = base + (size_t)(row0 + ai * 128 + m * 16) * ldc + col0;
#pragma unroll
                for (int bj = 0; bj < 2; ++bj) *(u32x4*)(rowp + bj * 128) = pack8(acc[ai][bj][m][0] * sc, acc[ai][bj][m][1] * sc); }
        if (pn == 8 && wc == 1 && fq == 0) {
            const f32x4 b0 = *(const f32x4*)fbias, b1 = *(const f32x4*)(fbias + 4);
#pragma unroll
            for (int ai = 0; ai < 2; ++ai)
#pragma unroll
                for (int m = 0; m < 4; ++m) { if (ai == 1 && u.half) continue; const int row = row0 + ai * 128 + m * 16; const f32x4 a = acc[ai][1][m][0] + b0, b = acc[ai][1][m][1] + b1;
                    f32x4 o0, o1;
#pragma unroll
                    for (int j = 0; j < 4; ++j) { o0[j] = logsig(a[j]); o1[j] = logsig(b[j]); }
                    *(f32x4*)(LF + (size_t)row * 8) = o0; *(f32x4*)(LF + (size_t)row * 8 + 4) = o1; }
        }
    }
};
struct EpiA2 {
    static constexpr bool PERM = true;
    bf16_t* Gm; bf16_t* Galt;
    __device__ __forceinline__ void operator()(const Acc& acc, const Unit& u, int wr, int wc, int fr, int fq) const {
        bf16_t* G = (u.pm == 128) ? Galt - (size_t)32768 * 2048 : Gm;
        const int row0 = u.pm * 256 + wr * 64 + fr, col0 = (u.pn - 9) * 256 + wc * 32 + 8 * fq;
#pragma unroll
        for (int ai = 0; ai < 2; ++ai)
#pragma unroll
            for (int m = 0; m < 4; ++m) { if (ai == 1 && u.half) continue; bf16_t* rowp = G + (size_t)(row0 + ai * 128 + m * 16) * 2048 + col0;
#pragma unroll
                for (int bj = 0; bj < 2; ++bj) { f32x4 a = acc[ai][bj][m][0], b = acc[ai][bj][m][1];
#pragma unroll
                    for (int j = 0; j < 4; ++j) { a[j] = sigm(a[j]); b[j] = sigm(b[j]); }
                    *(u32x4*)(rowp + bj * 128) = pack8(a, b); } }
    }
};
struct EpiA {
    static constexpr bool PERM = true;
    EpiA1 e1; EpiA2 e2;
    __device__ __forceinline__ void operator()(const Acc& acc, const Unit& u, int wr, int wc, int fr, int fq) const { if (u.pn < 9) e1(acc, u, wr, wc, fr, fq); else e2(acc, u, wr, wc, fr, fq); }
};
struct EpiQup {
    static constexpr bool PERM = false;
    bf16_t* Qm; const float* cosT; const float* sinT;
    __device__ __forceinline__ void operator()(const Acc& acc, const Unit& u, int wr, int wc, int fr, int fq) const {
        const int row0 = u.pm * 256 + wr * 64 + fr;
#pragma unroll
        for (int ai = 0; ai < 2; ++ai)
#pragma unroll
            for (int m = 0; m < 4; ++m) { if (ai == 1 && u.half) continue; const int row = row0 + ai * 128 + m * 16; const int pos = row % LSEQ;
#pragma unroll
                for (int bj = 0; bj < 2; ++bj) { const int Gi = u.pn * 8 + bj * 4 + wc; f32x4 x0 = acc[ai][bj][m][0], x1 = acc[ai][bj][m][1];
                    if (Gi % 3 == 2) { const f32x4 cs = *(const f32x4*)(cosT + pos * 16 + 4 * fq), sn = *(const f32x4*)(sinT + pos * 16 + 4 * fq);
                        const f32x4 y0 = x0 * cs - x1 * sn, y1 = x1 * cs + x0 * sn; x0 = y0; x1 = y1; }
                    x0 = x0 * C2M; x1 = x1 * C2M;
                    bf16_t* p = Qm + (size_t)row * 768 + Gi * 32 + 4 * fq;
                    u32x2 w0, w1; w0.x = pk_bf16(x0[0], x0[1]); w0.y = pk_bf16(x0[2], x0[3]); w1.x = pk_bf16(x1[0], x1[1]); w1.y = pk_bf16(x1[2], x1[3]);
                    *(u32x2*)p = w0; *(u32x2*)(p + 16) = w1; } }
    }
};
struct EpiKV {
    static constexpr bool PERM = true;
    bf16_t *Km, *Vm;
    __device__ __forceinline__ void operator()(const Acc& acc, const Unit& u, int wr, int wc, int fr, int fq) const {
        const int row0 = u.pm * 256 + wr * 64 + fr;
#pragma unroll
        for (int ai = 0; ai < 2; ++ai)
#pragma unroll
            for (int m = 0; m < 4; ++m) { if (ai == 1 && u.half) continue; const int row = row0 + ai * 128 + m * 16;
#pragma unroll
                for (int bj = 0; bj < 2; ++bj) { const int n = u.pn * 256 + bj * 128 + wc * 32 + 8 * fq; const u32x4 w = pack8(acc[ai][bj][m][0], acc[ai][bj][m][1]);
                    if (u.pn < 2) *(u32x4*)(Km + (size_t)row * 768 + 96 * (n >> 6) + (n & 63)) = w;
                    else *(u32x4*)(Vm + (size_t)row * 512 + (n - 512)) = w; } }
    }
};
struct EpiOut {
    static constexpr bool PERM = true;
    const bf16_t* Gm; const bf16_t* Galt; bf16_t* Mg;
    __device__ __forceinline__ void operator()(const Acc& acc, const Unit& u, int wr, int wc, int fr, int fq) const {
        const bf16_t* G = (u.pm == 128) ? Galt - (size_t)32768 * 2048 : Gm;
        const int row0 = u.pm * 256 + wr * 64 + fr, col0 = u.pn * 256 + wc * 32 + 8 * fq; const int pass = u.aux;
#pragma unroll
        for (int ai = 0; ai < 2; ++ai)
#pragma unroll
            for (int m = 0; m < 4; ++m) { if (ai == 1 && u.half) continue; const int row = row0 + ai * 128 + m * 16;
#pragma unroll
                for (int bj = 0; bj < 2; ++bj) { const int col = col0 + bj * 128;
                    const u32x4 g = *(const u32x4*)(G + (size_t)row * 2048 + pass * 1024 + col);
                    f32x4 a = acc[ai][bj][m][0], b = acc[ai][bj][m][1];
                    a[0] *= bf_lo(g.x); a[1] *= bf_hi(g.x); a[2] *= bf_lo(g.y); a[3] *= bf_hi(g.y); b[0] *= bf_lo(g.z); b[1] *= bf_hi(g.z); b[2] *= bf_lo(g.w); b[3] *= bf_hi(g.w);
                    bf16_t* mp = Mg + (size_t)row * 1024 + col;
                    if (pass) { const u32x4 p = *(const u32x4*)mp;
                        a[0] += bf_lo(p.x); a[1] += bf_hi(p.x); a[2] += bf_lo(p.y); a[3] += bf_hi(p.y); b[0] += bf_lo(p.z); b[1] += bf_hi(p.z); b[2] += bf_lo(p.w); b[3] += bf_hi(p.w); }
                    *(u32x4*)mp = pack8(a, b); } }
    }
};
struct EpiF {
    static constexpr bool PERM = false;
    const bf16_t* H; float* Z;
    __device__ __forceinline__ void operator()(const Acc& acc, const Unit& u, int wr, int wc, int fr, int fq) const {
        const int row0 = u.pm * 256 + wr * 64 + fr, col0 = u.pn * 256 + wc * 32 + 4 * fq;
#pragma unroll
        for (int ai = 0; ai < 2; ++ai)
#pragma unroll
            for (int m = 0; m < 4; ++m) { if (ai == 1 && u.half) continue; const size_t off = (size_t)(row0 + ai * 128 + m * 16) * 1024 + col0;
#pragma unroll
                for (int bj = 0; bj < 2; ++bj)
#pragma unroll
                    for (int n = 0; n < 2; ++n) { const u32x2 hv = *(const u32x2*)(H + off + bj * 128 + n * 16); f32x4 o = acc[ai][bj][m][n];
                        o[0] += ALPHA * bf_lo(hv.x); o[1] += ALPHA * bf_hi(hv.x); o[2] += ALPHA * bf_lo(hv.y); o[3] += ALPHA * bf_hi(hv.y);
                        *(f32x4*)(Z + off + bj * 128 + n * 16) = o; } }
    }
};
struct EpiM1 {
    static constexpr bool PERM = false;
    bf16_t* Hid;
    __device__ __forceinline__ void operator()(const Acc& acc, const Unit& u, int wr, int wc, int fr, int fq) const {
        const int row0 = u.pm * 256 + wr * 64 + fr, hc0 = u.pn * 128 + wc * 16 + 4 * fq;
#pragma unroll
        for (int ai = 0; ai < 2; ++ai)
#pragma unroll
            for (int m = 0; m < 4; ++m) { if (ai == 1 && u.half) continue; bf16_t* rowp = Hid + (size_t)(row0 + ai * 128 + m * 16) * 256 + hc0;
#pragma unroll
                for (int bj = 0; bj < 2; ++bj) { const f32x4 g = acc[ai][bj][m][0], up = acc[ai][bj][m][1]; f32x4 o;
#pragma unroll
                    for (int j = 0; j < 4; ++j) o[j] = g[j] * sigm(g[j]) * up[j];
                    u32x2 w; w.x = pk_bf16(o[0], o[1]); w.y = pk_bf16(o[2], o[3]); *(u32x2*)(rowp + bj * 64) = w; } }
    }
};
struct EpiM2 {
    static constexpr bool PERM = true;
    bf16_t* Ys;
    __device__ __forceinline__ void operator()(const Acc& acc, const Unit& u, int wr, int wc, int fr, int fq) const {
        const int row0 = u.pm * 256 + wr * 64 + fr, col0 = u.pn * 256 + wc * 32 + 8 * fq;
#pragma unroll
        for (int ai = 0; ai < 2; ++ai)
#pragma unroll
            for (int m = 0; m < 4; ++m) { if (ai == 1 && u.half) continue; bf16_t* rowp = Ys + (size_t)(row0 + ai * 128 + m * 16) * 1024 + col0;
#pragma unroll
                for (int bj = 0; bj < 2; ++bj) *(u32x4*)(rowp + bj * 128) = pack8(acc[ai][bj][m][0], acc[ai][bj][m][1]); }
    }
};
}

__device__ __forceinline__ int crow(int r, int hi) { return (r & 3) + 8 * (r >> 2) + 4 * hi; }
typedef short v4i16_t __attribute__((ext_vector_type(4)));
__device__ __forceinline__ s16x4 vtr(const LAS char* p) { return __builtin_bit_cast(s16x4, __builtin_amdgcn_ds_read_tr16_b64_v4i16((LAS v4i16_t*)p)); }
__device__ __forceinline__ float swapmax(float m) { auto rr = __builtin_amdgcn_permlane32_swap(__float_as_uint(m), __float_as_uint(m), false, false); return fmaxf(__uint_as_float(rr[0]), __uint_as_float(rr[1])); }
__device__ __forceinline__ float swapsum(float m) { auto rr = __builtin_amdgcn_permlane32_swap(__float_as_uint(m), __float_as_uint(m), false, false); return __uint_as_float(rr[0]) + __uint_as_float(rr[1]); }

template <int DK, bool FOX>
__device__ __forceinline__ void attn_unit(LAS char* lds, const bf16_t* Q, int ldq, const bf16_t* Kp, int ldk, const bf16_t* Vp, int ldv, bf16_t* O, int ldo,
                                          const float* cs, int b, int q0, int nvalid) {
    constexpr int NS = DK / 16, KB = 64 * DK * 2, BUF = KB + 8192 + 256;
    int tid_l = threadIdx.x; asm volatile("" : "+v"(tid_l));
    const int tid = tid_l, lane = tid & 63, r32 = lane & 31, hi = lane >> 5; const int wid = __builtin_amdgcn_readfirstlane(tid >> 6);
    const size_t rowbase = (size_t)b * LSEQ;
    const int qpos = q0 + 32 * wid + r32;
    const bool wave_on = (32 * wid) < nvalid;
    bf16x8 qf[NS];
#pragma unroll
    for (int s = 0; s < NS; ++s) qf[s] = *(const bf16x8*)(Q + (rowbase + qpos) * ldq + 16 * s + 8 * hi);
    float csq = 0.f; if (FOX) csq = cs[qpos];
    const int NT = (q0 + nvalid + 63) >> 6;
    const int skv = tid >> 3, sch = tid & 7;
    const bf16_t* kg = Kp + (rowbase + skv) * ldk + 8 * sch;
    const bf16_t* vg = Vp + (rowbase + skv) * ldv + 8 * sch;
    const int kdst = sch * 1024 + ((skv ^ sch) << 4);
    const int vdst = KB + ((sch >> 2) * 8 + (skv >> 3)) * 512 + (skv & 7) * 64 + (sch & 3) * 16;
    const int skv2 = tid >> 2, sch2 = 8 + (tid & 3);
    const bf16_t* kg2 = Kp + (rowbase + (skv2 & 63)) * ldk + 8 * sch2;
    const int kdst2 = sch2 * 1024 + (((skv2 & 63) ^ (sch2 & 7)) << 4);
    u32x4 kr0, kr1 = {0u, 0u, 0u, 0u}, vr0; f32x4 cr = {0.f, 0.f, 0.f, 0.f};
#define ATT_LOAD(t) do { kr0 = *(const u32x4*)(kg + (size_t)(t) * 64 * ldk); vr0 = *(const u32x4*)(vg + (size_t)(t) * 64 * ldv); \
        if (DK == 96 && tid < 256) kr1 = *(const u32x4*)(kg2 + (size_t)(t) * 64 * ldk); \
        if (FOX && tid < 16) cr = *(const f32x4*)(cs + (t) * 64 + 4 * tid); } while (0)
#define ATT_STORE(bufp) do { *(LAS u32x4*)((bufp) + kdst) = kr0; *(LAS u32x4*)((bufp) + vdst) = vr0; \
        if (DK == 96 && tid < 256) *(LAS u32x4*)((bufp) + kdst2) = kr1; \
        if (FOX && tid < 16) *(LAS f32x4*)((bufp) + KB + 8192 + 16 * tid) = cr; } while (0)
    ATT_LOAD(0);
    ATT_STORE(lds);
    __syncthreads();
    float mrun = -INFINITY, lrun = 0.f;
    f32x16 o0 = {}, o1 = {};
    const int vlane = ((lane >> 4) & 1) * 32 + (lane & 3) * 8 + (4 * hi + ((lane & 15) >> 2)) * 64;
    for (int t = 0; t < NT; ++t) {
        LAS char* cb = lds + (t & 1) * BUF; LAS char* nb = lds + ((t + 1) & 1) * BUF;
        const bool more = (t + 1 < NT);
        if (more) ATT_LOAD(t + 1);
        const bool active = wave_on && (64 * t <= q0 + 32 * wid + 31);
        if (active) {
            f32x16 p0 = {}, p1 = {};
#pragma unroll
            for (int s = 0; s < NS; ++s) {
                const int c = 2 * s + hi;
                const bf16x8 a0 = *(const LAS bf16x8*)(cb + c * 1024 + ((r32 ^ (c & 7)) << 4));
                const bf16x8 a1 = *(const LAS bf16x8*)(cb + c * 1024 + (((r32 + 32) ^ (c & 7)) << 4));
                p0 = __builtin_amdgcn_mfma_f32_32x32x16_bf16(a0, qf[s], p0, 0, 0, 0);
                p1 = __builtin_amdgcn_mfma_f32_32x32x16_bf16(a1, qf[s], p1, 0, 0, 0);
            }
            if (FOX) {
                const LAS float* cl = (const LAS float*)(cb + KB + 8192);
#pragma unroll
                for (int g = 0; g < 4; ++g) { const f32x4 c0 = *(const LAS f32x4*)(cl + 8 * g + 4 * hi), c1 = *(const LAS f32x4*)(cl + 32 + 8 * g + 4 * hi);
#pragma unroll
                    for (int j = 0; j < 4; ++j) { p0[4 * g + j] += csq - c0[j]; p1[4 * g + j] += csq - c1[j]; } }
            }
            if (64 * t + 63 > q0 + 32 * wid) {
                const int kb = 64 * t + 4 * hi;
#pragma unroll
                for (int r = 0; r < 16; ++r) { const int kv = kb + (r & 3) + 8 * (r >> 2); if (kv > qpos) p0[r] = -INFINITY; if (kv + 32 > qpos) p1[r] = -INFINITY; }
            }
            float mt = fmaxf(p0[0], p1[0]);
#pragma unroll
            for (int r = 1; r < 16; ++r) mt = fmaxf(mt, fmaxf(p0[r], p1[r]));
            mt = swapmax(mt);
            const float mnew = fmaxf(mrun, mt);
            const float alpha = __builtin_amdgcn_exp2f(mrun - mnew);
            mrun = mnew;
            float ls = 0.f;
#pragma unroll
            for (int r = 0; r < 16; ++r) { p0[r] = __builtin_amdgcn_exp2f(p0[r] - mnew); p1[r] = __builtin_amdgcn_exp2f(p1[r] - mnew); ls += p0[r] + p1[r]; }
            lrun = lrun * alpha + ls;
#pragma unroll
            for (int r = 0; r < 16; ++r) { o0[r] *= alpha; o1[r] *= alpha; }
            bf16x8 pb[4];
#pragma unroll
            for (int s = 0; s < 2; ++s) {
                u32x4 w; w.x = pk_bf16(p0[8 * s], p0[8 * s + 1]); w.y = pk_bf16(p0[8 * s + 2], p0[8 * s + 3]); w.z = pk_bf16(p0[8 * s + 4], p0[8 * s + 5]); w.w = pk_bf16(p0[8 * s + 6], p0[8 * s + 7]);
                pb[s] = __builtin_bit_cast(bf16x8, w);
                u32x4 w2; w2.x = pk_bf16(p1[8 * s], p1[8 * s + 1]); w2.y = pk_bf16(p1[8 * s + 2], p1[8 * s + 3]); w2.z = pk_bf16(p1[8 * s + 4], p1[8 * s + 5]); w2.w = pk_bf16(p1[8 * s + 6], p1[8 * s + 7]);
                pb[2 + s] = __builtin_bit_cast(bf16x8, w2);
            }
            const LAS char* vb = cb + KB + vlane;
#pragma unroll
            for (int ks = 0; ks < 4; ++ks) {
                const s16x4 l0 = vtr(vb + ks * 1024), h0 = vtr(vb + ks * 1024 + 512);
                const s16x4 l1 = vtr(vb + 4096 + ks * 1024), h1 = vtr(vb + 4096 + ks * 1024 + 512);
                const bf16x8 a0 = (bf16x8){l0[0], l0[1], l0[2], l0[3], h0[0], h0[1], h0[2], h0[3]};
                const bf16x8 a1 = (bf16x8){l1[0], l1[1], l1[2], l1[3], h1[0], h1[1], h1[2], h1[3]};
                o0 = __builtin_amdgcn_mfma_f32_32x32x16_bf16(a0, pb[ks], o0, 0, 0, 0);
                o1 = __builtin_amdgcn_mfma_f32_32x32x16_bf16(a1, pb[ks], o1, 0, 0, 0);
            }
        }
        if (more) ATT_STORE(nb);
        __syncthreads();
    }
#undef ATT_LOAD
#undef ATT_STORE
    if (wave_on) {
        const float lt = swapsum(lrun);
        const float inv = 1.0f / lt;
        if (32 * wid + r32 < nvalid) {
            bf16_t* op = O + (rowbase + qpos) * ldo;
#pragma unroll
            for (int g = 0; g < 4; ++g) {
                u32x2 w0, w1;
                w0.x = pk_bf16(o0[4 * g] * inv, o0[4 * g + 1] * inv); w0.y = pk_bf16(o0[4 * g + 2] * inv, o0[4 * g + 3] * inv);
                w1.x = pk_bf16(o1[4 * g] * inv, o1[4 * g + 1] * inv); w1.y = pk_bf16(o1[4 * g + 2] * inv, o1[4 * g + 3] * inv);
                *(u32x2*)(op + 8 * g + 4 * hi) = w0; *(u32x2*)(op + 32 + 8 * g + 4 * hi) = w1;
            }
        }
    }
}

template <int DK, bool FOX, int MODE = 0>
__device__ __forceinline__ void attn_unit2(LAS char* lds, const bf16_t* Q, int ldq, const bf16_t* Kp, int ldk, const bf16_t* Vp, int ldv, bf16_t* O, int ldo,
                                           const float* cs, int b, int j, int tau_min) {
    constexpr int NS = DK / 16, KB = 64 * DK * 2, SB = KB + 8192 + 256;
    constexpr float THR = 8.0f;
    int tid_l = threadIdx.x; asm volatile("" : "+v"(tid_l));
    const int tid = tid_l, lane = tid & 63, r32 = lane & 31, hi = lane >> 5; const int wid = __builtin_amdgcn_readfirstlane(tid >> 6);
    const size_t rowbase = (size_t)b * LSEQ;
    const int qp0 = (j == 0) ? 0 : 16 + 256 * (j - 1) + 32 * wid;
    const int qpos = qp0 + r32;
    const bool wave_on = (j > 0) || (wid == 0);
    const int tdiag = (j == 0) ? 0 : 4 * (j - 1) + 1 + (wid >> 1);
    const int qin = (j == 0) ? r32 : 32 * (wid & 1) + r32;
    const int NT = 4 * j + 1;
    bf16x8 qf[NS];
#pragma unroll
    for (int s = 0; s < NS; ++s) qf[s] = *(const bf16x8*)(Q + (rowbase + qpos) * ldq + 16 * s + 8 * hi);
    float csq = 0.f; if (FOX) csq = cs[qpos];
    const bf16_t* kg = Kp + (rowbase + lane) * ldk + 8 * wid;
    const bf16_t* kg2 = Kp + (rowbase + lane) * ldk + 8 * (8 + (wid & 3));
    const bf16_t* vg = Vp + (rowbase + 16 * (wid & 3) + 8 * (lane >> 5) + ((lane >> 2) & 7)) * ldv + 32 * (wid >> 2) + 8 * (lane & 3);
    const int nops = 2 + ((DK == 96) ? (wid < 4 ? 1 : 0) : (FOX ? (wid == 4 ? 1 : 0) : 0));
#define ATT_ISSUE(t, slot) do { const int ts_ = ((t) == 0) ? 0 : 64 * (t) - 48; LAS char* sb_ = lds + (slot) * SB; \
        __builtin_amdgcn_global_load_lds((const unsigned*)(kg + (size_t)ts_ * ldk), (LAS unsigned*)(sb_ + wid * 1024), 16, 0, 0); \
        __builtin_amdgcn_global_load_lds((const unsigned*)(vg + (size_t)ts_ * ldv), (LAS unsigned*)(sb_ + KB + (wid >> 2) * 4096 + (wid & 3) * 1024), 16, 0, 0); \
        if (DK == 96) { if (wid < 4) __builtin_amdgcn_global_load_lds((const unsigned*)(kg2 + (size_t)ts_ * ldk), (LAS unsigned*)(sb_ + (8 + wid) * 1024), 16, 0, 0); } \
        else if (FOX) { if (wid == 4) { if (lane < 16) __builtin_amdgcn_global_load_lds((const unsigned*)(cs + ts_ + 4 * lane), (LAS unsigned*)(sb_ + KB + 8192), 16, 0, 0); } } } while (0)
    int t = NT - 1;
    int slot = 0;
    if (MODE != 2) { ATT_ISSUE(t, 0);
    if (t - 1 >= tau_min) ATT_ISSUE(t - 1, 1); }
    float mhat = 0.f, lrun = 0.f;
    f32x16 o0 = {}, o1 = {};
    const int vlane = ((lane >> 4) & 1) * 32 + (lane & 3) * 8 + (4 * hi + ((lane & 15) >> 2)) * 64;
    bool started = false;
    for (; t >= tau_min; --t) {
        if (MODE != 2) { if (t - 1 >= tau_min) { if (nops == 3) asm volatile("s_waitcnt vmcnt(3)" ::: "memory"); else asm volatile("s_waitcnt vmcnt(2)" ::: "memory"); }
        else asm volatile("s_waitcnt vmcnt(0)" ::: "memory"); }
        __builtin_amdgcn_s_barrier(); asm volatile("" ::: "memory");
        { const int s2 = (slot >= 1) ? slot - 1 : 2;
          if (MODE != 2) { if (t - 2 >= tau_min) ATT_ISSUE(t - 2, s2); } }
        const LAS char* cb = lds + slot * SB;
        if (MODE != 1 && wave_on && t <= tdiag) {
            f32x16 p0, p1;
            if (FOX) {
                const LAS float* cl = (const LAS float*)(cb + KB + 8192); const float base = csq - mhat;
#pragma unroll
                for (int g = 0; g < 4; ++g) { const f32x4 c0 = *(const LAS f32x4*)(cl + 8 * g + 4 * hi), c1 = *(const LAS f32x4*)(cl + 32 + 8 * g + 4 * hi);
#pragma unroll
                    for (int jj = 0; jj < 4; ++jj) { p0[4 * g + jj] = base - c0[jj]; p1[4 * g + jj] = base - c1[jj]; } }
            } else {
                const float nm = -mhat;
#pragma unroll
                for (int r = 0; r < 16; ++r) { p0[r] = nm; p1[r] = nm; }
            }
            bf16x8 ka[NS][2];
#pragma unroll
            for (int s = 0; s < NS; ++s) { const int c = 2 * s + hi; ka[s][0] = *(const LAS bf16x8*)(cb + c * 1024 + r32 * 16); ka[s][1] = *(const LAS bf16x8*)(cb + c * 1024 + 512 + r32 * 16); }
            __builtin_amdgcn_sched_barrier(0);
#pragma unroll
            for (int s = 0; s < NS; ++s) { p0 = __builtin_amdgcn_mfma_f32_32x32x16_bf16(ka[s][0], qf[s], p0, 0, 0, 0); p1 = __builtin_amdgcn_mfma_f32_32x32x16_bf16(ka[s][1], qf[s], p1, 0, 0, 0); }
            __builtin_amdgcn_sched_barrier(0);
            const LAS char* vb = cb + KB + vlane;
            s16x4 vl0[4], vh0[4], vl1[4], vh1[4];
#pragma unroll
            for (int ks = 0; ks < 4; ++ks) { vl0[ks] = vtr(vb + ks * 1024); vh0[ks] = vtr(vb + ks * 1024 + 512); vl1[ks] = vtr(vb + 4096 + ks * 1024); vh1[ks] = vtr(vb + 4096 + ks * 1024 + 512); }
            __builtin_amdgcn_sched_barrier(0);
            if (t == tdiag) {
#pragma unroll
                for (int r = 0; r < 16; ++r) { const int kv = 4 * hi + (r & 3) + 8 * (r >> 2); if (kv > qin) p0[r] = -INFINITY; if (kv + 32 > qin) p1[r] = -INFINITY; }
            }
            if (t == 0) {
#pragma unroll
                for (int r = 0; r < 16; ++r) { const int kv = 4 * hi + (r & 3) + 8 * (r >> 2); if (kv >= 16) p0[r] = -INFINITY; p1[r] = -INFINITY; }
            }
            float mt = fmaxf(p0[0], p1[0]);
#pragma unroll
            for (int r = 1; r < 16; ++r) mt = fmaxf(mt, fmaxf(p0[r], p1[r]));
            mt = swapmax(mt);
            if (!started) {
                started = true; mhat = mt;
#pragma unroll
                for (int r = 0; r < 16; ++r) { p0[r] -= mt; p1[r] -= mt; }
            } else if (__any(mt > THR)) {
                const float dl = fmaxf(mt, 0.f); mhat += dl; const float f = __builtin_amdgcn_exp2f(-dl); lrun *= f;
#pragma unroll
                for (int r = 0; r < 16; ++r) { p0[r] -= dl; p1[r] -= dl; o0[r] *= f; o1[r] *= f; }
            }
            float ls = 0.f;
#pragma unroll
            for (int r = 0; r < 16; ++r) { p0[r] = __builtin_amdgcn_exp2f(p0[r]); p1[r] = __builtin_amdgcn_exp2f(p1[r]); ls += p0[r] + p1[r]; }
            lrun += ls;
            bf16x8 pb[4];
#pragma unroll
            for (int s = 0; s < 2; ++s) {
                u32x4 w; w.x = pk_bf16(p0[8 * s], p0[8 * s + 1]); w.y = pk_bf16(p0[8 * s + 2], p0[8 * s + 3]); w.z = pk_bf16(p0[8 * s + 4], p0[8 * s + 5]); w.w = pk_bf16(p0[8 * s + 6], p0[8 * s + 7]);
                pb[s] = __builtin_bit_cast(bf16x8, w);
                u32x4 w2; w2.x = pk_bf16(p1[8 * s], p1[8 * s + 1]); w2.y = pk_bf16(p1[8 * s + 2], p1[8 * s + 3]); w2.z = pk_bf16(p1[8 * s + 4], p1[8 * s + 5]); w2.w = pk_bf16(p1[8 * s + 6], p1[8 * s + 7]);
                pb[2 + s] = __builtin_bit_cast(bf16x8, w2);
            }
            __builtin_amdgcn_sched_barrier(0);
#pragma unroll
            for (int ks = 0; ks < 4; ++ks) {
                const bf16x8 a0 = (bf16x8){vl0[ks][0], vl0[ks][1], vl0[ks][2], vl0[ks][3], vh0[ks][0], vh0[ks][1], vh0[ks][2], vh0[ks][3]};
                const bf16x8 a1 = (bf16x8){vl1[ks][0], vl1[ks][1], vl1[ks][2], vl1[ks][3], vh1[ks][0], vh1[ks][1], vh1[ks][2], vh1[ks][3]};
                o0 = __builtin_amdgcn_mfma_f32_32x32x16_bf16(a0, pb[ks], o0, 0, 0, 0);
                o1 = __builtin_amdgcn_mfma_f32_32x32x16_bf16(a1, pb[ks], o1, 0, 0, 0);
            }
        }
        slot = (slot == 2) ? 0 : slot + 1;
    }
#undef ATT_ISSUE
    if (MODE != 1 && wave_on) {
        const float lt = swapsum(lrun);
        const float inv = 1.0f / lt;
        if (j > 0 || r32 < 16) {
            bf16_t* op = O + (rowbase + qpos) * ldo;
#pragma unroll
            for (int g = 0; g < 4; ++g) {
                u32x2 w0, w1;
                w0.x = pk_bf16(o0[4 * g] * inv, o0[4 * g + 1] * inv); w0.y = pk_bf16(o0[4 * g + 2] * inv, o0[4 * g + 3] * inv);
                w1.x = pk_bf16(o1[4 * g] * inv, o1[4 * g + 1] * inv); w1.y = pk_bf16(o1[4 * g + 2] * inv, o1[4 * g + 3] * inv);
                *(u32x2*)(op + 8 * g + 4 * hi) = w0; *(u32x2*)(op + 32 + 8 * g + 4 * hi) = w1;
            }
        }
    }
    asm volatile("s_waitcnt lgkmcnt(0)" ::: "memory");
    __builtin_amdgcn_s_barrier(); asm volatile("" ::: "memory");
}

struct Args { const float* in[22]; float* out; unsigned char* ws; };
struct Frame {
    LAS unsigned char* lds; volatile LAS unsigned* MISC; unsigned* ctl;
    int tid, lane, wave, vcu, G;
};

__device__ __forceinline__ void tr_item(const float* colp, int ld, const float* kscale, bf16_t* dst, int K, int n0, int k0, LAS float* scr, int lane) {
#pragma unroll
    for (int i = 0; i < 32; ++i) { const int kk = 2 * i + (lane >> 5); float v = colp ? colp[(size_t)(k0 + kk) * ld] : 0.f; if (kscale) v *= kscale[k0 + kk]; scr[kk * 33 + (lane & 31)] = v; }
    LDS_WAIT(); asm volatile("" ::: "memory");
    const int c = lane & 7;
#pragma unroll
    for (int j = 0; j < 4; ++j) { const int n = (lane >> 3) + 8 * j; const LAS float* s = scr + (8 * c) * 33 + n;
        u32x4 o; o.x = pk_bf16(s[0 * 33], s[1 * 33]); o.y = pk_bf16(s[2 * 33], s[3 * 33]); o.z = pk_bf16(s[4 * 33], s[5 * 33]); o.w = pk_bf16(s[6 * 33], s[7 * 33]);
        *(u32x4*)(dst + (size_t)(n0 + n) * K + k0 + 8 * c) = o; }
    LDS_WAIT(); asm volatile("" ::: "memory");
}
constexpr int ITEMS_PER_LAYER = 9616;
__device__ __forceinline__ void convert_item(const Args& a, bf16_t* W, int l, int r, LAS float* scr, int lane) {
    const int w = lane & 31;
    if (r < 1152) { const int kb = r / 72, nb = r % 72, n = nb * 32 + w; int col;
        if (n < 1536) col = n; else { const int j = n - 1536; col = j < 384 ? 1544 + j : j < 640 ? 1928 + (j - 384) : j < 672 ? 2184 + (j - 640) : j < 680 ? 1536 + (j - 672) : -1; }
        const float* src = a.in[4] + (size_t)l * 1024 * 4264;
        tr_item(col >= 0 ? src + col : nullptr, 4264, nullptr, W + W_BT1, 1024, nb * 32, kb * 64, scr, lane); return; }
    r -= 1152;
    if (r < 1024) { const int kb = r / 64, nb = r % 64, n = nb * 32 + w; const float* src = a.in[4] + (size_t)l * 1024 * 4264;
        tr_item(src + 2216 + n, 4264, nullptr, W + W_BT2, 1024, nb * 32, kb * 64, scr, lane); return; }
    r -= 1024;
    if (r < 256) { const int kb = r / 32, nb = r % 32, n = nb * 32 + w; tr_item(a.in[6] + (size_t)l * 512 * 1024 + n, 1024, nullptr, W + W_FOXO, 512, nb * 32, kb * 64, scr, lane); return; }
    r -= 256;
    if (r < 256) { const int kb = r / 32, nb = r % 32, n = nb * 32 + w; tr_item(a.in[11] + (size_t)l * 512 * 1024 + n, 1024, nullptr, W + W_MLAO, 512, nb * 32, kb * 64, scr, lane); return; }
    r -= 256;
    if (r < 144) { const int kb = r / 24, nb = r % 24, n = nb * 32 + w; tr_item(a.in[8] + (size_t)l * 384 * 768 + n, 768, a.in[7] + l * 384, W + W_UQ, 384, nb * 32, kb * 64, scr, lane); return; }
    r -= 144;
    if (r < 128) { const int kb = r / 32, nb = r % 32, n = nb * 32 + w; const int col = n < 512 ? (n >> 6) * 128 + (n & 63) : ((n - 512) >> 6) * 128 + 64 + (n & 63);
        tr_item(a.in[10] + (size_t)l * 256 * 1024 + col, 1024, a.in[9] + l * 256, W + W_UKV, 256, nb * 32, kb * 64, scr, lane); return; }
    r -= 128;
    if (r < 512) { const int kb = r / 32, nb = r % 32, n = nb * 32 + w; tr_item(a.in[12] + (size_t)l * 1024 * 1024 + n, 1024, nullptr, W + W_OUT, 1024, nb * 32, kb * 64, scr, lane); return; }
    r -= 512;
    if (r < 4096) { const int e = r / 256, rr = r % 256, kb = rr / 16, nb = rr % 16;
        const float* src = (w < 16 ? a.in[17] : a.in[18]) + ((size_t)(l * 16 + e) * 1024) * 256 + 16 * nb + (w & 15);
        tr_item(src, 256, nullptr, W + W_MOE1 + (size_t)e * 512 * 1024, 1024, nb * 32, kb * 64, scr, lane); return; }
    r -= 4096;
    { const int e = r / 128, rr = r % 128, kb = rr / 32, nb = rr % 32, n = nb * 32 + w;
        tr_item(a.in[19] + ((size_t)(l * 16 + e) * 256) * 1024 + n, 1024, nullptr, W + W_MOE2 + (size_t)e * 1024 * 256, 256, nb * 32, kb * 64, scr, lane); }
}

__device__ __forceinline__ void ln16(f32x4 (&v)[4], const float* g, const float* bta, int lane) {
    float s = 0.f;
#pragma unroll
    for (int j = 0; j < 4; ++j) s += (v[j][0] + v[j][1]) + (v[j][2] + v[j][3]);
    const float mean = wave_sum(s) * (1.f / DM); float s2 = 0.f;
#pragma unroll
    for (int j = 0; j < 4; ++j) { v[j] = v[j] - mean; s2 += (v[j][0] * v[j][0] + v[j][1] * v[j][1]) + (v[j][2] * v[j][2] + v[j][3] * v[j][3]); }
    const float rstd = 1.0f / sqrtf(wave_sum(s2) * (1.f / DM) + 1e-5f);
#pragma unroll
    for (int j = 0; j < 4; ++j) { const f32x4 gg = *(const f32x4*)(g + 4 * lane + 256 * j), bb = *(const f32x4*)(bta + 4 * lane + 256 * j); v[j] = v[j] * rstd * gg + bb; }
}
template <int R>
__device__ __forceinline__ void ln16xR(f32x4 (&v)[R][4], const float* g, const float* bta, int lane) {
    float s[R];
#pragma unroll
    for (int k = 0; k < R; ++k) { s[k] = 0.f;
#pragma unroll
        for (int j = 0; j < 4; ++j) s[k] += (v[k][j][0] + v[k][j][1]) + (v[k][j][2] + v[k][j][3]); }
#pragma unroll
    for (int o = 1; o < 64; o <<= 1) {
#pragma unroll
        for (int k = 0; k < R; ++k) s[k] += __shfl_xor(s[k], o); }
    float s2[R];
#pragma unroll
    for (int k = 0; k < R; ++k) { const float mean = s[k] * (1.f / DM); s2[k] = 0.f;
#pragma unroll
        for (int j = 0; j < 4; ++j) { v[k][j] = v[k][j] - mean; s2[k] += (v[k][j][0] * v[k][j][0] + v[k][j][1] * v[k][j][1]) + (v[k][j][2] * v[k][j][2] + v[k][j][3] * v[k][j][3]); } }
#pragma unroll
    for (int o = 1; o < 64; o <<= 1) {
#pragma unroll
        for (int k = 0; k < R; ++k) s2[k] += __shfl_xor(s2[k], o); }
#pragma unroll
    for (int j = 0; j < 4; ++j) { const f32x4 gg = *(const f32x4*)(g + 4 * lane + 256 * j), bb = *(const f32x4*)(bta + 4 * lane + 256 * j);
#pragma unroll
        for (int k = 0; k < R; ++k) { const float rstd = 1.0f / sqrtf(s2[k] * (1.f / DM) + 1e-5f); v[k][j] = v[k][j] * rstd * gg + bb; } }
}
__device__ __forceinline__ void store_row_bf16(bf16_t* orow, const f32x4 (&v)[4], int lane) {
#pragma unroll
    for (int j = 0; j < 4; ++j) { u32x2 w; w.x = pk_bf16(v[j][0], v[j][1]); w.y = pk_bf16(v[j][2], v[j][3]); *(u32x2*)(orow + 4 * lane + 256 * j) = w; }
}

__device__ const double ROPE_INV_REV[16] = {0.15915494309189535, 0.08949940160889101, 0.050329212104487035, 0.0283021958306234, 0.015915494309189534, 0.008949940160889102,
    0.005032921210448704, 0.00283021958306234, 0.0015915494309189536, 0.0008949940160889102, 0.0005032921210448703, 0.00028302195830623395, 0.00015915494309189535,
    8.949940160889102e-05, 5.0329212104487035e-05, 2.8302195830623396e-05};

__global__ void __launch_bounds__(512, 2) fwd_kernel(Args args) {
    extern __shared__ __attribute__((aligned(16))) unsigned char lds_raw[];
    Frame F;
    F.lds = (LAS unsigned char*)lds_raw;
    F.MISC = (volatile LAS unsigned*)(F.lds + MISC_OFF);
    F.tid = threadIdx.x; F.lane = F.tid & 63; F.wave = __builtin_amdgcn_readfirstlane(F.tid >> 6);
    F.G = gridDim.x; { const int bx = blockIdx.x; F.vcu = (F.G % 8 == 0) ? (bx % 8) * (F.G / 8) + bx / 8 : bx; }
    unsigned char* ws = args.ws;
    F.ctl = (unsigned*)(ws + WS_CTL);
    for (int u = F.tid; u < (LDS_BYTES - MISC_OFF) / 4; u += 512) ((LAS unsigned*)(F.lds + MISC_OFF))[u] = 0u;
    __syncthreads();
    XcdBarrier bar = xcd_barrier_post(F.ctl + CW_BAR, F.MISC);
    const int NGW = F.G * 8;
#define PHASE_IDS int tid = threadIdx.x; asm volatile("" : "+v"(tid)); const int lane = tid & 63; const int wave = __builtin_amdgcn_readfirstlane(tid >> 6); const int gw = F.vcu * 8 + wave; (void)lane; (void)gw;

#define PHASE_PTRS unsigned char* wsl = args.ws; asm volatile("" : "+s"(wsl)); \
    float* ropeC = (float*)(wsl + WS_ROPE); float* ropeS = ropeC + LSEQ * 16; float* LFp = (float*)(wsl + WS_LF); float* CSp = (float*)(wsl + WS_CS); \
    unsigned* TOK = (unsigned*)(wsl + WS_TOK); int* LIST = (int*)(wsl + WS_LIST); bf16_t* Wall = (bf16_t*)(wsl + WS_W); bf16_t* HB = (bf16_t*)(wsl + WS_H); unsigned char* X = wsl + WS_X; \
    bf16_t *Qf = (bf16_t*)(X + X_QF), *Kf = (bf16_t*)(X + X_KF), *Vf = (bf16_t*)(X + X_VF), *RAW = (bf16_t*)(X + X_RAW), *Qm = (bf16_t*)(X + X_QM), *Km = (bf16_t*)(X + X_KM), \
           *Vm = (bf16_t*)(X + X_VM), *Om = (bf16_t*)(X + X_OM), *Of = (bf16_t*)(X + X_OF), *GATES = (bf16_t*)(X + X_GATES), *MERGED = (bf16_t*)(X + X_MERGED), *H1 = (bf16_t*)(X + X_H1), \
           *HID = (bf16_t*)(X + X_HID), *YS = (bf16_t*)(X + X_YS); float* Zb = (float*)(X + X_Z); unsigned* ctl = (unsigned*)(wsl + WS_CTL); \
    (void)ropeC; (void)ropeS; (void)LFp; (void)CSp; (void)TOK; (void)LIST; (void)Wall; (void)HB; (void)Qf; (void)Kf; (void)Vf; (void)RAW; (void)Qm; (void)Km; (void)Vm; (void)Om; (void)Of; (void)GATES; (void)MERGED; (void)H1; (void)HID; (void)YS; (void)Zb; (void)ctl;

    {
        PHASE_IDS
        PHASE_PTRS
        LAS float* scr = (LAS float*)(F.lds + wave * 16384);
        for (int it = gw; it < 2 * ITEMS_PER_LAYER; it += NGW) { const int l = it / ITEMS_PER_LAYER, r = it % ITEMS_PER_LAYER; convert_item(args, Wall + (size_t)l * W_LAYER, l, r, scr, lane); }
        for (int r4 = gw * 4; r4 < TP; r4 += NGW * 4) {
            if (r4 >= T) {
#pragma unroll
                for (int k = 0; k < 4; ++k) { bf16_t* orow = HB + (size_t)(r4 + k) * DM; *(u32x4*)(orow + 8 * lane) = (u32x4){0u, 0u, 0u, 0u}; *(u32x4*)(orow + 512 + 8 * lane) = (u32x4){0u, 0u, 0u, 0u}; }
                continue; }
            f32x4 v[4][4];
#pragma unroll
            for (int k = 0; k < 4; ++k) { const int row = r4 + k; const int b = row / LSEQ, p = row % LSEQ;
                const float* src = p < NMETA ? args.in[1] + (size_t)p * DM : args.in[0] + ((size_t)b * SEQ + (p - NMETA)) * DM;
#pragma unroll
                for (int j = 0; j < 4; ++j) v[k][j] = *(const f32x4*)(src + 4 * lane + 256 * j); }
            ln16xR<4>(v, args.in[2], args.in[3], lane);
#pragma unroll
            for (int k = 0; k < 4; ++k) store_row_bf16(HB + (size_t)(r4 + k) * DM, v[k], lane);
        }
        { float* RWT = (float*)(wsl + WS_RWT); const float* rw = args.in[15];
          for (int idx = blockIdx.x * 512 + tid; idx < 16384; idx += F.G * 512) { const int e = idx >> 10, col = idx & 1023; RWT[idx] = rw[col * 16 + e]; } }
        for (int idx = blockIdx.x * 512 + tid; idx < LSEQ * 16; idx += F.G * 512) {
            const int p = idx >> 4, i = idx & 15; double x = (double)p * ROPE_INV_REV[i]; x -= floor(x); const float xr = (float)x;
            ropeC[idx] = __builtin_amdgcn_cosf(xr); ropeS[idx] = __builtin_amdgcn_sinf(xr);
        }
    }
    xcd_barrier(bar);

    for (int l = 0; l < 2; ++l) {
        for (int rep_ = 0; rep_ < REP_GEMM; ++rep_) {
        {
            PHASE_PTRS const bf16_t* W = Wall + (size_t)l * W_LAYER;
            pg8::SchedStatic S{(const char*)HB, (const char*)(W + W_BT1), NPANEL, 17, F.G, (int)blockIdx.x, (size_t)256 * DM * 2, (size_t)256 * DM * 2};
            pg8::EpiA E{pg8::EpiA1{Qf, Kf, Vf, RAW, LFp, args.in[5] + l * 8}, pg8::EpiA2{(bf16_t*)args.out, (bf16_t*)(wsl + WS_GALT)}};
            pg8::gemm_phase<pg8::EpiA, pg8::SchedStatic, false>(F.lds, 1024, 1024, 1024, S, E);
        }
        xcd_barrier(bar);
        }
        for (int rep_ = 0; rep_ < REP_THIN; ++rep_) {
        {
            PHASE_IDS
            PHASE_PTRS
            if (blockIdx.x < 64 && wave == 0) {
                const int bb = blockIdx.x >> 3, hh = blockIdx.x & 7; float carry = 0.f;
                for (int i0 = 0; i0 < 65; i0 += 13) {
                    float v[13];
#pragma unroll
                    for (int k = 0; k < 13; ++k) { const int p = 64 * (i0 + k) + lane; v[k] = p < LSEQ ? LFp[((size_t)bb * LSEQ + p) * 8 + hh] : 0.f; }
#pragma unroll
                    for (int k = 0; k < 13; ++k) { float x = v[k];
#pragma unroll
                        for (int d = 1; d < 64; d <<= 1) { const float y = __shfl_up(x, d); if (lane >= d) x += y; }
                        x += carry; carry = __shfl(x, 63);
                        CSp[(size_t)blockIdx.x * CSP + 64 * (i0 + k) + lane] = x * LOG2E; }
                }
            }
            LAS unsigned* qkl = (LAS unsigned*)F.lds;
            if (tid < 128) qkl[tid] = 0u;
            __syncthreads();
            for (int r4 = gw * 4; r4 < T; r4 += NGW * 4) {
                u32x4 qv[4], kv2[4];
#pragma unroll
                for (int k = 0; k < 4; ++k) { qv[k] = *(const u32x4*)(Qf + (size_t)(r4 + k) * 512 + 8 * lane); kv2[k] = *(const u32x4*)(Kf + (size_t)(r4 + k) * 512 + 8 * lane); }
                float sq[4], sk[4];
#pragma unroll
                for (int k = 0; k < 4; ++k) {
                    const float a0 = bf_lo(qv[k].x), a1 = bf_hi(qv[k].x), a2 = bf_lo(qv[k].y), a3 = bf_hi(qv[k].y), a4 = bf_lo(qv[k].z), a5 = bf_hi(qv[k].z), a6 = bf_lo(qv[k].w), a7 = bf_hi(qv[k].w);
                    const float c0 = bf_lo(kv2[k].x), c1 = bf_hi(kv2[k].x), c2 = bf_lo(kv2[k].y), c3 = bf_hi(kv2[k].y), c4 = bf_lo(kv2[k].z), c5 = bf_hi(kv2[k].z), c6 = bf_lo(kv2[k].w), c7 = bf_hi(kv2[k].w);
                    sq[k] = (a0 * a0 + a1 * a1) + (a2 * a2 + a3 * a3) + (a4 * a4 + a5 * a5) + (a6 * a6 + a7 * a7);
                    sk[k] = (c0 * c0 + c1 * c1) + (c2 * c2 + c3 * c3) + (c4 * c4 + c5 * c5) + (c6 * c6 + c7 * c7); }
#pragma unroll
                for (int o = 1; o < 8; o <<= 1) {
#pragma unroll
                    for (int k = 0; k < 4; ++k) { sq[k] += __shfl_xor(sq[k], o); sk[k] += __shfl_xor(sk[k], o); } }
                if ((lane & 7) == 0) {
#pragma unroll
                    for (int k = 0; k < 4; ++k) { const int bh = ((r4 + k) / LSEQ) * 8 + (lane >> 3);
                        atomicMax((unsigned*)&qkl[2 * bh], __float_as_uint(sq[k])); atomicMax((unsigned*)&qkl[2 * bh + 1], __float_as_uint(sk[k])); } }
            }
            __syncthreads();
            if (tid < 128) { const unsigned v = qkl[tid]; if (v) __hip_atomic_fetch_max(ctl + CW_QKMAX + 128 * l + tid, v, RLX_AGENT); }
            for (int r4 = gw * 4; r4 < TP; r4 += NGW * 4) {
                u32x4 q[4], kv[4]; u32x2 ka[4], kc[4];
#pragma unroll
                for (int k = 0; k < 4; ++k) { const bf16_t* raw = RAW + (size_t)(r4 + k) * 768;
                    q[k] = (u32x4){0u, 0u, 0u, 0u}; kv[k] = (u32x4){0u, 0u, 0u, 0u}; ka[k] = (u32x2){0u, 0u}; kc[k] = (u32x2){0u, 0u};
                    if (lane < 48) q[k] = *(const u32x4*)(raw + 8 * lane);
                    if (lane < 32) kv[k] = *(const u32x4*)(raw + 384 + 8 * lane);
                    if (lane < 4) { ka[k] = *(const u32x2*)(raw + 640 + 4 * lane); kc[k] = *(const u32x2*)(raw + 656 + 4 * lane); } }
                float fq_[4][8], fk_[4][8], sq[4], sk[4];
#pragma unroll
                for (int k = 0; k < 4; ++k) {
                    fq_[k][0] = bf_lo(q[k].x); fq_[k][1] = bf_hi(q[k].x); fq_[k][2] = bf_lo(q[k].y); fq_[k][3] = bf_hi(q[k].y); fq_[k][4] = bf_lo(q[k].z); fq_[k][5] = bf_hi(q[k].z); fq_[k][6] = bf_lo(q[k].w); fq_[k][7] = bf_hi(q[k].w);
                    fk_[k][0] = bf_lo(kv[k].x); fk_[k][1] = bf_hi(kv[k].x); fk_[k][2] = bf_lo(kv[k].y); fk_[k][3] = bf_hi(kv[k].y); fk_[k][4] = bf_lo(kv[k].z); fk_[k][5] = bf_hi(kv[k].z); fk_[k][6] = bf_lo(kv[k].w); fk_[k][7] = bf_hi(kv[k].w);
                    sq[k] = 0.f; sk[k] = 0.f;
#pragma unroll
                    for (int j = 0; j < 8; ++j) { sq[k] += fq_[k][j] * fq_[k][j]; sk[k] += fk_[k][j] * fk_[k][j]; } }
#pragma unroll
                for (int o = 1; o < 64; o <<= 1) {
#pragma unroll
                    for (int k = 0; k < 4; ++k) { sq[k] += __shfl_xor(sq[k], o); sk[k] += __shfl_xor(sk[k], o); } }
#pragma unroll
                for (int k = 0; k < 4; ++k) { bf16_t* raw = RAW + (size_t)(r4 + k) * 768; const int pos = (r4 + k) % LSEQ;
                    const float rq = 1.0f / sqrtf(sq[k] * (1.f / 384.f) + 1e-6f), rk = 1.0f / sqrtf(sk[k] * (1.f / 256.f) + 1e-6f);
                    if (lane < 48) { u32x4 o; o.x = pk_bf16(fq_[k][0] * rq, fq_[k][1] * rq); o.y = pk_bf16(fq_[k][2] * rq, fq_[k][3] * rq); o.z = pk_bf16(fq_[k][4] * rq, fq_[k][5] * rq); o.w = pk_bf16(fq_[k][6] * rq, fq_[k][7] * rq); *(u32x4*)(raw + 8 * lane) = o; }
                    if (lane < 32) { u32x4 o; o.x = pk_bf16(fk_[k][0] * rk, fk_[k][1] * rk); o.y = pk_bf16(fk_[k][2] * rk, fk_[k][3] * rk); o.z = pk_bf16(fk_[k][4] * rk, fk_[k][5] * rk); o.w = pk_bf16(fk_[k][6] * rk, fk_[k][7] * rk); *(u32x4*)(raw + 384 + 8 * lane) = o; }
                    if (lane < 4) {
                        const u32x2 a = ka[k], c = kc[k];
                        const f32x4 x1 = {bf_lo(a.x), bf_hi(a.x), bf_lo(a.y), bf_hi(a.y)}, x2 = {bf_lo(c.x), bf_hi(c.x), bf_lo(c.y), bf_hi(c.y)};
                        const f32x4 cs = *(const f32x4*)(ropeC + pos * 16 + 4 * lane), sn = *(const f32x4*)(ropeS + pos * 16 + 4 * lane);
                        const f32x4 y1 = x1 * cs - x2 * sn, y2 = x2 * cs + x1 * sn;
                        u32x2 w1, w2; w1.x = pk_bf16(y1[0], y1[1]); w1.y = pk_bf16(y1[2], y1[3]); w2.x = pk_bf16(y2[0], y2[1]); w2.y = pk_bf16(y2[2], y2[3]);
                        bf16_t* kp = Km + (size_t)(r4 + k) * 768 + 64 + 4 * lane;
#pragma unroll
                        for (int h = 0; h < 8; ++h) { *(u32x2*)(kp + 96 * h) = w1; *(u32x2*)(kp + 96 * h + 16) = w2; }
                    } }
            }
        }
        xcd_barrier(bar);
        }
        for (int rep_ = 0; rep_ < REP_GEMM; ++rep_) {
        {
            PHASE_PTRS const bf16_t* W = Wall + (size_t)l * W_LAYER;
            pg8::SchedStatic S{(const char*)RAW, (const char*)(W + W_UQ), NPANEL, 3, F.G, (int)blockIdx.x, (size_t)256 * 768 * 2, (size_t)256 * 384 * 2};
            pg8::EpiQup E{Qm, ropeC, ropeS};
            pg8::gemm_phase<pg8::EpiQup, pg8::SchedStatic, false>(F.lds, 384, 768, 384, S, E);
        }
        {
            PHASE_PTRS const bf16_t* W = Wall + (size_t)l * W_LAYER;
            pg8::SchedStatic S{(const char*)(RAW + 384), (const char*)(W + W_UKV), NPANEL, 4, F.G, (int)blockIdx.x, (size_t)256 * 768 * 2, (size_t)256 * 256 * 2};
            pg8::EpiKV E{Km, Vm};
            pg8::gemm_phase<pg8::EpiKV, pg8::SchedStatic, false>(F.lds, 256, 768, 256, S, E);
        }
        xcd_barrier(bar);
        }
        {
            PHASE_IDS
            PHASE_PTRS
            const int myx = (int)(xb_xcc_id() & 7u);
            for (int rep_ = 0; rep_ < REP_MLA; ++rep_)
            for (int xo = 0; xo < 8; ++xo) { const int x = (myx + xo) & 7; unsigned* qc = ctl + CW_QCTR + 64 * ((rep_ * 4 + l * 2) * 8 + x);
                for (;;) {
                    if (tid == 0) F.MISC[4] = __hip_atomic_fetch_add(qc, 1u, RLX_AGENT);
                    __syncthreads();
                    const int id = (int)F.MISC[4];
                    __syncthreads();
                    if (id >= 136) break;
                    const int g = id / 34, i = id % 34, j = 16 - (i >> 1), h = 2 * g + (i & 1), b = x;
                    if (rep_ == 0) attn_unit2<96, false>((LAS char*)F.lds, Qm + 96 * h, 768, Km + 96 * h, 768, Vm + 64 * h, 512, Om + 64 * h, 512, nullptr, b, j, 0);
                    else attn_unit2<96, false, REP2_MODE>((LAS char*)F.lds, Qm + 96 * h, 768, Km + 96 * h, 768, Vm + 64 * h, 512, (bf16_t*)args.out + 64 * h, 512, nullptr, b, j, 0);
                } }
            for (int rep_ = 0; rep_ < REP_FOX; ++rep_)
            for (int xo = 0; xo < 8; ++xo) { const int x = (myx + xo) & 7; unsigned* qc = ctl + CW_QCTR + 64 * ((rep_ * 4 + l * 2 + 1) * 8 + x);
                for (;;) {
                    if (tid == 0) F.MISC[4] = __hip_atomic_fetch_add(qc, 1u, RLX_AGENT);
                    __syncthreads();
                    const int id = (int)F.MISC[4];
                    __syncthreads();
                    if (id >= 136) break;
                    const int g = id / 34, i = id % 34, j = 16 - (i >> 1), h = 2 * g + (i & 1), b = x;
                    int tmin = 0;
                    if (j > 0) {
                        const float* csr = CSp + (size_t)(b * 8 + h) * CSP;
                        const float q2 = __uint_as_float(__hip_atomic_load(ctl + CW_QKMAX + 128 * l + (b * 8 + h) * 2, RLX_AGENT)), k2 = __uint_as_float(__hip_atomic_load(ctl + CW_QKMAX + 128 * l + (b * 8 + h) * 2 + 1, RLX_AGENT));
                        const float qk = 2.0f * sqrtf(q2 * k2) * 1.0001f + 0.01f;
                        const float cq = csr[16 + 256 * (j - 1)];
                        const float ck = csr[lane == 0 ? 15 : 64 * lane + 15];
                        const bool ok = (qk + cq - ck) >= -100.0f;
                        const unsigned long long m = __ballot(ok);
                        tmin = m ? (int)__builtin_ctzll(m) : 64;
                        const int tfirst = 4 * (j - 1) + 1; tmin = tmin < tfirst ? tmin : tfirst;
                    }
                    tmin = __builtin_amdgcn_readfirstlane(tmin);
                    if (rep_ == 0) attn_unit2<64, true>((LAS char*)F.lds, Qf + 64 * h, 512, Kf + 64 * h, 512, Vf + 64 * h, 512, Of + 64 * h, 512, CSp + (size_t)(b * 8 + h) * CSP, b, j, tmin);
                    else attn_unit2<64, true, REP2_MODE>((LAS char*)F.lds, Qf + 64 * h, 512, Kf + 64 * h, 512, Vf + 64 * h, 512, (bf16_t*)args.out + 64 * h, 512, CSp + (size_t)(b * 8 + h) * CSP, b, j, 0);
                } }
        }
        xcd_barrier(bar);
        for (int rep_ = 0; rep_ < REP_GEMM; ++rep_) {
        {
            PHASE_PTRS const bf16_t* W = Wall + (size_t)l * W_LAYER;
            pg8::SchedOut S{(const char*)Of, (const char*)Om, (const char*)(W + W_FOXO), (const char*)(W + W_MLAO), NPANEL, 4, F.G, (int)blockIdx.x, (size_t)256 * 512 * 2, (size_t)256 * 512 * 2};
            pg8::EpiOut E{(const bf16_t*)args.out, (const bf16_t*)(wsl + WS_GALT), MERGED};
            pg8::gemm_phase<pg8::EpiOut, pg8::SchedOut, false>(F.lds, 512, 512, 512, S, E);
        }
        xcd_barrier(bar);
        }
        for (int rep_ = 0; rep_ < REP_GEMM; ++rep_) {
        {
            PHASE_PTRS const bf16_t* W = Wall + (size_t)l * W_LAYER;
            pg8::SchedStatic S{(const char*)MERGED, (const char*)(W + W_OUT), NPANEL, 4, F.G, (int)blockIdx.x, (size_t)256 * DM * 2, (size_t)256 * DM * 2};
            pg8::EpiF E{HB, Zb};
            pg8::gemm_phase<pg8::EpiF, pg8::SchedStatic, false>(F.lds, 1024, 1024, 1024, S, E);
        }
        xcd_barrier(bar);
        }
        {
            PHASE_IDS
            PHASE_PTRS
            LAS float* rwT = (LAS float*)F.lds;
            LAS int* lcnt = (LAS int*)(F.lds + 65536);
            LAS int* gbase = lcnt + 16;
            LAS int* tE = lcnt + 64;
            LAS int* tP = tE + 272;
            LAS float* tG = (LAS float*)(tP + 272);
            { const f32x4* RWT4 = (const f32x4*)(wsl + WS_RWT); LAS f32x4* d4 = (LAS f32x4*)rwT;
#pragma unroll
              for (int i = 0; i < 8; ++i) d4[tid + 512 * i] = RWT4[tid + 512 * i]; }
            LAS float* lgb = (LAS float*)(F.lds + 65536 + 8192) + wave * 64;
            if (tid < 16) lcnt[tid] = 0;
            __syncthreads();
            const int r0 = blockIdx.x * 129, nrows = (r0 + 129 <= T) ? 129 : (T > r0 ? T - r0 : 0);
            const float* rb = args.in[16];
            for (int g4 = wave * 4; g4 < nrows; g4 += 32) {
                f32x4 v[4][4];
#pragma unroll
                for (int k = 0; k < 4; ++k) { const int lr = (g4 + k < nrows) ? g4 + k : nrows - 1; const int row = r0 + lr;
#pragma unroll
                    for (int j = 0; j < 4; ++j) v[k][j] = *(const f32x4*)(Zb + (size_t)row * DM + 4 * lane + 256 * j); }
                ln16xR<4>(v, args.in[13] + l * DM, args.in[14] + l * DM, lane);
#pragma unroll
                for (int k = 0; k < 4; ++k) if (g4 + k < nrows) store_row_bf16(H1 + (size_t)(r0 + g4 + k) * DM, v[k], lane);
                float s[4][16];
#pragma unroll
                for (int e = 0; e < 16; ++e) {
                    f32x4 wv[4];
#pragma unroll
                    for (int j = 0; j < 4; ++j) wv[j] = *(const LAS f32x4*)(rwT + e * 1024 + 4 * lane + 256 * j);
#pragma unroll
                    for (int k = 0; k < 4; ++k) { float a = 0.f;
#pragma unroll
                        for (int j = 0; j < 4; ++j) a += (v[k][j][0] * wv[j][0] + v[k][j][1] * wv[j][1]) + (v[k][j][2] * wv[j][2] + v[k][j][3] * wv[j][3]);
                        s[k][e] = a; }
                }
#pragma unroll
                for (int k = 0; k < 4; ++k) {
#pragma unroll
                    for (int i = 0; i < 8; ++i) { const bool up = (lane & 32) != 0; const float mine = up ? s[k][i + 8] : s[k][i], oth = up ? s[k][i] : s[k][i + 8]; s[k][i] = mine + __shfl_xor(oth, 32); }
#pragma unroll
                    for (int i = 0; i < 4; ++i) { const bool up = (lane & 16) != 0; const float mine = up ? s[k][i + 4] : s[k][i], oth = up ? s[k][i] : s[k][i + 4]; s[k][i] = mine + __shfl_xor(oth, 16); }
#pragma unroll
                    for (int i = 0; i < 2; ++i) { const bool up = (lane & 8) != 0; const float mine = up ? s[k][i + 2] : s[k][i], oth = up ? s[k][i] : s[k][i + 2]; s[k][i] = mine + __shfl_xor(oth, 8); }
                    { const bool up = (lane & 4) != 0; const float mine = up ? s[k][1] : s[k][0], oth = up ? s[k][0] : s[k][1]; s[k][0] = mine + __shfl_xor(oth, 4); }
                    s[k][0] += __shfl_xor(s[k][0], 2); s[k][0] += __shfl_xor(s[k][0], 1);
                }
                if ((lane & 3) == 0) {
#pragma unroll
                    for (int k = 0; k < 4; ++k) lgb[k * 16 + (lane >> 2)] = s[k][0]; }
                LDS_WAIT();
                {
                    const int k = lane & 3;
                    float lg[16];
#pragma unroll
                    for (int q4 = 0; q4 < 4; ++q4) { const f32x4 t4 = *(const LAS f32x4*)(lgb + k * 16 + 4 * q4); lg[4 * q4] = t4[0]; lg[4 * q4 + 1] = t4[1]; lg[4 * q4 + 2] = t4[2]; lg[4 * q4 + 3] = t4[3]; }
                    float sc[16], bi[16];
#pragma unroll
                    for (int e = 0; e < 16; ++e) { sc[e] = 1.0f / (1.0f + expf(-lg[e])); bi[e] = sc[e] + rb[e]; }
                    int gsel = 0; float gbest = -INFINITY;
#pragma unroll
                    for (int g = 0; g < 4; ++g) { float m1 = bi[4 * g], m2 = -INFINITY;
#pragma unroll
                        for (int kk = 1; kk < 4; ++kk) { const float x = bi[4 * g + kk]; if (x > m1) { m2 = m1; m1 = x; } else if (x > m2) m2 = x; }
                        const float gs = m1 + m2; if (gs > gbest) { gbest = gs; gsel = g; } }
                    float b4[4], s4[4];
#pragma unroll
                    for (int kk = 0; kk < 4; ++kk) { b4[kk] = gsel == 0 ? bi[kk] : gsel == 1 ? bi[4 + kk] : gsel == 2 ? bi[8 + kk] : bi[12 + kk]; s4[kk] = gsel == 0 ? sc[kk] : gsel == 1 ? sc[4 + kk] : gsel == 2 ? sc[8 + kk] : sc[12 + kk]; }
                    int i1 = 0; float bb1 = b4[0], ss1 = s4[0];
#pragma unroll
                    for (int kk = 1; kk < 4; ++kk) if (b4[kk] > bb1) { bb1 = b4[kk]; ss1 = s4[kk]; i1 = kk; }
                    int i2 = -1; float bb2 = -INFINITY, ss2 = 0.f;
#pragma unroll
                    for (int kk = 0; kk < 4; ++kk) if (kk != i1 && b4[kk] > bb2) { bb2 = b4[kk]; ss2 = s4[kk]; i2 = kk; }
                    const float inv = 1.0f / (ss1 + ss2);
                    if (lane < 4 && g4 + k < nrows) {
                        const int lr = g4 + k; const int e0 = gsel * 4 + i1, e1 = gsel * 4 + i2;
                        tE[2 * lr] = e0; tE[2 * lr + 1] = e1;
                        tP[2 * lr] = atomicAdd((int*)&lcnt[e0], 1); tP[2 * lr + 1] = atomicAdd((int*)&lcnt[e1], 1);
                        tG[2 * lr] = ss1 * inv; tG[2 * lr + 1] = ss2 * inv;
                    }
                }
            }
            __syncthreads();
            if (tid < 16) gbase[tid] = (int)__hip_atomic_fetch_add(ctl + CW_ECNT + 64 * (l * 16 + tid), (unsigned)lcnt[tid], RLX_AGENT);
            __syncthreads();
            if (tid < nrows) {
                const int row = r0 + tid; const int e0 = tE[2 * tid], e1 = tE[2 * tid + 1];
                const int p0 = gbase[e0] + tP[2 * tid], p1 = gbase[e1] + tP[2 * tid + 1];
                LIST[(size_t)e0 * TP + p0] = row; LIST[(size_t)e1 * TP + p1] = row;
                u32x4 w0; w0.x = (unsigned)e0; w0.y = (unsigned)p0; w0.z = (unsigned)e1; w0.w = (unsigned)p1;
                *(u32x4*)(TOK + (size_t)row * 8) = w0;
                u32x2 w1; w1.x = __float_as_uint(tG[2 * tid]); w1.y = __float_as_uint(tG[2 * tid + 1]);
                *(u32x2*)(TOK + (size_t)row * 8 + 4) = w1;
            }
        }
        xcd_barrier(bar);
        LAS int* tb = (LAS int*)(F.lds + MISC_OFF) + 16; LAS int* ecnt = (LAS int*)(F.lds + MISC_OFF) + 64;
        if (threadIdx.x == 0) { int acc = 0; for (int e = 0; e < 16; ++e) { const int c = (int)__hip_atomic_load(F.ctl + CW_ECNT + 64 * (l * 16 + e), RLX_AGENT); ecnt[e] = c; tb[e] = acc; acc += (c + 255) >> 8; } tb[16] = acc; }
        __syncthreads();
        for (int rep_ = 0; rep_ < REP_GEMM; ++rep_) {
        {
            PHASE_PTRS const bf16_t* W = Wall + (size_t)l * W_LAYER;
            pg8::SchedMoe S{(const char*)H1, (const char*)(W + W_MOE1), tb, ecnt, LIST, 1, F.G, (int)blockIdx.x, (size_t)512 * 1024 * 2, (size_t)256 * 1024 * 2, 0, true};
            pg8::EpiM1 E{HID};
            pg8::gemm_phase<pg8::EpiM1, pg8::SchedMoe, true>(F.lds, 1024, 1024, 1024, S, E);
        }
        xcd_barrier(bar);
        }
        for (int rep_ = 0; rep_ < REP_GEMM; ++rep_) {
        {
            PHASE_PTRS const bf16_t* W = Wall + (size_t)l * W_LAYER;
            pg8::SchedMoe S{(const char*)HID, (const char*)(W + W_MOE2), tb, ecnt, LIST, 2, F.G, (int)blockIdx.x, (size_t)1024 * 256 * 2, (size_t)256 * 256 * 2, (size_t)256 * 256 * 2, false};
            pg8::EpiM2 E{YS};
            pg8::gemm_phase<pg8::EpiM2, pg8::SchedMoe, false>(F.lds, 256, 256, 256, S, E);
        }
        xcd_barrier(bar);
        }
        {
            PHASE_IDS
            PHASE_PTRS
            for (int rep_ = 0; rep_ < REP_J; ++rep_)
            for (int r4 = gw * 4; r4 < T; r4 += NGW * 4) {
                u32x4 w0[4]; u32x2 w1[4];
#pragma unroll
                for (int k = 0; k < 4; ++k) { w0[k] = *(const u32x4*)(TOK + (size_t)(r4 + k) * 8); w1[k] = *(const u32x2*)(TOK + (size_t)(r4 + k) * 8 + 4); }
                u32x2 hv[4][4], ya[4][4], yc[4][4];
#pragma unroll
                for (int k = 0; k < 4; ++k) {
                    const size_t s0 = (size_t)tb[(int)w0[k].x] * 256 + (int)w0[k].y, s1 = (size_t)tb[(int)w0[k].z] * 256 + (int)w0[k].w;
#pragma unroll
                    for (int j = 0; j < 4; ++j) { hv[k][j] = *(const u32x2*)(H1 + (size_t)(r4 + k) * DM + 4 * lane + 256 * j); ya[k][j] = *(const u32x2*)(YS + s0 * DM + 4 * lane + 256 * j); yc[k][j] = *(const u32x2*)(YS + s1 * DM + 4 * lane + 256 * j); } }
                f32x4 v[4][4];
#pragma unroll
                for (int k = 0; k < 4; ++k) { const float g0 = __uint_as_float(w1[k].x), g1 = __uint_as_float(w1[k].y);
#pragma unroll
                    for (int j = 0; j < 4; ++j) {
                        v[k][j][0] = ALPHA * bf_lo(hv[k][j].x) + g0 * bf_lo(ya[k][j].x) + g1 * bf_lo(yc[k][j].x); v[k][j][1] = ALPHA * bf_hi(hv[k][j].x) + g0 * bf_hi(ya[k][j].x) + g1 * bf_hi(yc[k][j].x);
                        v[k][j][2] = ALPHA * bf_lo(hv[k][j].y) + g0 * bf_lo(ya[k][j].y) + g1 * bf_lo(yc[k][j].y); v[k][j][3] = ALPHA * bf_hi(hv[k][j].y) + g0 * bf_hi(ya[k][j].y) + g1 * bf_hi(yc[k][j].y); } }
                ln16xR<4>(v, args.in[20] + l * DM, args.in[21] + l * DM, lane);
#pragma unroll
                for (int k = 0; k < 4; ++k) { const int row = r4 + k;
                    if (l == 0) store_row_bf16(HB + (size_t)row * DM, v[k], lane);
                    else { const int b = row / LSEQ, p = row % LSEQ;
                        if (p >= NMETA) { float* orow = args.out + ((size_t)b * SEQ + (p - NMETA)) * DM;
#pragma unroll
                            for (int j = 0; j < 4; ++j) *(f32x4*)(orow + 4 * lane + 256 * j) = v[k][j]; } } }
            }
        }
        if (l == 0) xcd_barrier(bar);
    }
}

extern "C" void kernel_launch(void* const* d_in, const int* in_sizes, int n_in, void* d_out, int out_size, void* d_ws, size_t ws_size, hipStream_t stream) {
    static int grid = 0;
    if (grid == 0) {
        if (n_in != 22 || ws_size < WS_END) { fprintf(stderr, "kernel_launch: need 22 inputs and %zu bytes of workspace (got %d, %zu)\n", (size_t)WS_END, n_in, ws_size); grid = -1; return; }
        int dev = 0, cus = 0, per_cu = 0;
        if (hipGetDevice(&dev) != hipSuccess || hipDeviceGetAttribute(&cus, hipDeviceAttributeMultiprocessorCount, dev) != hipSuccess) { grid = -1; return; }
        if (hipFuncSetAttribute((const void*)fwd_kernel, hipFuncAttributeMaxDynamicSharedMemorySize, LDS_BYTES) != hipSuccess) { fprintf(stderr, "kernel_launch: hipFuncSetAttribute failed\n"); grid = -1; return; }
        if (hipOccupancyMaxActiveBlocksPerMultiprocessor(&per_cu, (const void*)fwd_kernel, 512, LDS_BYTES) != hipSuccess || per_cu < 1) { fprintf(stderr, "kernel_launch: occupancy query says %d\n", per_cu); }
        (void)hipGetLastError();
        grid = cus;
    }
    if (grid < 0) return;
    if (hipMemsetAsync((char*)d_ws + WS_CTL, 0, CTL_BYTES, stream) != hipSuccess) return;
    Args a{};
    for (int i = 0; i < 22; ++i) a.in[i] = (const float*)d_in[i];
    a.out = (float*)d_out; a.ws = (unsigned char*)d_ws;
    hipLaunchKernelGGL(fwd_kernel, dim3(grid), dim3(512), LDS_BYTES, stream, a);
}
```

```cpp
#include <hip/hip_runtime.h>
#include <cstdio>
#include <cstdint>

#ifndef REP_A
#define REP_A 1
#endif
#ifndef REP_C
#define REP_C 1
#endif
#ifndef REP_E
#define REP_E 1
#endif
#ifndef REP_F
#define REP_F 1
#endif
#ifndef REP_H
#define REP_H 1
#endif
#ifndef REP_I
#define REP_I 1
#endif
#ifndef REP_GEMM
#define REP_GEMM 1
#endif
#ifndef REP_MLA
#define REP_MLA 1
#endif
#ifndef REP2_MODE
#define REP2_MODE 0
#endif
#ifndef REP_FOX
#define REP_FOX 1
#endif
#ifndef REP_J
#define REP_J 1
#endif
#ifndef REP_THIN
#define REP_THIN 1
#endif
#define LAS __attribute__((address_space(3)))
typedef unsigned short bf16_t;
typedef short bf16x8 __attribute__((ext_vector_type(8)));
typedef short s16x4 __attribute__((ext_vector_type(4)));
typedef float f32x4 __attribute__((ext_vector_type(4)));
typedef float f32x2_t __attribute__((ext_vector_type(2)));
typedef __bf16 bf16x2_t __attribute__((ext_vector_type(2)));
typedef float f32x16 __attribute__((ext_vector_type(16)));
typedef unsigned u32x4 __attribute__((ext_vector_type(4)));
typedef unsigned u32x2 __attribute__((ext_vector_type(2)));
typedef int i32x4 __attribute__((ext_vector_type(4)));

constexpr int NB = 8, SEQ = 4096, NMETA = 16, LSEQ = 4112, T = NB * LSEQ  , TP = 33024  , DM = 1024;
constexpr int NPANEL = TP / 256;
constexpr int NREAL = NB * SEQ;
__host__ __device__ __forceinline__ int row_of(int b, int p) { return p < NMETA ? NREAL + NMETA * b + p : SEQ * b + (p - NMETA); }
__host__ __device__ __forceinline__ int pos_of(int row) { return row < NREAL ? NMETA + (row & (SEQ - 1)) : (row - NREAL) & (NMETA - 1); }
constexpr int NEXP = 16;
constexpr float ALPHA = 1.41421356237309515f;
constexpr float LOG2E = 1.4426950408889634f;
constexpr float C2F = 0.125f * LOG2E;
constexpr float C2M = 0.14724444602590310f;
constexpr int CSP = 4160;

constexpr size_t MiB = 1ull << 20;
constexpr size_t WS_CTL = 0, CTL_BYTES = 1 * MiB;
constexpr size_t WS_ROPE = 1 * MiB;
constexpr size_t WS_RWT = 1 * MiB + 640 * 1024;
constexpr size_t WS_LF = 2 * MiB;
constexpr size_t WS_CS = 3 * MiB + 256 * 1024;
constexpr size_t WS_HBS = 8 * MiB + 512 * 1024;
constexpr size_t WS_H1S = 8 * MiB + 768 * 1024;
constexpr size_t WS_SSQ = 9 * MiB;
constexpr size_t WS_TOK = 4 * MiB + 512 * 1024;
constexpr size_t WS_LIST = 5 * MiB + 768 * 1024;
constexpr size_t WS_GALT = 8 * MiB;
constexpr size_t WS_W = 12 * MiB;
constexpr size_t WS_H = 88 * MiB;
constexpr size_t WS_X = 153 * MiB;
constexpr size_t S512 = (size_t)TP * 512 * 2, S768 = (size_t)TP * 768 * 2, S1024 = (size_t)TP * 1024 * 2;
constexpr size_t X_QF = 0, X_KF = S512, X_VF = 2 * S512, X_RAW = 3 * S512, X_QM = 3 * S512 + S768, X_KM = 3 * S512 + 2 * S768,
                 X_VM = 3 * S512 + 3 * S768, X_OM = 4 * S512 + 3 * S768, X_OF = 5 * S512 + 3 * S768, X_END = 6 * S512 + 3 * S768;
constexpr size_t X_HBQ = X_OM;
constexpr size_t X_H1Q = X_RAW;
constexpr size_t X_GATES = X_KF;
constexpr size_t X_MERGED = X_KM;
constexpr size_t X_Z = X_KF;
constexpr size_t X_H1 = X_KM;
constexpr size_t X_HID = X_QF;
constexpr size_t X_YS = 36 * MiB;
constexpr int NSLOT_TILES = 273, NSLOT = NSLOT_TILES * 256;
constexpr size_t WS_QKN = WS_X + X_END;
constexpr size_t WS_KR = WS_QKN + (size_t)TP * 128;
constexpr size_t WS_END = WS_KR + (size_t)TP * 64;
static_assert(X_GATES + (size_t)TP * 2048 * 2 <= X_KM, "gates");
static_assert(X_MERGED + S1024 <= X_OM, "merged");
static_assert(X_HID + (size_t)NSLOT * 256 * 2 <= X_YS, "hid");
static_assert(X_YS + (size_t)NSLOT * 1024 * 2 <= X_KM, "ys");
static_assert(WS_LF + (size_t)TP * 32 <= WS_CS && WS_CS + 64ull * CSP * 4 <= WS_TOK && WS_TOK + (size_t)TP * 32 <= WS_LIST && WS_LIST + 16ull * TP * 4 <= WS_GALT && WS_GALT + MiB <= WS_SSQ && WS_SSQ + (size_t)TP * 80 <= WS_W, "small buffers");
static_assert(WS_W + 2ull * 19693568ull * 2ull <= WS_H, "weights");
static_assert(WS_H + S1024 <= WS_X, "h");
constexpr size_t W_BT1 = 0, W_BT2 = W_BT1 + 2304ull * 1024, W_FOXO = W_BT2 + 2048ull * 1024, W_MLAO = W_FOXO + 1024ull * 512,
                 W_UQ = W_MLAO + 1024ull * 512, W_UKV = W_UQ + 768ull * 384, W_OUT = W_UKV + 1024ull * 256, W_MOE1 = W_OUT + 1024ull * 1024,
                 W_MOE2 = W_MOE1 + 16ull * 512 * 1024, W_LAYER = W_MOE2 + 16ull * 1024 * 256;
static_assert(W_LAYER == 19693568ull, "weights per layer");
constexpr int CW_BAR = 4096;
constexpr int CW_QCTR = 8192;
constexpr int CW_ECNT = 16384;
constexpr int CW_CMAX = 131072;
constexpr int CW_QKMAX = 20480;

constexpr int RING_BYTES = 131072;
constexpr int MISC_OFF = RING_BYTES;
constexpr int LDS_BYTES = 147456;

__device__ __forceinline__ unsigned pk_bf16(float lo, float hi) { f32x2_t v = {lo, hi}; bf16x2_t b = __builtin_convertvector(v, bf16x2_t); return __builtin_bit_cast(unsigned, b); }
__device__ __forceinline__ float bf_lo(unsigned u) { return __uint_as_float(u << 16); }
__device__ __forceinline__ float bf_hi(unsigned u) { return __uint_as_float(u & 0xffff0000u); }
__device__ __forceinline__ float wave_sum(float v) {
#pragma unroll
    for (int o = 1; o < 64; o <<= 1) v += __shfl_xor(v, o);
    return v;
}
#define LDS_WAIT() asm volatile("s_waitcnt lgkmcnt(0)" ::: "memory")
#define RLX_AGENT __ATOMIC_RELAXED, __HIP_MEMORY_SCOPE_AGENT

#define XB_TMO      128
#define XB_XCNT(j)  (256  + 64 * (j))
#define XB_XSUB(j)  (1280 + 64 * (j))
#define XB_XGEN(j)  (2304 + 64 * (j))
#define XB_TOP      3328
#define XB_TOPGEN   3392
#define XCD_BAR_WORDS 3456
#define XB_SPIN_CAP (1u << 20)
__device__ __forceinline__ unsigned xb_ld(unsigned* p)              { return __hip_atomic_load(p, __ATOMIC_RELAXED, __HIP_MEMORY_SCOPE_AGENT); }
__device__ __forceinline__ unsigned xb_add(unsigned* p, unsigned v) { return __hip_atomic_fetch_add(p, v, __ATOMIC_RELAXED, __HIP_MEMORY_SCOPE_AGENT); }
__device__ __forceinline__ unsigned xb_xcc_id() { return (unsigned)__builtin_amdgcn_s_getreg((3 << 11) | 20) & 0xFu; }
#define XB_SPIN(cond, bar) do { unsigned _sp = 0; while (cond) { __builtin_amdgcn_s_sleep(1); \
    if ((++_sp & 255u) == 0u) { if (xb_ld(&(bar)[XB_TMO])) break; if (_sp > XB_SPIN_CAP) { atomicAdd(&(bar)[XB_TMO], 1u); break; } } } } while (0)
struct XcdBarrier { unsigned* bar; unsigned x; volatile LAS unsigned* st; };
__device__ __forceinline__ XcdBarrier xcd_barrier_post(unsigned* bar, volatile LAS unsigned* st) {
    XcdBarrier b; b.bar = bar; b.x = xb_xcc_id(); b.st = st;
    if (threadIdx.x == 0) (void)xb_add(&bar[XB_XCNT(b.x)], 1u);
    return b;
}
__device__ __forceinline__ void xcd_barrier_complete(unsigned* bar, unsigned x, unsigned& nloc, unsigned& nx) {
    const unsigned G = gridDim.x * gridDim.y * gridDim.z;
    unsigned sum, cnt, mine, sp = 0u;
    for (;;) {
        sum = 0u; cnt = 0u; mine = 0u;
#pragma unroll
        for (unsigned j = 0; j < 16; ++j) { const unsigned c = xb_ld(&bar[XB_XCNT(j)]); sum += c; cnt += (c > 0u) ? 1u : 0u; mine = (j == x) ? c : mine; }
        if (sum == G) break;
        __builtin_amdgcn_s_sleep(1);
        if ((++sp & 255u) == 0u) { if (xb_ld(&bar[XB_TMO])) break; if (sp > XB_SPIN_CAP) { atomicAdd(&bar[XB_TMO], 1u); break; } }
    }
    nloc = mine > 0u ? mine : 1u; nx = cnt > 0u ? cnt : 1u;
}
__device__ __forceinline__ void xcd_barrier(const XcdBarrier& b) {
    asm volatile("s_waitcnt vmcnt(0)" ::: "memory");
    __syncthreads();
    if (threadIdx.x == 0) {
        unsigned* bar = b.bar; unsigned bx = b.x; asm volatile("" : "+s"(bar), "+s"(bx));
        __builtin_amdgcn_s_waitcnt(0);
        unsigned nloc = b.st[0], nx = b.st[1];
        if (nloc == 0u) { xcd_barrier_complete(bar, bx, nloc, nx); b.st[0] = nloc; b.st[1] = nx; }
        const unsigned old = xb_add(&bar[XB_XSUB(bx)], 1u);
        const unsigned gen = old / nloc;
        if (old + 1u == (gen + 1u) * nloc) {
            __builtin_amdgcn_fence(__ATOMIC_RELEASE, "agent");
            asm volatile("s_waitcnt vmcnt(0)" ::: "memory");
            const unsigned og = xb_add(&bar[XB_TOP], 1u);
            const unsigned tg = og / nx;
            if (og + 1u == (tg + 1u) * nx) xb_add(&bar[XB_TOPGEN], 1u);
            else XB_SPIN(xb_ld(&bar[XB_TOPGEN]) == tg, bar);
            __builtin_amdgcn_fence(__ATOMIC_ACQUIRE, "agent");
            xb_add(&bar[XB_XGEN(bx)], 1u);
            asm volatile("s_waitcnt vmcnt(0)" ::: "memory");
        } else {
            XB_SPIN(xb_ld(&bar[XB_XGEN(bx)]) == gen, bar);
            __builtin_amdgcn_fence(__ATOMIC_ACQUIRE, "agent");
            asm volatile("s_waitcnt vmcnt(0)" ::: "memory");
        }
    }
    __syncthreads();
}

namespace pg8 {
constexpr int BM = 256, BK = 64, HALF = 128, HTB = HALF * BK * 2, STAGE_BYTES = 8 * HTB;
__device__ __forceinline__ int lds_byte(int r, int c) { const int st = (r >> 4) * 2 + (c >> 5), rr = r & 15, cc = c & 31, ob = rr * 64 + cc * 2; return st * 1024 + (ob ^ (((ob >> 9) & 1) << 5)); }
__device__ __forceinline__ void stage_rc(int b, int& R, int& C) { const int st = b / 1024, sb = b % 1024, swz = sb ^ (((sb >> 9) & 1) << 5); R = (st >> 1) * 16 + swz / 64; C = (st & 1) * 32 + (swz % 64) / 2; }
__device__ __forceinline__ int perm32(int rho) { const int n = rho >> 4, i = rho & 15; return 8 * (i >> 2) + 4 * n + (i & 3); }
struct Unit { const char* A; const char* B; int pm, pn, aux, half; };
typedef f32x4 Acc[2][2][4][2];

__device__ __forceinline__ void tile_of(int L, int nM, int nN, int& pm, int& pn) {
    const int nwg = nM * nN; int wgid = L;
    { const int q = nwg / 8, r = nwg % 8, xcd = wgid % 8, off = wgid / 8; wgid = (xcd < r ? xcd * (q + 1) : r * (q + 1) + (xcd - r) * q) + off; }
    const int nig = 8 * nN, gid = wgid / nig, fm = gid * 8, gsz = (nM - fm) < 8 ? (nM - fm) : 8;
    pm = fm + ((wgid % nig) % gsz); pn = (wgid % nig) / gsz;
}

template <class Epi, class Sched, bool GATHER, bool MIDHOOK = false, bool I8 = false>
__device__ __forceinline__ void gemm_phase(LAS unsigned char* lds, const int K, const int lda, const int ldb, const Sched& S, const Epi& E) {
    int tid_l = threadIdx.x; asm volatile("" : "+v"(tid_l));
    const int tid = tid_l, wid = __builtin_amdgcn_readfirstlane(tid >> 6), lane = tid & 63, wr = wid >> 2, wc = wid & 3, fr = lane & 15, fq = lane >> 4;
    int nt = K / BK; asm volatile("" : "+s"(nt));
    unsigned voA[2][2], voB[2]; int Rr[2], Cc[2];
#pragma unroll
    for (int i = 0; i < 2; ++i) { int R, C; stage_rc(tid * 16 + i * 8192, R, C); const int Rb = Epi::PERM ? ((R & ~31) + perm32(R & 31)) : R;
        Rr[i] = R; Cc[i] = C; voA[0][i] = (unsigned)(R * lda + C) * 2u; voA[1][i] = (unsigned)((R + HALF) * lda + C) * 2u; voB[i] = (unsigned)(Rb * ldb + C) * 2u; }
    const size_t kstep = (size_t)(BK * 2);
    const size_t hstepB = (size_t)HALF * ldb * 2, hstepA = (size_t)HALF * lda * 2;
    const unsigned ldsw = (unsigned)wid * 1024u;
    const int aoff = lds_byte(wr * 64 + fr, fq * 8), boff = lds_byte(wc * 32 + fr, fq * 8);
#define PG8_SA(b, h) (((b) * 2 + (h)) * HTB)
#define PG8_SB(b, h) ((4 + (b) * 2 + (h)) * HTB)
#define PG8_STAGE2(bufoff, gbase, o0, o1) do { \
        __builtin_amdgcn_global_load_lds((const unsigned*)((const char*)(gbase) + (o0)), (LAS unsigned*)(lds + (bufoff) + ldsw), 16, 0, 0); \
        __builtin_amdgcn_global_load_lds((const unsigned*)((const char*)(gbase) + (o1)), (LAS unsigned*)(lds + (bufoff) + ldsw + 8192), 16, 0, 0); } while (0)
#define PG8_STA(b, h, gbase, VO) do { if constexpr (GATHER) PG8_STAGE2(PG8_SA(b, h), gbase, (VO)[h][0], (VO)[h][1]); else PG8_STAGE2(PG8_SA(b, h), (gbase) + (h) * hstepA, (VO)[0][0], (VO)[0][1]); } while (0)
#define PG8_STB(b, h, gbase) PG8_STAGE2(PG8_SB(b, h), (gbase) + (h) * hstepB, voB[0], voB[1])
#define PG8_LDA(dst, b, h) do { _Pragma("unroll") for (int m = 0; m < 4; ++m) _Pragma("unroll") for (int k = 0; k < 2; ++k) dst[m][k] = *(const LAS bf16x8*)(lds + PG8_SA(b, h) + aoff + m * 2048 + k * 1024); } while (0)
#define PG8_LDB(dst, b, h) do { _Pragma("unroll") for (int n = 0; n < 2; ++n) _Pragma("unroll") for (int k = 0; k < 2; ++k) dst[n][k] = *(const LAS bf16x8*)(lds + PG8_SB(b, h) + boff + n * 2048 + k * 1024); } while (0)
#define PG8_MMA(ai, bj, At, Bt) do { __builtin_amdgcn_s_setprio(1); _Pragma("unroll") for (int m = 0; m < 4; ++m) _Pragma("unroll") for (int n = 0; n < 2; ++n) _Pragma("unroll") for (int k = 0; k < 2; ++k) { \
        if constexpr (I8) acc[ai][bj][m][n] = __builtin_bit_cast(f32x4, __builtin_amdgcn_mfma_i32_16x16x64_i8(__builtin_bit_cast(i32x4, Bt[n][k]), __builtin_bit_cast(i32x4, At[m][k]), __builtin_bit_cast(i32x4, acc[ai][bj][m][n]), 0, 0, 0)); \
        else acc[ai][bj][m][n] = __builtin_amdgcn_mfma_f32_16x16x32_bf16(Bt[n][k], At[m][k], acc[ai][bj][m][n], 0, 0, 0); } __builtin_amdgcn_s_setprio(0); } while (0)
#define PG8_WAIT_V(n) asm volatile("s_waitcnt vmcnt(" #n ")" ::: "memory")
#define PG8_WAIT_L(n) asm volatile("s_waitcnt lgkmcnt(" #n ")" ::: "memory")
#define PG8_BAR __builtin_amdgcn_s_barrier()
#define PG8_SCHED __builtin_amdgcn_sched_barrier(0)
    Unit cur, nxt; int ui = 0;
    if (!S.next(0, cur)) return;
    Acc acc;
#pragma unroll
    for (int a = 0; a < 2; ++a)
#pragma unroll
        for (int b = 0; b < 2; ++b)
#pragma unroll
            for (int m = 0; m < 4; ++m)
#pragma unroll
                for (int n = 0; n < 2; ++n) acc[a][b][m][n] = (f32x4){0.f, 0.f, 0.f, 0.f};
    bf16x8 At[4][2], B0[2][2], B1[2][2];
    const char* cA = cur.A; const char* cB = cur.B;
    if constexpr (GATHER) {
#pragma unroll
        for (int h = 0; h < 2; ++h)
#pragma unroll
            for (int i = 0; i < 2; ++i) voA[h][i] = S.row_off(cur, Rr[i] + h * HALF) + (unsigned)Cc[i] * 2u;
    }
    PG8_STB(0, 0, cB); PG8_STB(0, 1, cB); PG8_STA(0, 0, cA, voA); PG8_STA(0, 1, cA, voA);
    if (wr == 1) PG8_BAR;
    PG8_WAIT_V(2); PG8_BAR;
    PG8_STB(1, 0, cB + kstep); PG8_STA(1, 0, cA + kstep, voA); PG8_STB(1, 1, cB + kstep);
    PG8_WAIT_V(6); PG8_BAR;
    for (;;) {
        const bool has_next = S.next(ui + 1, nxt);
        const char* nA = has_next ? nxt.A : cA; const char* nB = has_next ? nxt.B : cB;
        unsigned vnA[2][2];
        if constexpr (GATHER) {
#pragma unroll
            for (int h = 0; h < 2; ++h)
#pragma unroll
                for (int i = 0; i < 2; ++i) vnA[h][i] = has_next ? (S.row_off(nxt, Rr[i] + h * HALF) + (unsigned)Cc[i] * 2u) : voA[h][i];
        }
        for (int t = 0; t < nt; t += 2) {
            if constexpr (MIDHOOK) { if (t == (nt >> 1)) { int le_ = threadIdx.x & 63; asm volatile("" : "+v"(le_)); E.mid(acc, cur, wr, wc, le_ & 15, le_ >> 4); } }
            const bool last = (t == nt - 2);
            const char* a1 = cA + (size_t)(t + 1) * kstep;
            const char* a2 = last ? nA : cA + (size_t)(t + 2) * kstep; const char* b2 = last ? nB : cB + (size_t)(t + 2) * kstep;
            const char* a3 = a2 + kstep; const char* b3 = b2 + kstep;
            unsigned vs[2][2];
#pragma unroll
            for (int h = 0; h < 2; ++h)
#pragma unroll
                for (int i = 0; i < 2; ++i) { if constexpr (GATHER) vs[h][i] = last ? vnA[h][i] : voA[h][i]; else vs[h][i] = voA[h][i]; }
            PG8_LDB(B0, 0, 0); PG8_LDB(B1, 0, 1); PG8_SCHED; PG8_LDA(At, 0, 0); PG8_STA(1, 1, a1, voA);
            PG8_WAIT_V(8); PG8_WAIT_L(0); PG8_BAR; PG8_MMA(0, 0, At, B0); PG8_MMA(0, 1, At, B1); PG8_BAR; PG8_SCHED;
            PG8_LDA(At, 0, 1); PG8_STB(0, 0, b2); PG8_STB(0, 1, b2); PG8_STA(0, 0, a2, vs);
            PG8_WAIT_V(8); PG8_WAIT_L(0); PG8_BAR; if (!cur.half) { PG8_MMA(1, 0, At, B0); PG8_MMA(1, 1, At, B1); } PG8_BAR; PG8_SCHED;
            PG8_LDB(B0, 1, 0); PG8_LDB(B1, 1, 1); PG8_SCHED; PG8_LDA(At, 1, 0); PG8_STA(0, 1, a2, vs);
            PG8_WAIT_V(8); PG8_WAIT_L(0); PG8_BAR; PG8_MMA(0, 0, At, B0); PG8_MMA(0, 1, At, B1); PG8_BAR; PG8_SCHED;
            PG8_LDA(At, 1, 1); PG8_STB(1, 0, b3); PG8_STB(1, 1, b3); PG8_STA(1, 0, a3, vs);
            PG8_WAIT_V(8); PG8_WAIT_L(0); PG8_BAR; if (!cur.half) { PG8_MMA(1, 0, At, B0); PG8_MMA(1, 1, At, B1); } PG8_BAR; PG8_SCHED;
        }
        if (wr == 0) PG8_BAR;
        { int le_ = threadIdx.x & 63; asm volatile("" : "+v"(le_));
          E(acc, cur, wr, wc, le_ & 15, le_ >> 4); }
        if (!has_next) break;
#pragma unroll
        for (int a = 0; a < 2; ++a)
#pragma unroll
            for (int b = 0; b < 2; ++b)
#pragma unroll
                for (int m = 0; m < 4; ++m)
#pragma unroll
                    for (int n = 0; n < 2; ++n) acc[a][b][m][n] = (f32x4){0.f, 0.f, 0.f, 0.f};
        cur = nxt; cA = nA; cB = nB; ++ui;
        if constexpr (GATHER) {
#pragma unroll
            for (int h = 0; h < 2; ++h)
#pragma unroll
                for (int i = 0; i < 2; ++i) voA[h][i] = vnA[h][i];
        }
        if (wr == 1) PG8_BAR;
    }
    PG8_WAIT_V(0);
    PG8_BAR;
#undef PG8_SA
#undef PG8_SB
#undef PG8_STAGE2
#undef PG8_STA
#undef PG8_STB
#undef PG8_LDA
#undef PG8_LDB
#undef PG8_MMA
#undef PG8_WAIT_V
#undef PG8_WAIT_L
#undef PG8_BAR
#undef PG8_SCHED
}

struct SchedStatic {
    const char* A; const char* B; int nM, nN, G, c; size_t astep, bstep; int tail;
    __device__ __forceinline__ bool next(int i, Unit& u) const {
        const long L = (long)i * G + c; if (L >= (long)nM * nN) return false;
        int pm, pn; const int nfull = (nM - tail) * nN;
        if ((int)L < nfull) { tile_of((int)L, nM - tail, nN, pm, pn); u.half = 0; } else { pm = nM - 1; pn = (int)L - nfull; u.half = 1; }
        u.pm = pm; u.pn = pn; u.aux = 0; u.A = A + (size_t)pm * astep; u.B = B + (size_t)pn * bstep; return true;
    }
    __device__ __forceinline__ unsigned row_off(const Unit&, int) const { return 0u; }
};
struct SchedOut {
    const char* A0; const char* A1; const char* B0; const char* B1; int nM, nN, G, c; size_t astep, bstep;
    __device__ __forceinline__ bool next(int i, Unit& u) const {
        const long L = (long)(i >> 1) * G + c; if (L >= (long)nM * nN) return false;
        int pm, pn; const int nfull = (nM - 1) * nN;
        if ((int)L < nfull) { tile_of((int)L, nM - 1, nN, pm, pn); u.half = 0; } else { pm = nM - 1; pn = (int)L - nfull; u.half = 1; }
        const int pass = i & 1;
        u.pm = pm; u.pn = pn; u.aux = pass; u.A = (pass ? A1 : A0) + (size_t)pm * astep; u.B = (pass ? B1 : B0) + (size_t)pn * bstep; return true;
    }
    __device__ __forceinline__ unsigned row_off(const Unit&, int) const { return 0u; }
};
struct SchedMoe {
    const char* A; const char* B; const LAS int* tb; const LAS int* cnt; const int* list; int npn_shift, G, c; size_t bstep_e, bstep_n, astep; bool gather; int rowbytes;
    __device__ __forceinline__ bool next(int i, Unit& u) const {
        const int L = i * G + c; const int ntile = tb[16];
        if (L >= (ntile << npn_shift)) return false;
        const int ti = L >> npn_shift, pn = L & ((1 << npn_shift) - 1);
        int e = 0; while (ti >= tb[e + 1]) ++e;
        u.pm = ti; u.pn = pn; u.aux = e; u.half = (cnt[e] - (ti - tb[e]) * 256) <= 128 ? 1 : 0;
        u.A = gather ? A : A + (size_t)ti * astep;
        u.B = B + (size_t)e * bstep_e + (size_t)pn * bstep_n; return true;
    }
    __device__ __forceinline__ unsigned row_off(const Unit& u, int r) const {
        const int e = u.aux; int idx = (u.pm - tb[e]) * 256 + r; const int ce = cnt[e]; idx = idx < ce ? idx : ce - 1;
        const int tok = list[(size_t)e * TP + idx];
        return (unsigned)tok * (unsigned)rowbytes;
    }
};

__device__ __forceinline__ f32x4 dq4(const f32x4& a, float srow, const f32x4& scol) { const i32x4 i = __builtin_bit_cast(i32x4, a); return (f32x4){(float)i[0], (float)i[1], (float)i[2], (float)i[3]} * srow * scol; }
__device__ __forceinline__ f32x4 cmscale(const unsigned* cm) { const u32x4 u = *(const u32x4*)cm; return (f32x4){__uint_as_float(u.x), __uint_as_float(u.y), __uint_as_float(u.z), __uint_as_float(u.w)} * (1.0f / 127.0f); }
__device__ __forceinline__ u32x4 pack8(f32x4 v0, f32x4 v1) { u32x4 w; w.x = pk_bf16(v0[0], v0[1]); w.y = pk_bf16(v0[2], v0[3]); w.z = pk_bf16(v1[0], v1[1]); w.w = pk_bf16(v1[2], v1[3]); return w; }
__device__ __forceinline__ float logsig(float x) { return fminf(x, 0.f) - log1pf(__expf(-fabsf(x))); }
__device__ __forceinline__ float sigm(float x) { return __builtin_amdgcn_rcpf(1.0f + __builtin_amdgcn_exp2f(-LOG2E * x)); }

struct EpiA1 {
    static constexpr bool PERM = true;
    bf16_t *Qf, *Kf, *Vf, *RAW; float* LF; const float* fbias; float* qkn; float* ssq; bf16_t* Km; const float* cosT; const float* sinT; const float* hbs; const unsigned* cm;
    __device__ __forceinline__ void operator()(const Acc& acc, const Unit& u, int wr, int wc, int fr, int fq) const {
        const int pn = u.pn; bf16_t* base; int ldc, colt; float sc = 1.f;
        if (pn < 2) { base = Qf; ldc = 512; colt = pn * 256; sc = C2F; } else if (pn < 4) { base = Kf; ldc = 512; colt = (pn - 2) * 256; }
        else if (pn < 6) { base = Vf; ldc = 512; colt = (pn - 4) * 256; } else { base = RAW; ldc = 768; colt = (pn - 6) * 256; }
        const int row0 = u.pm * 256 + wr * 64 + fr, col0 = colt + wc * 32 + 8 * fq;
        f32x4 sb[2][2];
#pragma unroll
        for (int bj = 0; bj < 2; ++bj) { const unsigned* c_ = cm + pn * 256 + bj * 128 + wc * 32 + 8 * fq; sb[bj][0] = cmscale(c_); sb[bj][1] = cmscale(c_ + 4); }
        float sa8[2][4];
#pragma unroll
        for (int ai = 0; ai < 2; ++ai)
#pragma unroll
            for (int m = 0; m < 4; ++m) sa8[ai][m] = hbs[row0 + ai * 128 + m * 16];
#pragma unroll
        for (int ai = 0; ai < 2; ++ai)
#pragma unroll
            for (int m = 0; m < 4; ++m) { if (ai == 1 && u.half && !(pn == 4 || pn == 5)) continue;
                const int row = row0 + ai * 128 + m * 16; bf16_t* rowp = base + (size_t)row * ldc + col0;
                const float sa = sa8[ai][m] * sc;
#pragma unroll
                for (int bj = 0; bj < 2; ++bj) { const u32x4 w = pack8(dq4(acc[ai][bj][m][0], sa, sb[bj][0]), dq4(acc[ai][bj][m][1], sa, sb[bj][1])); *(u32x4*)(rowp + bj * 128) = w;
                    if (pn < 4 || pn >= 6) {
                        const float a0 = bf_lo(w.x), a1 = bf_hi(w.x), a2 = bf_lo(w.y), a3 = bf_hi(w.y), a4 = bf_lo(w.z), a5 = bf_hi(w.z), a6 = bf_lo(w.w), a7 = bf_hi(w.w);
                        float ss = (a0 * a0 + a1 * a1) + (a2 * a2 + a3 * a3) + (a4 * a4 + a5 * a5) + (a6 * a6 + a7 * a7);
                        { auto r16 = __builtin_amdgcn_permlane16_swap(__float_as_uint(ss), __float_as_uint(ss), false, false); ss = __uint_as_float(r16[0]) + __uint_as_float(r16[1]); }
                        { auto r32_ = __builtin_amdgcn_permlane32_swap(__float_as_uint(ss), __float_as_uint(ss), false, false); ss = __uint_as_float(r32_[0]) + __uint_as_float(r32_[1]); }
                        if (pn < 4) { if (fq == 0) qkn[(size_t)row * 32 + (pn >> 1) * 16 + (pn & 1) * 8 + bj * 4 + wc] = ss; }
                        else { const int g32 = (pn - 6) * 8 + bj * 4 + wc;
                            if (fq == 0 && g32 < 20) ssq[(size_t)row * 20 + g32] = ss; } } } }
        if (pn == 8 && wc == 0) {
#pragma unroll
            for (int aim = 0; aim < 4; ++aim) { const int ai = aim >> 1; if (ai == 1 && u.half) continue;
                f32x4 cs4[2], sn4[2];
#pragma unroll
                for (int mm = 0; mm < 2; ++mm) { const int pos = pos_of(row0 + ai * 128 + ((aim & 1) * 2 + mm) * 16); cs4[mm] = *(const f32x4*)(cosT + pos * 16 + 4 * fq); sn4[mm] = *(const f32x4*)(sinT + pos * 16 + 4 * fq); }
#pragma unroll
                for (int mm = 0; mm < 2; ++mm) { const int m = (aim & 1) * 2 + mm; const int row = row0 + ai * 128 + m * 16;
                    const float sa = sa8[ai][m]; const f32x4 x1 = dq4(acc[ai][1][m][0], sa, sb[1][0]), x2 = dq4(acc[ai][1][m][1], sa, sb[1][1]);
                    const f32x4 cs = cs4[mm], sn = sn4[mm];
                    const f32x4 y1 = x1 * cs - x2 * sn, y2 = x2 * cs + x1 * sn;
                    u32x2 w1, w2; w1.x = pk_bf16(y1[0], y1[1]); w1.y = pk_bf16(y1[2], y1[3]); w2.x = pk_bf16(y2[0], y2[1]); w2.y = pk_bf16(y2[2], y2[3]);
                    bf16_t* kp = Km + (size_t)row * 32 + 4 * fq;
                    *(u32x2*)kp = w1; *(u32x2*)(kp + 16) = w2; } }
        }
        if (pn == 8 && wc == 1 && fq == 0) {
            const f32x4 b0 = *(const f32x4*)fbias, b1 = *(const f32x4*)(fbias + 4);
#pragma unroll
            for (int ai = 0; ai < 2; ++ai)
#pragma unroll
                for (int m = 0; m < 4; ++m) { if (ai == 1 && u.half) continue; const int row = row0 + ai * 128 + m * 16; const float sa = sa8[ai][m]; const f32x4 a = dq4(acc[ai][1][m][0], sa, sb[1][0]) + b0, b = dq4(acc[ai][1][m][1], sa, sb[1][1]) + b1;
                    f32x4 o0, o1;
#pragma unroll
                    for (int j = 0; j < 4; ++j) { o0[j] = logsig(a[j]); o1[j] = logsig(b[j]); }
                    *(f32x4*)(LF + (size_t)row * 8) = o0; *(f32x4*)(LF + (size_t)row * 8 + 4) = o1; }
        }
    }
};
struct EpiA2 {
    static constexpr bool PERM = true;
    unsigned char* Gm; unsigned char* Galt; const float* hbs; const unsigned* cm;
    __device__ __forceinline__ void operator()(const Acc& acc, const Unit& u, int wr, int wc, int fr, int fq) const {
        unsigned char* G = (u.pm == 128) ? Galt - (size_t)32768 * 2048 : Gm;
        const int row0 = u.pm * 256 + wr * 64 + fr, col0 = (u.pn - 9) * 256 + wc * 32 + 8 * fq;
        f32x4 sb[2][2];
#pragma unroll
        for (int bj = 0; bj < 2; ++bj) { const unsigned* c_ = cm + u.pn * 256 + bj * 128 + wc * 32 + 8 * fq; sb[bj][0] = cmscale(c_); sb[bj][1] = cmscale(c_ + 4); }
        float sa8[2][4];
#pragma unroll
        for (int ai = 0; ai < 2; ++ai)
#pragma unroll
            for (int m = 0; m < 4; ++m) sa8[ai][m] = hbs[row0 + ai * 128 + m * 16];
#pragma unroll
        for (int ai = 0; ai < 2; ++ai)
#pragma unroll
            for (int m = 0; m < 4; ++m) { if (ai == 1 && u.half) continue; unsigned char* rowp = G + (size_t)(row0 + ai * 128 + m * 16) * 2048 + col0; const float sa = sa8[ai][m];
#pragma unroll
                for (int bj = 0; bj < 2; ++bj) { const f32x4 a = dq4(acc[ai][bj][m][0], sa, sb[bj][0]), b = dq4(acc[ai][bj][m][1], sa, sb[bj][1]); unsigned q[8];
#pragma unroll
                    for (int j = 0; j < 4; ++j) { q[j] = (unsigned)fmaxf(255.0f * sigm(a[j]) + 0.5f, 1.0f); q[4 + j] = (unsigned)fmaxf(255.0f * sigm(b[j]) + 0.5f, 1.0f); }
                    u32x2 w; w.x = q[0] | (q[1] << 8) | (q[2] << 16) | (q[3] << 24); w.y = q[4] | (q[5] << 8) | (q[6] << 16) | (q[7] << 24);
                    *(u32x2*)(rowp + bj * 128) = w; } }
    }
};
struct EpiA {
    static constexpr bool PERM = true;
    EpiA1 e1; EpiA2 e2;
    __device__ __forceinline__ void operator()(const Acc& acc, const Unit& u, int wr, int wc, int fr, int fq) const { if (u.pn < 9) e1(acc, u, wr, wc, fr, fq); else e2(acc, u, wr, wc, fr, fq); }
};
struct EpiQup {
    static constexpr bool PERM = false;
    bf16_t* Qm; const float* cosT; const float* sinT; const float* ssq;
    __device__ __forceinline__ void operator()(const Acc& acc, const Unit& u, int wr, int wc, int fr, int fq) const {
        const int row0 = u.pm * 256 + wr * 64 + fr;
        float rq8[2][4];
#pragma unroll
        for (int ai = 0; ai < 2; ++ai)
#pragma unroll
            for (int m = 0; m < 4; ++m) { const int row = row0 + ai * 128 + m * 16;
                float sq_; { const f32x4 a = *(const f32x4*)(ssq + (size_t)row * 20), b4 = *(const f32x4*)(ssq + (size_t)row * 20 + 4), c4 = *(const f32x4*)(ssq + (size_t)row * 20 + 8); sq_ = ((a[0] + a[1]) + (a[2] + a[3])) + ((b4[0] + b4[1]) + (b4[2] + b4[3])) + ((c4[0] + c4[1]) + (c4[2] + c4[3])); }
                rq8[ai][m] = C2M * __builtin_amdgcn_rsqf(sq_ * (1.f / 384.f) + 1e-6f);
                if (m & 1) asm volatile("" : "+v"(rq8[ai][m - 1]), "+v"(rq8[ai][m])); }
        const bool anyrot = ((u.pn * 8 + wc) % 3 == 2) || ((u.pn * 8 + 4 + wc) % 3 == 2);
#pragma unroll
        for (int aim = 0; aim < 4; ++aim) { const int ai = aim >> 1; if (ai == 1 && u.half) continue;
            f32x4 cs4[2], sn4[2];
            if (anyrot) {
#pragma unroll
                for (int mm = 0; mm < 2; ++mm) { const int pos = pos_of(row0 + ai * 128 + ((aim & 1) * 2 + mm) * 16); cs4[mm] = *(const f32x4*)(cosT + pos * 16 + 4 * fq); sn4[mm] = *(const f32x4*)(sinT + pos * 16 + 4 * fq); } }
#pragma unroll
            for (int mm = 0; mm < 2; ++mm) { const int m = (aim & 1) * 2 + mm; const int row = row0 + ai * 128 + m * 16;
                const float rq = rq8[ai][m];
#pragma unroll
                for (int bj = 0; bj < 2; ++bj) { const int Gi = u.pn * 8 + bj * 4 + wc; f32x4 x0 = acc[ai][bj][m][0], x1 = acc[ai][bj][m][1];
                    if (Gi % 3 == 2) { const f32x4 cs = cs4[mm], sn = sn4[mm];
                        const f32x4 y0 = x0 * cs - x1 * sn, y1 = x1 * cs + x0 * sn; x0 = y0; x1 = y1; }
                    x0 = x0 * rq; x1 = x1 * rq;
                    bf16_t* p = Qm + (size_t)row * 768 + Gi * 32 + 4 * fq;
                    u32x2 w0, w1; w0.x = pk_bf16(x0[0], x0[1]); w0.y = pk_bf16(x0[2], x0[3]); w1.x = pk_bf16(x1[0], x1[1]); w1.y = pk_bf16(x1[2], x1[3]);
                    *(u32x2*)p = w0; *(u32x2*)(p + 16) = w1; } } }
    }
};
struct EpiKV {
    static constexpr bool PERM = true;
    bf16_t *Km, *Vm; const float* ssq;
    __device__ __forceinline__ void operator()(const Acc& acc, const Unit& u, int wr, int wc, int fr, int fq) const {
        const int row0 = u.pm * 256 + wr * 64 + fr;
        float rk8[2][4];
#pragma unroll
        for (int ai = 0; ai < 2; ++ai)
#pragma unroll
            for (int m = 0; m < 4; ++m) { const int row = row0 + ai * 128 + m * 16;
                float sk_; { const f32x4 a = *(const f32x4*)(ssq + (size_t)row * 20 + 12), b4 = *(const f32x4*)(ssq + (size_t)row * 20 + 16); sk_ = ((a[0] + a[1]) + (a[2] + a[3])) + ((b4[0] + b4[1]) + (b4[2] + b4[3])); }
                rk8[ai][m] = __builtin_amdgcn_rsqf(sk_ * (1.f / 256.f) + 1e-6f); }
#pragma unroll
        for (int ai = 0; ai < 2; ++ai)
#pragma unroll
            for (int m = 0; m < 4; ++m) { const bool padrows = (ai == 1 && u.half); if (padrows && u.pn < 2) continue; const int row = row0 + ai * 128 + m * 16;
                if (padrows) {
#pragma unroll
                    for (int bj = 0; bj < 2; ++bj) { const int n = u.pn * 256 + bj * 128 + wc * 32 + 8 * fq; *(u32x4*)(Vm + (size_t)row * 512 + (n - 512)) = (u32x4){0u, 0u, 0u, 0u}; }
                    continue; }
                const float rk = rk8[ai][m];
#pragma unroll
                for (int bj = 0; bj < 2; ++bj) { const int n = u.pn * 256 + bj * 128 + wc * 32 + 8 * fq; const u32x4 w = pack8(acc[ai][bj][m][0] * rk, acc[ai][bj][m][1] * rk);
                    if (u.pn < 2) *(u32x4*)(Km + (size_t)row * 768 + 96 * (n >> 6) + (n & 63)) = w;
                    else *(u32x4*)(Vm + (size_t)row * 512 + (n - 512)) = w; } }
    }
};
struct EpiOut {
    static constexpr bool PERM = true;
    const unsigned char* Gm; const unsigned char* Galt; bf16_t* Mg;
    __device__ __forceinline__ void mid(Acc& acc, const Unit& u, int wr, int wc, int fr, int fq) const {
        const unsigned char* G = (u.pm == 128) ? Galt - (size_t)32768 * 2048 : Gm;
        const int row0 = u.pm * 256 + wr * 64 + fr, col0 = u.pn * 256 + wc * 32 + 8 * fq;
#pragma unroll
        for (int ai = 0; ai < 2; ++ai)
#pragma unroll
            for (int m = 0; m < 4; ++m) { if (ai == 1 && u.half) continue; const int row = row0 + ai * 128 + m * 16;
#pragma unroll
                for (int bj = 0; bj < 2; ++bj) { const int col = col0 + bj * 128;
                    const u32x2 gf = *(const u32x2*)(G + (size_t)row * 2048 + col), gm = *(const u32x2*)(G + (size_t)row * 2048 + 1024 + col);
                    f32x4& a = acc[ai][bj][m][0]; f32x4& b = acc[ai][bj][m][1];
#pragma unroll
                    for (int j = 0; j < 4; ++j) { a[j] *= (float)((gf.x >> (8 * j)) & 255u) * __builtin_amdgcn_rcpf((float)((gm.x >> (8 * j)) & 255u)); b[j] *= (float)((gf.y >> (8 * j)) & 255u) * __builtin_amdgcn_rcpf((float)((gm.y >> (8 * j)) & 255u)); } }
                if (m & 1) asm volatile("" ::: "memory"); }
    }
    __device__ __forceinline__ void operator()(const Acc& acc, const Unit& u, int wr, int wc, int fr, int fq) const {
        const unsigned char* G = (u.pm == 128) ? Galt - (size_t)32768 * 2048 : Gm;
        const int row0 = u.pm * 256 + wr * 64 + fr, col0 = u.pn * 256 + wc * 32 + 8 * fq;
#pragma unroll
        for (int ai = 0; ai < 2; ++ai) { if (ai == 1 && u.half) continue;
            u32x2 g8[4][2];
#pragma unroll
            for (int m = 0; m < 4; ++m)
#pragma unroll
                for (int bj = 0; bj < 2; ++bj) g8[m][bj] = *(const u32x2*)(G + (size_t)(row0 + ai * 128 + m * 16) * 2048 + 1024 + col0 + bj * 128);
            if (ai == 0) asm volatile("" ::: "memory");
#pragma unroll
            for (int m = 0; m < 4; ++m) { const int row = row0 + ai * 128 + m * 16;
#pragma unroll
                for (int bj = 0; bj < 2; ++bj) { const int col = col0 + bj * 128;
                    const u32x2 g = g8[m][bj];
                    f32x4 a = acc[ai][bj][m][0], b = acc[ai][bj][m][1];
#pragma unroll
                    for (int j = 0; j < 4; ++j) { a[j] *= (float)((g.x >> (8 * j)) & 255u) * (1.0f / 255.0f); b[j] *= (float)((g.y >> (8 * j)) & 255u) * (1.0f / 255.0f); }
                    *(u32x4*)(Mg + (size_t)row * 1024 + col) = pack8(a, b); } } }
    }
};
struct EpiF {
    static constexpr bool PERM = true;
    const bf16_t* H; bf16_t* Z;
    __device__ __forceinline__ void operator()(const Acc& acc, const Unit& u, int wr, int wc, int fr, int fq) const {
        const int row0 = u.pm * 256 + wr * 64 + fr, col0 = u.pn * 256 + wc * 32 + 8 * fq;
#pragma unroll
        for (int ai = 0; ai < 2; ++ai) { if (ai == 1 && u.half) continue;
            u32x4 h8[4][2];
#pragma unroll
            for (int m = 0; m < 4; ++m)
#pragma unroll
                for (int bj = 0; bj < 2; ++bj) h8[m][bj] = *(const u32x4*)(H + (size_t)(row0 + ai * 128 + m * 16) * 1024 + col0 + bj * 128);
#pragma unroll
            for (int m = 0; m < 4; ++m) { const size_t off = (size_t)(row0 + ai * 128 + m * 16) * 1024 + col0;
#pragma unroll
                for (int bj = 0; bj < 2; ++bj) { const u32x4 hv = h8[m][bj]; f32x4 a = acc[ai][bj][m][0], b = acc[ai][bj][m][1];
                    a[0] += ALPHA * bf_lo(hv.x); a[1] += ALPHA * bf_hi(hv.x); a[2] += ALPHA * bf_lo(hv.y); a[3] += ALPHA * bf_hi(hv.y);
                    b[0] += ALPHA * bf_lo(hv.z); b[1] += ALPHA * bf_hi(hv.z); b[2] += ALPHA * bf_lo(hv.w); b[3] += ALPHA * bf_hi(hv.w);
                    *(u32x4*)(Z + off + bj * 128) = pack8(a, b); } } }
    }
};
struct EpiM1 {
    static constexpr bool PERM = false;
    bf16_t* Hid; const float* h1s; const unsigned* cm; const LAS int* tb; const LAS int* cnt; const int* list;
    __device__ __forceinline__ void operator()(const Acc& acc, const Unit& u, int wr, int wc, int fr, int fq) const {
        const int row0 = u.pm * 256 + wr * 64 + fr, hc0 = u.pn * 128 + wc * 16 + 4 * fq;
        const int e = u.aux; const unsigned* cme = cm + e * 512 + u.pn * 256 + wc * 32 + 4 * fq;
        f32x4 sg[2], su[2];
#pragma unroll
        for (int bj = 0; bj < 2; ++bj) { sg[bj] = cmscale(cme + bj * 128); su[bj] = cmscale(cme + bj * 128 + 16); }
        const int ce = cnt[e], tl = (u.pm - tb[e]) * 256;
        int tk8[2][4]; float sa8[2][4];
#pragma unroll
        for (int ai = 0; ai < 2; ++ai)
#pragma unroll
            for (int m = 0; m < 4; ++m) { int idx = tl + wr * 64 + fr + ai * 128 + m * 16; idx = idx < ce ? idx : ce - 1; tk8[ai][m] = list[(size_t)e * TP + idx]; }
#pragma unroll
        for (int ai = 0; ai < 2; ++ai)
#pragma unroll
            for (int m = 0; m < 4; ++m) sa8[ai][m] = h1s[tk8[ai][m]];
#pragma unroll
        for (int ai = 0; ai < 2; ++ai)
#pragma unroll
            for (int m = 0; m < 4; ++m) { if (ai == 1 && u.half) continue; bf16_t* rowp = Hid + (size_t)(row0 + ai * 128 + m * 16) * 256 + hc0;
                const float sa = sa8[ai][m];
#pragma unroll
                for (int bj = 0; bj < 2; ++bj) { const f32x4 g = dq4(acc[ai][bj][m][0], sa, sg[bj]), up = dq4(acc[ai][bj][m][1], sa, su[bj]); f32x4 o;
#pragma unroll
                    for (int j = 0; j < 4; ++j) o[j] = g[j] * sigm(g[j]) * up[j];
                    u32x2 w; w.x = pk_bf16(o[0], o[1]); w.y = pk_bf16(o[2], o[3]); *(u32x2*)(rowp + bj * 64) = w; } }
    }
};
struct EpiM2 {
    static constexpr bool PERM = true;
    bf16_t* Ys;
    __device__ __forceinline__ void operator()(const Acc& acc, const Unit& u, int wr, int wc, int fr, int fq) const {
        const int row0 = u.pm * 256 + wr * 64 + fr, col0 = u.pn * 256 + wc * 32 + 8 * fq;
#pragma unroll
        for (int ai = 0; ai < 2; ++ai)
#pragma unroll
            for (int m = 0; m < 4; ++m) { if (ai == 1 && u.half) continue; bf16_t* rowp = Ys + (size_t)(row0 + ai * 128 + m * 16) * 1024 + col0;
#pragma unroll
                for (int bj = 0; bj < 2; ++bj) *(u32x4*)(rowp + bj * 128) = pack8(acc[ai][bj][m][0], acc[ai][bj][m][1]); }
    }
};
}

__device__ __forceinline__ int crow(int r, int hi) { return (r & 3) + 8 * (r >> 2) + 4 * hi; }
typedef short v4i16_t __attribute__((ext_vector_type(4)));
__device__ __forceinline__ s16x4 vtr(const LAS char* p) { return __builtin_bit_cast(s16x4, __builtin_amdgcn_ds_read_tr16_b64_v4i16((LAS v4i16_t*)p)); }
__device__ __forceinline__ float swapmax(float m) { auto rr = __builtin_amdgcn_permlane32_swap(__float_as_uint(m), __float_as_uint(m), false, false); return fmaxf(__uint_as_float(rr[0]), __uint_as_float(rr[1])); }
__device__ __forceinline__ float swapsum(float m) { auto rr = __builtin_amdgcn_permlane32_swap(__float_as_uint(m), __float_as_uint(m), false, false); return __uint_as_float(rr[0]) + __uint_as_float(rr[1]); }

template <int DK, bool FOX>
__device__ __forceinline__ void attn_unit8(LAS char* lds, const bf16_t* Q, int ldq, const bf16_t* Kp, int ldk, const bf16_t* Vp, int ldv, bf16_t* O, int ldo,
                                           const float* cs, int b, int j, int tau_min, const bf16_t* K2 = nullptr) {
    constexpr int NS = DK / 16, KB = 64 * DK * 2, SB = KB + 8192 + 256;
    constexpr float THR = 8.0f;
    int tid_l = threadIdx.x; asm volatile("" : "+v"(tid_l));
    const int tid = tid_l, lane = tid & 63, r32 = lane & 31, hi = lane >> 5; const int wid = __builtin_amdgcn_readfirstlane(tid >> 6);
    const int qp0 = (j == 0) ? 0 : 16 + 256 * (j - 1) + 32 * wid;
    const int qpos = qp0 + r32;
    const size_t qrow = (j == 0) ? (size_t)(NREAL + NMETA * b + r32) : (size_t)(SEQ * b + 256 * (j - 1) + 32 * wid + r32);
    const size_t mrow0 = (size_t)(NREAL + NMETA * b), rrow0 = (size_t)SEQ * b;
    const bool wave_on = (j > 0) || (wid == 0);
    const int tdiag = wave_on ? ((j == 0) ? 0 : 4 * (j - 1) + 1 + (wid >> 1)) : -1;
    const int qin = (j == 0) ? r32 : 32 * (wid & 1) + r32;
    const int NT = 4 * j + 1;
    bf16x8 qf[NS];
#pragma unroll
    for (int s = 0; s < NS; ++s) qf[s] = *(const bf16x8*)(Q + qrow * ldq + 16 * s + 8 * hi);
    float csq = 0.f; if (FOX) csq = cs[qpos];
    const bf16_t* kg = Kp + (size_t)lane * ldk + 8 * wid;
    const bf16_t* kg2 = (DK == 96) ? K2 + (size_t)lane * 32 + 8 * (wid & 3) : Kp;
    const bf16_t* vg = Vp + (size_t)(16 * (wid & 3) + 8 * (lane >> 5) + ((lane >> 2) & 7)) * ldv + 32 * (wid >> 2) + 8 * (lane & 3);
    const int nops = 2 + ((DK == 96) ? (wid < 4 ? 1 : 0) : (FOX ? (wid == 4 ? 1 : 0) : 0));
#define ATT_ISSUE(t, slot) do { const int ts_ = ((t) == 0) ? 0 : 64 * (t) - 48; const size_t tr_ = ((t) == 0) ? mrow0 : rrow0 + 64 * ((t) - 1); LAS char* sb_ = lds + (slot) * SB; \
        __builtin_amdgcn_global_load_lds((const unsigned*)(kg + tr_ * ldk), (LAS unsigned*)(sb_ + wid * 1024), 16, 0, 0); \
        __builtin_amdgcn_global_load_lds((const unsigned*)(vg + tr_ * ldv), (LAS unsigned*)(sb_ + KB + (wid >> 2) * 4096 + (wid & 3) * 1024), 16, 0, 0); \
        if (DK == 96) { if (wid < 4) __builtin_amdgcn_global_load_lds((const unsigned*)(kg2 + tr_ * 32), (LAS unsigned*)(sb_ + (8 + wid) * 1024), 16, 0, 0); } \
        else if (FOX) { if (wid == 4) { if (lane < 16) __builtin_amdgcn_global_load_lds((const unsigned*)(cs + ts_ + 4 * lane), (LAS unsigned*)(sb_ + KB + 8192), 16, 0, 0); } } } while (0)
    int t = NT - 1;
    int slot = 0;
    ATT_ISSUE(t, 0);
    if (t - 1 >= tau_min) ATT_ISSUE(t - 1, 1);
    float mhat = 0.f, lrun = 0.f;
    f32x16 o0 = {}, o1 = {};
    const int vlane = ((lane >> 4) & 1) * 32 + (lane & 3) * 8 + (4 * hi + ((lane & 15) >> 2)) * 64;
    for (; t > tdiag && t >= tau_min; --t) {
        if (t - 1 >= tau_min) { if (nops == 3) asm volatile("s_waitcnt vmcnt(3)" ::: "memory"); else asm volatile("s_waitcnt vmcnt(2)" ::: "memory"); }
        else asm volatile("s_waitcnt vmcnt(0)" ::: "memory");
        __builtin_amdgcn_s_barrier(); asm volatile("" ::: "memory");
        { const int s2 = (slot >= 1) ? slot - 1 : 2; if (t - 2 >= tau_min) ATT_ISSUE(t - 2, s2); }
        const LAS char* cb = lds + slot * SB; (void)cb;
        slot = (slot == 2) ? 0 : slot + 1;
    }
    if (t >= tau_min) {
        if (t - 1 >= tau_min) { if (nops == 3) asm volatile("s_waitcnt vmcnt(3)" ::: "memory"); else asm volatile("s_waitcnt vmcnt(2)" ::: "memory"); }
        else asm volatile("s_waitcnt vmcnt(0)" ::: "memory");
        __builtin_amdgcn_s_barrier(); asm volatile("" ::: "memory");
        { const int s2 = (slot >= 1) ? slot - 1 : 2; if (t - 2 >= tau_min) ATT_ISSUE(t - 2, s2); }
        const LAS char* cb = lds + slot * SB; (void)cb;
        {
            f32x16 p0, p1;
            if (FOX) {
                const LAS float* cl = (const LAS float*)(cb + KB + 8192); const float base = csq - mhat;
#pragma unroll
                for (int g = 0; g < 4; ++g) { const f32x4 c0 = *(const LAS f32x4*)(cl + 8 * g + 4 * hi), c1 = *(const LAS f32x4*)(cl + 32 + 8 * g + 4 * hi);
#pragma unroll
                    for (int jj = 0; jj < 4; ++jj) { p0[4 * g + jj] = base - c0[jj]; p1[4 * g + jj] = base - c1[jj]; } }
            } else {
                const float nm = -mhat;
#pragma unroll
                for (int r = 0; r < 16; ++r) { p0[r] = nm; p1[r] = nm; }
            }
            bf16x8 ka[NS][2];
#pragma unroll
            for (int s = 0; s < NS; ++s) { const int c = 2 * s + hi; ka[s][0] = *(const LAS bf16x8*)(cb + c * 1024 + r32 * 16); ka[s][1] = *(const LAS bf16x8*)(cb + c * 1024 + 512 + r32 * 16); }
            __builtin_amdgcn_sched_barrier(0);
#pragma unroll
            for (int s = 0; s < NS; ++s) { p0 = __builtin_amdgcn_mfma_f32_32x32x16_bf16(ka[s][0], qf[s], p0, 0, 0, 0); p1 = __builtin_amdgcn_mfma_f32_32x32x16_bf16(ka[s][1], qf[s], p1, 0, 0, 0); }
            __builtin_amdgcn_sched_barrier(0);
            const LAS char* vb = cb + KB + vlane;
            s16x4 vl0[4], vh0[4], vl1[4], vh1[4];
#pragma unroll
            for (int ks = 0; ks < 4; ++ks) { vl0[ks] = vtr(vb + ks * 1024); vh0[ks] = vtr(vb + ks * 1024 + 512); vl1[ks] = vtr(vb + 4096 + ks * 1024); vh1[ks] = vtr(vb + 4096 + ks * 1024 + 512); }
            __builtin_amdgcn_sched_barrier(0);
            if (t == tdiag) {
#pragma unroll
                for (int r = 0; r < 16; ++r) { const int kv = 4 * hi + (r & 3) + 8 * (r >> 2); if (kv > qin) p0[r] = -INFINITY; if (kv + 32 > qin) p1[r] = -INFINITY; }
            }
            if (t == 0) {
#pragma unroll
                for (int r = 0; r < 16; ++r) { const int kv = 4 * hi + (r & 3) + 8 * (r >> 2); if (kv >= 16) p0[r] = -INFINITY; p1[r] = -INFINITY; }
            }
            float mt;
            { float ma = __builtin_fmaxf(__builtin_fmaxf(p0[0], p0[1]), p1[0]), mb = __builtin_fmaxf(__builtin_fmaxf(p0[2], p0[3]), p1[1]); ma = __builtin_fmaxf(__builtin_fmaxf(ma, p1[2]), p1[3]);
#pragma unroll
              for (int r = 4; r < 16; r += 4) { ma = __builtin_fmaxf(__builtin_fmaxf(ma, p0[r]), p0[r + 1]); mb = __builtin_fmaxf(__builtin_fmaxf(mb, p0[r + 2]), p0[r + 3]); ma = __builtin_fmaxf(__builtin_fmaxf(ma, p1[r]), p1[r + 1]); mb = __builtin_fmaxf(__builtin_fmaxf(mb, p1[r + 2]), p1[r + 3]); }
              mt = __builtin_fmaxf(ma, mb); }
            mt = swapmax(mt);
            { mhat = mt;
#pragma unroll
              for (int r = 0; r < 16; ++r) { p0[r] -= mt; p1[r] -= mt; } }
#pragma unroll
            for (int r = 0; r < 16; ++r) { p0[r] = __builtin_amdgcn_exp2f(p0[r]); p1[r] = __builtin_amdgcn_exp2f(p1[r]); }
            { f32x2_t sa = {p0[0], p0[1]}, sb2 = {p1[0], p1[1]};
#pragma unroll
              for (int r = 2; r < 16; r += 2) { sa += (f32x2_t){p0[r], p0[r + 1]}; sb2 += (f32x2_t){p1[r], p1[r + 1]}; }
              sa += sb2; lrun += sa[0] + sa[1]; }
            bf16x8 pb[4];
#pragma unroll
            for (int s = 0; s < 2; ++s) {
                u32x4 w; w.x = pk_bf16(p0[8 * s], p0[8 * s + 1]); w.y = pk_bf16(p0[8 * s + 2], p0[8 * s + 3]); w.z = pk_bf16(p0[8 * s + 4], p0[8 * s + 5]); w.w = pk_bf16(p0[8 * s + 6], p0[8 * s + 7]);
                pb[s] = __builtin_bit_cast(bf16x8, w);
                u32x4 w2; w2.x = pk_bf16(p1[8 * s], p1[8 * s + 1]); w2.y = pk_bf16(p1[8 * s + 2], p1[8 * s + 3]); w2.z = pk_bf16(p1[8 * s + 4], p1[8 * s + 5]); w2.w = pk_bf16(p1[8 * s + 6], p1[8 * s + 7]);
                pb[2 + s] = __builtin_bit_cast(bf16x8, w2);
            }
            __builtin_amdgcn_sched_barrier(0);
#pragma unroll
            for (int ks = 0; ks < 4; ++ks) {
                const bf16x8 a0 = (bf16x8){vl0[ks][0], vl0[ks][1], vl0[ks][2], vl0[ks][3], vh0[ks][0], vh0[ks][1], vh0[ks][2], vh0[ks][3]};
                const bf16x8 a1 = (bf16x8){vl1[ks][0], vl1[ks][1], vl1[ks][2], vl1[ks][3], vh1[ks][0], vh1[ks][1], vh1[ks][2], vh1[ks][3]};
                o0 = __builtin_amdgcn_mfma_f32_32x32x16_bf16(a0, pb[ks], o0, 0, 0, 0);
                o1 = __builtin_amdgcn_mfma_f32_32x32x16_bf16(a1, pb[ks], o1, 0, 0, 0);
            }
        }
        slot = (slot == 2) ? 0 : slot + 1;
        --t;
    }
    for (; t >= tau_min; --t) {
        if (t - 1 >= tau_min) { if (nops == 3) asm volatile("s_waitcnt vmcnt(3)" ::: "memory"); else asm volatile("s_waitcnt vmcnt(2)" ::: "memory"); }
        else asm volatile("s_waitcnt vmcnt(0)" ::: "memory");
        __builtin_amdgcn_s_barrier(); asm volatile("" ::: "memory");
        { const int s2 = (slot >= 1) ? slot - 1 : 2; if (t - 2 >= tau_min) ATT_ISSUE(t - 2, s2); }
        const LAS char* cb = lds + slot * SB; (void)cb;
        {
            f32x16 p0, p1;
            if (FOX) {
                const LAS float* cl = (const LAS float*)(cb + KB + 8192); const float base = csq - mhat;
#pragma unroll
                for (int g = 0; g < 4; ++g) { const f32x4 c0 = *(const LAS f32x4*)(cl + 8 * g + 4 * hi), c1 = *(const LAS f32x4*)(cl + 32 + 8 * g + 4 * hi);
#pragma unroll
                    for (int jj = 0; jj < 4; ++jj) { p0[4 * g + jj] = base - c0[jj]; p1[4 * g + jj] = base - c1[jj]; } }
            } else {
                const float nm = -mhat;
#pragma unroll
                for (int r = 0; r < 16; ++r) { p0[r] = nm; p1[r] = nm; }
            }
            bf16x8 ka[NS][2];
#pragma unroll
            for (int s = 0; s < NS; ++s) { const int c = 2 * s + hi; ka[s][0] = *(const LAS bf16x8*)(cb + c * 1024 + r32 * 16); ka[s][1] = *(const LAS bf16x8*)(cb + c * 1024 + 512 + r32 * 16); }
            __builtin_amdgcn_sched_barrier(0);
#pragma unroll
            for (int s = 0; s < NS; ++s) { p0 = __builtin_amdgcn_mfma_f32_32x32x16_bf16(ka[s][0], qf[s], p0, 0, 0, 0); p1 = __builtin_amdgcn_mfma_f32_32x32x16_bf16(ka[s][1], qf[s], p1, 0, 0, 0); }
            __builtin_amdgcn_sched_barrier(0);
            const LAS char* vb = cb + KB + vlane;
            s16x4 vl0[4], vh0[4], vl1[4], vh1[4];
#pragma unroll
            for (int ks = 0; ks < 4; ++ks) { vl0[ks] = vtr(vb + ks * 1024); vh0[ks] = vtr(vb + ks * 1024 + 512); vl1[ks] = vtr(vb + 4096 + ks * 1024); vh1[ks] = vtr(vb + 4096 + ks * 1024 + 512); }
            __builtin_amdgcn_sched_barrier(0);
            if (t == tdiag) {
#pragma unroll
                for (int r = 0; r < 16; ++r) { const int kv = 4 * hi + (r & 3) + 8 * (r >> 2); if (kv > qin) p0[r] = -INFINITY; if (kv + 32 > qin) p1[r] = -INFINITY; }
            }
            if (t == 0) {
#pragma unroll
                for (int r = 0; r < 16; ++r) { const int kv = 4 * hi + (r & 3) + 8 * (r >> 2); if (kv >= 16) p0[r] = -INFINITY; p1[r] = -INFINITY; }
            }
            float mt;
            { float ma = __builtin_fmaxf(__builtin_fmaxf(p0[0], p0[1]), p1[0]), mb = __builtin_fmaxf(__builtin_fmaxf(p0[2], p0[3]), p1[1]); ma = __builtin_fmaxf(__builtin_fmaxf(ma, p1[2]), p1[3]);
#pragma unroll
              for (int r = 4; r < 16; r += 4) { ma = __builtin_fmaxf(__builtin_fmaxf(ma, p0[r]), p0[r + 1]); mb = __builtin_fmaxf(__builtin_fmaxf(mb, p0[r + 2]), p0[r + 3]); ma = __builtin_fmaxf(__builtin_fmaxf(ma, p1[r]), p1[r + 1]); mb = __builtin_fmaxf(__builtin_fmaxf(mb, p1[r + 2]), p1[r + 3]); }
              mt = __builtin_fmaxf(ma, mb); }
            mt = swapmax(mt);
            if (__any(mt > THR)) {
                const float dl = fmaxf(mt, 0.f); mhat += dl; const float f = __builtin_amdgcn_exp2f(-dl); lrun *= f;
#pragma unroll
                for (int r = 0; r < 16; ++r) { p0[r] -= dl; p1[r] -= dl; asm volatile("v_mul_f32 %0, %0, %1" : "+v"(o0[r]) : "v"(f)); asm volatile("v_mul_f32 %0, %0, %1" : "+v"(o1[r]) : "v"(f)); }
            }
#pragma unroll
            for (int r = 0; r < 16; ++r) { p0[r] = __builtin_amdgcn_exp2f(p0[r]); p1[r] = __builtin_amdgcn_exp2f(p1[r]); }
            { f32x2_t sa = {p0[0], p0[1]}, sb2 = {p1[0], p1[1]};
#pragma unroll
              for (int r = 2; r < 16; r += 2) { sa += (f32x2_t){p0[r], p0[r + 1]}; sb2 += (f32x2_t){p1[r], p1[r + 1]}; }
              sa += sb2; lrun += sa[0] + sa[1]; }
            bf16x8 pb[4];
#pragma unroll
            for (int s = 0; s < 2; ++s) {
                u32x4 w; w.x = pk_bf16(p0[8 * s], p0[8 * s + 1]); w.y = pk_bf16(p0[8 * s + 2], p0[8 * s + 3]); w.z = pk_bf16(p0[8 * s + 4], p0[8 * s + 5]); w.w = pk_bf16(p0[8 * s + 6], p0[8 * s + 7]);
                pb[s] = __builtin_bit_cast(bf16x8, w);
                u32x4 w2; w2.x = pk_bf16(p1[8 * s], p1[8 * s + 1]); w2.y = pk_bf16(p1[8 * s + 2], p1[8 * s + 3]); w2.z = pk_bf16(p1[8 * s + 4], p1[8 * s + 5]); w2.w = pk_bf16(p1[8 * s + 6], p1[8 * s + 7]);
                pb[2 + s] = __builtin_bit_cast(bf16x8, w2);
            }
            __builtin_amdgcn_sched_barrier(0);
#pragma unroll
            for (int ks = 0; ks < 4; ++ks) {
                const bf16x8 a0 = (bf16x8){vl0[ks][0], vl0[ks][1], vl0[ks][2], vl0[ks][3], vh0[ks][0], vh0[ks][1], vh0[ks][2], vh0[ks][3]};
                const bf16x8 a1 = (bf16x8){vl1[ks][0], vl1[ks][1], vl1[ks][2], vl1[ks][3], vh1[ks][0], vh1[ks][1], vh1[ks][2], vh1[ks][3]};
                o0 = __builtin_amdgcn_mfma_f32_32x32x16_bf16(a0, pb[ks], o0, 0, 0, 0);
                o1 = __builtin_amdgcn_mfma_f32_32x32x16_bf16(a1, pb[ks], o1, 0, 0, 0);
            }
        }
        slot = (slot == 2) ? 0 : slot + 1;
    }
#undef ATT_ISSUE
    if (wave_on) {
        const float lt = swapsum(lrun);
        const float inv = 1.0f / lt;
        if (j > 0 || r32 < 16) {
            bf16_t* op = O + qrow * ldo;
#pragma unroll
            for (int g = 0; g < 4; ++g) {
                u32x2 w0, w1;
                w0.x = pk_bf16(o0[4 * g] * inv, o0[4 * g + 1] * inv); w0.y = pk_bf16(o0[4 * g + 2] * inv, o0[4 * g + 3] * inv);
                w1.x = pk_bf16(o1[4 * g] * inv, o1[4 * g + 1] * inv); w1.y = pk_bf16(o1[4 * g + 2] * inv, o1[4 * g + 3] * inv);
                *(u32x2*)(op + 8 * g + 4 * hi) = w0; *(u32x2*)(op + 32 + 8 * g + 4 * hi) = w1;
            }
        }
    }
    asm volatile("s_waitcnt lgkmcnt(0)" ::: "memory");
    __builtin_amdgcn_s_barrier(); asm volatile("" ::: "memory");
}

struct Args { const float* in[22]; float* out; unsigned char* ws; };
struct Frame {
    LAS unsigned char* lds; volatile LAS unsigned* MISC; unsigned* ctl;
    int tid, lane, wave, vcu, G;
};

template <int QM>
__device__ __forceinline__ void tr_item(const float* colp, int ld, const float* kscale, void* dstv, int K, int n0, int k0, LAS float* scr, int lane, unsigned* cmax) {
    float am = 0.f;
#pragma unroll
    for (int i = 0; i < 32; ++i) { const int kk = 2 * i + (lane >> 5); float v = colp ? colp[(size_t)(k0 + kk) * ld] : 0.f; if (kscale) v *= kscale[k0 + kk];
        if (QM == 1) am = fmaxf(am, fabsf(v)); else scr[kk * 33 + (lane & 31)] = v; }
    if (QM == 1) { am = fmaxf(am, __shfl_xor(am, 32)); if (lane < 32) __hip_atomic_fetch_max(cmax + n0 + lane, __float_as_uint(am), RLX_AGENT); return; }
    LDS_WAIT(); asm volatile("" ::: "memory");
    const int c = lane & 7;
#pragma unroll
    for (int j = 0; j < 4; ++j) { const int n = (lane >> 3) + 8 * j; const LAS float* s = scr + (8 * c) * 33 + n;
        if (QM == 0) { bf16_t* dst = (bf16_t*)dstv;
            u32x4 o; o.x = pk_bf16(s[0 * 33], s[1 * 33]); o.y = pk_bf16(s[2 * 33], s[3 * 33]); o.z = pk_bf16(s[4 * 33], s[5 * 33]); o.w = pk_bf16(s[6 * 33], s[7 * 33]);
            *(u32x4*)(dst + (size_t)(n0 + n) * K + k0 + 8 * c) = o; }
        else { unsigned char* dst = (unsigned char*)dstv; const float cm = __uint_as_float(cmax[n0 + n]); const float inv = cm > 0.f ? 127.0f / cm : 0.f;
            unsigned q[8];
#pragma unroll
            for (int i = 0; i < 8; ++i) q[i] = (unsigned)(int)rintf(s[i * 33] * inv) & 255u;
            u32x2 o; o.x = q[0] | (q[1] << 8) | (q[2] << 16) | (q[3] << 24); o.y = q[4] | (q[5] << 8) | (q[6] << 16) | (q[7] << 24);
            *(u32x2*)(dst + (size_t)(n0 + n) * K + k0 + 8 * c) = o; } }
    LDS_WAIT(); asm volatile("" ::: "memory");
}
__device__ __forceinline__ void quant_strip(const float* colp, bool valid, int ld, unsigned char* dst, int n0, LAS float* scr, LAS float* part, unsigned* cm_out, int wave, int lane) {
    float v[2][32]; float am = 0.f;
    { const float* pp = colp + (size_t)(wave * 128 + (lane >> 5)) * ld; const size_t st2 = (size_t)2 * ld;
#pragma unroll
      for (int sidx = 0; sidx < 2; ++sidx)
#pragma unroll
        for (int i = 0; i < 32; ++i) { v[sidx][i] = *pp; pp += st2; asm volatile("" : "+v"(pp)); } }
    if (!valid) {
#pragma unroll
      for (int sidx = 0; sidx < 2; ++sidx)
#pragma unroll
        for (int i = 0; i < 32; ++i) v[sidx][i] = 0.f; }
#pragma unroll
    for (int sidx = 0; sidx < 2; ++sidx)
#pragma unroll
        for (int i = 0; i < 32; ++i) am = fmaxf(am, fabsf(v[sidx][i]));
    am = fmaxf(am, __shfl_xor(am, 32));
    if (lane < 32) part[wave * 32 + lane] = am;
    __syncthreads();
    float cmx = part[lane & 31];
#pragma unroll
    for (int w = 1; w < 8; ++w) cmx = fmaxf(cmx, part[w * 32 + (lane & 31)]);
    if (wave == 0 && lane < 32) cm_out[n0 + lane] = __float_as_uint(cmx);
    float inv4[4];
#pragma unroll
    for (int j = 0; j < 4; ++j) { const float c = __shfl(cmx, (lane >> 3) + 8 * j); inv4[j] = c > 0.f ? 127.0f / c : 0.f; }
    const int c = lane & 7;
#pragma unroll
    for (int sidx = 0; sidx < 2; ++sidx) {
#pragma unroll
        for (int i = 0; i < 32; ++i) scr[(2 * i + (lane >> 5)) * 33 + (lane & 31)] = v[sidx][i];
        LDS_WAIT(); asm volatile("" ::: "memory");
#pragma unroll
        for (int j = 0; j < 4; ++j) { const int n = (lane >> 3) + 8 * j; const LAS float* sp = scr + (8 * c) * 33 + n;
            unsigned q[8];
#pragma unroll
            for (int i = 0; i < 8; ++i) q[i] = (unsigned)(int)rintf(sp[i * 33] * inv4[j]) & 255u;
            u32x2 o; o.x = q[0] | (q[1] << 8) | (q[2] << 16) | (q[3] << 24); o.y = q[4] | (q[5] << 8) | (q[6] << 16) | (q[7] << 24);
            *(u32x2*)(dst + (size_t)(n0 + n) * 1024 + wave * 128 + sidx * 64 + 8 * c) = o; }
        LDS_WAIT(); asm volatile("" ::: "memory");
    }
    __syncthreads();
}
constexpr int STRIPS_PER_LAYER = 392;
__device__ __forceinline__ void strip_item(const Args& a, bf16_t* W, unsigned* cm, int l, int sidx, LAS float* scr, LAS float* part, int wave, int lane) {
    const int w = lane & 31;
    if (sidx < 72) { const int nb = sidx, n = nb * 32 + w; int col;
        if (n < 1536) col = n; else { const int j = n - 1536; col = j < 384 ? 1544 + j : j < 640 ? 1928 + (j - 384) : j < 672 ? 2184 + (16 * (((j - 640) >> 2) & 1) + 4 * ((j - 640) >> 3) + ((j - 640) & 3)) : j < 680 ? 1536 + (j - 672) : -1; }
        const float* src = a.in[4] + (size_t)l * 1024 * 4264;
        quant_strip(src + (col >= 0 ? col : 0), col >= 0, 4264, (unsigned char*)(W + W_BT1), nb * 32, scr, part, cm, wave, lane); return; }
    sidx -= 72;
    if (sidx < 64) { const int nb = sidx, n = nb * 32 + w; const float* src = a.in[4] + (size_t)l * 1024 * 4264;
        quant_strip(src + 2216 + n, true, 4264, (unsigned char*)(W + W_BT1), 2304 + nb * 32, scr, part, cm, wave, lane); return; }
    sidx -= 64;
    { const int e = sidx >> 4, nb = sidx & 15;
      const float* src = (w < 16 ? a.in[17] : a.in[18]) + ((size_t)(l * 16 + e) * 1024) * 256 + 16 * nb + (w & 15);
      quant_strip(src, true, 256, (unsigned char*)(W + W_MOE1) + (size_t)e * 512 * 1024, nb * 32, scr, part, cm + 4608 + e * 512, wave, lane); }
}
constexpr int ITEMS_PER_LAYER = 3344;
__device__ __forceinline__ void convert_item(const Args& a, bf16_t* W, int l, int r, LAS float* scr, int lane) {
    const int w = lane & 31; (void)w;
    if (r < 1296) {
    if (r < 256) { const int kb = r / 32, nb = r % 32, n = nb * 32 + w; tr_item<0>(a.in[6] + (size_t)l * 512 * 1024 + n, 1024, nullptr, W + W_FOXO, 1024, nb * 32, kb * 64, scr, lane, nullptr); return; }
    r -= 256;
    if (r < 256) { const int kb = r / 32, nb = r % 32, n = nb * 32 + w; tr_item<0>(a.in[11] + (size_t)l * 512 * 1024 + n, 1024, nullptr, W + W_FOXO + 512, 1024, nb * 32, kb * 64, scr, lane, nullptr); return; }
    r -= 256;
    if (r < 144) { const int kb = r / 24, nb = r % 24, n = nb * 32 + w; tr_item<0>(a.in[8] + (size_t)l * 384 * 768 + n, 768, a.in[7] + l * 384, W + W_UQ, 384, nb * 32, kb * 64, scr, lane, nullptr); return; }
    r -= 144;
    if (r < 128) { const int kb = r / 32, nb = r % 32, n = nb * 32 + w; const int col = n < 512 ? (n >> 6) * 128 + (n & 63) : ((n - 512) >> 6) * 128 + 64 + (n & 63);
        tr_item<0>(a.in[10] + (size_t)l * 256 * 1024 + col, 1024, a.in[9] + l * 256, W + W_UKV, 256, nb * 32, kb * 64, scr, lane, nullptr); return; }
    r -= 128;
    { const int kb = r / 32, nb = r % 32, n = nb * 32 + w; tr_item<0>(a.in[12] + (size_t)l * 1024 * 1024 + n, 1024, nullptr, W + W_OUT, 1024, nb * 32, kb * 64, scr, lane, nullptr); return; } }
    r -= 1296;
    { const int e = r / 128, rr = r % 128, kb = rr / 32, nb = rr % 32, n = nb * 32 + w;
        tr_item<0>(a.in[19] + ((size_t)(l * 16 + e) * 256) * 1024 + n, 1024, nullptr, W + W_MOE2 + (size_t)e * 1024 * 256, 256, nb * 32, kb * 64, scr, lane, nullptr); }
}

template <int R>
__device__ __forceinline__ void quant_rows(const f32x4 (&v)[R][4], unsigned char* const (&qrow)[R], float* const (&srow)[R], int lane) {
    float am[R];
#pragma unroll
    for (int k = 0; k < R; ++k) { am[k] = 0.f;
#pragma unroll
        for (int j = 0; j < 4; ++j) am[k] = fmaxf(am[k], fmaxf(fmaxf(fabsf(v[k][j][0]), fabsf(v[k][j][1])), fmaxf(fabsf(v[k][j][2]), fabsf(v[k][j][3])))); }
#pragma unroll
    for (int o = 1; o < 64; o <<= 1) {
#pragma unroll
        for (int k = 0; k < R; ++k) am[k] = fmaxf(am[k], __shfl_xor(am[k], o)); }
#pragma unroll
    for (int k = 0; k < R; ++k) { if (!qrow[k]) continue; const float inv = am[k] > 0.f ? 127.0f / am[k] : 0.f;
#pragma unroll
        for (int j = 0; j < 4; ++j) { const unsigned q = ((unsigned)(int)rintf(v[k][j][0] * inv) & 255u) | (((unsigned)(int)rintf(v[k][j][1] * inv) & 255u) << 8) | (((unsigned)(int)rintf(v[k][j][2] * inv) & 255u) << 16) | (((unsigned)(int)rintf(v[k][j][3] * inv) & 255u) << 24);
            *(unsigned*)(qrow[k] + 4 * lane + 256 * j) = q; }
        if (lane == 0) *srow[k] = am[k] * (1.0f / 127.0f); }
}

__device__ __forceinline__ void ln16(f32x4 (&v)[4], const float* g, const float* bta, int lane) {
    float s = 0.f;
#pragma unroll
    for (int j = 0; j < 4; ++j) s += (v[j][0] + v[j][1]) + (v[j][2] + v[j][3]);
    const float mean = wave_sum(s) * (1.f / DM); float s2 = 0.f;
#pragma unroll
    for (int j = 0; j < 4; ++j) { v[j] = v[j] - mean; s2 += (v[j][0] * v[j][0] + v[j][1] * v[j][1]) + (v[j][2] * v[j][2] + v[j][3] * v[j][3]); }
    const float rstd = 1.0f / sqrtf(wave_sum(s2) * (1.f / DM) + 1e-5f);
#pragma unroll
    for (int j = 0; j < 4; ++j) { const f32x4 gg = *(const f32x4*)(g + 4 * lane + 256 * j), bb = *(const f32x4*)(bta + 4 * lane + 256 * j); v[j] = v[j] * rstd * gg + bb; }
}
template <int R>
__device__ __forceinline__ void ln16xR(f32x4 (&v)[R][4], const float* g, const float* bta, int lane) {
    float s[R];
#pragma unroll
    for (int k = 0; k < R; ++k) { s[k] = 0.f;
#pragma unroll
        for (int j = 0; j < 4; ++j) s[k] += (v[k][j][0] + v[k][j][1]) + (v[k][j][2] + v[k][j][3]); }
#pragma unroll
    for (int o = 1; o < 64; o <<= 1) {
#pragma unroll
        for (int k = 0; k < R; ++k) s[k] += __shfl_xor(s[k], o); }
    float s2[R];
#pragma unroll
    for (int k = 0; k < R; ++k) { const float mean = s[k] * (1.f / DM); s2[k] = 0.f;
#pragma unroll
        for (int j = 0; j < 4; ++j) { v[k][j] = v[k][j] - mean; s2[k] += (v[k][j][0] * v[k][j][0] + v[k][j][1] * v[k][j][1]) + (v[k][j][2] * v[k][j][2] + v[k][j][3] * v[k][j][3]); } }
#pragma unroll
    for (int o = 1; o < 64; o <<= 1) {
#pragma unroll
        for (int k = 0; k < R; ++k) s2[k] += __shfl_xor(s2[k], o); }
#pragma unroll
    for (int j = 0; j < 4; ++j) { const f32x4 gg = *(const f32x4*)(g + 4 * lane + 256 * j), bb = *(const f32x4*)(bta + 4 * lane + 256 * j);
#pragma unroll
        for (int k = 0; k < R; ++k) { const float rstd = 1.0f / sqrtf(s2[k] * (1.f / DM) + 1e-5f); v[k][j] = v[k][j] * rstd * gg + bb; } }
}
__device__ __forceinline__ void store_row_bf16(bf16_t* orow, const f32x4 (&v)[4], int lane) {
#pragma unroll
    for (int j = 0; j < 4; ++j) { u32x2 w; w.x = pk_bf16(v[j][0], v[j][1]); w.y = pk_bf16(v[j][2], v[j][3]); *(u32x2*)(orow + 4 * lane + 256 * j) = w; }
}

__device__ const double ROPE_INV_REV[16] = {0.15915494309189535, 0.08949940160889101, 0.050329212104487035, 0.0283021958306234, 0.015915494309189534, 0.008949940160889102,
    0.005032921210448704, 0.00283021958306234, 0.0015915494309189536, 0.0008949940160889102, 0.0005032921210448703, 0.00028302195830623395, 0.00015915494309189535,
    8.949940160889102e-05, 5.0329212104487035e-05, 2.8302195830623396e-05};

#define PHASE_IDS int tid = threadIdx.x; asm volatile("" : "+v"(tid)); const int lane = tid & 63; const int wave = __builtin_amdgcn_readfirstlane(tid >> 6); const int gw = F.vcu * 8 + wave; (void)lane; (void)gw;

#define PHASE_PTRS unsigned long long wsi_ = (unsigned long long)args.ws; asm volatile("" : "+s"(wsi_)); unsigned char* wsl = (unsigned char*)(__attribute__((address_space(1))) unsigned char*)wsi_;     \
    float* ropeC = (float*)(wsl + WS_ROPE); float* ropeS = ropeC + LSEQ * 16; float* LFp = (float*)(wsl + WS_LF); float* CSp = (float*)(wsl + WS_CS); \
    unsigned* TOK = (unsigned*)(wsl + WS_TOK); int* LIST = (int*)(wsl + WS_LIST); bf16_t* Wall = (bf16_t*)(wsl + WS_W); bf16_t* HB = (bf16_t*)(wsl + WS_H); unsigned char* X = wsl + WS_X; \
    bf16_t *Qf = (bf16_t*)(X + X_QF), *Kf = (bf16_t*)(X + X_KF), *Vf = (bf16_t*)(X + X_VF), *RAW = (bf16_t*)(X + X_RAW), *Qm = (bf16_t*)(X + X_QM), *Km = (bf16_t*)(X + X_KM), \
           *Vm = (bf16_t*)(X + X_VM), *Om = (bf16_t*)(X + X_OM), *Of = (bf16_t*)(X + X_OF), *GATES = (bf16_t*)(X + X_GATES), *MERGED = (bf16_t*)(X + X_MERGED), *H1 = (bf16_t*)(X + X_H1), \
           *HID = (bf16_t*)(X + X_HID), *YS = (bf16_t*)(X + X_YS); bf16_t* Zb = (bf16_t*)(X + X_Z); unsigned* ctl = (unsigned*)(wsl + WS_CTL); \
    (void)ropeC; (void)ropeS; (void)LFp; (void)CSp; (void)TOK; (void)LIST; (void)Wall; (void)HB; (void)Qf; (void)Kf; (void)Vf; (void)RAW; (void)Qm; (void)Km; (void)Vm; (void)Om; (void)Of; (void)GATES; (void)MERGED; (void)H1; (void)HID; (void)YS; (void)Zb; (void)ctl;


template <int L>
__device__ __forceinline__ void run_layer(const Args& args, const Frame& F, const XcdBarrier& bar, const int NGW) {
    constexpr int l = L;
        for (int rep_ = 0; rep_ < REP_A; ++rep_) {
        {
            PHASE_PTRS const bf16_t* W = Wall + (size_t)l * W_LAYER;
            pg8::SchedStatic S{(const char*)(X + X_HBQ), (const char*)(W + W_BT1), NPANEL, 17, F.G, (int)blockIdx.x, (size_t)256 * DM, (size_t)256 * DM, 1};
            pg8::EpiA E{pg8::EpiA1{Qf, Kf, Vf, RAW, LFp, args.in[5] + l * 8, (float*)(wsl + WS_QKN), (float*)(wsl + WS_SSQ), (bf16_t*)(wsl + WS_KR), ropeC, ropeS, (const float*)(wsl + WS_HBS), ctl + CW_CMAX + 16384 * l}, pg8::EpiA2{(unsigned char*)args.out, (unsigned char*)(wsl + WS_GALT), (const float*)(wsl + WS_HBS), ctl + CW_CMAX + 16384 * l}};
            pg8::gemm_phase<pg8::EpiA, pg8::SchedStatic, false, false, true>(F.lds, 512, 512, 512, S, E);
        }
        xcd_barrier(bar);
        }
        {
            PHASE_IDS
            PHASE_PTRS
            if (blockIdx.x < 64) {
                const int bb = blockIdx.x >> 3, hh = blockIdx.x & 7;
                float v[9];
#pragma unroll
                for (int k = 0; k < 9; ++k) { const int p = 9 * tid + k; v[k] = p < LSEQ ? LFp[(size_t)row_of(bb, p) * 8 + hh] : 0.f; }
#pragma unroll
                for (int k = 1; k < 9; ++k) v[k] += v[k - 1];
                float x = v[8];
#pragma unroll
                for (int d = 1; d < 64; d <<= 1) { const float y = __shfl_up(x, d); if (lane >= d) x += y; }
                LAS float* wt = (LAS float*)(F.lds + 1024);
                if (lane == 63) wt[wave] = x;
                __syncthreads();
                float off = x - v[8];
                for (int w2 = 0; w2 < wave; ++w2) off += wt[w2];
#pragma unroll
                for (int k = 0; k < 9; ++k) { const int p = 9 * tid + k; if (p < CSP) CSp[(size_t)blockIdx.x * CSP + p] = (v[k] + off) * LOG2E; }
                __syncthreads();
                {
                    const float* qkn = (const float*)(wsl + WS_QKN); float mq = 0.f, mk = 0.f;
#pragma unroll
                    for (int k = 0; k < 9; ++k) { const int p = 9 * tid + k; if (p < LSEQ) { const float* r_ = qkn + (size_t)row_of(bb, p) * 32 + 2 * hh;
                        mq = fmaxf(mq, r_[0] + r_[1]); mk = fmaxf(mk, r_[16] + r_[17]); } }
#pragma unroll
                    for (int o = 1; o < 64; o <<= 1) { mq = fmaxf(mq, __shfl_xor(mq, o)); mk = fmaxf(mk, __shfl_xor(mk, o)); }
                    LAS float* wq = (LAS float*)(F.lds + 2048);
                    if (lane == 0) { wq[2 * wave] = mq; wq[2 * wave + 1] = mk; }
                    __syncthreads();
                    if (tid == 0) { float a = 0.f, c = 0.f; for (int w2 = 0; w2 < 8; ++w2) { a = fmaxf(a, wq[2 * w2]); c = fmaxf(c, wq[2 * w2 + 1]); }
                        ctl[CW_QKMAX + 128 * l + blockIdx.x * 2] = __float_as_uint(a); ctl[CW_QKMAX + 128 * l + blockIdx.x * 2 + 1] = __float_as_uint(c); }
                }
            }
        }
        xcd_barrier(bar);
        for (int rep_ = 0; rep_ < REP_C; ++rep_) {
        {
            PHASE_IDS
            PHASE_PTRS const bf16_t* W = Wall + (size_t)l * W_LAYER;
            pg8::SchedStatic S{(const char*)RAW, (const char*)(W + W_UQ), NPANEL, 3, F.G, (int)blockIdx.x, (size_t)256 * 768 * 2, (size_t)256 * 384 * 2, 1};
            pg8::EpiQup E{Qm, ropeC, ropeS, (const float*)(wsl + WS_SSQ)};
            pg8::gemm_phase<pg8::EpiQup, pg8::SchedStatic, false>(F.lds, 384, 768, 384, S, E);
        }
        {
            PHASE_PTRS const bf16_t* W = Wall + (size_t)l * W_LAYER;
            pg8::SchedStatic S{(const char*)(RAW + 384), (const char*)(W + W_UKV), NPANEL, 4, F.G, (int)blockIdx.x, (size_t)256 * 768 * 2, (size_t)256 * 256 * 2, 1};
            pg8::EpiKV E{Km, Vm, (const float*)(wsl + WS_SSQ)};
            pg8::gemm_phase<pg8::EpiKV, pg8::SchedStatic, false>(F.lds, 256, 768, 256, S, E);
        }
        {
            PHASE_IDS
            PHASE_PTRS
            const int myx = (int)(xb_xcc_id() & 7u);
            for (int rep_ = 0; rep_ < REP_FOX; ++rep_)
            for (int xo = 0; xo < 8; ++xo) { const int x = (myx + xo) & 7; unsigned* qc = ctl + CW_QCTR + 64 * ((rep_ * 4 + l * 2 + 1) * 8 + x);
                for (;;) {
                    if (tid == 0) F.MISC[4] = __hip_atomic_fetch_add(qc, 1u, RLX_AGENT);
                    __syncthreads();
                    const int id = (int)F.MISC[4];
                    __syncthreads();
                    if (id >= 136) break;
                    const int g = id / 34, i = id % 34, j = 16 - (i >> 1), h = 2 * g + (i & 1), b = x;
                    int tmin = 0;
                    if (j > 0) {
                        const float* csr = CSp + (size_t)(b * 8 + h) * CSP;
                        const float q2 = __uint_as_float(__hip_atomic_load(ctl + CW_QKMAX + 128 * l + (b * 8 + h) * 2, RLX_AGENT)), k2 = __uint_as_float(__hip_atomic_load(ctl + CW_QKMAX + 128 * l + (b * 8 + h) * 2 + 1, RLX_AGENT));
                        const float qk = 2.0f * sqrtf(q2 * k2) * 1.0001f + 0.01f;
                        const float cq = csr[16 + 256 * (j - 1)];
                        const float ck = csr[lane == 0 ? 15 : 64 * lane + 15];
                        const bool ok = (qk + cq - ck) >= -64.0f;
                        const unsigned long long m = __ballot(ok);
                        tmin = m ? (int)__builtin_ctzll(m) : 64;
                        const int tfirst = 4 * (j - 1) + 1; tmin = tmin < tfirst ? tmin : tfirst;
                    }
                    tmin = __builtin_amdgcn_readfirstlane(tmin);
                    attn_unit8<64, true>((LAS char*)F.lds, Qf + 64 * h, 512, Kf + 64 * h, 512, Vf + 64 * h, 512, Om + 64 * h, 1024, CSp + (size_t)(b * 8 + h) * CSP, b, j, tmin);
                } }
        }
        xcd_barrier(bar);
        }
        {
            PHASE_IDS
            PHASE_PTRS
            const int myx = (int)(xb_xcc_id() & 7u);
            for (int rep_ = 0; rep_ < REP_MLA; ++rep_)
            for (int xo = 0; xo < 8; ++xo) { const int x = (myx + xo) & 7; unsigned* qc = ctl + CW_QCTR + 64 * ((rep_ * 4 + l * 2) * 8 + x);
                for (;;) {
                    if (tid == 0) F.MISC[4] = __hip_atomic_fetch_add(qc, 1u, RLX_AGENT);
                    __syncthreads();
                    const int id = (int)F.MISC[4];
                    __syncthreads();
                    if (id >= 136) break;
                    const int g = id / 34, i = id % 34, j = 16 - (i >> 1), h = 2 * g + (i & 1), b = x;
                    attn_unit8<96, false>((LAS char*)F.lds, Qm + 96 * h, 768, Km + 96 * h, 768, Vm + 64 * h, 512, Om + 512 + 64 * h, 1024, nullptr, b, j, 0, (const bf16_t*)(wsl + WS_KR));
                } }
        }
        xcd_barrier(bar);
        for (int rep_ = 0; rep_ < REP_E; ++rep_) {
        {
            PHASE_PTRS const bf16_t* W = Wall + (size_t)l * W_LAYER;
            pg8::SchedStatic S{(const char*)Om, (const char*)(W + W_FOXO), (l == 0) ? NPANEL : NPANEL - 1, 4, F.G, (int)blockIdx.x, (size_t)256 * DM * 2, (size_t)256 * DM * 2, (l == 0) ? 1 : 0};
            pg8::EpiOut E{(const unsigned char*)args.out, (const unsigned char*)(wsl + WS_GALT), MERGED};
            pg8::gemm_phase<pg8::EpiOut, pg8::SchedStatic, false, true>(F.lds, 1024, 1024, 1024, S, E);
        }
        xcd_barrier(bar);
        }
        for (int rep_ = 0; rep_ < REP_F; ++rep_) {
        {
            PHASE_PTRS const bf16_t* W = Wall + (size_t)l * W_LAYER;
            pg8::SchedStatic S{(const char*)MERGED, (const char*)(W + W_OUT), (l == 0) ? NPANEL : NPANEL - 1, 4, F.G, (int)blockIdx.x, (size_t)256 * DM * 2, (size_t)256 * DM * 2, (l == 0) ? 1 : 0};
            pg8::EpiF E{HB, Zb};
            pg8::gemm_phase<pg8::EpiF, pg8::SchedStatic, false>(F.lds, 1024, 1024, 1024, S, E);
        }
        xcd_barrier(bar);
        }
        {
            PHASE_IDS
            PHASE_PTRS
            LAS float* rwT = (LAS float*)F.lds;
            LAS int* lcnt = (LAS int*)(F.lds + 65536);
            LAS int* gbase = lcnt + 16;
            LAS int* tE = lcnt + 64;
            LAS int* tP = tE + 384;
            LAS float* tG = (LAS float*)(tP + 384);
            { const f32x4* RWT4 = (const f32x4*)(wsl + WS_RWT); LAS f32x4* d4 = (LAS f32x4*)rwT;
#pragma unroll
              for (int i = 0; i < 8; ++i) d4[tid + 512 * i] = RWT4[tid + 512 * i]; }
            LAS float* lgb = (LAS float*)(F.lds + 65536 + 8192) + wave * 64;
            if (tid < 16) lcnt[tid] = 0;
            __syncthreads();
            const int TG = (l == 0) ? T : NREAL;
            const int rpw = (TG + F.G - 1) / F.G;
            const int r0 = blockIdx.x * rpw, nrows = (r0 + rpw <= TG) ? rpw : (TG > r0 ? TG - r0 : 0);
            const float* rb = args.in[16];
            for (int g4 = wave * 4; g4 < nrows; g4 += 32) {
                f32x4 v[4][4];
#pragma unroll
                for (int k = 0; k < 4; ++k) { const int lr = (g4 + k < nrows) ? g4 + k : nrows - 1; const int row = r0 + lr;
#pragma unroll
                    for (int j = 0; j < 4; ++j) { const u32x2 zv = *(const u32x2*)(Zb + (size_t)row * DM + 4 * lane + 256 * j); v[k][j] = (f32x4){bf_lo(zv.x), bf_hi(zv.x), bf_lo(zv.y), bf_hi(zv.y)}; } }
                ln16xR<4>(v, args.in[13] + l * DM, args.in[14] + l * DM, lane);
#pragma unroll
                for (int k = 0; k < 4; ++k) if (g4 + k < nrows) store_row_bf16(H1 + (size_t)(r0 + g4 + k) * DM, v[k], lane);
                { unsigned char* qr[4]; float* sr[4];
#pragma unroll
                  for (int k = 0; k < 4; ++k) { const bool ok = g4 + k < nrows; qr[k] = ok ? X + X_H1Q + (size_t)(r0 + g4 + k) * DM : nullptr; sr[k] = (float*)(wsl + WS_H1S) + (ok ? r0 + g4 + k : 0); }
                  unsigned char* const qc[4] = {qr[0], qr[1], qr[2], qr[3]}; float* const sc4[4] = {sr[0], sr[1], sr[2], sr[3]};
                  quant_rows<4>(v, qc, sc4, lane); }
                float s[4][16];
#pragma unroll
                for (int e = 0; e < 16; ++e) {
                    f32x4 wv[4];
#pragma unroll
                    for (int j = 0; j < 4; ++j) wv[j] = *(const LAS f32x4*)(rwT + e * 1024 + 4 * lane + 256 * j);
#pragma unroll
                    for (int k = 0; k < 4; ++k) { float a = 0.f;
#pragma unroll
                        for (int j = 0; j < 4; ++j) a += (v[k][j][0] * wv[j][0] + v[k][j][1] * wv[j][1]) + (v[k][j][2] * wv[j][2] + v[k][j][3] * wv[j][3]);
                        s[k][e] = a; }
                }
#pragma unroll
                for (int k = 0; k < 4; ++k) {
#pragma unroll
                    for (int i = 0; i < 8; ++i) { const bool up = (lane & 32) != 0; const float mine = up ? s[k][i + 8] : s[k][i], oth = up ? s[k][i] : s[k][i + 8]; s[k][i] = mine + __shfl_xor(oth, 32); }
#pragma unroll
                    for (int i = 0; i < 4; ++i) { const bool up = (lane & 16) != 0; const float mine = up ? s[k][i + 4] : s[k][i], oth = up ? s[k][i] : s[k][i + 4]; s[k][i] = mine + __shfl_xor(oth, 16); }
#pragma unroll
                    for (int i = 0; i < 2; ++i) { const bool up = (lane & 8) != 0; const float mine = up ? s[k][i + 2] : s[k][i], oth = up ? s[k][i] : s[k][i + 2]; s[k][i] = mine + __shfl_xor(oth, 8); }
                    { const bool up = (lane & 4) != 0; const float mine = up ? s[k][1] : s[k][0], oth = up ? s[k][0] : s[k][1]; s[k][0] = mine + __shfl_xor(oth, 4); }
                    s[k][0] += __shfl_xor(s[k][0], 2); s[k][0] += __shfl_xor(s[k][0], 1);
                }
                if ((lane & 3) == 0) {
#pragma unroll
                    for (int k = 0; k < 4; ++k) lgb[k * 16 + (lane >> 2)] = s[k][0]; }
                LDS_WAIT();
                {
                    const int k = lane & 3;
                    float lg[16];
#pragma unroll
                    for (int q4 = 0; q4 < 4; ++q4) { const f32x4 t4 = *(const LAS f32x4*)(lgb + k * 16 + 4 * q4); lg[4 * q4] = t4[0]; lg[4 * q4 + 1] = t4[1]; lg[4 * q4 + 2] = t4[2]; lg[4 * q4 + 3] = t4[3]; }
                    float sc[16], bi[16];
#pragma unroll
                    for (int e = 0; e < 16; ++e) { sc[e] = __builtin_amdgcn_rcpf(1.0f + __builtin_amdgcn_exp2f(-LOG2E * lg[e])); bi[e] = sc[e] + rb[e]; }
                    int gsel = 0; float gbest = -INFINITY;
#pragma unroll
                    for (int g = 0; g < 4; ++g) { float m1 = bi[4 * g], m2 = -INFINITY;
#pragma unroll
                        for (int kk = 1; kk < 4; ++kk) { const float x = bi[4 * g + kk]; if (x > m1) { m2 = m1; m1 = x; } else if (x > m2) m2 = x; }
                        const float gs = m1 + m2; if (gs > gbest) { gbest = gs; gsel = g; } }
                    float b4[4], s4[4];
#pragma unroll
                    for (int kk = 0; kk < 4; ++kk) { b4[kk] = gsel == 0 ? bi[kk] : gsel == 1 ? bi[4 + kk] : gsel == 2 ? bi[8 + kk] : bi[12 + kk]; s4[kk] = gsel == 0 ? sc[kk] : gsel == 1 ? sc[4 + kk] : gsel == 2 ? sc[8 + kk] : sc[12 + kk]; }
                    int i1 = 0; float bb1 = b4[0], ss1 = s4[0];
#pragma unroll
                    for (int kk = 1; kk < 4; ++kk) if (b4[kk] > bb1) { bb1 = b4[kk]; ss1 = s4[kk]; i1 = kk; }
                    int i2 = -1; float bb2 = -INFINITY, ss2 = 0.f;
#pragma unroll
                    for (int kk = 0; kk < 4; ++kk) if (kk != i1 && b4[kk] > bb2) { bb2 = b4[kk]; ss2 = s4[kk]; i2 = kk; }
                    const float inv = 1.0f / (ss1 + ss2);
                    if (lane < 4 && g4 + k < nrows) {
                        const int lr = g4 + k; const int e0 = gsel * 4 + i1, e1 = gsel * 4 + i2;
                        tE[2 * lr] = e0; tE[2 * lr + 1] = e1;
                        tP[2 * lr] = atomicAdd((int*)&lcnt[e0], 1); tP[2 * lr + 1] = atomicAdd((int*)&lcnt[e1], 1);
                        tG[2 * lr] = ss1 * inv; tG[2 * lr + 1] = ss2 * inv;
                    }
                }
            }
            __syncthreads();
            if (tid < 16) gbase[tid] = (int)__hip_atomic_fetch_add(ctl + CW_ECNT + 64 * (l * 16 + tid), (unsigned)lcnt[tid], RLX_AGENT);
            __syncthreads();
            if (tid < nrows) {
                const int row = r0 + tid; const int e0 = tE[2 * tid], e1 = tE[2 * tid + 1];
                const int p0 = gbase[e0] + tP[2 * tid], p1 = gbase[e1] + tP[2 * tid + 1];
                LIST[(size_t)e0 * TP + p0] = row; LIST[(size_t)e1 * TP + p1] = row;
                u32x4 w0; w0.x = (unsigned)e0; w0.y = (unsigned)p0; w0.z = (unsigned)e1; w0.w = (unsigned)p1;
                *(u32x4*)(TOK + (size_t)row * 8) = w0;
                u32x2 w1; w1.x = __float_as_uint(tG[2 * tid]); w1.y = __float_as_uint(tG[2 * tid + 1]);
                *(u32x2*)(TOK + (size_t)row * 8 + 4) = w1;
            }
        }
        xcd_barrier(bar);
        LAS int* tb = (LAS int*)(F.lds + MISC_OFF) + 16; LAS int* ecnt = (LAS int*)(F.lds + MISC_OFF) + 64;
        if (threadIdx.x == 0) { int acc = 0; for (int e = 0; e < 16; ++e) { const int c = (int)__hip_atomic_load(F.ctl + CW_ECNT + 64 * (l * 16 + e), RLX_AGENT); ecnt[e] = c; tb[e] = acc; acc += (c + 255) >> 8; } tb[16] = acc; }
        __syncthreads();
        for (int rep_ = 0; rep_ < REP_H; ++rep_) {
        {
            PHASE_PTRS const bf16_t* W = Wall + (size_t)l * W_LAYER;
            pg8::SchedMoe S{(const char*)(X + X_H1Q), (const char*)(W + W_MOE1), tb, ecnt, LIST, 1, F.G, (int)blockIdx.x, (size_t)512 * 1024, (size_t)256 * 1024, 0, true, DM};
            pg8::EpiM1 E{HID, (const float*)(wsl + WS_H1S), ctl + CW_CMAX + 16384 * l + 4608, tb, ecnt, LIST};
            pg8::gemm_phase<pg8::EpiM1, pg8::SchedMoe, true, false, true>(F.lds, 512, 512, 512, S, E);
        }
        xcd_barrier(bar);
        }
        for (int rep_ = 0; rep_ < REP_I; ++rep_) {
        {
            PHASE_PTRS const bf16_t* W = Wall + (size_t)l * W_LAYER;
            pg8::SchedMoe S{(const char*)HID, (const char*)(W + W_MOE2), tb, ecnt, LIST, 2, F.G, (int)blockIdx.x, (size_t)1024 * 256 * 2, (size_t)256 * 256 * 2, (size_t)256 * 256 * 2, false, DM * 2};
            pg8::EpiM2 E{YS};
            pg8::gemm_phase<pg8::EpiM2, pg8::SchedMoe, false>(F.lds, 256, 256, 256, S, E);
        }
        xcd_barrier(bar);
        }
        {
            PHASE_IDS
            PHASE_PTRS
            for (int rep_ = 0; rep_ < REP_J; ++rep_)
            for (int r4 = gw * 4; r4 < (l == 0 ? T : NREAL); r4 += NGW * 4) {
                u32x4 w0[4]; u32x2 w1[4];
#pragma unroll
                for (int k = 0; k < 4; ++k) { w0[k] = *(const u32x4*)(TOK + (size_t)(r4 + k) * 8); w1[k] = *(const u32x2*)(TOK + (size_t)(r4 + k) * 8 + 4); }
                u32x2 hv[4][4], ya[4][4], yc[4][4];
#pragma unroll
                for (int k = 0; k < 4; ++k) {
                    const size_t s0 = (size_t)tb[(int)w0[k].x] * 256 + (int)w0[k].y, s1 = (size_t)tb[(int)w0[k].z] * 256 + (int)w0[k].w;
#pragma unroll
                    for (int j = 0; j < 4; ++j) { hv[k][j] = *(const u32x2*)(H1 + (size_t)(r4 + k) * DM + 4 * lane + 256 * j); ya[k][j] = *(const u32x2*)(YS + s0 * DM + 4 * lane + 256 * j); yc[k][j] = *(const u32x2*)(YS + s1 * DM + 4 * lane + 256 * j); } }
                f32x4 v[4][4];
#pragma unroll
                for (int k = 0; k < 4; ++k) { const float g0 = __uint_as_float(w1[k].x), g1 = __uint_as_float(w1[k].y);
#pragma unroll
                    for (int j = 0; j < 4; ++j) {
                        v[k][j][0] = ALPHA * bf_lo(hv[k][j].x) + g0 * bf_lo(ya[k][j].x) + g1 * bf_lo(yc[k][j].x); v[k][j][1] = ALPHA * bf_hi(hv[k][j].x) + g0 * bf_hi(ya[k][j].x) + g1 * bf_hi(yc[k][j].x);
                        v[k][j][2] = ALPHA * bf_lo(hv[k][j].y) + g0 * bf_lo(ya[k][j].y) + g1 * bf_lo(yc[k][j].y); v[k][j][3] = ALPHA * bf_hi(hv[k][j].y) + g0 * bf_hi(ya[k][j].y) + g1 * bf_hi(yc[k][j].y); } }
                ln16xR<4>(v, args.in[20] + l * DM, args.in[21] + l * DM, lane);
                if (l == 0) { unsigned char* const qr[4] = {X + X_HBQ + (size_t)r4 * DM, X + X_HBQ + (size_t)(r4 + 1) * DM, X + X_HBQ + (size_t)(r4 + 2) * DM, X + X_HBQ + (size_t)(r4 + 3) * DM};
                    float* const hs = (float*)(wsl + WS_HBS) + r4; float* const sr[4] = {hs, hs + 1, hs + 2, hs + 3};
                    quant_rows<4>(v, qr, sr, lane); }
#pragma unroll
                for (int k = 0; k < 4; ++k) { const int row = r4 + k;
                    if (l == 0) store_row_bf16(HB + (size_t)row * DM, v[k], lane);
                    else { float* orow = args.out + (size_t)row * DM;
#pragma unroll
                        for (int j = 0; j < 4; ++j) *(f32x4*)(orow + 4 * lane + 256 * j) = v[k][j]; } }
            }
        }
        if (l == 0) xcd_barrier(bar);
}

__global__ void __launch_bounds__(512, 2) fwd_kernel(Args args) {
    extern __shared__ __attribute__((aligned(16))) unsigned char lds_raw[];
    Frame F;
    F.lds = (LAS unsigned char*)lds_raw;
    F.MISC = (volatile LAS unsigned*)(F.lds + MISC_OFF);
    F.tid = threadIdx.x; F.lane = F.tid & 63; F.wave = __builtin_amdgcn_readfirstlane(F.tid >> 6);
    F.G = gridDim.x; { const int bx = blockIdx.x; F.vcu = (F.G % 8 == 0) ? (bx % 8) * (F.G / 8) + bx / 8 : bx; }
    unsigned char* ws = args.ws;
    F.ctl = (unsigned*)(ws + WS_CTL);
    for (int u = F.tid; u < (LDS_BYTES - MISC_OFF) / 4; u += 512) ((LAS unsigned*)(F.lds + MISC_OFF))[u] = 0u;
    __syncthreads();
    XcdBarrier bar = xcd_barrier_post(F.ctl + CW_BAR, F.MISC);
    const int NGW = F.G * 8;
    {
        PHASE_IDS
        PHASE_PTRS
        LAS float* scr = (LAS float*)(F.lds + wave * 16384);
        { LAS float* part = (LAS float*)(F.lds + 12288);
          for (int it = F.vcu; it < 2 * STRIPS_PER_LAYER; it += F.G) { const int l = it / STRIPS_PER_LAYER, sidx = it % STRIPS_PER_LAYER;
              strip_item(args, Wall + (size_t)l * W_LAYER, ctl + CW_CMAX + 16384 * l, l, sidx, scr, part, wave, lane); } }
        for (int it = gw; it < 2 * ITEMS_PER_LAYER; it += NGW) { const int l = it / ITEMS_PER_LAYER, r = it % ITEMS_PER_LAYER; convert_item(args, Wall + (size_t)l * W_LAYER, l, r, scr, lane); }
        for (int r4 = gw * 4; r4 < TP; r4 += NGW * 4) {
            if (r4 >= T) {
#pragma unroll
                for (int k = 0; k < 4; ++k) { bf16_t* orow = HB + (size_t)(r4 + k) * DM; *(u32x4*)(orow + 8 * lane) = (u32x4){0u, 0u, 0u, 0u}; *(u32x4*)(orow + 512 + 8 * lane) = (u32x4){0u, 0u, 0u, 0u};
                    *(u32x4*)(X + X_HBQ + (size_t)(r4 + k) * DM + 16 * lane) = (u32x4){0u, 0u, 0u, 0u}; if (lane == 0) ((float*)(wsl + WS_HBS))[r4 + k] = 0.f; }
                continue; }
            f32x4 v[4][4];
#pragma unroll
            for (int k = 0; k < 4; ++k) { const int row = r4 + k;
                const float* src = row < NREAL ? args.in[0] + (size_t)row * DM : args.in[1] + (size_t)((row - NREAL) & (NMETA - 1)) * DM;
#pragma unroll
                for (int j = 0; j < 4; ++j) v[k][j] = *(const f32x4*)(src + 4 * lane + 256 * j); }
            ln16xR<4>(v, args.in[2], args.in[3], lane);
#pragma unroll
            for (int k = 0; k < 4; ++k) store_row_bf16(HB + (size_t)(r4 + k) * DM, v[k], lane);
            { unsigned char* const qr[4] = {X + X_HBQ + (size_t)r4 * DM, X + X_HBQ + (size_t)(r4 + 1) * DM, X + X_HBQ + (size_t)(r4 + 2) * DM, X + X_HBQ + (size_t)(r4 + 3) * DM};
              float* const hs = (float*)(wsl + WS_HBS) + r4; float* const sr[4] = {hs, hs + 1, hs + 2, hs + 3};
              quant_rows<4>(v, qr, sr, lane); }
        }
        { float* RWT = (float*)(wsl + WS_RWT); const float* rw = args.in[15];
          for (int idx = blockIdx.x * 512 + tid; idx < 16384; idx += F.G * 512) { const int e = idx >> 10, col = idx & 1023; RWT[idx] = rw[col * 16 + e]; } }
        for (int idx = blockIdx.x * 512 + tid; idx < LSEQ * 16; idx += F.G * 512) {
            const int p = idx >> 4, i = idx & 15; double x = (double)p * ROPE_INV_REV[i]; x -= floor(x); const float xr = (float)x;
            ropeC[idx] = __builtin_amdgcn_cosf(xr); ropeS[idx] = __builtin_amdgcn_sinf(xr);
        }
    }
    xcd_barrier(bar);

    run_layer<0>(args, F, bar, NGW);
    run_layer<1>(args, F, bar, NGW);
}

extern "C" void kernel_launch(void* const* d_in, const int* in_sizes, int n_in, void* d_out, int out_size, void* d_ws, size_t ws_size, hipStream_t stream) {
    static int grid = 0;
    if (grid == 0) {
        if (n_in != 22 || ws_size < WS_END) { fprintf(stderr, "kernel_launch: need 22 inputs and %zu bytes of workspace (got %d, %zu)\n", (size_t)WS_END, n_in, ws_size); grid = -1; return; }
        int dev = 0, cus = 0, per_cu = 0;
        if (hipGetDevice(&dev) != hipSuccess || hipDeviceGetAttribute(&cus, hipDeviceAttributeMultiprocessorCount, dev) != hipSuccess) { grid = -1; return; }
        if (hipFuncSetAttribute((const void*)fwd_kernel, hipFuncAttributeMaxDynamicSharedMemorySize, LDS_BYTES) != hipSuccess) { fprintf(stderr, "kernel_launch: hipFuncSetAttribute failed\n"); grid = -1; return; }
        if (hipOccupancyMaxActiveBlocksPerMultiprocessor(&per_cu, (const void*)fwd_kernel, 512, LDS_BYTES) != hipSuccess || per_cu < 1) { fprintf(stderr, "kernel_launch: occupancy query says %d\n", per_cu); }
        (void)hipGetLastError();
        grid = cus;
    }
    if (grid < 0) return;
    if (hipMemsetAsync((char*)d_ws + WS_CTL, 0, CTL_BYTES, stream) != hipSuccess) return;
    Args a{};
    for (int i = 0; i < 22; ++i) a.in[i] = (const float*)d_in[i];
    a.out = (float*)d_out; a.ws = (unsigned char*)d_ws;
    hipLaunchKernelGGL(fwd_kernel, dim3(grid), dim3(512), LDS_BYTES, stream, a);
}
```

```cpp
#include <hip/hip_runtime.h>
#include <cstdio>
#include <cstdint>

#ifndef REP_A
#define REP_A 1
#endif
#ifndef REP_C
#define REP_C 1
#endif
#ifndef REP_E
#define REP_E 1
#endif
#ifndef REP_F
#define REP_F 1
#endif
#ifndef REP_H
#define REP_H 1
#endif
#ifndef REP_I
#define REP_I 1
#endif
#ifndef REP_GEMM
#define REP_GEMM 1
#endif
#ifndef REP_MLA
#define REP_MLA 1
#endif
#ifndef REP2_MODE
#define REP2_MODE 0
#endif
#ifndef REP_FOX
#define REP_FOX 1
#endif
#ifndef REP_J
#define REP_J 1
#endif
#ifndef REP_THIN
#define REP_THIN 1
#endif
#define LAS __attribute__((address_space(3)))
typedef unsigned short bf16_t;
typedef short bf16x8 __attribute__((ext_vector_type(8)));
typedef short s16x4 __attribute__((ext_vector_type(4)));
typedef float f32x4 __attribute__((ext_vector_type(4)));
typedef float f32x2_t __attribute__((ext_vector_type(2)));
typedef __bf16 bf16x2_t __attribute__((ext_vector_type(2)));
typedef float f32x16 __attribute__((ext_vector_type(16)));
typedef unsigned u32x4 __attribute__((ext_vector_type(4)));
typedef unsigned u32x2 __attribute__((ext_vector_type(2)));
typedef int i32x4 __attribute__((ext_vector_type(4)));

constexpr int NB = 8, SEQ = 4096, NMETA = 16, LSEQ = 4112, T = NB * LSEQ  , TP = 33024  , DM = 1024;
constexpr int NPANEL = TP / 256;
constexpr int NREAL = NB * SEQ;
__host__ __device__ __forceinline__ int row_of(int b, int p) { return p < NMETA ? NREAL + NMETA * b + p : SEQ * b + (p - NMETA); }
__host__ __device__ __forceinline__ int pos_of(int row) { return row < NREAL ? NMETA + (row & (SEQ - 1)) : (row - NREAL) & (NMETA - 1); }
constexpr int NEXP = 16;
constexpr float ALPHA = 1.41421356237309515f;
constexpr float LOG2E = 1.4426950408889634f;
constexpr float C2F = 0.125f * LOG2E;
constexpr float C2M = 0.14724444602590310f;
constexpr int CSP = 4160;

constexpr size_t MiB = 1ull << 20;
constexpr size_t WS_CTL = 0, CTL_BYTES = 1 * MiB;
constexpr size_t WS_ROPE = 1 * MiB;
constexpr size_t WS_RWT = 1 * MiB + 640 * 1024;
constexpr size_t WS_LF = 2 * MiB;
constexpr size_t WS_CS = 3 * MiB + 256 * 1024;
constexpr size_t WS_HBS = 8 * MiB + 512 * 1024;
constexpr size_t WS_H1S = 8 * MiB + 768 * 1024;
constexpr size_t WS_SSQ = 9 * MiB;
constexpr size_t WS_TOK = 4 * MiB + 512 * 1024;
constexpr size_t WS_LIST = 5 * MiB + 768 * 1024;
constexpr size_t WS_GALT = 8 * MiB;
constexpr size_t WS_W = 12 * MiB;
constexpr size_t WS_H = 88 * MiB;
constexpr size_t WS_X = 153 * MiB;
constexpr size_t S512 = (size_t)TP * 512 * 2, S768 = (size_t)TP * 768 * 2, S1024 = (size_t)TP * 1024 * 2;
constexpr size_t X_QF = 0, X_KF = S512, X_VF = 2 * S512, X_RAW = 3 * S512, X_QM = 3 * S512 + S768, X_KM = 3 * S512 + 2 * S768,
                 X_VM = 3 * S512 + 3 * S768, X_OM = 4 * S512 + 3 * S768, X_OF = 5 * S512 + 3 * S768, X_END = 6 * S512 + 3 * S768;
constexpr size_t X_HBQ = X_OM;
constexpr size_t X_H1Q = X_RAW;
constexpr size_t X_GATES = X_KF;
constexpr size_t X_MERGED = X_KM;
constexpr size_t X_Z = X_KF;
constexpr size_t X_H1 = X_KM;
constexpr size_t X_HID = X_QF;
constexpr size_t X_YS = 36 * MiB;
constexpr int NSLOT_TILES = 273, NSLOT = NSLOT_TILES * 256;
constexpr size_t WS_QKN = WS_X + X_END;
constexpr size_t WS_KR = WS_QKN + (size_t)TP * 128;
constexpr size_t WS_END = WS_KR + (size_t)TP * 64;
static_assert(X_GATES + (size_t)TP * 2048 * 2 <= X_KM, "gates");
static_assert(X_MERGED + S1024 <= X_OM, "merged");
static_assert(X_HID + (size_t)NSLOT * 256 * 2 <= X_YS, "hid");
static_assert(X_YS + (size_t)NSLOT * 1024 * 2 <= X_KM, "ys");
static_assert(WS_LF + (size_t)TP * 32 <= WS_CS && WS_CS + 64ull * CSP * 4 <= WS_TOK && WS_TOK + (size_t)TP * 32 <= WS_LIST && WS_LIST + 16ull * TP * 4 <= WS_GALT && WS_GALT + MiB <= WS_SSQ && WS_SSQ + (size_t)TP * 80 <= WS_W, "small buffers");
static_assert(WS_W + 2ull * 19693568ull * 2ull <= WS_H, "weights");
static_assert(WS_H + S1024 <= WS_X, "h");
constexpr size_t W_BT1 = 0, W_BT2 = W_BT1 + 2304ull * 1024, W_FOXO = W_BT2 + 2048ull * 1024, W_MLAO = W_FOXO + 1024ull * 512,
                 W_UQ = W_MLAO + 1024ull * 512, W_UKV = W_UQ + 768ull * 384, W_OUT = W_UKV + 1024ull * 256, W_MOE1 = W_OUT + 1024ull * 1024,
                 W_MOE2 = W_MOE1 + 16ull * 512 * 1024, W_LAYER = W_MOE2 + 16ull * 1024 * 256;
static_assert(W_LAYER == 19693568ull, "weights per layer");
constexpr int CW_BAR = 4096;
constexpr int CW_QCTR = 8192;
constexpr int CW_ECNT = 16384;
constexpr int CW_CMAX = 131072;
constexpr int CW_QKMAX = 20480;

constexpr int RING_BYTES = 131072;
constexpr int MISC_OFF = RING_BYTES;
constexpr int LDS_BYTES = 147456;

__device__ __forceinline__ unsigned pk_bf16(float lo, float hi) { f32x2_t v = {lo, hi}; bf16x2_t b = __builtin_convertvector(v, bf16x2_t); return __builtin_bit_cast(unsigned, b); }
__device__ __forceinline__ float bf_lo(unsigned u) { return __uint_as_float(u << 16); }
__device__ __forceinline__ float bf_hi(unsigned u) { return __uint_as_float(u & 0xffff0000u); }
__device__ __forceinline__ float wave_sum(float v) {
#pragma unroll
    for (int o = 1; o < 64; o <<= 1) v += __shfl_xor(v, o);
    return v;
}
#define LDS_WAIT() asm volatile("s_waitcnt lgkmcnt(0)" ::: "memory")
#define RLX_AGENT __ATOMIC_RELAXED, __HIP_MEMORY_SCOPE_AGENT

#define XB_TMO      128
#define XB_XCNT(j)  (256  + 64 * (j))
#define XB_XSUB(j)  (1280 + 64 * (j))
#define XB_XGEN(j)  (2304 + 64 * (j))
#define XB_TOP      3328
#define XB_TOPGEN   3392
#define XCD_BAR_WORDS 3456
#define XB_SPIN_CAP (1u << 20)
__device__ __forceinline__ unsigned xb_ld(unsigned* p)              { return __hip_atomic_load(p, __ATOMIC_RELAXED, __HIP_MEMORY_SCOPE_AGENT); }
__device__ __forceinline__ unsigned xb_add(unsigned* p, unsigned v) { return __hip_atomic_fetch_add(p, v, __ATOMIC_RELAXED, __HIP_MEMORY_SCOPE_AGENT); }
__device__ __forceinline__ unsigned xb_xcc_id() { return (unsigned)__builtin_amdgcn_s_getreg((3 << 11) | 20) & 0xFu; }
#define XB_SPIN(cond, bar) do { unsigned _sp = 0; while (cond) { __builtin_amdgcn_s_sleep(1); \
    if ((++_sp & 255u) == 0u) { if (xb_ld(&(bar)[XB_TMO])) break; if (_sp > XB_SPIN_CAP) { atomicAdd(&(bar)[XB_TMO], 1u); break; } } } } while (0)
struct XcdBarrier { unsigned* bar; unsigned x; volatile LAS unsigned* st; };
__device__ __forceinline__ XcdBarrier xcd_barrier_post(unsigned* bar, volatile LAS unsigned* st) {
    XcdBarrier b; b.bar = bar; b.x = xb_xcc_id(); b.st = st;
    if (threadIdx.x == 0) (void)xb_add(&bar[XB_XCNT(b.x)], 1u);
    return b;
}
__device__ __forceinline__ void xcd_barrier_complete(unsigned* bar, unsigned x, unsigned& nloc, unsigned& nx) {
    const unsigned G = gridDim.x * gridDim.y * gridDim.z;
    unsigned sum, cnt, mine, sp = 0u;
    for (;;) {
        sum = 0u; cnt = 0u; mine = 0u;
#pragma unroll
        for (unsigned j = 0; j < 16; ++j) { const unsigned c = xb_ld(&bar[XB_XCNT(j)]); sum += c; cnt += (c > 0u) ? 1u : 0u; mine = (j == x) ? c : mine; }
        if (sum == G) break;
        __builtin_amdgcn_s_sleep(1);
        if ((++sp & 255u) == 0u) { if (xb_ld(&bar[XB_TMO])) break; if (sp > XB_SPIN_CAP) { atomicAdd(&bar[XB_TMO], 1u); break; } }
    }
    nloc = mine > 0u ? mine : 1u; nx = cnt > 0u ? cnt : 1u;
}
__device__ __forceinline__ void xcd_barrier(const XcdBarrier& b) {
    asm volatile("s_waitcnt vmcnt(0)" ::: "memory");
    __syncthreads();
    if (threadIdx.x == 0) {
        unsigned* bar = b.bar; unsigned bx = b.x; asm volatile("" : "+s"(bar), "+s"(bx));
        __builtin_amdgcn_s_waitcnt(0);
        unsigned nloc = b.st[0], nx = b.st[1];
        if (nloc == 0u) { xcd_barrier_complete(bar, bx, nloc, nx); b.st[0] = nloc; b.st[1] = nx; }
        const unsigned old = xb_add(&bar[XB_XSUB(bx)], 1u);
        const unsigned gen = old / nloc;
        if (old + 1u == (gen + 1u) * nloc) {
            __builtin_amdgcn_fence(__ATOMIC_RELEASE, "agent");
            asm volatile("s_waitcnt vmcnt(0)" ::: "memory");
            const unsigned og = xb_add(&bar[XB_TOP], 1u);
            const unsigned tg = og / nx;
            if (og + 1u == (tg + 1u) * nx) xb_add(&bar[XB_TOPGEN], 1u);
            else XB_SPIN(xb_ld(&bar[XB_TOPGEN]) == tg, bar);
            __builtin_amdgcn_fence(__ATOMIC_ACQUIRE, "agent");
            xb_add(&bar[XB_XGEN(bx)], 1u);
            asm volatile("s_waitcnt vmcnt(0)" ::: "memory");
        } else {
            XB_SPIN(xb_ld(&bar[XB_XGEN(bx)]) == gen, bar);
            __builtin_amdgcn_fence(__ATOMIC_ACQUIRE, "agent");
            asm volatile("s_waitcnt vmcnt(0)" ::: "memory");
        }
    }
    __syncthreads();
}

namespace pg8 {
constexpr int BM = 256, BK = 64, HALF = 128, HTB = HALF * BK * 2, STAGE_BYTES = 8 * HTB;
__device__ __forceinline__ int lds_byte(int r, int c) { const int st = (r >> 4) * 2 + (c >> 5), rr = r & 15, cc = c & 31, ob = rr * 64 + cc * 2; return st * 1024 + (ob ^ (((ob >> 9) & 1) << 5)); }
__device__ __forceinline__ void stage_rc(int b, int& R, int& C) { const int st = b / 1024, sb = b % 1024, swz = sb ^ (((sb >> 9) & 1) << 5); R = (st >> 1) * 16 + swz / 64; C = (st & 1) * 32 + (swz % 64) / 2; }
__device__ __forceinline__ int perm32(int rho) { const int n = rho >> 4, i = rho & 15; return 8 * (i >> 2) + 4 * n + (i & 3); }
struct Unit { const char* A; const char* B; int pm, pn, aux, half; };
typedef f32x4 Acc[2][2][4][2];

__device__ __forceinline__ void tile_of(int L, int nM, int nN, int& pm, int& pn) {
    const int nwg = nM * nN; int wgid = L;
    { const int q = nwg / 8, r = nwg % 8, xcd = wgid % 8, off = wgid / 8; wgid = (xcd < r ? xcd * (q + 1) : r * (q + 1) + (xcd - r) * q) + off; }
    const int nig = 8 * nN, gid = wgid / nig, fm = gid * 8, gsz = (nM - fm) < 8 ? (nM - fm) : 8;
    pm = fm + ((wgid % nig) % gsz); pn = (wgid % nig) / gsz;
}

template <class Epi, class Sched, bool GATHER, bool MIDHOOK = false, bool I8 = false>
__device__ __forceinline__ void gemm_phase(LAS unsigned char* lds, const int K, const int lda, const int ldb, const Sched& S, const Epi& E) {
    int tid_l = threadIdx.x; asm volatile("" : "+v"(tid_l));
    const int tid = tid_l, wid = __builtin_amdgcn_readfirstlane(tid >> 6), lane = tid & 63, wr = wid >> 2, wc = wid & 3, fr = lane & 15, fq = lane >> 4;
    int nt = K / BK; asm volatile("" : "+s"(nt));
    unsigned voA[2][2], voB[2]; int Rr[2], Cc[2];
#pragma unroll
    for (int i = 0; i < 2; ++i) { int R, C; stage_rc(tid * 16 + i * 8192, R, C); const int Rb = Epi::PERM ? ((R & ~31) + perm32(R & 31)) : R;
        Rr[i] = R; Cc[i] = C; voA[0][i] = (unsigned)(R * lda + C) * 2u; voA[1][i] = (unsigned)((R + HALF) * lda + C) * 2u; voB[i] = (unsigned)(Rb * ldb + C) * 2u; }
    const size_t kstep = (size_t)(BK * 2);
    const size_t hstepB = (size_t)HALF * ldb * 2, hstepA = (size_t)HALF * lda * 2;
    const unsigned ldsw = (unsigned)wid * 1024u;
    const int aoff = lds_byte(wr * 64 + fr, fq * 8), boff = lds_byte(wc * 32 + fr, fq * 8);
#define PG8_SA(b, h) (((b) * 2 + (h)) * HTB)
#define PG8_SB(b, h) ((4 + (b) * 2 + (h)) * HTB)
#define PG8_STAGE2(bufoff, gbase, o0, o1) do { \
        __builtin_amdgcn_global_load_lds((const unsigned*)((const char*)(gbase) + (o0)), (LAS unsigned*)(lds + (bufoff) + ldsw), 16, 0, 0); \
        __builtin_amdgcn_global_load_lds((const unsigned*)((const char*)(gbase) + (o1)), (LAS unsigned*)(lds + (bufoff) + ldsw + 8192), 16, 0, 0); } while (0)
#define PG8_STA(b, h, gbase, VO) do { if constexpr (GATHER) PG8_STAGE2(PG8_SA(b, h), gbase, (VO)[h][0], (VO)[h][1]); else PG8_STAGE2(PG8_SA(b, h), (gbase) + (h) * hstepA, (VO)[0][0], (VO)[0][1]); } while (0)
#define PG8_STB(b, h, gbase) PG8_STAGE2(PG8_SB(b, h), (gbase) + (h) * hstepB, voB[0], voB[1])
#define PG8_LDA(dst, b, h) do { _Pragma("unroll") for (int m = 0; m < 4; ++m) _Pragma("unroll") for (int k = 0; k < 2; ++k) dst[m][k] = *(const LAS bf16x8*)(lds + PG8_SA(b, h) + aoff + m * 2048 + k * 1024); } while (0)
#define PG8_LDB(dst, b, h) do { _Pragma("unroll") for (int n = 0; n < 2; ++n) _Pragma("unroll") for (int k = 0; k < 2; ++k) dst[n][k] = *(const LAS bf16x8*)(lds + PG8_SB(b, h) + boff + n * 2048 + k * 1024); } while (0)
#define PG8_MMA(ai, bj, At, Bt) do { __builtin_amdgcn_s_setprio(1); _Pragma("unroll") for (int m = 0; m < 4; ++m) _Pragma("unroll") for (int n = 0; n < 2; ++n) _Pragma("unroll") for (int k = 0; k < 2; ++k) { \
        if constexpr (I8) acc[ai][bj][m][n] = __builtin_bit_cast(f32x4, __builtin_amdgcn_mfma_i32_16x16x64_i8(__builtin_bit_cast(i32x4, Bt[n][k]), __builtin_bit_cast(i32x4, At[m][k]), __builtin_bit_cast(i32x4, acc[ai][bj][m][n]), 0, 0, 0)); \
        else acc[ai][bj][m][n] = __builtin_amdgcn_mfma_f32_16x16x32_bf16(Bt[n][k], At[m][k], acc[ai][bj][m][n], 0, 0, 0); } __builtin_amdgcn_s_setprio(0); } while (0)
#define PG8_WAIT_V(n) asm volatile("s_waitcnt vmcnt(" #n ")" ::: "memory")
#define PG8_WAIT_L(n) asm volatile("s_waitcnt lgkmcnt(" #n ")" ::: "memory")
#define PG8_BAR __builtin_amdgcn_s_barrier()
#define PG8_SCHED __builtin_amdgcn_sched_barrier(0)
    Unit cur, nxt; int ui = 0;
    if (!S.next(0, cur)) return;
    Acc acc;
#pragma unroll
    for (int a = 0; a < 2; ++a)
#pragma unroll
        for (int b = 0; b < 2; ++b)
#pragma unroll
            for (int m = 0; m < 4; ++m)
#pragma unroll
                for (int n = 0; n < 2; ++n) acc[a][b][m][n] = (f32x4){0.f, 0.f, 0.f, 0.f};
    bf16x8 At[4][2], B0[2][2], B1[2][2];
    const char* cA = cur.A; const char* cB = cur.B;
    if constexpr (GATHER) {
#pragma unroll
        for (int h = 0; h < 2; ++h)
#pragma unroll
            for (int i = 0; i < 2; ++i) voA[h][i] = S.row_off(cur, Rr[i] + h * HALF) + (unsigned)Cc[i] * 2u;
    }
    PG8_STB(0, 0, cB); PG8_STB(0, 1, cB); PG8_STA(0, 0, cA, voA); PG8_STA(0, 1, cA, voA);
    if (wr == 1) PG8_BAR;
    PG8_WAIT_V(2); PG8_BAR;
    PG8_STB(1, 0, cB + kstep); PG8_STA(1, 0, cA + kstep, voA); PG8_STB(1, 1, cB + kstep);
    PG8_WAIT_V(6); PG8_BAR;
    for (;;) {
        const bool has_next = S.next(ui + 1, nxt);
        const char* nA = has_next ? nxt.A : cA; const char* nB = has_next ? nxt.B : cB;
        unsigned vnA[2][2];
        if constexpr (GATHER) {
#pragma unroll
            for (int h = 0; h < 2; ++h)
#pragma unroll
                for (int i = 0; i < 2; ++i) vnA[h][i] = has_next ? (S.row_off(nxt, Rr[i] + h * HALF) + (unsigned)Cc[i] * 2u) : voA[h][i];
        }
        for (int t = 0; t < nt; t += 2) {
            if constexpr (MIDHOOK) { if (t == (nt >> 1)) { int le_ = threadIdx.x & 63; asm volatile("" : "+v"(le_)); E.mid(acc, cur, wr, wc, le_ & 15, le_ >> 4); } }
            const bool last = (t == nt - 2);
            const char* a1 = cA + (size_t)(t + 1) * kstep;
            const char* a2 = last ? nA : cA + (size_t)(t + 2) * kstep; const char* b2 = last ? nB : cB + (size_t)(t + 2) * kstep;
            const char* a3 = a2 + kstep; const char* b3 = b2 + kstep;
            unsigned vs[2][2];
#pragma unroll
            for (int h = 0; h < 2; ++h)
#pragma unroll
                for (int i = 0; i < 2; ++i) { if constexpr (GATHER) vs[h][i] = last ? vnA[h][i] : voA[h][i]; else vs[h][i] = voA[h][i]; }
            PG8_LDB(B0, 0, 0); PG8_LDB(B1, 0, 1); PG8_SCHED; PG8_LDA(At, 0, 0); PG8_STA(1, 1, a1, voA);
            PG8_WAIT_V(8); PG8_WAIT_L(0); PG8_BAR; PG8_MMA(0, 0, At, B0); PG8_MMA(0, 1, At, B1); PG8_BAR; PG8_SCHED;
            PG8_LDA(At, 0, 1); PG8_STB(0, 0, b2); PG8_STB(0, 1, b2); PG8_STA(0, 0, a2, vs);
            PG8_WAIT_V(8); PG8_WAIT_L(0); PG8_BAR; if (!cur.half) { PG8_MMA(1, 0, At, B0); PG8_MMA(1, 1, At, B1); } PG8_BAR; PG8_SCHED;
            PG8_LDB(B0, 1, 0); PG8_LDB(B1, 1, 1); PG8_SCHED; PG8_LDA(At, 1, 0); PG8_STA(0, 1, a2, vs);
            PG8_WAIT_V(8); PG8_WAIT_L(0); PG8_BAR; PG8_MMA(0, 0, At, B0); PG8_MMA(0, 1, At, B1); PG8_BAR; PG8_SCHED;
            PG8_LDA(At, 1, 1); PG8_STB(1, 0, b3); PG8_STB(1, 1, b3); PG8_STA(1, 0, a3, vs);
            PG8_WAIT_V(8); PG8_WAIT_L(0); PG8_BAR; if (!cur.half) { PG8_MMA(1, 0, At, B0); PG8_MMA(1, 1, At, B1); } PG8_BAR; PG8_SCHED;
        }
        if (wr == 0) PG8_BAR;
        { int le_ = threadIdx.x & 63; asm volatile("" : "+v"(le_));
          E(acc, cur, wr, wc, le_ & 15, le_ >> 4); }
        if (!has_next) break;
#pragma unroll
        for (int a = 0; a < 2; ++a)
#pragma unroll
            for (int b = 0; b < 2; ++b)
#pragma unroll
                for (int m = 0; m < 4; ++m)
#pragma unroll
                    for (int n = 0; n < 2; ++n) acc[a][b][m][n] = (f32x4){0.f, 0.f, 0.f, 0.f};
        cur = nxt; cA = nA; cB = nB; ++ui;
        if constexpr (GATHER) {
#pragma unroll
            for (int h = 0; h < 2; ++h)
#pragma unroll
                for (int i = 0; i < 2; ++i) voA[h][i] = vnA[h][i];
        }
        if (wr == 1) PG8_BAR;
    }
    PG8_WAIT_V(0);
    PG8_BAR;
#undef PG8_SA
#undef PG8_SB
#undef PG8_STAGE2
#undef PG8_STA
#undef PG8_STB
#undef PG8_LDA
#undef PG8_LDB
#undef PG8_MMA
#undef PG8_WAIT_V
#undef PG8_WAIT_L
#undef PG8_BAR
#undef PG8_SCHED
}

struct SchedStatic {
    const char* A; const char* B; int nM, nN, G, c; size_t astep, bstep; int tail;
    __device__ __forceinline__ bool next(int i, Unit& u) const {
        const long L = (long)i * G + c; if (L >= (long)nM * nN) return false;
        int pm, pn; const int nfull = (nM - tail) * nN;
        if ((int)L < nfull) { tile_of((int)L, nM - tail, nN, pm, pn); u.half = 0; } else { pm = nM - 1; pn = (int)L - nfull; u.half = 1; }
        u.pm = pm; u.pn = pn; u.aux = 0; u.A = A + (size_t)pm * astep; u.B = B + (size_t)pn * bstep; return true;
    }
    __device__ __forceinline__ unsigned row_off(const Unit&, int) const { return 0u; }
};
struct SchedOut {
    const char* A0; const char* A1; const char* B0; const char* B1; int nM, nN, G, c; size_t astep, bstep;
    __device__ __forceinline__ bool next(int i, Unit& u) const {
        const long L = (long)(i >> 1) * G + c; if (L >= (long)nM * nN) return false;
        int pm, pn; const int nfull = (nM - 1) * nN;
        if ((int)L < nfull) { tile_of((int)L, nM - 1, nN, pm, pn); u.half = 0; } else { pm = nM - 1; pn = (int)L - nfull; u.half = 1; }
        const int pass = i & 1;
        u.pm = pm; u.pn = pn; u.aux = pass; u.A = (pass ? A1 : A0) + (size_t)pm * astep; u.B = (pass ? B1 : B0) + (size_t)pn * bstep; return true;
    }
    __device__ __forceinline__ unsigned row_off(const Unit&, int) const { return 0u; }
};
struct SchedMoe {
    const char* A; const char* B; const LAS int* tb; const LAS int* cnt; const int* list; int npn_shift, G, c; size_t bstep_e, bstep_n, astep; bool gather; int rowbytes;
    __device__ __forceinline__ bool next(int i, Unit& u) const {
        const int L = i * G + c; const int ntile = tb[16];
        if (L >= (ntile << npn_shift)) return false;
        const int ti = L >> npn_shift, pn = L & ((1 << npn_shift) - 1);
        int e = 0; while (ti >= tb[e + 1]) ++e;
        u.pm = ti; u.pn = pn; u.aux = e; u.half = (cnt[e] - (ti - tb[e]) * 256) <= 128 ? 1 : 0;
        u.A = gather ? A : A + (size_t)ti * astep;
        u.B = B + (size_t)e * bstep_e + (size_t)pn * bstep_n; return true;
    }
    __device__ __forceinline__ unsigned row_off(const Unit& u, int r) const {
        const int e = u.aux; int idx = (u.pm - tb[e]) * 256 + r; const int ce = cnt[e]; idx = idx < ce ? idx : ce - 1;
        const int tok = list[(size_t)e * TP + idx];
        return (unsigned)tok * (unsigned)rowbytes;
    }
};

__device__ __forceinline__ f32x4 dq4(const f32x4& a, float srow, const f32x4& scol) { const i32x4 i = __builtin_bit_cast(i32x4, a); return (f32x4){(float)i[0], (float)i[1], (float)i[2], (float)i[3]} * srow * scol; }
__device__ __forceinline__ f32x4 cmscale(const unsigned* cm) { const u32x4 u = *(const u32x4*)cm; return (f32x4){__uint_as_float(u.x), __uint_as_float(u.y), __uint_as_float(u.z), __uint_as_float(u.w)} * (1.0f / 127.0f); }
__device__ __forceinline__ u32x4 pack8(f32x4 v0, f32x4 v1) { u32x4 w; w.x = pk_bf16(v0[0], v0[1]); w.y = pk_bf16(v0[2], v0[3]); w.z = pk_bf16(v1[0], v1[1]); w.w = pk_bf16(v1[2], v1[3]); return w; }
__device__ __forceinline__ float logsig(float x) { return fminf(x, 0.f) - log1pf(__expf(-fabsf(x))); }
__device__ __forceinline__ float sigm(float x) { return __builtin_amdgcn_rcpf(1.0f + __builtin_amdgcn_exp2f(-LOG2E * x)); }

struct EpiA1 {
    static constexpr bool PERM = true;
    bf16_t *Qf, *Kf, *Vf, *RAW; float* LF; const float* fbias; float* qkn; float* ssq; bf16_t* Km; const float* cosT; const float* sinT; const float* hbs; const unsigned* cm;
    __device__ __forceinline__ void operator()(const Acc& acc, const Unit& u, int wr, int wc, int fr, int fq) const {
        const int pn = u.pn; bf16_t* base; int ldc, colt; float sc = 1.f;
        if (pn < 2) { base = Qf; ldc = 512; colt = pn * 256; sc = C2F; } else if (pn < 4) { base = Kf; ldc = 512; colt = (pn - 2) * 256; }
        else if (pn < 6) { base = Vf; ldc = 512; colt = (pn - 4) * 256; } else { base = RAW; ldc = 768; colt = (pn - 6) * 256; }
        const int row0 = u.pm * 256 + wr * 64 + fr, col0 = colt + wc * 32 + 8 * fq;
        f32x4 sb[2][2];
#pragma unroll
        for (int bj = 0; bj < 2; ++bj) { const unsigned* c_ = cm + pn * 256 + bj * 128 + wc * 32 + 8 * fq; sb[bj][0] = cmscale(c_); sb[bj][1] = cmscale(c_ + 4); }
        float sa8[2][4];
#pragma unroll
        for (int ai = 0; ai < 2; ++ai)
#pragma unroll
            for (int m = 0; m < 4; ++m) sa8[ai][m] = hbs[row0 + ai * 128 + m * 16];
#pragma unroll
        for (int ai = 0; ai < 2; ++ai)
#pragma unroll
            for (int m = 0; m < 4; ++m) { if (ai == 1 && u.half && !(pn == 4 || pn == 5)) continue;
                const int row = row0 + ai * 128 + m * 16; bf16_t* rowp = base + (size_t)row * ldc + col0;
                const float sa = sa8[ai][m] * sc;
#pragma unroll
                for (int bj = 0; bj < 2; ++bj) { const u32x4 w = pack8(dq4(acc[ai][bj][m][0], sa, sb[bj][0]), dq4(acc[ai][bj][m][1], sa, sb[bj][1])); *(u32x4*)(rowp + bj * 128) = w;
                    if (pn < 4 || pn >= 6) {
                        const float a0 = bf_lo(w.x), a1 = bf_hi(w.x), a2 = bf_lo(w.y), a3 = bf_hi(w.y), a4 = bf_lo(w.z), a5 = bf_hi(w.z), a6 = bf_lo(w.w), a7 = bf_hi(w.w);
                        float ss = (a0 * a0 + a1 * a1) + (a2 * a2 + a3 * a3) + (a4 * a4 + a5 * a5) + (a6 * a6 + a7 * a7);
                        { auto r16 = __builtin_amdgcn_permlane16_swap(__float_as_uint(ss), __float_as_uint(ss), false, false); ss = __uint_as_float(r16[0]) + __uint_as_float(r16[1]); }
                        { auto r32_ = __builtin_amdgcn_permlane32_swap(__float_as_uint(ss), __float_as_uint(ss), false, false); ss = __uint_as_float(r32_[0]) + __uint_as_float(r32_[1]); }
                        if (pn < 4) { if (fq == 0) qkn[(size_t)row * 32 + (pn >> 1) * 16 + (pn & 1) * 8 + bj * 4 + wc] = ss; }
                        else { const int g32 = (pn - 6) * 8 + bj * 4 + wc;
                            if (fq == 0 && g32 < 20) ssq[(size_t)row * 20 + g32] = ss; } } } }
        if (pn == 8 && wc == 0) {
#pragma unroll
            for (int aim = 0; aim < 4; ++aim) { const int ai = aim >> 1; if (ai == 1 && u.half) continue;
                f32x4 cs4[2], sn4[2];
#pragma unroll
                for (int mm = 0; mm < 2; ++mm) { const int pos = pos_of(row0 + ai * 128 + ((aim & 1) * 2 + mm) * 16); cs4[mm] = *(const f32x4*)(cosT + pos * 16 + 4 * fq); sn4[mm] = *(const f32x4*)(sinT + pos * 16 + 4 * fq); }
#pragma unroll
                for (int mm = 0; mm < 2; ++mm) { const int m = (aim & 1) * 2 + mm; const int row = row0 + ai * 128 + m * 16;
                    const float sa = sa8[ai][m]; const f32x4 x1 = dq4(acc[ai][1][m][0], sa, sb[1][0]), x2 = dq4(acc[ai][1][m][1], sa, sb[1][1]);
                    const f32x4 cs = cs4[mm], sn = sn4[mm];
                    const f32x4 y1 = x1 * cs - x2 * sn, y2 = x2 * cs + x1 * sn;
                    u32x2 w1, w2; w1.x = pk_bf16(y1[0], y1[1]); w1.y = pk_bf16(y1[2], y1[3]); w2.x = pk_bf16(y2[0], y2[1]); w2.y = pk_bf16(y2[2], y2[3]);
                    bf16_t* kp = Km + (size_t)row * 32 + 4 * fq;
                    *(u32x2*)kp = w1; *(u32x2*)(kp + 16) = w2; } }
        }
        if (pn == 8 && wc == 1 && fq == 0) {
            const f32x4 b0 = *(const f32x4*)fbias, b1 = *(const f32x4*)(fbias + 4);
#pragma unroll
            for (int ai = 0; ai < 2; ++ai)
#pragma unroll
                for (int m = 0; m < 4; ++m) { if (ai == 1 && u.half) continue; const int row = row0 + ai * 128 + m * 16; const float sa = sa8[ai][m]; const f32x4 a = dq4(acc[ai][1][m][0], sa, sb[1][0]) + b0, b = dq4(acc[ai][1][m][1], sa, sb[1][1]) + b1;
                    f32x4 o0, o1;
#pragma unroll
                    for (int j = 0; j < 4; ++j) { o0[j] = logsig(a[j]); o1[j] = logsig(b[j]); }
                    *(f32x4*)(LF + (size_t)row * 8) = o0; *(f32x4*)(LF + (size_t)row * 8 + 4) = o1; }
        }
    }
};
struct EpiA2 {
    static constexpr bool PERM = true;
    unsigned char* Gm; unsigned char* Galt; const float* hbs; const unsigned* cm;
    __device__ __forceinline__ void operator()(const Acc& acc, const Unit& u, int wr, int wc, int fr, int fq) const {
        unsigned char* G = (u.pm == 128) ? Galt - (size_t)32768 * 2048 : Gm;
        const int row0 = u.pm * 256 + wr * 64 + fr, col0 = (u.pn - 9) * 256 + wc * 64 + 16 * fq;
        f32x4 sb[2][2];
#pragma unroll
        for (int bj = 0; bj < 2; ++bj) { const unsigned* c_ = cm + u.pn * 256 + bj * 128 + wc * 32 + 8 * fq; sb[bj][0] = cmscale(c_); sb[bj][1] = cmscale(c_ + 4); }
        float sa8[2][4];
#pragma unroll
        for (int ai = 0; ai < 2; ++ai)
#pragma unroll
            for (int m = 0; m < 4; ++m) sa8[ai][m] = hbs[row0 + ai * 128 + m * 16];
#pragma unroll
        for (int ai = 0; ai < 2; ++ai)
#pragma unroll
            for (int m = 0; m < 4; ++m) { if (ai == 1 && u.half) continue; unsigned char* rowp = G + (size_t)(row0 + ai * 128 + m * 16) * 2048 + col0; const float sa = sa8[ai][m]; u32x2 wv[2];
#pragma unroll
                for (int bj = 0; bj < 2; ++bj) { const f32x4 a = dq4(acc[ai][bj][m][0], sa, sb[bj][0]), b = dq4(acc[ai][bj][m][1], sa, sb[bj][1]); unsigned q[8];
#pragma unroll
                    for (int j = 0; j < 4; ++j) { q[j] = (unsigned)fmaxf(255.0f * sigm(a[j]) + 0.5f, 1.0f); q[4 + j] = (unsigned)fmaxf(255.0f * sigm(b[j]) + 0.5f, 1.0f); }
                    wv[bj].x = q[0] | (q[1] << 8) | (q[2] << 16) | (q[3] << 24); wv[bj].y = q[4] | (q[5] << 8) | (q[6] << 16) | (q[7] << 24); }
                *(u32x4*)rowp = (u32x4){wv[0].x, wv[0].y, wv[1].x, wv[1].y}; }
    }
};
struct EpiA {
    static constexpr bool PERM = true;
    EpiA1 e1; EpiA2 e2;
    __device__ __forceinline__ void operator()(const Acc& acc, const Unit& u, int wr, int wc, int fr, int fq) const { if (u.pn < 9) e1(acc, u, wr, wc, fr, fq); else e2(acc, u, wr, wc, fr, fq); }
};
struct EpiQup {
    static constexpr bool PERM = false;
    bf16_t* Qm; const float* cosT; const float* sinT; const float* ssq;
    __device__ __forceinline__ void operator()(const Acc& acc, const Unit& u, int wr, int wc, int fr, int fq) const {
        const int row0 = u.pm * 256 + wr * 64 + fr;
        float rq8[2][4];
#pragma unroll
        for (int ai = 0; ai < 2; ++ai)
#pragma unroll
            for (int m = 0; m < 4; ++m) { const int row = row0 + ai * 128 + m * 16;
                float sq_; { const f32x4 a = *(const f32x4*)(ssq + (size_t)row * 20), b4 = *(const f32x4*)(ssq + (size_t)row * 20 + 4), c4 = *(const f32x4*)(ssq + (size_t)row * 20 + 8); sq_ = ((a[0] + a[1]) + (a[2] + a[3])) + ((b4[0] + b4[1]) + (b4[2] + b4[3])) + ((c4[0] + c4[1]) + (c4[2] + c4[3])); }
                rq8[ai][m] = C2M * __builtin_amdgcn_rsqf(sq_ * (1.f / 384.f) + 1e-6f);
                if (m & 1) asm volatile("" : "+v"(rq8[ai][m - 1]), "+v"(rq8[ai][m])); }
        const bool anyrot = ((u.pn * 8 + wc) % 3 == 2) || ((u.pn * 8 + 4 + wc) % 3 == 2);
#pragma unroll
        for (int aim = 0; aim < 4; ++aim) { const int ai = aim >> 1; if (ai == 1 && u.half) continue;
            f32x4 cs4[2], sn4[2];
            if (anyrot) {
#pragma unroll
                for (int mm = 0; mm < 2; ++mm) { const int pos = pos_of(row0 + ai * 128 + ((aim & 1) * 2 + mm) * 16); cs4[mm] = *(const f32x4*)(cosT + pos * 16 + 4 * fq); sn4[mm] = *(const f32x4*)(sinT + pos * 16 + 4 * fq); } }
#pragma unroll
            for (int mm = 0; mm < 2; ++mm) { const int m = (aim & 1) * 2 + mm; const int row = row0 + ai * 128 + m * 16;
                const float rq = rq8[ai][m];
#pragma unroll
                for (int bj = 0; bj < 2; ++bj) { const int Gi = u.pn * 8 + bj * 4 + wc; f32x4 x0 = acc[ai][bj][m][0], x1 = acc[ai][bj][m][1];
                    if (Gi % 3 == 2) { const f32x4 cs = cs4[mm], sn = sn4[mm];
                        const f32x4 y0 = x0 * cs - x1 * sn, y1 = x1 * cs + x0 * sn; x0 = y0; x1 = y1; }
                    x0 = x0 * rq; x1 = x1 * rq;
                    bf16_t* p = Qm + (size_t)row * 768 + Gi * 32 + 4 * fq;
                    u32x2 w0, w1; w0.x = pk_bf16(x0[0], x0[1]); w0.y = pk_bf16(x0[2], x0[3]); w1.x = pk_bf16(x1[0], x1[1]); w1.y = pk_bf16(x1[2], x1[3]);
                    *(u32x2*)p = w0; *(u32x2*)(p + 16) = w1; } } }
    }
};
struct EpiKV {
    static constexpr bool PERM = true;
    bf16_t *Km, *Vm; const float* ssq;
    __device__ __forceinline__ void operator()(const Acc& acc, const Unit& u, int wr, int wc, int fr, int fq) const {
        const int row0 = u.pm * 256 + wr * 64 + fr;
        float rk8[2][4];
#pragma unroll
        for (int ai = 0; ai < 2; ++ai)
#pragma unroll
            for (int m = 0; m < 4; ++m) { const int row = row0 + ai * 128 + m * 16;
                float sk_; { const f32x4 a = *(const f32x4*)(ssq + (size_t)row * 20 + 12), b4 = *(const f32x4*)(ssq + (size_t)row * 20 + 16); sk_ = ((a[0] + a[1]) + (a[2] + a[3])) + ((b4[0] + b4[1]) + (b4[2] + b4[3])); }
                rk8[ai][m] = __builtin_amdgcn_rsqf(sk_ * (1.f / 256.f) + 1e-6f); }
#pragma unroll
        for (int ai = 0; ai < 2; ++ai)
#pragma unroll
            for (int m = 0; m < 4; ++m) { const bool padrows = (ai == 1 && u.half); if (padrows && u.pn < 2) continue; const int row = row0 + ai * 128 + m * 16;
                if (padrows) {
#pragma unroll
                    for (int bj = 0; bj < 2; ++bj) { const int n = u.pn * 256 + bj * 128 + wc * 32 + 8 * fq; *(u32x4*)(Vm + (size_t)row * 512 + (n - 512)) = (u32x4){0u, 0u, 0u, 0u}; }
                    continue; }
                const float rk = rk8[ai][m];
#pragma unroll
                for (int bj = 0; bj < 2; ++bj) { const int n = u.pn * 256 + bj * 128 + wc * 32 + 8 * fq; const u32x4 w = pack8(acc[ai][bj][m][0] * rk, acc[ai][bj][m][1] * rk);
                    if (u.pn < 2) *(u32x4*)(Km + (size_t)row * 768 + 96 * (n >> 6) + (n & 63)) = w;
                    else *(u32x4*)(Vm + (size_t)row * 512 + (n - 512)) = w; } }
    }
};
__device__ __forceinline__ void store_lines16(bf16_t* rp, int ld, const u32x4& w0, const u32x4& w1, int up) {
    const u32x4 keep = up ? w1 : w0, send = up ? w0 : w1; u32x4 recv;
    recv.x = (unsigned)__builtin_amdgcn_update_dpp(0, (int)send.x, 0x128, 0xf, 0xf, false); recv.y = (unsigned)__builtin_amdgcn_update_dpp(0, (int)send.y, 0x128, 0xf, 0xf, false);
    recv.z = (unsigned)__builtin_amdgcn_update_dpp(0, (int)send.z, 0x128, 0xf, 0xf, false); recv.w = (unsigned)__builtin_amdgcn_update_dpp(0, (int)send.w, 0x128, 0xf, 0xf, false);
    *(u32x4*)rp = up ? recv : keep;
    *(u32x4*)(rp + (size_t)8 * ld) = up ? keep : recv;
}
struct EpiOut {
    static constexpr bool PERM = true;
    const unsigned char* Gm; const unsigned char* Galt; bf16_t* Mg;
    __device__ __forceinline__ void mid(Acc& acc, const Unit& u, int wr, int wc, int fr, int fq) const {
        const unsigned char* G = (u.pm == 128) ? Galt - (size_t)32768 * 2048 : Gm;
        const int row0 = u.pm * 256 + wr * 64 + fr, col0 = u.pn * 256 + wc * 64 + 8 * fq;
#pragma unroll
        for (int ai = 0; ai < 2; ++ai)
#pragma unroll
            for (int m = 0; m < 4; ++m) { if (ai == 1 && u.half) continue; const int row = row0 + ai * 128 + m * 16;
#pragma unroll
                for (int bj = 0; bj < 2; ++bj) { const int col = col0 + bj * 32;
                    const u32x2 gf = *(const u32x2*)(G + (size_t)row * 2048 + col), gm = *(const u32x2*)(G + (size_t)row * 2048 + 1024 + col);
                    f32x4& a = acc[ai][bj][m][0]; f32x4& b = acc[ai][bj][m][1];
#pragma unroll
                    for (int j = 0; j < 4; ++j) { a[j] *= (float)((gf.x >> (8 * j)) & 255u) * __builtin_amdgcn_rcpf((float)((gm.x >> (8 * j)) & 255u)); b[j] *= (float)((gf.y >> (8 * j)) & 255u) * __builtin_amdgcn_rcpf((float)((gm.y >> (8 * j)) & 255u)); } }
                if (m & 1) asm volatile("" ::: "memory"); }
    }
    __device__ __forceinline__ void operator()(const Acc& acc, const Unit& u, int wr, int wc, int fr, int fq) const {
        const unsigned char* G = (u.pm == 128) ? Galt - (size_t)32768 * 2048 : Gm;
        const int row0 = u.pm * 256 + wr * 64 + fr, col0 = u.pn * 256 + wc * 64 + 8 * fq;
        const int fr8 = fr & 7, up = fr >> 3;
        bf16_t* mb = Mg + (size_t)(u.pm * 256 + wr * 64 + fr8) * 1024 + u.pn * 256 + wc * 64 + up * 32 + 8 * fq;
#pragma unroll
        for (int ai = 0; ai < 2; ++ai) { if (ai == 1 && u.half) continue;
            u32x2 g8[4][2];
#pragma unroll
            for (int m = 0; m < 4; ++m)
#pragma unroll
                for (int bj = 0; bj < 2; ++bj) g8[m][bj] = *(const u32x2*)(G + (size_t)(row0 + ai * 128 + m * 16) * 2048 + 1024 + col0 + bj * 32);
            if (ai == 0) asm volatile("" ::: "memory");
#pragma unroll
            for (int m = 0; m < 4; ++m) { u32x4 wv[2];
#pragma unroll
                for (int bj = 0; bj < 2; ++bj) {
                    const u32x2 g = g8[m][bj];
                    f32x4 a = acc[ai][bj][m][0], b = acc[ai][bj][m][1];
#pragma unroll
                    for (int j = 0; j < 4; ++j) { a[j] *= (float)((g.x >> (8 * j)) & 255u) * (1.0f / 255.0f); b[j] *= (float)((g.y >> (8 * j)) & 255u) * (1.0f / 255.0f); }
                    wv[bj] = pack8(a, b); }
                store_lines16(mb + (size_t)(ai * 128 + m * 16) * 1024, 1024, wv[0], wv[1], up); } }
    }
};
struct EpiF {
    static constexpr bool PERM = true;
    const bf16_t* H; bf16_t* Z;
    __device__ __forceinline__ void operator()(const Acc& acc, const Unit& u, int wr, int wc, int fr, int fq) const {
        const int row0 = u.pm * 256 + wr * 64 + fr, col0 = u.pn * 256 + wc * 64 + 8 * fq;
        const int fr8 = fr & 7, up = fr >> 3;
        bf16_t* zb = Z + (size_t)(u.pm * 256 + wr * 64 + fr8) * 1024 + u.pn * 256 + wc * 64 + up * 32 + 8 * fq;
#pragma unroll
        for (int ai = 0; ai < 2; ++ai) { if (ai == 1 && u.half) continue;
            u32x4 h8[4][2];
#pragma unroll
            for (int m = 0; m < 4; ++m)
#pragma unroll
                for (int bj = 0; bj < 2; ++bj) h8[m][bj] = *(const u32x4*)(H + (size_t)(row0 + ai * 128 + m * 16) * 1024 + col0 + bj * 32);
#pragma unroll
            for (int m = 0; m < 4; ++m) { u32x4 wv[2];
#pragma unroll
                for (int bj = 0; bj < 2; ++bj) { const u32x4 hv = h8[m][bj]; f32x4 a = acc[ai][bj][m][0], b = acc[ai][bj][m][1];
                    a[0] += ALPHA * bf_lo(hv.x); a[1] += ALPHA * bf_hi(hv.x); a[2] += ALPHA * bf_lo(hv.y); a[3] += ALPHA * bf_hi(hv.y);
                    b[0] += ALPHA * bf_lo(hv.z); b[1] += ALPHA * bf_hi(hv.z); b[2] += ALPHA * bf_lo(hv.w); b[3] += ALPHA * bf_hi(hv.w);
                    wv[bj] = pack8(a, b); }
                store_lines16(zb + (size_t)(ai * 128 + m * 16) * 1024, 1024, wv[0], wv[1], up); } }
    }
};
struct EpiM1 {
    static constexpr bool PERM = true;
    bf16_t* Hid; const float* h1s; const unsigned* cm; const LAS int* tb; const LAS int* cnt; const int* list;
    __device__ __forceinline__ void operator()(const Acc& acc, const Unit& u, int wr, int wc, int fr, int fq) const {
        const int row0 = u.pm * 256 + wr * 64 + fr, hc0 = u.pn * 128 + wc * 32 + 8 * fq;
        const int e = u.aux; const unsigned* cme = cm + e * 512 + u.pn * 256 + wc * 32 + 8 * fq;
        f32x4 sg[2], su[2];
#pragma unroll
        for (int n = 0; n < 2; ++n) { sg[n] = cmscale(cme + 4 * n); su[n] = cmscale(cme + 128 + 4 * n); }
        const int ce = cnt[e], tl = (u.pm - tb[e]) * 256;
        int tk8[2][4]; float sa8[2][4];
#pragma unroll
        for (int ai = 0; ai < 2; ++ai)
#pragma unroll
            for (int m = 0; m < 4; ++m) { int idx = tl + wr * 64 + fr + ai * 128 + m * 16; idx = idx < ce ? idx : ce - 1; tk8[ai][m] = list[(size_t)e * TP + idx]; }
#pragma unroll
        for (int ai = 0; ai < 2; ++ai)
#pragma unroll
            for (int m = 0; m < 4; ++m) sa8[ai][m] = h1s[tk8[ai][m]];
#pragma unroll
        for (int ai = 0; ai < 2; ++ai)
#pragma unroll
            for (int m = 0; m < 4; ++m) { if (ai == 1 && u.half) continue; bf16_t* rowp = Hid + (size_t)(row0 + ai * 128 + m * 16) * 256 + hc0;
                const float sa = sa8[ai][m]; f32x4 o[2];
#pragma unroll
                for (int n = 0; n < 2; ++n) { const f32x4 g = dq4(acc[ai][0][m][n], sa, sg[n]), up = dq4(acc[ai][1][m][n], sa, su[n]);
#pragma unroll
                    for (int j = 0; j < 4; ++j) o[n][j] = g[j] * sigm(g[j]) * up[j]; }
                *(u32x4*)rowp = pack8(o[0], o[1]); }
    }
};
struct EpiM2 {
    static constexpr bool PERM = true;
    bf16_t* Ys;
    __device__ __forceinline__ void operator()(const Acc& acc, const Unit& u, int wr, int wc, int fr, int fq) const {
        const int fr8 = fr & 7, up = fr >> 3;
        bf16_t* base = Ys + (size_t)(u.pm * 256 + wr * 64 + fr8) * 1024 + u.pn * 256 + wc * 64 + up * 32 + 8 * fq;
#pragma unroll
        for (int ai = 0; ai < 2; ++ai)
#pragma unroll
            for (int m = 0; m < 4; ++m) { if (ai == 1 && u.half) continue;
                const u32x4 w0 = pack8(acc[ai][0][m][0], acc[ai][0][m][1]), w1 = pack8(acc[ai][1][m][0], acc[ai][1][m][1]);
                const u32x4 keep = up ? w1 : w0, send = up ? w0 : w1; u32x4 recv;
                recv.x = (unsigned)__builtin_amdgcn_update_dpp(0, (int)send.x, 0x128, 0xf, 0xf, false); recv.y = (unsigned)__builtin_amdgcn_update_dpp(0, (int)send.y, 0x128, 0xf, 0xf, false);
                recv.z = (unsigned)__builtin_amdgcn_update_dpp(0, (int)send.z, 0x128, 0xf, 0xf, false); recv.w = (unsigned)__builtin_amdgcn_update_dpp(0, (int)send.w, 0x128, 0xf, 0xf, false);
                bf16_t* rp = base + (size_t)(ai * 128 + m * 16) * 1024;
                *(u32x4*)rp = up ? recv : keep;
                *(u32x4*)(rp + 8 * 1024) = up ? keep : recv; }
    }
};
}

__device__ __forceinline__ int crow(int r, int hi) { return (r & 3) + 8 * (r >> 2) + 4 * hi; }
typedef short v4i16_t __attribute__((ext_vector_type(4)));
__device__ __forceinline__ s16x4 vtr(const LAS char* p) { return __builtin_bit_cast(s16x4, __builtin_amdgcn_ds_read_tr16_b64_v4i16((LAS v4i16_t*)p)); }
template <int OFF> __device__ __forceinline__ s16x4 vtr_a(unsigned a) { s16x4 r; asm volatile("ds_read_b64_tr_b16 %0, %1 offset:%2" : "=v"(r) : "v"(a), "n"(OFF)); return r; }
#define VTR_WAIT(A, B, C, D) do { \
    asm volatile("s_waitcnt lgkmcnt(0)" : "+v"(A[0]), "+v"(A[1]), "+v"(A[2]), "+v"(A[3]), "+v"(B[0]), "+v"(B[1]), "+v"(B[2]), "+v"(B[3])); \
    asm volatile("" : "+v"(C[0]), "+v"(C[1]), "+v"(C[2]), "+v"(C[3]), "+v"(D[0]), "+v"(D[1]), "+v"(D[2]), "+v"(D[3])); } while (0)
__device__ __forceinline__ float swapmax(float m) { auto rr = __builtin_amdgcn_permlane32_swap(__float_as_uint(m), __float_as_uint(m), false, false); return fmaxf(__uint_as_float(rr[0]), __uint_as_float(rr[1])); }
__device__ __forceinline__ float swapsum(float m) { auto rr = __builtin_amdgcn_permlane32_swap(__float_as_uint(m), __float_as_uint(m), false, false); return __uint_as_float(rr[0]) + __uint_as_float(rr[1]); }

template <int DK, bool FOX>
__device__ __forceinline__ void attn_unit8(LAS char* lds, const bf16_t* Q, int ldq, const bf16_t* Kp, int ldk, const bf16_t* Vp, int ldv, bf16_t* O, int ldo,
                                           const float* cs, int b, int j, int tau_min, unsigned* qnext, unsigned& ticket, const bf16_t* K2 = nullptr) {
    constexpr int NS = DK / 16, KB = 64 * DK * 2, SB = KB + 8192 + 256;
    constexpr float THR = 8.0f;
    int tid_l = threadIdx.x; asm volatile("" : "+v"(tid_l));
    const int tid = tid_l, lane = tid & 63, r32 = lane & 31, hi = lane >> 5; const int wid = __builtin_amdgcn_readfirstlane(tid >> 6);
    const int qp0 = (j == 0) ? 0 : 16 + 256 * (j - 1) + 32 * wid;
    const int qpos = qp0 + r32;
    const size_t qrow = (j == 0) ? (size_t)(NREAL + NMETA * b + r32) : (size_t)(SEQ * b + 256 * (j - 1) + 32 * wid + r32);
    const size_t mrow0 = (size_t)(NREAL + NMETA * b), rrow0 = (size_t)SEQ * b;
    const bool wave_on = (j > 0) || (wid == 0);
    const int tdiag = wave_on ? ((j == 0) ? 0 : 4 * (j - 1) + 1 + (wid >> 1)) : -1;
    const int qin = (j == 0) ? r32 : 32 * (wid & 1) + r32;
    const int NT = 4 * j + 1;
    bf16x8 qf[NS];
#pragma unroll
    for (int s = 0; s < NS; ++s) qf[s] = *(const bf16x8*)(Q + qrow * ldq + 16 * s + 8 * hi);
    float csq = 0.f; if (FOX) csq = cs[qpos];
    const bf16_t* kg = Kp + (size_t)lane * ldk + 8 * wid;
    const bf16_t* kg2 = (DK == 96) ? K2 + (size_t)lane * 32 + 8 * (wid & 3) : Kp;
    const bf16_t* vg = Vp + (size_t)(16 * (wid & 3) + 8 * (lane >> 5) + ((lane >> 2) & 7)) * ldv + 32 * (wid >> 2) + 8 * (lane & 3);
    const int nops = 2 + ((DK == 96) ? (wid < 4 ? 1 : 0) : (FOX ? (wid == 4 ? 1 : 0) : 0));
#define ATT_ISSUE(t, slot) do { const int ts_ = ((t) == 0) ? 0 : 64 * (t) - 48; const size_t tr_ = ((t) == 0) ? mrow0 : rrow0 + 64 * ((t) - 1); LAS char* sb_ = lds + (slot) * SB; \
        __builtin_amdgcn_global_load_lds((const unsigned*)(kg + tr_ * ldk), (LAS unsigned*)(sb_ + wid * 1024), 16, 0, 0); \
        __builtin_amdgcn_global_load_lds((const unsigned*)(vg + tr_ * ldv), (LAS unsigned*)(sb_ + KB + (wid >> 2) * 4096 + (wid & 3) * 1024), 16, 0, 0); \
        if (DK == 96) { if (wid < 4) __builtin_amdgcn_global_load_lds((const unsigned*)(kg2 + tr_ * 32), (LAS unsigned*)(sb_ + (8 + wid) * 1024), 16, 0, 0); } \
        else if (FOX) { if (wid == 4) { if (lane < 16) __builtin_amdgcn_global_load_lds((const unsigned*)(cs + ts_ + 4 * lane), (LAS unsigned*)(sb_ + KB + 8192), 16, 0, 0); } } } while (0)
    int t = NT - 1;
    int slot = 0;
    ATT_ISSUE(t, 0);
    if (t - 1 >= tau_min) ATT_ISSUE(t - 1, 1);
    float mhat = 0.f, lrun = 0.f;
    f32x16 o0 = {}, o1 = {};
    const int vlane = ((lane >> 4) & 1) * 32 + (lane & 3) * 8 + (4 * hi + ((lane & 15) >> 2)) * 64;
    for (; t > tdiag && t >= tau_min; --t) {
        if (t - 1 >= tau_min) { if (nops == 3) asm volatile("s_waitcnt vmcnt(3)" ::: "memory"); else asm volatile("s_waitcnt vmcnt(2)" ::: "memory"); }
        else asm volatile("s_waitcnt vmcnt(0)" ::: "memory");
        __builtin_amdgcn_s_barrier(); asm volatile("" ::: "memory");
        { const int s2 = (slot >= 1) ? slot - 1 : 2; if (t - 2 >= tau_min) ATT_ISSUE(t - 2, s2); }
        const LAS char* cb = lds + slot * SB; (void)cb;
        slot = (slot == 2) ? 0 : slot + 1;
    }
    if (t >= tau_min) {
        if (t - 1 >= tau_min) { if (nops == 3) asm volatile("s_waitcnt vmcnt(3)" ::: "memory"); else asm volatile("s_waitcnt vmcnt(2)" ::: "memory"); }
        else asm volatile("s_waitcnt vmcnt(0)" ::: "memory");
        __builtin_amdgcn_s_barrier(); asm volatile("" ::: "memory");
        const LAS char* cb = lds + slot * SB; (void)cb;
        {
            f32x16 p0, p1;
            if (FOX) {
                const LAS float* cl = (const LAS float*)(cb + KB + 8192); const float base = csq - mhat;
#pragma unroll
                for (int g = 0; g < 4; ++g) { const f32x4 c0 = *(const LAS f32x4*)(cl + 8 * g + 4 * hi), c1 = *(const LAS f32x4*)(cl + 32 + 8 * g + 4 * hi);
#pragma unroll
                    for (int jj = 0; jj < 4; ++jj) { p0[4 * g + jj] = base - c0[jj]; p1[4 * g + jj] = base - c1[jj]; } }
            } else {
                const float nm = -mhat;
#pragma unroll
                for (int r = 0; r < 16; ++r) { p0[r] = nm; p1[r] = nm; }
            }
            bf16x8 ka[NS][2];
#pragma unroll
            for (int s = 0; s < NS; ++s) { const int c = 2 * s + hi; ka[s][0] = *(const LAS bf16x8*)(cb + c * 1024 + r32 * 16); ka[s][1] = *(const LAS bf16x8*)(cb + c * 1024 + 512 + r32 * 16); }
            __builtin_amdgcn_sched_barrier(0);
#pragma unroll
            for (int s = 0; s < NS; ++s) { p0 = __builtin_amdgcn_mfma_f32_32x32x16_bf16(ka[s][0], qf[s], p0, 0, 0, 0); p1 = __builtin_amdgcn_mfma_f32_32x32x16_bf16(ka[s][1], qf[s], p1, 0, 0, 0); }
            __builtin_amdgcn_sched_barrier(0);
            const unsigned vb = (unsigned)(size_t)(cb + KB + vlane);
            s16x4 vl0[4], vh0[4], vl1[4], vh1[4];
            vl0[0] = vtr_a<0>(vb); vh0[0] = vtr_a<512>(vb); vl1[0] = vtr_a<4096>(vb); vh1[0] = vtr_a<4608>(vb);
            vl0[1] = vtr_a<1024>(vb); vh0[1] = vtr_a<1536>(vb); vl1[1] = vtr_a<5120>(vb); vh1[1] = vtr_a<5632>(vb);
            vl0[2] = vtr_a<2048>(vb); vh0[2] = vtr_a<2560>(vb); vl1[2] = vtr_a<6144>(vb); vh1[2] = vtr_a<6656>(vb);
            vl0[3] = vtr_a<3072>(vb); vh0[3] = vtr_a<3584>(vb); vl1[3] = vtr_a<7168>(vb); vh1[3] = vtr_a<7680>(vb);
            __builtin_amdgcn_sched_barrier(0);
            if (t == tdiag) {
#pragma unroll
                for (int r = 0; r < 16; ++r) { const int kv = 4 * hi + (r & 3) + 8 * (r >> 2); if (kv > qin) p0[r] = -INFINITY; if (kv + 32 > qin) p1[r] = -INFINITY; }
            }
            if (t == 0) {
#pragma unroll
                for (int r = 0; r < 16; ++r) { const int kv = 4 * hi + (r & 3) + 8 * (r >> 2); if (kv >= 16) p0[r] = -INFINITY; p1[r] = -INFINITY; }
            }
            float mt;
            { float ma = __builtin_fmaxf(__builtin_fmaxf(p0[0], p0[1]), p1[0]), mb = __builtin_fmaxf(__builtin_fmaxf(p0[2], p0[3]), p1[1]); ma = __builtin_fmaxf(__builtin_fmaxf(ma, p1[2]), p1[3]);
#pragma unroll
              for (int r = 4; r < 16; r += 4) { ma = __builtin_fmaxf(__builtin_fmaxf(ma, p0[r]), p0[r + 1]); mb = __builtin_fmaxf(__builtin_fmaxf(mb, p0[r + 2]), p0[r + 3]); ma = __builtin_fmaxf(__builtin_fmaxf(ma, p1[r]), p1[r + 1]); mb = __builtin_fmaxf(__builtin_fmaxf(mb, p1[r + 2]), p1[r + 3]); }
              mt = __builtin_fmaxf(ma, mb); }
            mt = swapmax(mt);
            { mhat = mt;
#pragma unroll
              for (int r = 0; r < 16; ++r) { p0[r] -= mt; p1[r] -= mt; } }
#pragma unroll
            for (int r = 0; r < 16; ++r) p0[r] = __builtin_amdgcn_exp2f(p0[r]);
            bf16x8 pb[4];
#pragma unroll
            for (int s = 0; s < 2; ++s) {
                u32x4 w; w.x = pk_bf16(p0[8 * s], p0[8 * s + 1]); w.y = pk_bf16(p0[8 * s + 2], p0[8 * s + 3]); w.z = pk_bf16(p0[8 * s + 4], p0[8 * s + 5]); w.w = pk_bf16(p0[8 * s + 6], p0[8 * s + 7]);
                pb[s] = __builtin_bit_cast(bf16x8, w); }
            __builtin_amdgcn_sched_barrier(0);
            VTR_WAIT(vl0, vh0, vl1, vh1);
            __builtin_amdgcn_sched_barrier(0);
#pragma unroll
            for (int ks = 0; ks < 2; ++ks) {
                const bf16x8 a0 = (bf16x8){vl0[ks][0], vl0[ks][1], vl0[ks][2], vl0[ks][3], vh0[ks][0], vh0[ks][1], vh0[ks][2], vh0[ks][3]};
                const bf16x8 a1 = (bf16x8){vl1[ks][0], vl1[ks][1], vl1[ks][2], vl1[ks][3], vh1[ks][0], vh1[ks][1], vh1[ks][2], vh1[ks][3]};
                o0 = __builtin_amdgcn_mfma_f32_32x32x16_bf16(a0, pb[ks], o0, 0, 0, 0);
                o1 = __builtin_amdgcn_mfma_f32_32x32x16_bf16(a1, pb[ks], o1, 0, 0, 0);
            }
            __builtin_amdgcn_sched_barrier(0);
#pragma unroll
            for (int r = 0; r < 16; ++r) p1[r] = __builtin_amdgcn_exp2f(p1[r]);
            { f32x2_t sa = {p0[0], p0[1]}, sb2 = {p1[0], p1[1]};
#pragma unroll
              for (int r = 2; r < 16; r += 2) { sa += (f32x2_t){p0[r], p0[r + 1]}; sb2 += (f32x2_t){p1[r], p1[r + 1]}; }
              sa += sb2; lrun += sa[0] + sa[1]; }
#pragma unroll
            for (int s = 0; s < 2; ++s) {
                u32x4 w2; w2.x = pk_bf16(p1[8 * s], p1[8 * s + 1]); w2.y = pk_bf16(p1[8 * s + 2], p1[8 * s + 3]); w2.z = pk_bf16(p1[8 * s + 4], p1[8 * s + 5]); w2.w = pk_bf16(p1[8 * s + 6], p1[8 * s + 7]);
                pb[2 + s] = __builtin_bit_cast(bf16x8, w2); }
            __builtin_amdgcn_sched_barrier(0);
#pragma unroll
            for (int ks = 2; ks < 4; ++ks) {
                const bf16x8 a0 = (bf16x8){vl0[ks][0], vl0[ks][1], vl0[ks][2], vl0[ks][3], vh0[ks][0], vh0[ks][1], vh0[ks][2], vh0[ks][3]};
                const bf16x8 a1 = (bf16x8){vl1[ks][0], vl1[ks][1], vl1[ks][2], vl1[ks][3], vh1[ks][0], vh1[ks][1], vh1[ks][2], vh1[ks][3]};
                o0 = __builtin_amdgcn_mfma_f32_32x32x16_bf16(a0, pb[ks], o0, 0, 0, 0);
                o1 = __builtin_amdgcn_mfma_f32_32x32x16_bf16(a1, pb[ks], o1, 0, 0, 0);
            }
            __builtin_amdgcn_sched_barrier(0);
            { const int s2 = (slot >= 1) ? slot - 1 : 2; if (t - 2 >= tau_min) ATT_ISSUE(t - 2, s2); }
        }
        slot = (slot == 2) ? 0 : slot + 1;
        --t;
    }
    for (; t >= tau_min; --t) {
        if (t - 1 >= tau_min) { if (nops == 3) asm volatile("s_waitcnt vmcnt(3)" ::: "memory"); else asm volatile("s_waitcnt vmcnt(2)" ::: "memory"); }
        else asm volatile("s_waitcnt vmcnt(0)" ::: "memory");
        __builtin_amdgcn_s_barrier(); asm volatile("" ::: "memory");
        const LAS char* cb = lds + slot * SB; (void)cb;
        {
            f32x16 p0, p1;
            if (FOX) {
                const LAS float* cl = (const LAS float*)(cb + KB + 8192); const float base = csq - mhat;
#pragma unroll
                for (int g = 0; g < 4; ++g) { const f32x4 c0 = *(const LAS f32x4*)(cl + 8 * g + 4 * hi), c1 = *(const LAS f32x4*)(cl + 32 + 8 * g + 4 * hi);
#pragma unroll
                    for (int jj = 0; jj < 4; ++jj) { p0[4 * g + jj] = base - c0[jj]; p1[4 * g + jj] = base - c1[jj]; } }
            } else {
                const float nm = -mhat;
#pragma unroll
                for (int r = 0; r < 16; ++r) { p0[r] = nm; p1[r] = nm; }
            }
            bf16x8 ka[NS][2];
#pragma unroll
            for (int s = 0; s < NS; ++s) { const int c = 2 * s + hi; ka[s][0] = *(const LAS bf16x8*)(cb + c * 1024 + r32 * 16); ka[s][1] = *(const LAS bf16x8*)(cb + c * 1024 + 512 + r32 * 16); }
            __builtin_amdgcn_sched_barrier(0);
#pragma unroll
            for (int s = 0; s < NS; ++s) { p0 = __builtin_amdgcn_mfma_f32_32x32x16_bf16(ka[s][0], qf[s], p0, 0, 0, 0); p1 = __builtin_amdgcn_mfma_f32_32x32x16_bf16(ka[s][1], qf[s], p1, 0, 0, 0); }
            __builtin_amdgcn_sched_barrier(0);
            const unsigned vb = (unsigned)(size_t)(cb + KB + vlane);
            s16x4 vl0[4], vh0[4], vl1[4], vh1[4];
            vl0[0] = vtr_a<0>(vb); vh0[0] = vtr_a<512>(vb); vl1[0] = vtr_a<4096>(vb); vh1[0] = vtr_a<4608>(vb);
            vl0[1] = vtr_a<1024>(vb); vh0[1] = vtr_a<1536>(vb); vl1[1] = vtr_a<5120>(vb); vh1[1] = vtr_a<5632>(vb);
            vl0[2] = vtr_a<2048>(vb); vh0[2] = vtr_a<2560>(vb); vl1[2] = vtr_a<6144>(vb); vh1[2] = vtr_a<6656>(vb);
            vl0[3] = vtr_a<3072>(vb); vh0[3] = vtr_a<3584>(vb); vl1[3] = vtr_a<7168>(vb); vh1[3] = vtr_a<7680>(vb);
            __builtin_amdgcn_sched_barrier(0);
            if (t == tdiag) {
#pragma unroll
                for (int r = 0; r < 16; ++r) { const int kv = 4 * hi + (r & 3) + 8 * (r >> 2); if (kv > qin) p0[r] = -INFINITY; if (kv + 32 > qin) p1[r] = -INFINITY; }
            }
            if (t == 0) {
#pragma unroll
                for (int r = 0; r < 16; ++r) { const int kv = 4 * hi + (r & 3) + 8 * (r >> 2); if (kv >= 16) p0[r] = -INFINITY; p1[r] = -INFINITY; }
            }
            float mt;
            { float ma = __builtin_fmaxf(__builtin_fmaxf(p0[0], p0[1]), p1[0]), mb = __builtin_fmaxf(__builtin_fmaxf(p0[2], p0[3]), p1[1]); ma = __builtin_fmaxf(__builtin_fmaxf(ma, p1[2]), p1[3]);
#pragma unroll
              for (int r = 4; r < 16; r += 4) { ma = __builtin_fmaxf(__builtin_fmaxf(ma, p0[r]), p0[r + 1]); mb = __builtin_fmaxf(__builtin_fmaxf(mb, p0[r + 2]), p0[r + 3]); ma = __builtin_fmaxf(__builtin_fmaxf(ma, p1[r]), p1[r + 1]); mb = __builtin_fmaxf(__builtin_fmaxf(mb, p1[r + 2]), p1[r + 3]); }
              mt = __builtin_fmaxf(ma, mb); }
            mt = swapmax(mt);
            if (__any(mt > THR)) {
                const float dl = fmaxf(mt, 0.f); mhat += dl; const float f = __builtin_amdgcn_exp2f(-dl); lrun *= f;
#pragma unroll
                for (int r = 0; r < 16; ++r) { p0[r] -= dl; p1[r] -= dl; asm volatile("v_mul_f32 %0, %0, %1" : "+v"(o0[r]) : "v"(f)); asm volatile("v_mul_f32 %0, %0, %1" : "+v"(o1[r]) : "v"(f)); }
            }
#pragma unroll
            for (int r = 0; r < 16; ++r) p0[r] = __builtin_amdgcn_exp2f(p0[r]);
            bf16x8 pb[4];
#pragma unroll
            for (int s = 0; s < 2; ++s) {
                u32x4 w; w.x = pk_bf16(p0[8 * s], p0[8 * s + 1]); w.y = pk_bf16(p0[8 * s + 2], p0[8 * s + 3]); w.z = pk_bf16(p0[8 * s + 4], p0[8 * s + 5]); w.w = pk_bf16(p0[8 * s + 6], p0[8 * s + 7]);
                pb[s] = __builtin_bit_cast(bf16x8, w); }
            __builtin_amdgcn_sched_barrier(0);
            VTR_WAIT(vl0, vh0, vl1, vh1);
            __builtin_amdgcn_sched_barrier(0);
#pragma unroll
            for (int ks = 0; ks < 2; ++ks) {
                const bf16x8 a0 = (bf16x8){vl0[ks][0], vl0[ks][1], vl0[ks][2], vl0[ks][3], vh0[ks][0], vh0[ks][1], vh0[ks][2], vh0[ks][3]};
                const bf16x8 a1 = (bf16x8){vl1[ks][0], vl1[ks][1], vl1[ks][2], vl1[ks][3], vh1[ks][0], vh1[ks][1], vh1[ks][2], vh1[ks][3]};
                o0 = __builtin_amdgcn_mfma_f32_32x32x16_bf16(a0, pb[ks], o0, 0, 0, 0);
                o1 = __builtin_amdgcn_mfma_f32_32x32x16_bf16(a1, pb[ks], o1, 0, 0, 0);
            }
            __builtin_amdgcn_sched_barrier(0);
#pragma unroll
            for (int r = 0; r < 16; ++r) p1[r] = __builtin_amdgcn_exp2f(p1[r]);
            { f32x2_t sa = {p0[0], p0[1]}, sb2 = {p1[0], p1[1]};
#pragma unroll
              for (int r = 2; r < 16; r += 2) { sa += (f32x2_t){p0[r], p0[r + 1]}; sb2 += (f32x2_t){p1[r], p1[r + 1]}; }
              sa += sb2; lrun += sa[0] + sa[1]; }
#pragma unroll
            for (int s = 0; s < 2; ++s) {
                u32x4 w2; w2.x = pk_bf16(p1[8 * s], p1[8 * s + 1]); w2.y = pk_bf16(p1[8 * s + 2], p1[8 * s + 3]); w2.z = pk_bf16(p1[8 * s + 4], p1[8 * s + 5]); w2.w = pk_bf16(p1[8 * s + 6], p1[8 * s + 7]);
                pb[2 + s] = __builtin_bit_cast(bf16x8, w2); }
            __builtin_amdgcn_sched_barrier(0);
#pragma unroll
            for (int ks = 2; ks < 4; ++ks) {
                const bf16x8 a0 = (bf16x8){vl0[ks][0], vl0[ks][1], vl0[ks][2], vl0[ks][3], vh0[ks][0], vh0[ks][1], vh0[ks][2], vh0[ks][3]};
                const bf16x8 a1 = (bf16x8){vl1[ks][0], vl1[ks][1], vl1[ks][2], vl1[ks][3], vh1[ks][0], vh1[ks][1], vh1[ks][2], vh1[ks][3]};
                o0 = __builtin_amdgcn_mfma_f32_32x32x16_bf16(a0, pb[ks], o0, 0, 0, 0);
                o1 = __builtin_amdgcn_mfma_f32_32x32x16_bf16(a1, pb[ks], o1, 0, 0, 0);
            }
            __builtin_amdgcn_sched_barrier(0);
            { const int s2 = (slot >= 1) ? slot - 1 : 2; if (t - 2 >= tau_min) ATT_ISSUE(t - 2, s2); }
        }
        slot = (slot == 2) ? 0 : slot + 1;
    }
#undef ATT_ISSUE
    if (threadIdx.x == 0) ticket = __hip_atomic_fetch_add(qnext, 1u, RLX_AGENT);
    if (wave_on) {
        const float lt = swapsum(lrun);
        const float inv = 1.0f / lt;
        if (j > 0 || r32 < 16) {
            bf16_t* op = O + qrow * ldo;
#pragma unroll
            for (int g = 0; g < 4; ++g) {
                u32x2 w0, w1;
                w0.x = pk_bf16(o0[4 * g] * inv, o0[4 * g + 1] * inv); w0.y = pk_bf16(o0[4 * g + 2] * inv, o0[4 * g + 3] * inv);
                w1.x = pk_bf16(o1[4 * g] * inv, o1[4 * g + 1] * inv); w1.y = pk_bf16(o1[4 * g + 2] * inv, o1[4 * g + 3] * inv);
                *(u32x2*)(op + 8 * g + 4 * hi) = w0; *(u32x2*)(op + 32 + 8 * g + 4 * hi) = w1;
            }
        }
    }
    asm volatile("s_waitcnt lgkmcnt(0)" ::: "memory");
    __builtin_amdgcn_s_barrier(); asm volatile("" ::: "memory");
}

struct Args { const float* in[22]; float* out; unsigned char* ws; };
struct Frame {
    LAS unsigned char* lds; volatile LAS unsigned* MISC; unsigned* ctl;
    int tid, lane, wave, vcu, G;
};

template <int QM>
__device__ __forceinline__ void tr_item(const float* colp, int ld, const float* kscale, void* dstv, int K, int n0, int k0, LAS float* scr, int lane, unsigned* cmax) {
    float am = 0.f;
#pragma unroll
    for (int i = 0; i < 32; ++i) { const int kk = 2 * i + (lane >> 5); float v = colp ? colp[(size_t)(k0 + kk) * ld] : 0.f; if (kscale) v *= kscale[k0 + kk];
        if (QM == 1) am = fmaxf(am, fabsf(v)); else scr[kk * 33 + (lane & 31)] = v; }
    if (QM == 1) { am = fmaxf(am, __shfl_xor(am, 32)); if (lane < 32) __hip_atomic_fetch_max(cmax + n0 + lane, __float_as_uint(am), RLX_AGENT); return; }
    LDS_WAIT(); asm volatile("" ::: "memory");
    const int c = lane & 7;
#pragma unroll
    for (int j = 0; j < 4; ++j) { const int n = (lane >> 3) + 8 * j; const LAS float* s = scr + (8 * c) * 33 + n;
        if (QM == 0) { bf16_t* dst = (bf16_t*)dstv;
            u32x4 o; o.x = pk_bf16(s[0 * 33], s[1 * 33]); o.y = pk_bf16(s[2 * 33], s[3 * 33]); o.z = pk_bf16(s[4 * 33], s[5 * 33]); o.w = pk_bf16(s[6 * 33], s[7 * 33]);
            *(u32x4*)(dst + (size_t)(n0 + n) * K + k0 + 8 * c) = o; }
        else { unsigned char* dst = (unsigned char*)dstv; const float cm = __uint_as_float(cmax[n0 + n]); const float inv = cm > 0.f ? 127.0f / cm : 0.f;
            unsigned q[8];
#pragma unroll
            for (int i = 0; i < 8; ++i) q[i] = (unsigned)(int)rintf(s[i * 33] * inv) & 255u;
            u32x2 o; o.x = q[0] | (q[1] << 8) | (q[2] << 16) | (q[3] << 24); o.y = q[4] | (q[5] << 8) | (q[6] << 16) | (q[7] << 24);
            *(u32x2*)(dst + (size_t)(n0 + n) * K + k0 + 8 * c) = o; } }
    LDS_WAIT(); asm volatile("" ::: "memory");
}
__device__ __forceinline__ void quant_strip(const float* colp, bool valid, int ld, unsigned char* dst, int n0, LAS float* scr, LAS float* part, unsigned* cm_out, int wave, int lane) {
    float v[2][32]; float am = 0.f;
    { const float* pp = colp + (size_t)(wave * 128 + (lane >> 5)) * ld; const size_t st2 = (size_t)2 * ld;
#pragma unroll
      for (int sidx = 0; sidx < 2; ++sidx)
#pragma unroll
        for (int i = 0; i < 32; ++i) { v[sidx][i] = *pp; pp += st2; asm volatile("" : "+v"(pp)); } }
    if (!valid) {
#pragma unroll
      for (int sidx = 0; sidx < 2; ++sidx)
#pragma unroll
        for (int i = 0; i < 32; ++i) v[sidx][i] = 0.f; }
#pragma unroll
    for (int sidx = 0; sidx < 2; ++sidx)
#pragma unroll
        for (int i = 0; i < 32; ++i) am = fmaxf(am, fabsf(v[sidx][i]));
    am = fmaxf(am, __shfl_xor(am, 32));
    if (lane < 32) part[wave * 32 + lane] = am;
    __syncthreads();
    float cmx = part[lane & 31];
#pragma unroll
    for (int w = 1; w < 8; ++w) cmx = fmaxf(cmx, part[w * 32 + (lane & 31)]);
    if (wave == 0 && lane < 32) cm_out[n0 + lane] = __float_as_uint(cmx);
    float inv4[4];
#pragma unroll
    for (int j = 0; j < 4; ++j) { const float c = __shfl(cmx, (lane >> 3) + 8 * j); inv4[j] = c > 0.f ? 127.0f / c : 0.f; }
    const int c = lane & 7;
#pragma unroll
    for (int sidx = 0; sidx < 2; ++sidx) {
#pragma unroll
        for (int i = 0; i < 32; ++i) scr[(2 * i + (lane >> 5)) * 33 + (lane & 31)] = v[sidx][i];
        LDS_WAIT(); asm volatile("" ::: "memory");
#pragma unroll
        for (int j = 0; j < 4; ++j) { const int n = (lane >> 3) + 8 * j; const LAS float* sp = scr + (8 * c) * 33 + n;
            unsigned q[8];
#pragma unroll
            for (int i = 0; i < 8; ++i) q[i] = (unsigned)(int)rintf(sp[i * 33] * inv4[j]) & 255u;
            u32x2 o; o.x = q[0] | (q[1] << 8) | (q[2] << 16) | (q[3] << 24); o.y = q[4] | (q[5] << 8) | (q[6] << 16) | (q[7] << 24);
            *(u32x2*)(dst + (size_t)(n0 + n) * 1024 + wave * 128 + sidx * 64 + 8 * c) = o; }
        LDS_WAIT(); asm volatile("" ::: "memory");
    }
    __syncthreads();
}
constexpr int STRIPS_PER_LAYER = 392;
__device__ __forceinline__ void strip_item(const Args& a, bf16_t* W, unsigned* cm, int l, int sidx, LAS float* scr, LAS float* part, int wave, int lane) {
    const int w = lane & 31;
    if (sidx < 72) { const int nb = sidx, n = nb * 32 + w; int col;
        if (n < 1536) col = n; else { const int j = n - 1536; col = j < 384 ? 1544 + j : j < 640 ? 1928 + (j - 384) : j < 672 ? 2184 + (16 * (((j - 640) >> 2) & 1) + 4 * ((j - 640) >> 3) + ((j - 640) & 3)) : j < 680 ? 1536 + (j - 672) : -1; }
        const float* src = a.in[4] + (size_t)l * 1024 * 4264;
        quant_strip(src + (col >= 0 ? col : 0), col >= 0, 4264, (unsigned char*)(W + W_BT1), nb * 32, scr, part, cm, wave, lane); return; }
    sidx -= 72;
    if (sidx < 64) { const int nb = sidx, n = (nb >> 3) * 256 + 64 * (nb & 3) + 16 * (w >> 3) + 8 * ((nb >> 2) & 1) + (w & 7); const float* src = a.in[4] + (size_t)l * 1024 * 4264;
        quant_strip(src + 2216 + n, true, 4264, (unsigned char*)(W + W_BT1), 2304 + nb * 32, scr, part, cm, wave, lane); return; }
    sidx -= 64;
    { const int e = sidx >> 4, nb = sidx & 15;
      const float* src = (((nb >> 2) & 1) ? a.in[18] : a.in[17]) + ((size_t)(l * 16 + e) * 1024) * 256 + (nb >> 3) * 128 + 32 * (nb & 3) + w;
      quant_strip(src, true, 256, (unsigned char*)(W + W_MOE1) + (size_t)e * 512 * 1024, nb * 32, scr, part, cm + 4608 + e * 512, wave, lane); }
}
constexpr int ITEMS_PER_LAYER = 3344;
__device__ __forceinline__ void convert_item(const Args& a, bf16_t* W, int l, int r, LAS float* scr, int lane) {
    const int w = lane & 31; (void)w;
    if (r < 1296) {
    if (r < 256) { const int kb = r / 32, nb = r % 32, n = (nb >> 3) * 256 + 64 * (nb & 3) + 32 * ((nb >> 2) & 1) + w; tr_item<0>(a.in[6] + (size_t)l * 512 * 1024 + n, 1024, nullptr, W + W_FOXO, 1024, nb * 32, kb * 64, scr, lane, nullptr); return; }
    r -= 256;
    if (r < 256) { const int kb = r / 32, nb = r % 32, n = (nb >> 3) * 256 + 64 * (nb & 3) + 32 * ((nb >> 2) & 1) + w; tr_item<0>(a.in[11] + (size_t)l * 512 * 1024 + n, 1024, nullptr, W + W_FOXO + 512, 1024, nb * 32, kb * 64, scr, lane, nullptr); return; }
    r -= 256;
    if (r < 144) { const int kb = r / 24, nb = r % 24, n = nb * 32 + w; tr_item<0>(a.in[8] + (size_t)l * 384 * 768 + n, 768, a.in[7] + l * 384, W + W_UQ, 384, nb * 32, kb * 64, scr, lane, nullptr); return; }
    r -= 144;
    if (r < 128) { const int kb = r / 32, nb = r % 32, n = nb * 32 + w; const int col = n < 512 ? (n >> 6) * 128 + (n & 63) : ((n - 512) >> 6) * 128 + 64 + (n & 63);
        tr_item<0>(a.in[10] + (size_t)l * 256 * 1024 + col, 1024, a.in[9] + l * 256, W + W_UKV, 256, nb * 32, kb * 64, scr, lane, nullptr); return; }
    r -= 128;
    { const int kb = r / 32, nb = r % 32, n = (nb >> 3) * 256 + 64 * (nb & 3) + 32 * ((nb >> 2) & 1) + w; tr_item<0>(a.in[12] + (size_t)l * 1024 * 1024 + n, 1024, nullptr, W + W_OUT, 1024, nb * 32, kb * 64, scr, lane, nullptr); return; } }
    r -= 1296;
    { const int e = r / 128, rr = r % 128, kb = rr / 32, nb = rr % 32, n = (nb >> 3) * 256 + 64 * (nb & 3) + 32 * ((nb >> 2) & 1) + w;
        tr_item<0>(a.in[19] + ((size_t)(l * 16 + e) * 256) * 1024 + n, 1024, nullptr, W + W_MOE2 + (size_t)e * 1024 * 256, 256, nb * 32, kb * 64, scr, lane, nullptr); }
}

template <int R>
__device__ __forceinline__ void quant_rows(const f32x4 (&v)[R][4], unsigned char* const (&qrow)[R], float* const (&srow)[R], int lane) {
    float am[R];
#pragma unroll
    for (int k = 0; k < R; ++k) { am[k] = 0.f;
#pragma unroll
        for (int j = 0; j < 4; ++j) am[k] = fmaxf(am[k], fmaxf(fmaxf(fabsf(v[k][j][0]), fabsf(v[k][j][1])), fmaxf(fabsf(v[k][j][2]), fabsf(v[k][j][3])))); }
#pragma unroll
    for (int o = 1; o < 64; o <<= 1) {
#pragma unroll
        for (int k = 0; k < R; ++k) am[k] = fmaxf(am[k], __shfl_xor(am[k], o)); }
#pragma unroll
    for (int k = 0; k < R; ++k) { if (!qrow[k]) continue; const float inv = am[k] > 0.f ? 127.0f / am[k] : 0.f;
#pragma unroll
        for (int j = 0; j < 4; ++j) { const unsigned q = ((unsigned)(int)rintf(v[k][j][0] * inv) & 255u) | (((unsigned)(int)rintf(v[k][j][1] * inv) & 255u) << 8) | (((unsigned)(int)rintf(v[k][j][2] * inv) & 255u) << 16) | (((unsigned)(int)rintf(v[k][j][3] * inv) & 255u) << 24);
            *(unsigned*)(qrow[k] + 4 * lane + 256 * j) = q; }
        if (lane == 0) *srow[k] = am[k] * (1.0f / 127.0f); }
}

__device__ __forceinline__ void ln16(f32x4 (&v)[4], const float* g, const float* bta, int lane) {
    float s = 0.f;
#pragma unroll
    for (int j = 0; j < 4; ++j) s += (v[j][0] + v[j][1]) + (v[j][2] + v[j][3]);
    const float mean = wave_sum(s) * (1.f / DM); float s2 = 0.f;
#pragma unroll
    for (int j = 0; j < 4; ++j) { v[j] = v[j] - mean; s2 += (v[j][0] * v[j][0] + v[j][1] * v[j][1]) + (v[j][2] * v[j][2] + v[j][3] * v[j][3]); }
    const float rstd = 1.0f / sqrtf(wave_sum(s2) * (1.f / DM) + 1e-5f);
#pragma unroll
    for (int j = 0; j < 4; ++j) { const f32x4 gg = *(const f32x4*)(g + 4 * lane + 256 * j), bb = *(const f32x4*)(bta + 4 * lane + 256 * j); v[j] = v[j] * rstd * gg + bb; }
}
template <int R>
__device__ __forceinline__ void ln16xR(f32x4 (&v)[R][4], const float* g, const float* bta, int lane) {
    float s[R];
#pragma unroll
    for (int k = 0; k < R; ++k) { s[k] = 0.f;
#pragma unroll
        for (int j = 0; j < 4; ++j) s[k] += (v[k][j][0] + v[k][j][1]) + (v[k][j][2] + v[k][j][3]); }
#pragma unroll
    for (int o = 1; o < 64; o <<= 1) {
#pragma unroll
        for (int k = 0; k < R; ++k) s[k] += __shfl_xor(s[k], o); }
    float s2[R];
#pragma unroll
    for (int k = 0; k < R; ++k) { const float mean = s[k] * (1.f / DM); s2[k] = 0.f;
#pragma unroll
        for (int j = 0; j < 4; ++j) { v[k][j] = v[k][j] - mean; s2[k] += (v[k][j][0] * v[k][j][0] + v[k][j][1] * v[k][j][1]) + (v[k][j][2] * v[k][j][2] + v[k][j][3] * v[k][j][3]); } }
#pragma unroll
    for (int o = 1; o < 64; o <<= 1) {
#pragma unroll
        for (int k = 0; k < R; ++k) s2[k] += __shfl_xor(s2[k], o); }
#pragma unroll
    for (int j = 0; j < 4; ++j) { const f32x4 gg = *(const f32x4*)(g + 4 * lane + 256 * j), bb = *(const f32x4*)(bta + 4 * lane + 256 * j);
#pragma unroll
        for (int k = 0; k < R; ++k) { const float rstd = 1.0f / sqrtf(s2[k] * (1.f / DM) + 1e-5f); v[k][j] = v[k][j] * rstd * gg + bb; } }
}
__device__ __forceinline__ void store_row_bf16(bf16_t* orow, const f32x4 (&v)[4], int lane) {
#pragma unroll
    for (int j = 0; j < 4; ++j) { u32x2 w; w.x = pk_bf16(v[j][0], v[j][1]); w.y = pk_bf16(v[j][2], v[j][3]); *(u32x2*)(orow + 4 * lane + 256 * j) = w; }
}

__device__ const double ROPE_INV_REV[16] = {0.15915494309189535, 0.08949940160889101, 0.050329212104487035, 0.0283021958306234, 0.015915494309189534, 0.008949940160889102,
    0.005032921210448704, 0.00283021958306234, 0.0015915494309189536, 0.0008949940160889102, 0.0005032921210448703, 0.00028302195830623395, 0.00015915494309189535,
    8.949940160889102e-05, 5.0329212104487035e-05, 2.8302195830623396e-05};

#define PHASE_IDS int tid = threadIdx.x; asm volatile("" : "+v"(tid)); const int lane = tid & 63; const int wave = __builtin_amdgcn_readfirstlane(tid >> 6); const int gw = F.vcu * 8 + wave; (void)lane; (void)gw;

#define PHASE_PTRS unsigned long long wsi_ = (unsigned long long)args.ws; asm volatile("" : "+s"(wsi_)); unsigned char* wsl = (unsigned char*)(__attribute__((address_space(1))) unsigned char*)wsi_;     \
    float* ropeC = (float*)(wsl + WS_ROPE); float* ropeS = ropeC + LSEQ * 16; float* LFp = (float*)(wsl + WS_LF); float* CSp = (float*)(wsl + WS_CS); \
    unsigned* TOK = (unsigned*)(wsl + WS_TOK); int* LIST = (int*)(wsl + WS_LIST); bf16_t* Wall = (bf16_t*)(wsl + WS_W); bf16_t* HB = (bf16_t*)(wsl + WS_H); unsigned char* X = wsl + WS_X; \
    bf16_t *Qf = (bf16_t*)(X + X_QF), *Kf = (bf16_t*)(X + X_KF), *Vf = (bf16_t*)(X + X_VF), *RAW = (bf16_t*)(X + X_RAW), *Qm = (bf16_t*)(X + X_QM), *Km = (bf16_t*)(X + X_KM), \
           *Vm = (bf16_t*)(X + X_VM), *Om = (bf16_t*)(X + X_OM), *Of = (bf16_t*)(X + X_OF), *GATES = (bf16_t*)(X + X_GATES), *MERGED = (bf16_t*)(X + X_MERGED), *H1 = (bf16_t*)(X + X_H1), \
           *HID = (bf16_t*)(X + X_HID), *YS = (bf16_t*)(X + X_YS); bf16_t* Zb = (bf16_t*)(X + X_Z); unsigned* ctl = (unsigned*)(wsl + WS_CTL); \
    (void)ropeC; (void)ropeS; (void)LFp; (void)CSp; (void)TOK; (void)LIST; (void)Wall; (void)HB; (void)Qf; (void)Kf; (void)Vf; (void)RAW; (void)Qm; (void)Km; (void)Vm; (void)Om; (void)Of; (void)GATES; (void)MERGED; (void)H1; (void)HID; (void)YS; (void)Zb; (void)ctl;


template <int L>
__device__ __forceinline__ void run_layer(const Args& args, const Frame& F, const XcdBarrier& bar, const int NGW) {
    constexpr int l = L;
        for (int rep_ = 0; rep_ < REP_A; ++rep_) {
        {
            PHASE_PTRS const bf16_t* W = Wall + (size_t)l * W_LAYER;
            pg8::SchedStatic S{(const char*)(X + X_HBQ), (const char*)(W + W_BT1), NPANEL, 17, F.G, (int)blockIdx.x, (size_t)256 * DM, (size_t)256 * DM, 1};
            pg8::EpiA E{pg8::EpiA1{Qf, Kf, Vf, RAW, LFp, args.in[5] + l * 8, (float*)(wsl + WS_QKN), (float*)(wsl + WS_SSQ), (bf16_t*)(wsl + WS_KR), ropeC, ropeS, (const float*)(wsl + WS_HBS), ctl + CW_CMAX + 16384 * l}, pg8::EpiA2{(unsigned char*)args.out, (unsigned char*)(wsl + WS_GALT), (const float*)(wsl + WS_HBS), ctl + CW_CMAX + 16384 * l}};
            pg8::gemm_phase<pg8::EpiA, pg8::SchedStatic, false, false, true>(F.lds, 512, 512, 512, S, E);
        }
        xcd_barrier(bar);
        }
        {
            PHASE_IDS
            PHASE_PTRS
            if (blockIdx.x < 64) {
                const int bb = blockIdx.x >> 3, hh = blockIdx.x & 7;
                float v[9];
#pragma unroll
                for (int k = 0; k < 9; ++k) { const int p = 9 * tid + k; v[k] = p < LSEQ ? LFp[(size_t)row_of(bb, p) * 8 + hh] : 0.f; }
#pragma unroll
                for (int k = 1; k < 9; ++k) v[k] += v[k - 1];
                float x = v[8];
#pragma unroll
                for (int d = 1; d < 64; d <<= 1) { const float y = __shfl_up(x, d); if (lane >= d) x += y; }
                LAS float* wt = (LAS float*)(F.lds + 1024);
                if (lane == 63) wt[wave] = x;
                __syncthreads();
                float off = x - v[8];
                for (int w2 = 0; w2 < wave; ++w2) off += wt[w2];
#pragma unroll
                for (int k = 0; k < 9; ++k) { const int p = 9 * tid + k; if (p < CSP) CSp[(size_t)blockIdx.x * CSP + p] = (v[k] + off) * LOG2E; }
                __syncthreads();
                {
                    const float* qkn = (const float*)(wsl + WS_QKN); float mq = 0.f, mk = 0.f;
#pragma unroll
                    for (int k = 0; k < 9; ++k) { const int p = 9 * tid + k; if (p < LSEQ) { const float* r_ = qkn + (size_t)row_of(bb, p) * 32 + 2 * hh;
                        mq = fmaxf(mq, r_[0] + r_[1]); mk = fmaxf(mk, r_[16] + r_[17]); } }
#pragma unroll
                    for (int o = 1; o < 64; o <<= 1) { mq = fmaxf(mq, __shfl_xor(mq, o)); mk = fmaxf(mk, __shfl_xor(mk, o)); }
                    LAS float* wq = (LAS float*)(F.lds + 2048);
                    if (lane == 0) { wq[2 * wave] = mq; wq[2 * wave + 1] = mk; }
                    __syncthreads();
                    if (tid == 0) { float a = 0.f, c = 0.f; for (int w2 = 0; w2 < 8; ++w2) { a = fmaxf(a, wq[2 * w2]); c = fmaxf(c, wq[2 * w2 + 1]); }
                        ctl[CW_QKMAX + 128 * l + blockIdx.x * 2] = __float_as_uint(a); ctl[CW_QKMAX + 128 * l + blockIdx.x * 2 + 1] = __float_as_uint(c); }
                }
            }
        }
        xcd_barrier(bar);
        for (int rep_ = 0; rep_ < REP_C; ++rep_) {
        {
            PHASE_IDS
            PHASE_PTRS const bf16_t* W = Wall + (size_t)l * W_LAYER;
            pg8::SchedStatic S{(const char*)RAW, (const char*)(W + W_UQ), NPANEL, 3, F.G, (int)blockIdx.x, (size_t)256 * 768 * 2, (size_t)256 * 384 * 2, 1};
            pg8::EpiQup E{Qm, ropeC, ropeS, (const float*)(wsl + WS_SSQ)};
            pg8::gemm_phase<pg8::EpiQup, pg8::SchedStatic, false>(F.lds, 384, 768, 384, S, E);
        }
        {
            PHASE_PTRS const bf16_t* W = Wall + (size_t)l * W_LAYER;
            pg8::SchedStatic S{(const char*)(RAW + 384), (const char*)(W + W_UKV), NPANEL, 4, F.G, (int)blockIdx.x, (size_t)256 * 768 * 2, (size_t)256 * 256 * 2, 1};
            pg8::EpiKV E{Km, Vm, (const float*)(wsl + WS_SSQ)};
            pg8::gemm_phase<pg8::EpiKV, pg8::SchedStatic, false>(F.lds, 256, 768, 256, S, E);
        }
        {
            PHASE_IDS
            PHASE_PTRS
            const int myx = (int)(xb_xcc_id() & 7u);
            for (int rep_ = 0; rep_ < REP_FOX; ++rep_)
            for (int xo = 0; xo < 8; ++xo) { const int x = (myx + xo) & 7; unsigned* qc = ctl + CW_QCTR + 64 * ((rep_ * 4 + l * 2 + 1) * 8 + x);
                unsigned ticket = 0u; bool have_ticket = false;
                for (;;) {
                    if (tid == 0) F.MISC[4] = have_ticket ? ticket : __hip_atomic_fetch_add(qc, 1u, RLX_AGENT);
                    __syncthreads();
                    const int id = (int)F.MISC[4];
                    __syncthreads();
                    if (id >= 136) break;
                    have_ticket = true;
                    const int g = id / 34, i = id % 34, j = 16 - (i >> 1), h = 2 * g + (i & 1), b = x;
                    int tmin = 0;
                    if (j > 0) {
                        const float* csr = CSp + (size_t)(b * 8 + h) * CSP;
                        const float q2 = __uint_as_float(__hip_atomic_load(ctl + CW_QKMAX + 128 * l + (b * 8 + h) * 2, RLX_AGENT)), k2 = __uint_as_float(__hip_atomic_load(ctl + CW_QKMAX + 128 * l + (b * 8 + h) * 2 + 1, RLX_AGENT));
                        const float qk = 2.0f * sqrtf(q2 * k2) * 1.0001f + 0.01f;
                        const float cq = csr[16 + 256 * (j - 1)];
                        const float ck = csr[lane == 0 ? 15 : 64 * lane + 15];
                        const bool ok = (qk + cq - ck) >= -64.0f;
                        const unsigned long long m = __ballot(ok);
                        tmin = m ? (int)__builtin_ctzll(m) : 64;
                        const int tfirst = 4 * (j - 1) + 1; tmin = tmin < tfirst ? tmin : tfirst;
                    }
                    tmin = __builtin_amdgcn_readfirstlane(tmin);
                    attn_unit8<64, true>((LAS char*)F.lds, Qf + 64 * h, 512, Kf + 64 * h, 512, Vf + 64 * h, 512, Om + 64 * h, 1024, CSp + (size_t)(b * 8 + h) * CSP, b, j, tmin, qc, ticket);
                } }
        }
        xcd_barrier(bar);
        }
        {
            PHASE_IDS
            PHASE_PTRS
            const int myx = (int)(xb_xcc_id() & 7u);
            for (int rep_ = 0; rep_ < REP_MLA; ++rep_)
            for (int xo = 0; xo < 8; ++xo) { const int x = (myx + xo) & 7; unsigned* qc = ctl + CW_QCTR + 64 * ((rep_ * 4 + l * 2) * 8 + x);
                unsigned ticket = 0u; bool have_ticket = false;
                for (;;) {
                    if (tid == 0) F.MISC[4] = have_ticket ? ticket : __hip_atomic_fetch_add(qc, 1u, RLX_AGENT);
                    __syncthreads();
                    const int id = (int)F.MISC[4];
                    __syncthreads();
                    if (id >= 136) break;
                    have_ticket = true;
                    const int g = id / 34, i = id % 34, j = 16 - (i >> 1), h = 2 * g + (i & 1), b = x;
                    attn_unit8<96, false>((LAS char*)F.lds, Qm + 96 * h, 768, Km + 96 * h, 768, Vm + 64 * h, 512, Om + 512 + 64 * h, 1024, nullptr, b, j, 0, qc, ticket, (const bf16_t*)(wsl + WS_KR));
                } }
        }
        xcd_barrier(bar);
        for (int rep_ = 0; rep_ < REP_E; ++rep_) {
        {
            PHASE_PTRS const bf16_t* W = Wall + (size_t)l * W_LAYER;
            pg8::SchedStatic S{(const char*)Om, (const char*)(W + W_FOXO), (l == 0) ? NPANEL : NPANEL - 1, 4, F.G, (int)blockIdx.x, (size_t)256 * DM * 2, (size_t)256 * DM * 2, (l == 0) ? 1 : 0};
            pg8::EpiOut E{(const unsigned char*)args.out, (const unsigned char*)(wsl + WS_GALT), MERGED};
            pg8::gemm_phase<pg8::EpiOut, pg8::SchedStatic, false, true>(F.lds, 1024, 1024, 1024, S, E);
        }
        xcd_barrier(bar);
        }
        for (int rep_ = 0; rep_ < REP_F; ++rep_) {
        {
            PHASE_PTRS const bf16_t* W = Wall + (size_t)l * W_LAYER;
            pg8::SchedStatic S{(const char*)MERGED, (const char*)(W + W_OUT), (l == 0) ? NPANEL : NPANEL - 1, 4, F.G, (int)blockIdx.x, (size_t)256 * DM * 2, (size_t)256 * DM * 2, (l == 0) ? 1 : 0};
            pg8::EpiF E{HB, Zb};
            pg8::gemm_phase<pg8::EpiF, pg8::SchedStatic, false>(F.lds, 1024, 1024, 1024, S, E);
        }
        xcd_barrier(bar);
        }
        {
            PHASE_IDS
            PHASE_PTRS
            LAS float* rwT = (LAS float*)F.lds;
            LAS int* lcnt = (LAS int*)(F.lds + 65536);
            LAS int* gbase = lcnt + 16;
            LAS int* tE = lcnt + 64;
            LAS int* tP = tE + 384;
            LAS float* tG = (LAS float*)(tP + 384);
            { const f32x4* RWT4 = (const f32x4*)(wsl + WS_RWT); LAS f32x4* d4 = (LAS f32x4*)rwT;
#pragma unroll
              for (int i = 0; i < 8; ++i) d4[tid + 512 * i] = RWT4[tid + 512 * i]; }
            LAS float* lgb = (LAS float*)(F.lds + 65536 + 8192) + wave * 64;
            if (tid < 16) lcnt[tid] = 0;
            __syncthreads();
            const int TG = (l == 0) ? T : NREAL;
            const int rpw = (TG + F.G - 1) / F.G;
            const int r0 = blockIdx.x * rpw, nrows = (r0 + rpw <= TG) ? rpw : (TG > r0 ? TG - r0 : 0);
            const float* rb = args.in[16];
            for (int g4 = wave * 4; g4 < nrows; g4 += 32) {
                f32x4 v[4][4];
#pragma unroll
                for (int k = 0; k < 4; ++k) { const int lr = (g4 + k < nrows) ? g4 + k : nrows - 1; const int row = r0 + lr;
#pragma unroll
                    for (int j = 0; j < 4; ++j) { const u32x2 zv = *(const u32x2*)(Zb + (size_t)row * DM + 4 * lane + 256 * j); v[k][j] = (f32x4){bf_lo(zv.x), bf_hi(zv.x), bf_lo(zv.y), bf_hi(zv.y)}; } }
                ln16xR<4>(v, args.in[13] + l * DM, args.in[14] + l * DM, lane);
#pragma unroll
                for (int k = 0; k < 4; ++k) if (g4 + k < nrows) store_row_bf16(H1 + (size_t)(r0 + g4 + k) * DM, v[k], lane);
                { unsigned char* qr[4]; float* sr[4];
#pragma unroll
                  for (int k = 0; k < 4; ++k) { const bool ok = g4 + k < nrows; qr[k] = ok ? X + X_H1Q + (size_t)(r0 + g4 + k) * DM : nullptr; sr[k] = (float*)(wsl + WS_H1S) + (ok ? r0 + g4 + k : 0); }
                  unsigned char* const qc[4] = {qr[0], qr[1], qr[2], qr[3]}; float* const sc4[4] = {sr[0], sr[1], sr[2], sr[3]};
                  quant_rows<4>(v, qc, sc4, lane); }
                float s[4][16];
#pragma unroll
                for (int e = 0; e < 16; ++e) {
                    f32x4 wv[4];
#pragma unroll
                    for (int j = 0; j < 4; ++j) wv[j] = *(const LAS f32x4*)(rwT + e * 1024 + 4 * lane + 256 * j);
#pragma unroll
                    for (int k = 0; k < 4; ++k) { float a = 0.f;
#pragma unroll
                        for (int j = 0; j < 4; ++j) a += (v[k][j][0] * wv[j][0] + v[k][j][1] * wv[j][1]) + (v[k][j][2] * wv[j][2] + v[k][j][3] * wv[j][3]);
                        s[k][e] = a; }
                }
#pragma unroll
                for (int k = 0; k < 4; ++k) {
#pragma unroll
                    for (int i = 0; i < 8; ++i) { const bool up = (lane & 32) != 0; const float mine = up ? s[k][i + 8] : s[k][i], oth = up ? s[k][i] : s[k][i + 8]; s[k][i] = mine + __shfl_xor(oth, 32); }
#pragma unroll
                    for (int i = 0; i < 4; ++i) { const bool up = (lane & 16) != 0; const float mine = up ? s[k][i + 4] : s[k][i], oth = up ? s[k][i] : s[k][i + 4]; s[k][i] = mine + __shfl_xor(oth, 16); }
#pragma unroll
                    for (int i = 0; i < 2; ++i) { const bool up = (lane & 8) != 0; const float mine = up ? s[k][i + 2] : s[k][i], oth = up ? s[k][i] : s[k][i + 2]; s[k][i] = mine + __shfl_xor(oth, 8); }
                    { const bool up = (lane & 4) != 0; const float mine = up ? s[k][1] : s[k][0], oth = up ? s[k][0] : s[k][1]; s[k][0] = mine + __shfl_xor(oth, 4); }
                    s[k][0] += __shfl_xor(s[k][0], 2); s[k][0] += __shfl_xor(s[k][0], 1);
                }
                if ((lane & 3) == 0) {
#pragma unroll
                    for (int k = 0; k < 4; ++k) lgb[k * 16 + (lane >> 2)] = s[k][0]; }
                LDS_WAIT();
                {
                    const int k = lane & 3;
                    float lg[16];
#pragma unroll
                    for (int q4 = 0; q4 < 4; ++q4) { const f32x4 t4 = *(const LAS f32x4*)(lgb + k * 16 + 4 * q4); lg[4 * q4] = t4[0]; lg[4 * q4 + 1] = t4[1]; lg[4 * q4 + 2] = t4[2]; lg[4 * q4 + 3] = t4[3]; }
                    float sc[16], bi[16];
#pragma unroll
                    for (int e = 0; e < 16; ++e) { sc[e] = __builtin_amdgcn_rcpf(1.0f + __builtin_amdgcn_exp2f(-LOG2E * lg[e])); bi[e] = sc[e] + rb[e]; }
                    int gsel = 0; float gbest = -INFINITY;
#pragma unroll
                    for (int g = 0; g < 4; ++g) { float m1 = bi[4 * g], m2 = -INFINITY;
#pragma unroll
                        for (int kk = 1; kk < 4; ++kk) { const float x = bi[4 * g + kk]; if (x > m1) { m2 = m1; m1 = x; } else if (x > m2) m2 = x; }
                        const float gs = m1 + m2; if (gs > gbest) { gbest = gs; gsel = g; } }
                    float b4[4], s4[4];
#pragma unroll
                    for (int kk = 0; kk < 4; ++kk) { b4[kk] = gsel == 0 ? bi[kk] : gsel == 1 ? bi[4 + kk] : gsel == 2 ? bi[8 + kk] : bi[12 + kk]; s4[kk] = gsel == 0 ? sc[kk] : gsel == 1 ? sc[4 + kk] : gsel == 2 ? sc[8 + kk] : sc[12 + kk]; }
                    int i1 = 0; float bb1 = b4[0], ss1 = s4[0];
#pragma unroll
                    for (int kk = 1; kk < 4; ++kk) if (b4[kk] > bb1) { bb1 = b4[kk]; ss1 = s4[kk]; i1 = kk; }
                    int i2 = -1; float bb2 = -INFINITY, ss2 = 0.f;
#pragma unroll
                    for (int kk = 0; kk < 4; ++kk) if (kk != i1 && b4[kk] > bb2) { bb2 = b4[kk]; ss2 = s4[kk]; i2 = kk; }
                    const float inv = 1.0f / (ss1 + ss2);
                    if (lane < 4 && g4 + k < nrows) {
                        const int lr = g4 + k; const int e0 = gsel * 4 + i1, e1 = gsel * 4 + i2;
                        tE[2 * lr] = e0; tE[2 * lr + 1] = e1;
                        tP[2 * lr] = atomicAdd((int*)&lcnt[e0], 1); tP[2 * lr + 1] = atomicAdd((int*)&lcnt[e1], 1);
                        tG[2 * lr] = ss1 * inv; tG[2 * lr + 1] = ss2 * inv;
                    }
                }
            }
            __syncthreads();
            if (tid < 16) gbase[tid] = (int)__hip_atomic_fetch_add(ctl + CW_ECNT + 64 * (l * 16 + tid), (unsigned)lcnt[tid], RLX_AGENT);
            __syncthreads();
            if (tid < nrows) {
                const int row = r0 + tid; const int e0 = tE[2 * tid], e1 = tE[2 * tid + 1];
                const int p0 = gbase[e0] + tP[2 * tid], p1 = gbase[e1] + tP[2 * tid + 1];
                LIST[(size_t)e0 * TP + p0] = row; LIST[(size_t)e1 * TP + p1] = row;
                u32x4 w0; w0.x = (unsigned)e0; w0.y = (unsigned)p0; w0.z = (unsigned)e1; w0.w = (unsigned)p1;
                *(u32x4*)(TOK + (size_t)row * 8) = w0;
                u32x2 w1; w1.x = __float_as_uint(tG[2 * tid]); w1.y = __float_as_uint(tG[2 * tid + 1]);
                *(u32x2*)(TOK + (size_t)row * 8 + 4) = w1;
            }
        }
        xcd_barrier(bar);
        LAS int* tb = (LAS int*)(F.lds + MISC_OFF) + 16; LAS int* ecnt = (LAS int*)(F.lds + MISC_OFF) + 64;
        if (threadIdx.x == 0) { int acc = 0; for (int e = 0; e < 16; ++e) { const int c = (int)__hip_atomic_load(F.ctl + CW_ECNT + 64 * (l * 16 + e), RLX_AGENT); ecnt[e] = c; tb[e] = acc; acc += (c + 255) >> 8; } tb[16] = acc; }
        __syncthreads();
        for (int rep_ = 0; rep_ < REP_H; ++rep_) {
        {
            PHASE_PTRS const bf16_t* W = Wall + (size_t)l * W_LAYER;
            pg8::SchedMoe S{(const char*)(X + X_H1Q), (const char*)(W + W_MOE1), tb, ecnt, LIST, 1, F.G, (int)blockIdx.x, (size_t)512 * 1024, (size_t)256 * 1024, 0, true, DM};
            pg8::EpiM1 E{HID, (const float*)(wsl + WS_H1S), ctl + CW_CMAX + 16384 * l + 4608, tb, ecnt, LIST};
            pg8::gemm_phase<pg8::EpiM1, pg8::SchedMoe, true, false, true>(F.lds, 512, 512, 512, S, E);
        }
        xcd_barrier(bar);
        }
        for (int rep_ = 0; rep_ < REP_I; ++rep_) {
        {
            PHASE_PTRS const bf16_t* W = Wall + (size_t)l * W_LAYER;
            pg8::SchedMoe S{(const char*)HID, (const char*)(W + W_MOE2), tb, ecnt, LIST, 2, F.G, (int)blockIdx.x, (size_t)1024 * 256 * 2, (size_t)256 * 256 * 2, (size_t)256 * 256 * 2, false, DM * 2};
            pg8::EpiM2 E{YS};
            pg8::gemm_phase<pg8::EpiM2, pg8::SchedMoe, false>(F.lds, 256, 256, 256, S, E);
        }
        xcd_barrier(bar);
        }
        {
            PHASE_IDS
            PHASE_PTRS
            for (int rep_ = 0; rep_ < REP_J; ++rep_)
            for (int r4 = gw * 4; r4 < (l == 0 ? T : NREAL); r4 += NGW * 4) {
                u32x4 w0[4]; u32x2 w1[4];
#pragma unroll
                for (int k = 0; k < 4; ++k) { w0[k] = *(const u32x4*)(TOK + (size_t)(r4 + k) * 8); w1[k] = *(const u32x2*)(TOK + (size_t)(r4 + k) * 8 + 4); }
                u32x2 hv[4][4], ya[4][4], yc[4][4];
#pragma unroll
                for (int k = 0; k < 4; ++k) {
                    const size_t s0 = (size_t)tb[(int)w0[k].x] * 256 + (int)w0[k].y, s1 = (size_t)tb[(int)w0[k].z] * 256 + (int)w0[k].w;
#pragma unroll
                    for (int j = 0; j < 4; ++j) { hv[k][j] = *(const u32x2*)(H1 + (size_t)(r4 + k) * DM + 4 * lane + 256 * j); ya[k][j] = *(const u32x2*)(YS + s0 * DM + 4 * lane + 256 * j); yc[k][j] = *(const u32x2*)(YS + s1 * DM + 4 * lane + 256 * j); } }
                f32x4 v[4][4];
#pragma unroll
                for (int k = 0; k < 4; ++k) { const float g0 = __uint_as_float(w1[k].x), g1 = __uint_as_float(w1[k].y);
#pragma unroll
                    for (int j = 0; j < 4; ++j) {
                        v[k][j][0] = ALPHA * bf_lo(hv[k][j].x) + g0 * bf_lo(ya[k][j].x) + g1 * bf_lo(yc[k][j].x); v[k][j][1] = ALPHA * bf_hi(hv[k][j].x) + g0 * bf_hi(ya[k][j].x) + g1 * bf_hi(yc[k][j].x);
                        v[k][j][2] = ALPHA * bf_lo(hv[k][j].y) + g0 * bf_lo(ya[k][j].y) + g1 * bf_lo(yc[k][j].y); v[k][j][3] = ALPHA * bf_hi(hv[k][j].y) + g0 * bf_hi(ya[k][j].y) + g1 * bf_hi(yc[k][j].y); } }
                ln16xR<4>(v, args.in[20] + l * DM, args.in[21] + l * DM, lane);
                if (l == 0) { unsigned char* const qr[4] = {X + X_HBQ + (size_t)r4 * DM, X + X_HBQ + (size_t)(r4 + 1) * DM, X + X_HBQ + (size_t)(r4 + 2) * DM, X + X_HBQ + (size_t)(r4 + 3) * DM};
                    float* const hs = (float*)(wsl + WS_HBS) + r4; float* const sr[4] = {hs, hs + 1, hs + 2, hs + 3};
                    quant_rows<4>(v, qr, sr, lane); }
#pragma unroll
                for (int k = 0; k < 4; ++k) { const int row = r4 + k;
                    if (l == 0) store_row_bf16(HB + (size_t)row * DM, v[k], lane);
                    else { float* orow = args.out + (size_t)row * DM;
#pragma unroll
                        for (int j = 0; j < 4; ++j) *(f32x4*)(orow + 4 * lane + 256 * j) = v[k][j]; } }
            }
        }
        if (l == 0) xcd_barrier(bar);
}

__global__ void __launch_bounds__(512, 2) fwd_kernel(Args args) {
    extern __shared__ __attribute__((aligned(16))) unsigned char lds_raw[];
    Frame F;
    F.lds = (LAS unsigned char*)lds_raw;
    F.MISC = (volatile LAS unsigned*)(F.lds + MISC_OFF);
    F.tid = threadIdx.x; F.lane = F.tid & 63; F.wave = __builtin_amdgcn_readfirstlane(F.tid >> 6);
    F.G = gridDim.x; { const int bx = blockIdx.x; F.vcu = (F.G % 8 == 0) ? (bx % 8) * (F.G / 8) + bx / 8 : bx; }
    unsigned char* ws = args.ws;
    F.ctl = (unsigned*)(ws + WS_CTL);
    for (int u = F.tid; u < (LDS_BYTES - MISC_OFF) / 4; u += 512) ((LAS unsigned*)(F.lds + MISC_OFF))[u] = 0u;
    __syncthreads();
    XcdBarrier bar = xcd_barrier_post(F.ctl + CW_BAR, F.MISC);
    const int NGW = F.G * 8;
    {
        PHASE_IDS
        PHASE_PTRS
        LAS float* scr = (LAS float*)(F.lds + wave * 16384);
        { LAS float* part = (LAS float*)(F.lds + 12288);
          for (int it = F.vcu; it < 2 * STRIPS_PER_LAYER; it += F.G) { const int l = it / STRIPS_PER_LAYER, sidx = it % STRIPS_PER_LAYER;
              strip_item(args, Wall + (size_t)l * W_LAYER, ctl + CW_CMAX + 16384 * l, l, sidx, scr, part, wave, lane); } }
        for (int it = gw; it < 2 * ITEMS_PER_LAYER; it += NGW) { const int l = it / ITEMS_PER_LAYER, r = it % ITEMS_PER_LAYER; convert_item(args, Wall + (size_t)l * W_LAYER, l, r, scr, lane); }
        for (int r4 = gw * 4; r4 < TP; r4 += NGW * 4) {
            if (r4 >= T) {
#pragma unroll
                for (int k = 0; k < 4; ++k) { bf16_t* orow = HB + (size_t)(r4 + k) * DM; *(u32x4*)(orow + 8 * lane) = (u32x4){0u, 0u, 0u, 0u}; *(u32x4*)(orow + 512 + 8 * lane) = (u32x4){0u, 0u, 0u, 0u};
                    *(u32x4*)(X + X_HBQ + (size_t)(r4 + k) * DM + 16 * lane) = (u32x4){0u, 0u, 0u, 0u}; if (lane == 0) ((float*)(wsl + WS_HBS))[r4 + k] = 0.f; }
                continue; }
            f32x4 v[4][4];
#pragma unroll
            for (int k = 0; k < 4; ++k) { const int row = r4 + k;
                const float* src = row < NREAL ? args.in[0] + (size_t)row * DM : args.in[1] + (size_t)((row - NREAL) & (NMETA - 1)) * DM;
#pragma unroll
                for (int j = 0; j < 4; ++j) v[k][j] = *(const f32x4*)(src + 4 * lane + 256 * j); }
            ln16xR<4>(v, args.in[2], args.in[3], lane);
#pragma unroll
            for (int k = 0; k < 4; ++k) store_row_bf16(HB + (size_t)(r4 + k) * DM, v[k], lane);
            { unsigned char* const qr[4] = {X + X_HBQ + (size_t)r4 * DM, X + X_HBQ + (size_t)(r4 + 1) * DM, X + X_HBQ + (size_t)(r4 + 2) * DM, X + X_HBQ + (size_t)(r4 + 3) * DM};
              float* const hs = (float*)(wsl + WS_HBS) + r4; float* const sr[4] = {hs, hs + 1, hs + 2, hs + 3};
              quant_rows<4>(v, qr, sr, lane); }
        }
        { float* RWT = (float*)(wsl + WS_RWT); const float* rw = args.in[15];
          for (int idx = blockIdx.x * 512 + tid; idx < 16384; idx += F.G * 512) { const int e = idx >> 10, col = idx & 1023; RWT[idx] = rw[col * 16 + e]; } }
        for (int idx = blockIdx.x * 512 + tid; idx < LSEQ * 16; idx += F.G * 512) {
            const int p = idx >> 4, i = idx & 15; double x = (double)p * ROPE_INV_REV[i]; x -= floor(x); const float xr = (float)x;
            ropeC[idx] = __builtin_amdgcn_cosf(xr); ropeS[idx] = __builtin_amdgcn_sinf(xr);
        }
    }
    xcd_barrier(bar);

    run_layer<0>(args, F, bar, NGW);
    run_layer<1>(args, F, bar, NGW);
}

extern "C" void kernel_launch(void* const* d_in, const int* in_sizes, int n_in, void* d_out, int out_size, void* d_ws, size_t ws_size, hipStream_t stream) {
    static int grid = 0;
    if (grid == 0) {
        if (n_in != 22 || ws_size < WS_END) { fprintf(stderr, "kernel_launch: need 22 inputs and %zu bytes of workspace (got %d, %zu)\n", (size_t)WS_END, n_in, ws_size); grid = -1; return; }
        int dev = 0, cus = 0, per_cu = 0;
        if (hipGetDevice(&dev) != hipSuccess || hipDeviceGetAttribute(&cus, hipDeviceAttributeMultiprocessorCount, dev) != hipSuccess) { grid = -1; return; }
        if (hipFuncSetAttribute((const void*)fwd_kernel, hipFuncAttributeMaxDynamicSharedMemorySize, LDS_BYTES) != hipSuccess) { fprintf(stderr, "kernel_launch: hipFuncSetAttribute failed\n"); grid = -1; return; }
        if (hipOccupancyMaxActiveBlocksPerMultiprocessor(&per_cu, (const void*)fwd_kernel, 512, LDS_BYTES) != hipSuccess || per_cu < 1) { fprintf(stderr, "kernel_launch: occupancy query says %d\n", per_cu); }
        (void)hipGetLastError();
        grid = cus;
    }
    if (grid < 0) return;
    if (hipMemsetAsync((char*)d_ws + WS_CTL, 0, CTL_BYTES, stream) != hipSuccess) return;
    Args a{};
    for (int i = 0; i < 22; ++i) a.in[i] = (const float*)d_in[i];
    a.out = (float*)d_out; a.ws = (unsigned char*)d_ws;
    hipLaunchKernelGGL(fwd_kernel, dim3(grid), dim3(512), LDS_BYTES, stream, a);
}
```

```cpp
#include <hip/hip_runtime.h>
#include <cstdio>
#include <cstdint>

#ifndef REP_A
#define REP_A 1
#endif
#ifndef REP_C
#define REP_C 1
#endif
#ifndef REP_E
#define REP_E 1
#endif
#ifndef REP_F
#define REP_F 1
#endif
#ifndef REP_H
#define REP_H 1
#endif
#ifndef REP_I
#define REP_I 1
#endif
#ifndef REP_GEMM
#define REP_GEMM 1
#endif
#ifndef REP_MLA
#define REP_MLA 1
#endif
#ifndef REP2_MODE
#define REP2_MODE 0
#endif
#ifndef REP_FOX
#define REP_FOX 1
#endif
#ifndef REP_J
#define REP_J 1
#endif
#ifndef REP_THIN
#define REP_THIN 1
#endif
#define LAS __attribute__((address_space(3)))
typedef unsigned short bf16_t;
typedef short bf16x8 __attribute__((ext_vector_type(8)));
typedef short s16x4 __attribute__((ext_vector_type(4)));
typedef float f32x4 __attribute__((ext_vector_type(4)));
typedef float f32x2_t __attribute__((ext_vector_type(2)));
typedef __bf16 bf16x2_t __attribute__((ext_vector_type(2)));
typedef float f32x16 __attribute__((ext_vector_type(16)));
typedef unsigned u32x4 __attribute__((ext_vector_type(4)));
typedef unsigned u32x2 __attribute__((ext_vector_type(2)));
typedef int i32x4 __attribute__((ext_vector_type(4)));

constexpr int NB = 8, SEQ = 4096, NMETA = 16, LSEQ = 4112, T = NB * LSEQ  , TP = 33024  , DM = 1024;
constexpr int NPANEL = TP / 256;
constexpr int NREAL = NB * SEQ;
__host__ __device__ __forceinline__ int row_of(int b, int p) { return p < NMETA ? NREAL + NMETA * b + p : SEQ * b + (p - NMETA); }
__host__ __device__ __forceinline__ int pos_of(int row) { return row < NREAL ? NMETA + (row & (SEQ - 1)) : (row - NREAL) & (NMETA - 1); }
constexpr int NEXP = 16;
constexpr float ALPHA = 1.41421356237309515f;
constexpr float LOG2E = 1.4426950408889634f;
constexpr float C2F = 0.125f * LOG2E;
constexpr float C2M = 0.14724444602590310f;
constexpr int CSP = 4160;

constexpr size_t MiB = 1ull << 20;
constexpr size_t WS_CTL = 0, CTL_BYTES = 1 * MiB;
constexpr size_t WS_ROPE = 1 * MiB;
constexpr size_t WS_RWT = 1 * MiB + 640 * 1024;
constexpr size_t WS_LF = 2 * MiB;
constexpr size_t WS_CS = 3 * MiB + 256 * 1024;
constexpr size_t WS_HBS = 8 * MiB + 512 * 1024;
constexpr size_t WS_H1S = 8 * MiB + 768 * 1024;
constexpr size_t WS_SSQ = 9 * MiB;
constexpr size_t WS_TOK = 4 * MiB + 512 * 1024;
constexpr size_t WS_LIST = 5 * MiB + 768 * 1024;
constexpr size_t WS_GALT = 8 * MiB;
constexpr size_t WS_W = 12 * MiB;
constexpr size_t WS_H = 88 * MiB;
constexpr size_t WS_X = 153 * MiB;
constexpr size_t S512 = (size_t)TP * 512 * 2, S768 = (size_t)TP * 768 * 2, S1024 = (size_t)TP * 1024 * 2;
constexpr size_t X_QF = 0, X_KF = S512, X_VF = 2 * S512, X_RAW = 3 * S512, X_QM = 3 * S512 + S768, X_KM = 3 * S512 + 2 * S768,
                 X_VM = 3 * S512 + 3 * S768, X_OM = 4 * S512 + 3 * S768, X_OF = 5 * S512 + 3 * S768, X_END = 6 * S512 + 3 * S768;
constexpr size_t X_HBQ = X_OM;
constexpr size_t X_H1Q = X_RAW;
constexpr size_t X_GATES = X_KF;
constexpr size_t X_MERGED = X_KM;
constexpr size_t X_Z = X_KF;
constexpr size_t X_H1 = X_KM;
constexpr size_t X_HID = X_QF;
constexpr size_t X_YS = 36 * MiB;
constexpr int NSLOT_TILES = 273, NSLOT = NSLOT_TILES * 256;
constexpr size_t WS_QKN = WS_X + X_END;
constexpr size_t WS_KR = WS_QKN + (size_t)TP * 128;
constexpr size_t WS_END = WS_KR + (size_t)TP * 64;
static_assert(X_GATES + (size_t)TP * 2048 * 2 <= X_KM, "gates");
static_assert(X_MERGED + S1024 <= X_OM, "merged");
static_assert(X_HID + (size_t)NSLOT * 256 * 2 <= X_YS, "hid");
static_assert(X_YS + (size_t)NSLOT * 1024 * 2 <= X_KM, "ys");
static_assert(WS_LF + (size_t)TP * 32 <= WS_CS && WS_CS + 64ull * CSP * 4 <= WS_TOK && WS_TOK + (size_t)TP * 32 <= WS_LIST && WS_LIST + 16ull * TP * 4 <= WS_GALT && WS_GALT + MiB <= WS_SSQ && WS_SSQ + (size_t)TP * 80 <= WS_W, "small buffers");
static_assert(WS_W + 2ull * 19693568ull * 2ull <= WS_H, "weights");
static_assert(WS_H + S1024 <= WS_X, "h");
constexpr size_t W_BT1 = 0, W_BT2 = W_BT1 + 2304ull * 1024, W_FOXO = W_BT2 + 2048ull * 1024, W_MLAO = W_FOXO + 1024ull * 512,
                 W_UQ = W_MLAO + 1024ull * 512, W_UKV = W_UQ + 768ull * 384, W_OUT = W_UKV + 1024ull * 256, W_MOE1 = W_OUT + 1024ull * 1024,
                 W_MOE2 = W_MOE1 + 16ull * 512 * 1024, W_LAYER = W_MOE2 + 16ull * 1024 * 256;
static_assert(W_LAYER == 19693568ull, "weights per layer");
constexpr int CW_BAR = 4096;
constexpr int CW_QCTR = 8192;
constexpr int CW_ECNT = 16384;
constexpr int CW_CMAX = 131072;
constexpr int CW_QKMAX = 20480;

constexpr int RING_BYTES = 131072;
constexpr int MISC_OFF = RING_BYTES;
constexpr int LDS_BYTES = 147456;

__device__ __forceinline__ unsigned pk_bf16(float lo, float hi) { f32x2_t v = {lo, hi}; bf16x2_t b = __builtin_convertvector(v, bf16x2_t); return __builtin_bit_cast(unsigned, b); }
__device__ __forceinline__ float bf_lo(unsigned u) { return __uint_as_float(u << 16); }
__device__ __forceinline__ float bf_hi(unsigned u) { return __uint_as_float(u & 0xffff0000u); }
__device__ __forceinline__ float wave_sum(float v) {
#pragma unroll
    for (int o = 1; o < 64; o <<= 1) v += __shfl_xor(v, o);
    return v;
}
#define LDS_WAIT() asm volatile("s_waitcnt lgkmcnt(0)" ::: "memory")
#define RLX_AGENT __ATOMIC_RELAXED, __HIP_MEMORY_SCOPE_AGENT

#define XB_TMO      128
#define XB_XCNT(j)  (256  + 64 * (j))
#define XB_XSUB(j)  (1280 + 64 * (j))
#define XB_XGEN(j)  (2304 + 64 * (j))
#define XB_TOP      3328
#define XB_TOPGEN   3392
#define XCD_BAR_WORDS 3456
#define XB_SPIN_CAP (1u << 20)
__device__ __forceinline__ unsigned xb_ld(unsigned* p)              { return __hip_atomic_load(p, __ATOMIC_RELAXED, __HIP_MEMORY_SCOPE_AGENT); }
__device__ __forceinline__ unsigned xb_add(unsigned* p, unsigned v) { return __hip_atomic_fetch_add(p, v, __ATOMIC_RELAXED, __HIP_MEMORY_SCOPE_AGENT); }
__device__ __forceinline__ unsigned xb_xcc_id() { return (unsigned)__builtin_amdgcn_s_getreg((3 << 11) | 20) & 0xFu; }
#define XB_SPIN(cond, bar) do { unsigned _sp = 0; while (cond) { __builtin_amdgcn_s_sleep(1); \
    if ((++_sp & 255u) == 0u) { if (xb_ld(&(bar)[XB_TMO])) break; if (_sp > XB_SPIN_CAP) { atomicAdd(&(bar)[XB_TMO], 1u); break; } } } } while (0)
struct XcdBarrier { unsigned* bar; unsigned x; volatile LAS unsigned* st; };
__device__ __forceinline__ XcdBarrier xcd_barrier_post(unsigned* bar, volatile LAS unsigned* st) {
    XcdBarrier b; b.bar = bar; b.x = xb_xcc_id(); b.st = st;
    if (threadIdx.x == 0) (void)xb_add(&bar[XB_XCNT(b.x)], 1u);
    return b;
}
__device__ __forceinline__ void xcd_barrier_complete(unsigned* bar, unsigned x, unsigned& nloc, unsigned& nx) {
    const unsigned G = gridDim.x * gridDim.y * gridDim.z;
    unsigned sum, cnt, mine, sp = 0u;
    for (;;) {
        sum = 0u; cnt = 0u; mine = 0u;
#pragma unroll
        for (unsigned j = 0; j < 16; ++j) { const unsigned c = xb_ld(&bar[XB_XCNT(j)]); sum += c; cnt += (c > 0u) ? 1u : 0u; mine = (j == x) ? c : mine; }
        if (sum == G) break;
        __builtin_amdgcn_s_sleep(1);
        if ((++sp & 255u) == 0u) { if (xb_ld(&bar[XB_TMO])) break; if (sp > XB_SPIN_CAP) { atomicAdd(&bar[XB_TMO], 1u); break; } }
    }
    nloc = mine > 0u ? mine : 1u; nx = cnt > 0u ? cnt : 1u;
}
__device__ __forceinline__ void xcd_barrier(const XcdBarrier& b) {
    asm volatile("s_waitcnt vmcnt(0)" ::: "memory");
    __syncthreads();
    if (threadIdx.x == 0) {
        unsigned* bar = b.bar; unsigned bx = b.x; asm volatile("" : "+s"(bar), "+s"(bx));
        __builtin_amdgcn_s_waitcnt(0);
        unsigned nloc = b.st[0], nx = b.st[1];
        if (nloc == 0u) { xcd_barrier_complete(bar, bx, nloc, nx); b.st[0] = nloc; b.st[1] = nx; }
        const unsigned old = xb_add(&bar[XB_XSUB(bx)], 1u);
        const unsigned gen = old / nloc;
        if (old + 1u == (gen + 1u) * nloc) {
            __builtin_amdgcn_fence(__ATOMIC_RELEASE, "agent");
            asm volatile("s_waitcnt vmcnt(0)" ::: "memory");
            const unsigned og = xb_add(&bar[XB_TOP], 1u);
            const unsigned tg = og / nx;
            if (og + 1u == (tg + 1u) * nx) xb_add(&bar[XB_TOPGEN], 1u);
            else XB_SPIN(xb_ld(&bar[XB_TOPGEN]) == tg, bar);
            __builtin_amdgcn_fence(__ATOMIC_ACQUIRE, "agent");
            xb_add(&bar[XB_XGEN(bx)], 1u);
            asm volatile("s_waitcnt vmcnt(0)" ::: "memory");
        } else {
            XB_SPIN(xb_ld(&bar[XB_XGEN(bx)]) == gen, bar);
            __builtin_amdgcn_fence(__ATOMIC_ACQUIRE, "agent");
            asm volatile("s_waitcnt vmcnt(0)" ::: "memory");
        }
    }
    __syncthreads();
}

namespace pg8 {
constexpr int BM = 256, BK = 64, HALF = 128, HTB = HALF * BK * 2, STAGE_BYTES = 8 * HTB;
__device__ __forceinline__ int lds_byte(int r, int c) { const int st = (r >> 4) * 2 + (c >> 5), rr = r & 15, cc = c & 31, ob = rr * 64 + cc * 2; return st * 1024 + (ob ^ (((ob >> 9) & 1) << 5)); }
__device__ __forceinline__ void stage_rc(int b, int& R, int& C) { const int st = b / 1024, sb = b % 1024, swz = sb ^ (((sb >> 9) & 1) << 5); R = (st >> 1) * 16 + swz / 64; C = (st & 1) * 32 + (swz % 64) / 2; }
__device__ __forceinline__ int perm32(int rho) { const int n = rho >> 4, i = rho & 15; return 8 * (i >> 2) + 4 * n + (i & 3); }
struct Unit { const char* A; const char* B; int pm, pn, aux, half; };
typedef f32x4 Acc[2][2][4][2];

__device__ __forceinline__ void tile_of(int L, int nM, int nN, int& pm, int& pn) {
    const int nwg = nM * nN; int wgid = L;
    { const int q = nwg / 8, r = nwg % 8, xcd = wgid % 8, off = wgid / 8; wgid = (xcd < r ? xcd * (q + 1) : r * (q + 1) + (xcd - r) * q) + off; }
    const int nig = 8 * nN, gid = wgid / nig, fm = gid * 8, gsz = (nM - fm) < 8 ? (nM - fm) : 8;
    pm = fm + ((wgid % nig) % gsz); pn = (wgid % nig) / gsz;
}

template <class Epi, class Sched, bool GATHER, bool MIDHOOK = false, bool I8 = false>
__device__ __forceinline__ void gemm_phase(LAS unsigned char* lds, const int K, const int lda, const int ldb, const Sched& S, const Epi& E) {
    int tid_l = threadIdx.x; asm volatile("" : "+v"(tid_l));
    const int tid = tid_l, wid = __builtin_amdgcn_readfirstlane(tid >> 6), lane = tid & 63, wr = wid >> 2, wc = wid & 3, fr = lane & 15, fq = lane >> 4;
    int nt = K / BK; asm volatile("" : "+s"(nt));
    unsigned voA[2][2], voB[2]; int Rr[2], Cc[2];
#pragma unroll
    for (int i = 0; i < 2; ++i) { int R, C; stage_rc(tid * 16 + i * 8192, R, C); const int Rb = Epi::PERM ? ((R & ~31) + perm32(R & 31)) : R;
        Rr[i] = R; Cc[i] = C; voA[0][i] = (unsigned)(R * lda + C) * 2u; voA[1][i] = (unsigned)((R + HALF) * lda + C) * 2u; voB[i] = (unsigned)(Rb * ldb + C) * 2u; }
    const size_t kstep = (size_t)(BK * 2);
    const size_t hstepB = (size_t)HALF * ldb * 2, hstepA = (size_t)HALF * lda * 2;
    const unsigned ldsw = (unsigned)wid * 1024u;
    const int aoff = lds_byte(wr * 64 + fr, fq * 8), boff = lds_byte(wc * 32 + fr, fq * 8);
#define PG8_SA(b, h) (((b) * 2 + (h)) * HTB)
#define PG8_SB(b, h) ((4 + (b) * 2 + (h)) * HTB)
#define PG8_STAGE2(bufoff, gbase, o0, o1) do { \
        __builtin_amdgcn_global_load_lds((const unsigned*)((const char*)(gbase) + (o0)), (LAS unsigned*)(lds + (bufoff) + ldsw), 16, 0, 0); \
        __builtin_amdgcn_global_load_lds((const unsigned*)((const char*)(gbase) + (o1)), (LAS unsigned*)(lds + (bufoff) + ldsw + 8192), 16, 0, 0); } while (0)
#define PG8_STA(b, h, gbase, VO) do { if constexpr (GATHER) PG8_STAGE2(PG8_SA(b, h), gbase, (VO)[h][0], (VO)[h][1]); else PG8_STAGE2(PG8_SA(b, h), (gbase) + (h) * hstepA, (VO)[0][0], (VO)[0][1]); } while (0)
#define PG8_STB(b, h, gbase) PG8_STAGE2(PG8_SB(b, h), (gbase) + (h) * hstepB, voB[0], voB[1])
#define PG8_LDA(dst, b, h) do { _Pragma("unroll") for (int m = 0; m < 4; ++m) _Pragma("unroll") for (int k = 0; k < 2; ++k) dst[m][k] = *(const LAS bf16x8*)(lds + PG8_SA(b, h) + aoff + m * 2048 + k * 1024); } while (0)
#define PG8_LDB(dst, b, h) do { _Pragma("unroll") for (int n = 0; n < 2; ++n) _Pragma("unroll") for (int k = 0; k < 2; ++k) dst[n][k] = *(const LAS bf16x8*)(lds + PG8_SB(b, h) + boff + n * 2048 + k * 1024); } while (0)
#define PG8_MMA(ai, bj, At, Bt) do { __builtin_amdgcn_s_setprio(1); _Pragma("unroll") for (int m = 0; m < 4; ++m) _Pragma("unroll") for (int n = 0; n < 2; ++n) _Pragma("unroll") for (int k = 0; k < 2; ++k) { \
        if constexpr (I8) acc[ai][bj][m][n] = __builtin_bit_cast(f32x4, __builtin_amdgcn_mfma_i32_16x16x64_i8(__builtin_bit_cast(i32x4, Bt[n][k]), __builtin_bit_cast(i32x4, At[m][k]), __builtin_bit_cast(i32x4, acc[ai][bj][m][n]), 0, 0, 0)); \
        else acc[ai][bj][m][n] = __builtin_amdgcn_mfma_f32_16x16x32_bf16(Bt[n][k], At[m][k], acc[ai][bj][m][n], 0, 0, 0); } __builtin_amdgcn_s_setprio(0); } while (0)
#define PG8_WAIT_V(n) asm volatile("s_waitcnt vmcnt(" #n ")" ::: "memory")
#define PG8_WAIT_L(n) asm volatile("s_waitcnt lgkmcnt(" #n ")" ::: "memory")
#define PG8_BAR __builtin_amdgcn_s_barrier()
#define PG8_SCHED __builtin_amdgcn_sched_barrier(0)
    Unit cur, nxt; int ui = 0;
    if (!S.next(0, cur)) return;
    Acc acc;
#pragma unroll
    for (int a = 0; a < 2; ++a)
#pragma unroll
        for (int b = 0; b < 2; ++b)
#pragma unroll
            for (int m = 0; m < 4; ++m)
#pragma unroll
                for (int n = 0; n < 2; ++n) acc[a][b][m][n] = (f32x4){0.f, 0.f, 0.f, 0.f};
    bf16x8 At[4][2], B0[2][2], B1[2][2];
    const char* cA = cur.A; const char* cB = cur.B;
    if constexpr (GATHER) {
#pragma unroll
        for (int h = 0; h < 2; ++h)
#pragma unroll
            for (int i = 0; i < 2; ++i) voA[h][i] = S.row_off(cur, Rr[i] + h * HALF) + (unsigned)Cc[i] * 2u;
    }
    PG8_STB(0, 0, cB); PG8_STB(0, 1, cB); PG8_STA(0, 0, cA, voA); PG8_STA(0, 1, cA, voA);
    if (wr == 1) PG8_BAR;
    PG8_WAIT_V(2); PG8_BAR;
    PG8_STB(1, 0, cB + kstep); PG8_STA(1, 0, cA + kstep, voA); PG8_STB(1, 1, cB + kstep);
    PG8_WAIT_V(6); PG8_BAR;
    for (;;) {
        const bool has_next = S.next(ui + 1, nxt);
        const char* nA = has_next ? nxt.A : cA; const char* nB = has_next ? nxt.B : cB;
        unsigned vnA[2][2];
        if constexpr (GATHER) {
#pragma unroll
            for (int h = 0; h < 2; ++h)
#pragma unroll
                for (int i = 0; i < 2; ++i) vnA[h][i] = has_next ? (S.row_off(nxt, Rr[i] + h * HALF) + (unsigned)Cc[i] * 2u) : voA[h][i];
        }
        for (int t = 0; t < nt; t += 2) {
            if constexpr (MIDHOOK) { if (t == (nt >> 1)) { int le_ = threadIdx.x & 63; asm volatile("" : "+v"(le_)); E.mid(acc, cur, wr, wc, le_ & 15, le_ >> 4); } }
            const bool last = (t == nt - 2);
            const char* a1 = cA + (size_t)(t + 1) * kstep;
            const char* a2 = last ? nA : cA + (size_t)(t + 2) * kstep; const char* b2 = last ? nB : cB + (size_t)(t + 2) * kstep;
            const char* a3 = a2 + kstep; const char* b3 = b2 + kstep;
            unsigned vs[2][2];
#pragma unroll
            for (int h = 0; h < 2; ++h)
#pragma unroll
                for (int i = 0; i < 2; ++i) { if constexpr (GATHER) vs[h][i] = last ? vnA[h][i] : voA[h][i]; else vs[h][i] = voA[h][i]; }
            PG8_LDB(B0, 0, 0); PG8_LDB(B1, 0, 1); PG8_SCHED; PG8_LDA(At, 0, 0); PG8_STA(1, 1, a1, voA);
            PG8_WAIT_V(8); PG8_WAIT_L(0); PG8_BAR; PG8_MMA(0, 0, At, B0); PG8_MMA(0, 1, At, B1); PG8_BAR; PG8_SCHED;
            PG8_LDA(At, 0, 1); PG8_STB(0, 0, b2); PG8_STB(0, 1, b2); PG8_STA(0, 0, a2, vs);
            PG8_WAIT_V(8); PG8_WAIT_L(0); PG8_BAR; if (!cur.half) { PG8_MMA(1, 0, At, B0); PG8_MMA(1, 1, At, B1); } PG8_BAR; PG8_SCHED;
            PG8_LDB(B0, 1, 0); PG8_LDB(B1, 1, 1); PG8_SCHED; PG8_LDA(At, 1, 0); PG8_STA(0, 1, a2, vs);
            PG8_WAIT_V(8); PG8_WAIT_L(0); PG8_BAR; PG8_MMA(0, 0, At, B0); PG8_MMA(0, 1, At, B1); PG8_BAR; PG8_SCHED;
            PG8_LDA(At, 1, 1); PG8_STB(1, 0, b3); PG8_STB(1, 1, b3); PG8_STA(1, 0, a3, vs);
            PG8_WAIT_V(8); PG8_WAIT_L(0); PG8_BAR; if (!cur.half) { PG8_MMA(1, 0, At, B0); PG8_MMA(1, 1, At, B1); } PG8_BAR; PG8_SCHED;
        }
        if (wr == 0) PG8_BAR;
        { int le_ = threadIdx.x & 63; asm volatile("" : "+v"(le_));
          E(acc, cur, wr, wc, le_ & 15, le_ >> 4); }
        if (!has_next) break;
#pragma unroll
        for (int a = 0; a < 2; ++a)
#pragma unroll
            for (int b = 0; b < 2; ++b)
#pragma unroll
                for (int m = 0; m < 4; ++m)
#pragma unroll
                    for (int n = 0; n < 2; ++n) acc[a][b][m][n] = (f32x4){0.f, 0.f, 0.f, 0.f};
        cur = nxt; cA = nA; cB = nB; ++ui;
        if constexpr (GATHER) {
#pragma unroll
            for (int h = 0; h < 2; ++h)
#pragma unroll
                for (int i = 0; i < 2; ++i) voA[h][i] = vnA[h][i];
        }
        if (wr == 1) PG8_BAR;
    }
    PG8_WAIT_V(0);
    PG8_BAR;
#undef PG8_SA
#undef PG8_SB
#undef PG8_STAGE2
#undef PG8_STA
#undef PG8_STB
#undef PG8_LDA
#undef PG8_LDB
#undef PG8_MMA
#undef PG8_WAIT_V
#undef PG8_WAIT_L
#undef PG8_BAR
#undef PG8_SCHED
}

struct SchedStatic {
    const char* A; const char* B; int nM, nN, G, c; size_t astep, bstep; int tail;
    __device__ __forceinline__ bool next(int i, Unit& u) const {
        const long L = (long)i * G + c; if (L >= (long)nM * nN) return false;
        int pm, pn; const int nfull = (nM - tail) * nN;
        if ((int)L < nfull) { tile_of((int)L, nM - tail, nN, pm, pn); u.half = 0; } else { pm = nM - 1; pn = (int)L - nfull; u.half = 1; }
        u.pm = pm; u.pn = pn; u.aux = 0; u.A = A + (size_t)pm * astep; u.B = B + (size_t)pn * bstep; return true;
    }
    __device__ __forceinline__ unsigned row_off(const Unit&, int) const { return 0u; }
};
struct SchedOut {
    const char* A0; const char* A1; const char* B0; const char* B1; int nM, nN, G, c; size_t astep, bstep;
    __device__ __forceinline__ bool next(int i, Unit& u) const {
        const long L = (long)(i >> 1) * G + c; if (L >= (long)nM * nN) return false;
        int pm, pn; const int nfull = (nM - 1) * nN;
        if ((int)L < nfull) { tile_of((int)L, nM - 1, nN, pm, pn); u.half = 0; } else { pm = nM - 1; pn = (int)L - nfull; u.half = 1; }
        const int pass = i & 1;
        u.pm = pm; u.pn = pn; u.aux = pass; u.A = (pass ? A1 : A0) + (size_t)pm * astep; u.B = (pass ? B1 : B0) + (size_t)pn * bstep; return true;
    }
    __device__ __forceinline__ unsigned row_off(const Unit&, int) const { return 0u; }
};
struct SchedMoe {
    const char* A; const char* B; const LAS int* tb; const LAS int* cnt; const int* list; int npn_shift, G, c; size_t bstep_e, bstep_n, astep; bool gather; int rowbytes;
    __device__ __forceinline__ bool next(int i, Unit& u) const {
        const int L = i * G + c; const int ntile = tb[16];
        if (L >= (ntile << npn_shift)) return false;
        const int ti = L >> npn_shift, pn = L & ((1 << npn_shift) - 1);
        int e = 0; while (ti >= tb[e + 1]) ++e;
        u.pm = ti; u.pn = pn; u.aux = e; u.half = (cnt[e] - (ti - tb[e]) * 256) <= 128 ? 1 : 0;
        u.A = gather ? A : A + (size_t)ti * astep;
        u.B = B + (size_t)e * bstep_e + (size_t)pn * bstep_n; return true;
    }
    __device__ __forceinline__ unsigned row_off(const Unit& u, int r) const {
        const int e = u.aux; int idx = (u.pm - tb[e]) * 256 + r; const int ce = cnt[e]; idx = idx < ce ? idx : ce - 1;
        const int tok = list[(size_t)e * TP + idx];
        return (unsigned)tok * (unsigned)rowbytes;
    }
};

__device__ __forceinline__ f32x4 dq4(const f32x4& a, float srow, const f32x4& scol) { const i32x4 i = __builtin_bit_cast(i32x4, a); return (f32x4){(float)i[0], (float)i[1], (float)i[2], (float)i[3]} * srow * scol; }
__device__ __forceinline__ f32x4 cmscale(const unsigned* cm) { const u32x4 u = *(const u32x4*)cm; return (f32x4){__uint_as_float(u.x), __uint_as_float(u.y), __uint_as_float(u.z), __uint_as_float(u.w)} * (1.0f / 127.0f); }
__device__ __forceinline__ u32x4 pack8(f32x4 v0, f32x4 v1) { u32x4 w; w.x = pk_bf16(v0[0], v0[1]); w.y = pk_bf16(v0[2], v0[3]); w.z = pk_bf16(v1[0], v1[1]); w.w = pk_bf16(v1[2], v1[3]); return w; }
__device__ __forceinline__ float logsig(float x) { return fminf(x, 0.f) - log1pf(__expf(-fabsf(x))); }
__device__ __forceinline__ float sigm(float x) { return __builtin_amdgcn_rcpf(1.0f + __builtin_amdgcn_exp2f(-LOG2E * x)); }

struct EpiA1 {
    static constexpr bool PERM = true;
    bf16_t *Qf, *Kf, *Vf, *RAW; float* LF; const float* fbias; float* qkn; float* ssq; bf16_t* Km; const float* cosT; const float* sinT; const float* hbs; const unsigned* cm;
    __device__ __forceinline__ void operator()(const Acc& acc, const Unit& u, int wr, int wc, int fr, int fq) const {
        const int pn = u.pn; bf16_t* base; int ldc, colt; float sc = 1.f;
        if (pn < 2) { base = Qf; ldc = 512; colt = pn * 256; sc = C2F; } else if (pn < 4) { base = Kf; ldc = 512; colt = (pn - 2) * 256; }
        else if (pn < 6) { base = Vf; ldc = 512; colt = (pn - 4) * 256; } else { base = RAW; ldc = 768; colt = (pn - 6) * 256; }
        const int row0 = u.pm * 256 + wr * 64 + fr, col0 = colt + wc * 32 + 8 * fq;
        f32x4 sb[2][2];
#pragma unroll
        for (int bj = 0; bj < 2; ++bj) { const unsigned* c_ = cm + pn * 256 + bj * 128 + wc * 32 + 8 * fq; sb[bj][0] = cmscale(c_); sb[bj][1] = cmscale(c_ + 4); }
        float sa8[2][4];
#pragma unroll
        for (int ai = 0; ai < 2; ++ai)
#pragma unroll
            for (int m = 0; m < 4; ++m) sa8[ai][m] = hbs[row0 + ai * 128 + m * 16];
#pragma unroll
        for (int ai = 0; ai < 2; ++ai) {
            float ssv[4][2];
#pragma unroll
            for (int m = 0; m < 4; ++m) { if (ai == 1 && u.half && !(pn == 4 || pn == 5)) continue;
                const int row = row0 + ai * 128 + m * 16; bf16_t* rowp = base + (size_t)row * ldc + col0;
                const float sa = sa8[ai][m] * sc;
#pragma unroll
                for (int bj = 0; bj < 2; ++bj) { const u32x4 w = pack8(dq4(acc[ai][bj][m][0], sa, sb[bj][0]), dq4(acc[ai][bj][m][1], sa, sb[bj][1])); *(u32x4*)(rowp + bj * 128) = w;
                    if (pn < 4 || pn >= 6) {
                        const float a0 = bf_lo(w.x), a1 = bf_hi(w.x), a2 = bf_lo(w.y), a3 = bf_hi(w.y), a4 = bf_lo(w.z), a5 = bf_hi(w.z), a6 = bf_lo(w.w), a7 = bf_hi(w.w);
                        float ss = (a0 * a0 + a1 * a1) + (a2 * a2 + a3 * a3) + (a4 * a4 + a5 * a5) + (a6 * a6 + a7 * a7);
                        { auto r16 = __builtin_amdgcn_permlane16_swap(__float_as_uint(ss), __float_as_uint(ss), false, false); ss = __uint_as_float(r16[0]) + __uint_as_float(r16[1]); }
                        { auto r32_ = __builtin_amdgcn_permlane32_swap(__float_as_uint(ss), __float_as_uint(ss), false, false); ss = __uint_as_float(r32_[0]) + __uint_as_float(r32_[1]); }
                        ssv[m][bj] = ss; } } }
            if ((pn < 4 || pn >= 6) && !(ai == 1 && u.half)) {
#pragma unroll
                for (int bj = 0; bj < 2; ++bj) { const float v = fq == 0 ? ssv[0][bj] : fq == 1 ? ssv[1][bj] : fq == 2 ? ssv[2][bj] : ssv[3][bj];
                    const int row = row0 + ai * 128 + fq * 16;
                    if (pn < 4) qkn[(size_t)row * 32 + (pn >> 1) * 16 + (pn & 1) * 8 + bj * 4 + wc] = v;
                    else { const int g32 = (pn - 6) * 8 + bj * 4 + wc;
                        if (g32 < 20) ssq[(size_t)row * 20 + g32] = v; } } } }
        if (pn == 8 && wc == 0) {
#pragma unroll
            for (int aim = 0; aim < 4; ++aim) { const int ai = aim >> 1; if (ai == 1 && u.half) continue;
                f32x4 cs4[2], sn4[2];
#pragma unroll
                for (int mm = 0; mm < 2; ++mm) { const int pos = pos_of(row0 + ai * 128 + ((aim & 1) * 2 + mm) * 16); cs4[mm] = *(const f32x4*)(cosT + pos * 16 + 4 * fq); sn4[mm] = *(const f32x4*)(sinT + pos * 16 + 4 * fq); }
#pragma unroll
                for (int mm = 0; mm < 2; ++mm) { const int m = (aim & 1) * 2 + mm; const int row = row0 + ai * 128 + m * 16;
                    const float sa = sa8[ai][m]; const f32x4 x1 = dq4(acc[ai][1][m][0], sa, sb[1][0]), x2 = dq4(acc[ai][1][m][1], sa, sb[1][1]);
                    const f32x4 cs = cs4[mm], sn = sn4[mm];
                    const f32x4 y1 = x1 * cs - x2 * sn, y2 = x2 * cs + x1 * sn;
                    u32x2 w1, w2; w1.x = pk_bf16(y1[0], y1[1]); w1.y = pk_bf16(y1[2], y1[3]); w2.x = pk_bf16(y2[0], y2[1]); w2.y = pk_bf16(y2[2], y2[3]);
                    bf16_t* kp = Km + (size_t)row * 32 + 4 * fq;
                    *(u32x2*)kp = w1; *(u32x2*)(kp + 16) = w2; } }
        }
        if (pn == 8 && wc == 1 && fq == 0) {
            const f32x4 b0 = *(const f32x4*)fbias, b1 = *(const f32x4*)(fbias + 4);
#pragma unroll
            for (int ai = 0; ai < 2; ++ai)
#pragma unroll
                for (int m = 0; m < 4; ++m) { if (ai == 1 && u.half) continue; const int row = row0 + ai * 128 + m * 16; const float sa = sa8[ai][m]; const f32x4 a = dq4(acc[ai][1][m][0], sa, sb[1][0]) + b0, b = dq4(acc[ai][1][m][1], sa, sb[1][1]) + b1;
                    f32x4 o0, o1;
#pragma unroll
                    for (int j = 0; j < 4; ++j) { o0[j] = logsig(a[j]); o1[j] = logsig(b[j]); }
                    *(f32x4*)(LF + (size_t)row * 8) = o0; *(f32x4*)(LF + (size_t)row * 8 + 4) = o1; }
        }
    }
};
struct EpiA2 {
    static constexpr bool PERM = true;
    unsigned char* Gm; unsigned char* Galt; const float* hbs; const unsigned* cm;
    __device__ __forceinline__ void operator()(const Acc& acc, const Unit& u, int wr, int wc, int fr, int fq) const {
        unsigned char* G = (u.pm == 128) ? Galt - (size_t)32768 * 2048 : Gm;
        const int row0 = u.pm * 256 + wr * 64 + fr, col0 = (u.pn - 9) * 256 + wc * 64 + 16 * fq;
        f32x4 sb[2][2];
#pragma unroll
        for (int bj = 0; bj < 2; ++bj) { const unsigned* c_ = cm + u.pn * 256 + bj * 128 + wc * 32 + 8 * fq; sb[bj][0] = cmscale(c_); sb[bj][1] = cmscale(c_ + 4); }
        float sa8[2][4];
#pragma unroll
        for (int ai = 0; ai < 2; ++ai)
#pragma unroll
            for (int m = 0; m < 4; ++m) sa8[ai][m] = hbs[row0 + ai * 128 + m * 16];
#pragma unroll
        for (int ai = 0; ai < 2; ++ai)
#pragma unroll
            for (int m = 0; m < 4; ++m) { if (ai == 1 && u.half) continue; unsigned char* rowp = G + (size_t)(row0 + ai * 128 + m * 16) * 2048 + col0; const float sa = sa8[ai][m]; u32x2 wv[2];
#pragma unroll
                for (int bj = 0; bj < 2; ++bj) { const f32x4 a = dq4(acc[ai][bj][m][0], sa, sb[bj][0]), b = dq4(acc[ai][bj][m][1], sa, sb[bj][1]); unsigned q[8];
#pragma unroll
                    for (int j = 0; j < 4; ++j) { q[j] = (unsigned)fmaxf(255.0f * sigm(a[j]) + 0.5f, 1.0f); q[4 + j] = (unsigned)fmaxf(255.0f * sigm(b[j]) + 0.5f, 1.0f); }
                    wv[bj].x = q[0] | (q[1] << 8) | (q[2] << 16) | (q[3] << 24); wv[bj].y = q[4] | (q[5] << 8) | (q[6] << 16) | (q[7] << 24); }
                *(u32x4*)rowp = (u32x4){wv[0].x, wv[0].y, wv[1].x, wv[1].y}; }
    }
};
struct EpiA {
    static constexpr bool PERM = true;
    EpiA1 e1; EpiA2 e2;
    __device__ __forceinline__ void operator()(const Acc& acc, const Unit& u, int wr, int wc, int fr, int fq) const { if (u.pn < 9) e1(acc, u, wr, wc, fr, fq); else e2(acc, u, wr, wc, fr, fq); }
};
struct EpiQup {
    static constexpr bool PERM = false;
    bf16_t* Qm; const float* cosT; const float* sinT; const float* ssq;
    __device__ __forceinline__ void operator()(const Acc& acc, const Unit& u, int wr, int wc, int fr, int fq) const {
        const int row0 = u.pm * 256 + wr * 64 + fr;
        float rq8[2][4];
#pragma unroll
        for (int ai = 0; ai < 2; ++ai)
#pragma unroll
            for (int m = 0; m < 4; ++m) { const int row = row0 + ai * 128 + m * 16;
                float sq_; { const f32x4 a = *(const f32x4*)(ssq + (size_t)row * 20), b4 = *(const f32x4*)(ssq + (size_t)row * 20 + 4), c4 = *(const f32x4*)(ssq + (size_t)row * 20 + 8); sq_ = ((a[0] + a[1]) + (a[2] + a[3])) + ((b4[0] + b4[1]) + (b4[2] + b4[3])) + ((c4[0] + c4[1]) + (c4[2] + c4[3])); }
                rq8[ai][m] = C2M * __builtin_amdgcn_rsqf(sq_ * (1.f / 384.f) + 1e-6f);
                if (m & 1) asm volatile("" : "+v"(rq8[ai][m - 1]), "+v"(rq8[ai][m])); }
        const bool anyrot = ((u.pn * 8 + wc) % 3 == 2) || ((u.pn * 8 + 4 + wc) % 3 == 2);
#pragma unroll
        for (int aim = 0; aim < 4; ++aim) { const int ai = aim >> 1; if (ai == 1 && u.half) continue;
            f32x4 cs4[2], sn4[2];
            if (anyrot) {
#pragma unroll
                for (int mm = 0; mm < 2; ++mm) { const int pos = pos_of(row0 + ai * 128 + ((aim & 1) * 2 + mm) * 16); cs4[mm] = *(const f32x4*)(cosT + pos * 16 + 4 * fq); sn4[mm] = *(const f32x4*)(sinT + pos * 16 + 4 * fq); } }
#pragma unroll
            for (int mm = 0; mm < 2; ++mm) { const int m = (aim & 1) * 2 + mm; const int row = row0 + ai * 128 + m * 16;
                const float rq = rq8[ai][m];
#pragma unroll
                for (int bj = 0; bj < 2; ++bj) { const int Gi = u.pn * 8 + bj * 4 + wc; f32x4 x0 = acc[ai][bj][m][0], x1 = acc[ai][bj][m][1];
                    if (Gi % 3 == 2) { const f32x4 cs = cs4[mm], sn = sn4[mm];
                        const f32x4 y0 = x0 * cs - x1 * sn, y1 = x1 * cs + x0 * sn; x0 = y0; x1 = y1; }
                    x0 = x0 * rq; x1 = x1 * rq;
                    u32x2 w0, w1; w0.x = pk_bf16(x0[0], x0[1]); w0.y = pk_bf16(x0[2], x0[3]); w1.x = pk_bf16(x1[0], x1[1]); w1.y = pk_bf16(x1[2], x1[3]);
                    const auto sx = __builtin_amdgcn_permlane16_swap(w0.x, w1.x, false, false); const auto sy = __builtin_amdgcn_permlane16_swap(w0.y, w1.y, false, false);
                    bf16_t* p = Qm + (size_t)row * 768 + Gi * 32 + ((fq & 1) ? 12 + 4 * fq : 4 * fq);
                    *(u32x4*)p = (u32x4){sx[0], sy[0], sx[1], sy[1]}; } } }
    }
};
struct EpiKV {
    static constexpr bool PERM = true;
    bf16_t *Km, *Vm; const float* ssq;
    __device__ __forceinline__ void operator()(const Acc& acc, const Unit& u, int wr, int wc, int fr, int fq) const {
        const int row0 = u.pm * 256 + wr * 64 + fr;
        float rk8[2][4];
#pragma unroll
        for (int ai = 0; ai < 2; ++ai)
#pragma unroll
            for (int m = 0; m < 4; ++m) { const int row = row0 + ai * 128 + m * 16;
                float sk_; { const f32x4 a = *(const f32x4*)(ssq + (size_t)row * 20 + 12), b4 = *(const f32x4*)(ssq + (size_t)row * 20 + 16); sk_ = ((a[0] + a[1]) + (a[2] + a[3])) + ((b4[0] + b4[1]) + (b4[2] + b4[3])); }
                rk8[ai][m] = __builtin_amdgcn_rsqf(sk_ * (1.f / 256.f) + 1e-6f); }
#pragma unroll
        for (int ai = 0; ai < 2; ++ai)
#pragma unroll
            for (int m = 0; m < 4; ++m) { const bool padrows = (ai == 1 && u.half); if (padrows && u.pn < 2) continue; const int row = row0 + ai * 128 + m * 16;
                if (padrows) {
#pragma unroll
                    for (int bj = 0; bj < 2; ++bj) { const int n = u.pn * 256 + bj * 128 + wc * 32 + 8 * fq; *(u32x4*)(Vm + (size_t)row * 512 + (n - 512)) = (u32x4){0u, 0u, 0u, 0u}; }
                    continue; }
                const float rk = rk8[ai][m];
#pragma unroll
                for (int bj = 0; bj < 2; ++bj) { const int n = u.pn * 256 + bj * 128 + wc * 32 + 8 * fq; const u32x4 w = pack8(acc[ai][bj][m][0] * rk, acc[ai][bj][m][1] * rk);
                    if (u.pn < 2) *(u32x4*)(Km + (size_t)row * 768 + 96 * (n >> 6) + (n & 63)) = w;
                    else *(u32x4*)(Vm + (size_t)row * 512 + (n - 512)) = w; } }
    }
};
__device__ __forceinline__ void store_lines16(bf16_t* rp, int ld, const u32x4& w0, const u32x4& w1, int up) {
    const u32x4 keep = up ? w1 : w0, send = up ? w0 : w1; u32x4 recv;
    recv.x = (unsigned)__builtin_amdgcn_update_dpp(0, (int)send.x, 0x128, 0xf, 0xf, false); recv.y = (unsigned)__builtin_amdgcn_update_dpp(0, (int)send.y, 0x128, 0xf, 0xf, false);
    recv.z = (unsigned)__builtin_amdgcn_update_dpp(0, (int)send.z, 0x128, 0xf, 0xf, false); recv.w = (unsigned)__builtin_amdgcn_update_dpp(0, (int)send.w, 0x128, 0xf, 0xf, false);
    *(u32x4*)rp = up ? recv : keep;
    *(u32x4*)(rp + (size_t)8 * ld) = up ? keep : recv;
}
struct EpiOut {
    static constexpr bool PERM = true;
    const unsigned char* Gm; const unsigned char* Galt; bf16_t* Mg;
    __device__ __forceinline__ void mid(Acc& acc, const Unit& u, int wr, int wc, int fr, int fq) const {
        const unsigned char* G = (u.pm == 128) ? Galt - (size_t)32768 * 2048 : Gm;
        const int row0 = u.pm * 256 + wr * 64 + fr, col0 = u.pn * 256 + wc * 64 + 8 * fq;
#pragma unroll
        for (int ai = 0; ai < 2; ++ai)
#pragma unroll
            for (int m = 0; m < 4; ++m) { if (ai == 1 && u.half) continue; const int row = row0 + ai * 128 + m * 16;
#pragma unroll
                for (int bj = 0; bj < 2; ++bj) { const int col = col0 + bj * 32;
                    const u32x2 gf = *(const u32x2*)(G + (size_t)row * 2048 + col), gm = *(const u32x2*)(G + (size_t)row * 2048 + 1024 + col);
                    f32x4& a = acc[ai][bj][m][0]; f32x4& b = acc[ai][bj][m][1];
#pragma unroll
                    for (int j = 0; j < 4; ++j) { a[j] *= (float)((gf.x >> (8 * j)) & 255u) * __builtin_amdgcn_rcpf((float)((gm.x >> (8 * j)) & 255u)); b[j] *= (float)((gf.y >> (8 * j)) & 255u) * __builtin_amdgcn_rcpf((float)((gm.y >> (8 * j)) & 255u)); } }
                if (m & 1) asm volatile("" ::: "memory"); }
    }
    __device__ __forceinline__ void operator()(const Acc& acc, const Unit& u, int wr, int wc, int fr, int fq) const {
        const unsigned char* G = (u.pm == 128) ? Galt - (size_t)32768 * 2048 : Gm;
        const int row0 = u.pm * 256 + wr * 64 + fr, col0 = u.pn * 256 + wc * 64 + 8 * fq;
        const int fr8 = fr & 7, up = fr >> 3;
        bf16_t* mb = Mg + (size_t)(u.pm * 256 + wr * 64 + fr8) * 1024 + u.pn * 256 + wc * 64 + up * 32 + 8 * fq;
#pragma unroll
        for (int ai = 0; ai < 2; ++ai) { if (ai == 1 && u.half) continue;
            u32x2 g8[4][2];
#pragma unroll
            for (int m = 0; m < 4; ++m)
#pragma unroll
                for (int bj = 0; bj < 2; ++bj) g8[m][bj] = *(const u32x2*)(G + (size_t)(row0 + ai * 128 + m * 16) * 2048 + 1024 + col0 + bj * 32);
            if (ai == 0) asm volatile("" ::: "memory");
#pragma unroll
            for (int m = 0; m < 4; ++m) { u32x4 wv[2];
#pragma unroll
                for (int bj = 0; bj < 2; ++bj) {
                    const u32x2 g = g8[m][bj];
                    f32x4 a = acc[ai][bj][m][0], b = acc[ai][bj][m][1];
#pragma unroll
                    for (int j = 0; j < 4; ++j) { a[j] *= (float)((g.x >> (8 * j)) & 255u) * (1.0f / 255.0f); b[j] *= (float)((g.y >> (8 * j)) & 255u) * (1.0f / 255.0f); }
                    wv[bj] = pack8(a, b); }
                store_lines16(mb + (size_t)(ai * 128 + m * 16) * 1024, 1024, wv[0], wv[1], up); } }
    }
};
struct EpiF {
    static constexpr bool PERM = true;
    const bf16_t* H; bf16_t* Z;
    __device__ __forceinline__ void operator()(const Acc& acc, const Unit& u, int wr, int wc, int fr, int fq) const {
        const int row0 = u.pm * 256 + wr * 64 + fr, col0 = u.pn * 256 + wc * 64 + 8 * fq;
        const int fr8 = fr & 7, up = fr >> 3;
        bf16_t* zb = Z + (size_t)(u.pm * 256 + wr * 64 + fr8) * 1024 + u.pn * 256 + wc * 64 + up * 32 + 8 * fq;
#pragma unroll
        for (int ai = 0; ai < 2; ++ai) { if (ai == 1 && u.half) continue;
            u32x4 h8[4][2];
#pragma unroll
            for (int m = 0; m < 4; ++m)
#pragma unroll
                for (int bj = 0; bj < 2; ++bj) h8[m][bj] = *(const u32x4*)(H + (size_t)(row0 + ai * 128 + m * 16) * 1024 + col0 + bj * 32);
#pragma unroll
            for (int m = 0; m < 4; ++m) { u32x4 wv[2];
#pragma unroll
                for (int bj = 0; bj < 2; ++bj) { const u32x4 hv = h8[m][bj]; f32x4 a = acc[ai][bj][m][0], b = acc[ai][bj][m][1];
                    a[0] += ALPHA * bf_lo(hv.x); a[1] += ALPHA * bf_hi(hv.x); a[2] += ALPHA * bf_lo(hv.y); a[3] += ALPHA * bf_hi(hv.y);
                    b[0] += ALPHA * bf_lo(hv.z); b[1] += ALPHA * bf_hi(hv.z); b[2] += ALPHA * bf_lo(hv.w); b[3] += ALPHA * bf_hi(hv.w);
                    wv[bj] = pack8(a, b); }
                store_lines16(zb + (size_t)(ai * 128 + m * 16) * 1024, 1024, wv[0], wv[1], up); } }
    }
};
struct EpiM1 {
    static constexpr bool PERM = true;
    bf16_t* Hid; const float* h1s; const unsigned* cm; const LAS int* tb; const LAS int* cnt; const int* list;
    __device__ __forceinline__ void operator()(const Acc& acc, const Unit& u, int wr, int wc, int fr, int fq) const {
        const int row0 = u.pm * 256 + wr * 64 + fr, hc0 = u.pn * 128 + wc * 32 + 8 * fq;
        const int e = u.aux; const unsigned* cme = cm + e * 512 + u.pn * 256 + wc * 32 + 8 * fq;
        f32x4 sg[2], su[2];
#pragma unroll
        for (int n = 0; n < 2; ++n) { sg[n] = cmscale(cme + 4 * n); su[n] = cmscale(cme + 128 + 4 * n); }
        const int ce = cnt[e], tl = (u.pm - tb[e]) * 256;
        int tk8[2][4]; float sa8[2][4];
#pragma unroll
        for (int ai = 0; ai < 2; ++ai)
#pragma unroll
            for (int m = 0; m < 4; ++m) { int idx = tl + wr * 64 + fr + ai * 128 + m * 16; idx = idx < ce ? idx : ce - 1; tk8[ai][m] = list[(size_t)e * TP + idx]; }
#pragma unroll
        for (int ai = 0; ai < 2; ++ai)
#pragma unroll
            for (int m = 0; m < 4; ++m) sa8[ai][m] = h1s[tk8[ai][m]];
#pragma unroll
        for (int ai = 0; ai < 2; ++ai)
#pragma unroll
            for (int m = 0; m < 4; ++m) { if (ai == 1 && u.half) continue; bf16_t* rowp = Hid + (size_t)(row0 + ai * 128 + m * 16) * 256 + hc0;
                const float sa = sa8[ai][m]; f32x4 o[2];
#pragma unroll
                for (int n = 0; n < 2; ++n) { const f32x4 g = dq4(acc[ai][0][m][n], sa, sg[n]), up = dq4(acc[ai][1][m][n], sa, su[n]);
#pragma unroll
                    for (int j = 0; j < 4; ++j) o[n][j] = g[j] * sigm(g[j]) * up[j]; }
                *(u32x4*)rowp = pack8(o[0], o[1]); }
    }
};
struct EpiM2 {
    static constexpr bool PERM = true;
    bf16_t* Ys;
    __device__ __forceinline__ void operator()(const Acc& acc, const Unit& u, int wr, int wc, int fr, int fq) const {
        const int fr8 = fr & 7, up = fr >> 3;
        bf16_t* base = Ys + (size_t)(u.pm * 256 + wr * 64 + fr8) * 1024 + u.pn * 256 + wc * 64 + up * 32 + 8 * fq;
#pragma unroll
        for (int ai = 0; ai < 2; ++ai)
#pragma unroll
            for (int m = 0; m < 4; ++m) { if (ai == 1 && u.half) continue;
                const u32x4 w0 = pack8(acc[ai][0][m][0], acc[ai][0][m][1]), w1 = pack8(acc[ai][1][m][0], acc[ai][1][m][1]);
                const u32x4 keep = up ? w1 : w0, send = up ? w0 : w1; u32x4 recv;
                recv.x = (unsigned)__builtin_amdgcn_update_dpp(0, (int)send.x, 0x128, 0xf, 0xf, false); recv.y = (unsigned)__builtin_amdgcn_update_dpp(0, (int)send.y, 0x128, 0xf, 0xf, false);
                recv.z = (unsigned)__builtin_amdgcn_update_dpp(0, (int)send.z, 0x128, 0xf, 0xf, false); recv.w = (unsigned)__builtin_amdgcn_update_dpp(0, (int)send.w, 0x128, 0xf, 0xf, false);
                bf16_t* rp = base + (size_t)(ai * 128 + m * 16) * 1024;
                *(u32x4*)rp = up ? recv : keep;
                *(u32x4*)(rp + 8 * 1024) = up ? keep : recv; }
    }
};
}

__device__ __forceinline__ int crow(int r, int hi) { return (r & 3) + 8 * (r >> 2) + 4 * hi; }
typedef short v4i16_t __attribute__((ext_vector_type(4)));
__device__ __forceinline__ s16x4 vtr(const LAS char* p) { return __builtin_bit_cast(s16x4, __builtin_amdgcn_ds_read_tr16_b64_v4i16((LAS v4i16_t*)p)); }
template <int OFF> __device__ __forceinline__ s16x4 vtr_a(unsigned a) { s16x4 r; asm volatile("ds_read_b64_tr_b16 %0, %1 offset:%2" : "=v"(r) : "v"(a), "n"(OFF)); return r; }
#define VTR_WAIT(A, B, C, D) do { \
    asm volatile("s_waitcnt lgkmcnt(0)" : "+v"(A[0]), "+v"(A[1]), "+v"(A[2]), "+v"(A[3]), "+v"(B[0]), "+v"(B[1]), "+v"(B[2]), "+v"(B[3])); \
    asm volatile("" : "+v"(C[0]), "+v"(C[1]), "+v"(C[2]), "+v"(C[3]), "+v"(D[0]), "+v"(D[1]), "+v"(D[2]), "+v"(D[3])); } while (0)
__device__ __forceinline__ float swapmax(float m) { auto rr = __builtin_amdgcn_permlane32_swap(__float_as_uint(m), __float_as_uint(m), false, false); return fmaxf(__uint_as_float(rr[0]), __uint_as_float(rr[1])); }
__device__ __forceinline__ float swapsum(float m) { auto rr = __builtin_amdgcn_permlane32_swap(__float_as_uint(m), __float_as_uint(m), false, false); return __uint_as_float(rr[0]) + __uint_as_float(rr[1]); }

template <int DK, bool FOX>
__device__ __forceinline__ void attn_unit8(LAS char* lds, const bf16_t* Q, int ldq, const bf16_t* Kp, int ldk, const bf16_t* Vp, int ldv, bf16_t* O, int ldo,
                                           const float* cs, int b, int j, int tau_min, unsigned* qnext, unsigned& ticket, const bf16_t* K2 = nullptr) {
    constexpr int NS = DK / 16, KB = 64 * DK * 2, SB = KB + 8192 + 256;
    constexpr float THR = 8.0f;
    int tid_l = threadIdx.x; asm volatile("" : "+v"(tid_l));
    const int tid = tid_l, lane = tid & 63, r32 = lane & 31, hi = lane >> 5; const int wid = __builtin_amdgcn_readfirstlane(tid >> 6);
    const int qp0 = (j == 0) ? 0 : 16 + 256 * (j - 1) + 32 * wid;
    const int qpos = qp0 + r32;
    const size_t qrow = (j == 0) ? (size_t)(NREAL + NMETA * b + r32) : (size_t)(SEQ * b + 256 * (j - 1) + 32 * wid + r32);
    const size_t mrow0 = (size_t)(NREAL + NMETA * b), rrow0 = (size_t)SEQ * b;
    const bool wave_on = (j > 0) || (wid == 0);
    const int tdiag = wave_on ? ((j == 0) ? 0 : 4 * (j - 1) + 1 + (wid >> 1)) : -1;
    const int qin = (j == 0) ? r32 : 32 * (wid & 1) + r32;
    const int NT = 4 * j + 1;
    bf16x8 qf[NS];
#pragma unroll
    for (int s = 0; s < NS; ++s) qf[s] = *(const bf16x8*)(Q + qrow * ldq + 16 * s + 8 * hi);
    float csq = 0.f; if (FOX) csq = cs[qpos];
    const bf16_t* kg = Kp + (size_t)lane * ldk + 8 * wid;
    const bf16_t* kg2 = (DK == 96) ? K2 + (size_t)lane * 32 + 8 * (wid & 3) : Kp;
    const bf16_t* vg = Vp + (size_t)(16 * (wid & 3) + 8 * (lane >> 5) + ((lane >> 2) & 7)) * ldv + 32 * (wid >> 2) + 8 * (lane & 3);
    const int nops = 2 + ((DK == 96) ? (wid < 4 ? 1 : 0) : (FOX ? (wid == 4 ? 1 : 0) : 0));
#define ATT_ISSUE(t, slot) do { const int ts_ = ((t) == 0) ? 0 : 64 * (t) - 48; const size_t tr_ = ((t) == 0) ? mrow0 : rrow0 + 64 * ((t) - 1); LAS char* sb_ = lds + (slot) * SB; \
        __builtin_amdgcn_global_load_lds((const unsigned*)(kg + tr_ * ldk), (LAS unsigned*)(sb_ + wid * 1024), 16, 0, 0); \
        __builtin_amdgcn_global_load_lds((const unsigned*)(vg + tr_ * ldv), (LAS unsigned*)(sb_ + KB + (wid >> 2) * 4096 + (wid & 3) * 1024), 16, 0, 0); \
        if (DK == 96) { if (wid < 4) __builtin_amdgcn_global_load_lds((const unsigned*)(kg2 + tr_ * 32), (LAS unsigned*)(sb_ + (8 + wid) * 1024), 16, 0, 0); } \
        else if (FOX) { if (wid == 4) { if (lane < 16) __builtin_amdgcn_global_load_lds((const unsigned*)(cs + ts_ + 4 * lane), (LAS unsigned*)(sb_ + KB + 8192), 16, 0, 0); } } } while (0)
    int t = NT - 1;
    int slot = 0;
    ATT_ISSUE(t, 0);
    if (t - 1 >= tau_min) ATT_ISSUE(t - 1, 1);
    float mhat = 0.f, lrun = 0.f;
    f32x16 o0 = {}, o1 = {};
    const int vlane = ((lane >> 4) & 1) * 32 + (lane & 3) * 8 + (4 * hi + ((lane & 15) >> 2)) * 64;
    for (; t > tdiag && t >= tau_min; --t) {
        if (t - 1 >= tau_min) { if (nops == 3) asm volatile("s_waitcnt vmcnt(3)" ::: "memory"); else asm volatile("s_waitcnt vmcnt(2)" ::: "memory"); }
        else asm volatile("s_waitcnt vmcnt(0)" ::: "memory");
        __builtin_amdgcn_s_barrier(); asm volatile("" ::: "memory");
        { const int s2 = (slot >= 1) ? slot - 1 : 2; if (t - 2 >= tau_min) ATT_ISSUE(t - 2, s2); }
        const LAS char* cb = lds + slot * SB; (void)cb;
        slot = (slot == 2) ? 0 : slot + 1;
    }
    if (t >= tau_min) {
        if (t - 1 >= tau_min) { if (nops == 3) asm volatile("s_waitcnt vmcnt(3)" ::: "memory"); else asm volatile("s_waitcnt vmcnt(2)" ::: "memory"); }
        else asm volatile("s_waitcnt vmcnt(0)" ::: "memory");
        __builtin_amdgcn_s_barrier(); asm volatile("" ::: "memory");
        const LAS char* cb = lds + slot * SB; (void)cb;
        {
            f32x16 p0, p1;
            if (FOX) {
                const LAS float* cl = (const LAS float*)(cb + KB + 8192); const float base = csq - mhat;
#pragma unroll
                for (int g = 0; g < 4; ++g) { const f32x4 c0 = *(const LAS f32x4*)(cl + 8 * g + 4 * hi), c1 = *(const LAS f32x4*)(cl + 32 + 8 * g + 4 * hi);
#pragma unroll
                    for (int jj = 0; jj < 4; ++jj) { p0[4 * g + jj] = base - c0[jj]; p1[4 * g + jj] = base - c1[jj]; } }
            } else {
                const float nm = -mhat;
#pragma unroll
                for (int r = 0; r < 16; ++r) { p0[r] = nm; p1[r] = nm; }
            }
            bf16x8 ka[NS][2];
#pragma unroll
            for (int s = 0; s < NS; ++s) { const int c = 2 * s + hi; ka[s][0] = *(const LAS bf16x8*)(cb + c * 1024 + r32 * 16); ka[s][1] = *(const LAS bf16x8*)(cb + c * 1024 + 512 + r32 * 16); }
            __builtin_amdgcn_sched_barrier(0);
#pragma unroll
            for (int s = 0; s < NS; ++s) { p0 = __builtin_amdgcn_mfma_f32_32x32x16_bf16(ka[s][0], qf[s], p0, 0, 0, 0); p1 = __builtin_amdgcn_mfma_f32_32x32x16_bf16(ka[s][1], qf[s], p1, 0, 0, 0); }
            __builtin_amdgcn_sched_barrier(0);
            const unsigned vb = (unsigned)(size_t)(cb + KB + vlane);
            s16x4 vl0[4], vh0[4], vl1[4], vh1[4];
            vl0[0] = vtr_a<0>(vb); vh0[0] = vtr_a<512>(vb); vl1[0] = vtr_a<4096>(vb); vh1[0] = vtr_a<4608>(vb);
            vl0[1] = vtr_a<1024>(vb); vh0[1] = vtr_a<1536>(vb); vl1[1] = vtr_a<5120>(vb); vh1[1] = vtr_a<5632>(vb);
            vl0[2] = vtr_a<2048>(vb); vh0[2] = vtr_a<2560>(vb); vl1[2] = vtr_a<6144>(vb); vh1[2] = vtr_a<6656>(vb);
            vl0[3] = vtr_a<3072>(vb); vh0[3] = vtr_a<3584>(vb); vl1[3] = vtr_a<7168>(vb); vh1[3] = vtr_a<7680>(vb);
            __builtin_amdgcn_sched_barrier(0);
            if (t == tdiag) {
#pragma unroll
                for (int r = 0; r < 16; ++r) { const int kv = 4 * hi + (r & 3) + 8 * (r >> 2); if (kv > qin) p0[r] = -INFINITY; if (kv + 32 > qin) p1[r] = -INFINITY; }
            }
            if (t == 0) {
#pragma unroll
                for (int r = 0; r < 16; ++r) { const int kv = 4 * hi + (r & 3) + 8 * (r >> 2); if (kv >= 16) p0[r] = -INFINITY; p1[r] = -INFINITY; }
            }
            float mt;
            { float ma = __builtin_fmaxf(__builtin_fmaxf(p0[0], p0[1]), p1[0]), mb = __builtin_fmaxf(__builtin_fmaxf(p0[2], p0[3]), p1[1]); ma = __builtin_fmaxf(__builtin_fmaxf(ma, p1[2]), p1[3]);
#pragma unroll
              for (int r = 4; r < 16; r += 4) { ma = __builtin_fmaxf(__builtin_fmaxf(ma, p0[r]), p0[r + 1]); mb = __builtin_fmaxf(__builtin_fmaxf(mb, p0[r + 2]), p0[r + 3]); ma = __builtin_fmaxf(__builtin_fmaxf(ma, p1[r]), p1[r + 1]); mb = __builtin_fmaxf(__builtin_fmaxf(mb, p1[r + 2]), p1[r + 3]); }
              mt = __builtin_fmaxf(ma, mb); }
            mt = swapmax(mt);
            { mhat = mt;
#pragma unroll
              for (int r = 0; r < 16; ++r) { p0[r] -= mt; p1[r] -= mt; } }
#pragma unroll
            for (int r = 0; r < 16; ++r) p0[r] = __builtin_amdgcn_exp2f(p0[r]);
            bf16x8 pb[4];
#pragma unroll
            for (int s = 0; s < 2; ++s) {
                u32x4 w; w.x = pk_bf16(p0[8 * s], p0[8 * s + 1]); w.y = pk_bf16(p0[8 * s + 2], p0[8 * s + 3]); w.z = pk_bf16(p0[8 * s + 4], p0[8 * s + 5]); w.w = pk_bf16(p0[8 * s + 6], p0[8 * s + 7]);
                pb[s] = __builtin_bit_cast(bf16x8, w); }
            __builtin_amdgcn_sched_barrier(0);
            VTR_WAIT(vl0, vh0, vl1, vh1);
            __builtin_amdgcn_sched_barrier(0);
#pragma unroll
            for (int ks = 0; ks < 2; ++ks) {
                const bf16x8 a0 = (bf16x8){vl0[ks][0], vl0[ks][1], vl0[ks][2], vl0[ks][3], vh0[ks][0], vh0[ks][1], vh0[ks][2], vh0[ks][3]};
                const bf16x8 a1 = (bf16x8){vl1[ks][0], vl1[ks][1], vl1[ks][2], vl1[ks][3], vh1[ks][0], vh1[ks][1], vh1[ks][2], vh1[ks][3]};
                o0 = __builtin_amdgcn_mfma_f32_32x32x16_bf16(a0, pb[ks], o0, 0, 0, 0);
                o1 = __builtin_amdgcn_mfma_f32_32x32x16_bf16(a1, pb[ks], o1, 0, 0, 0);
            }
            __builtin_amdgcn_sched_barrier(0);
#pragma unroll
            for (int r = 0; r < 16; ++r) p1[r] = __builtin_amdgcn_exp2f(p1[r]);
            { f32x2_t sa = {p0[0], p0[1]}, sb2 = {p1[0], p1[1]};
#pragma unroll
              for (int r = 2; r < 16; r += 2) { sa += (f32x2_t){p0[r], p0[r + 1]}; sb2 += (f32x2_t){p1[r], p1[r + 1]}; }
              sa += sb2; lrun += sa[0] + sa[1]; }
#pragma unroll
            for (int s = 0; s < 2; ++s) {
                u32x4 w2; w2.x = pk_bf16(p1[8 * s], p1[8 * s + 1]); w2.y = pk_bf16(p1[8 * s + 2], p1[8 * s + 3]); w2.z = pk_bf16(p1[8 * s + 4], p1[8 * s + 5]); w2.w = pk_bf16(p1[8 * s + 6], p1[8 * s + 7]);
                pb[2 + s] = __builtin_bit_cast(bf16x8, w2); }
            __builtin_amdgcn_sched_barrier(0);
#pragma unroll
            for (int ks = 2; ks < 4; ++ks) {
                const bf16x8 a0 = (bf16x8){vl0[ks][0], vl0[ks][1], vl0[ks][2], vl0[ks][3], vh0[ks][0], vh0[ks][1], vh0[ks][2], vh0[ks][3]};
                const bf16x8 a1 = (bf16x8){vl1[ks][0], vl1[ks][1], vl1[ks][2], vl1[ks][3], vh1[ks][0], vh1[ks][1], vh1[ks][2], vh1[ks][3]};
                o0 = __builtin_amdgcn_mfma_f32_32x32x16_bf16(a0, pb[ks], o0, 0, 0, 0);
                o1 = __builtin_amdgcn_mfma_f32_32x32x16_bf16(a1, pb[ks], o1, 0, 0, 0);
            }
            __builtin_amdgcn_sched_barrier(0);
            { const int s2 = (slot >= 1) ? slot - 1 : 2; if (t - 2 >= tau_min) ATT_ISSUE(t - 2, s2); }
        }
        slot = (slot == 2) ? 0 : slot + 1;
        --t;
    }
    for (; t >= tau_min; --t) {
        if (t - 1 >= tau_min) { if (nops == 3) asm volatile("s_waitcnt vmcnt(3)" ::: "memory"); else asm volatile("s_waitcnt vmcnt(2)" ::: "memory"); }
        else asm volatile("s_waitcnt vmcnt(0)" ::: "memory");
        __builtin_amdgcn_s_barrier(); asm volatile("" ::: "memory");
        const LAS char* cb = lds + slot * SB; (void)cb;
        {
            f32x16 p0, p1;
            if (FOX) {
                const LAS float* cl = (const LAS float*)(cb + KB + 8192); const float base = csq - mhat;
#pragma unroll
                for (int g = 0; g < 4; ++g) { const f32x4 c0 = *(const LAS f32x4*)(cl + 8 * g + 4 * hi), c1 = *(const LAS f32x4*)(cl + 32 + 8 * g + 4 * hi);
#pragma unroll
                    for (int jj = 0; jj < 4; ++jj) { p0[4 * g + jj] = base - c0[jj]; p1[4 * g + jj] = base - c1[jj]; } }
            } else {
                const float nm = -mhat;
#pragma unroll
                for (int r = 0; r < 16; ++r) { p0[r] = nm; p1[r] = nm; }
            }
            bf16x8 ka[NS][2];
#pragma unroll
            for (int s = 0; s < NS; ++s) { const int c = 2 * s + hi; ka[s][0] = *(const LAS bf16x8*)(cb + c * 1024 + r32 * 16); ka[s][1] = *(const LAS bf16x8*)(cb + c * 1024 + 512 + r32 * 16); }
            __builtin_amdgcn_sched_barrier(0);
#pragma unroll
            for (int s = 0; s < NS; ++s) { p0 = __builtin_amdgcn_mfma_f32_32x32x16_bf16(ka[s][0], qf[s], p0, 0, 0, 0); p1 = __builtin_amdgcn_mfma_f32_32x32x16_bf16(ka[s][1], qf[s], p1, 0, 0, 0); }
            __builtin_amdgcn_sched_barrier(0);
            const unsigned vb = (unsigned)(size_t)(cb + KB + vlane);
            s16x4 vl0[4], vh0[4], vl1[4], vh1[4];
            vl0[0] = vtr_a<0>(vb); vh0[0] = vtr_a<512>(vb); vl1[0] = vtr_a<4096>(vb); vh1[0] = vtr_a<4608>(vb);
            vl0[1] = vtr_a<1024>(vb); vh0[1] = vtr_a<1536>(vb); vl1[1] = vtr_a<5120>(vb); vh1[1] = vtr_a<5632>(vb);
            vl0[2] = vtr_a<2048>(vb); vh0[2] = vtr_a<2560>(vb); vl1[2] = vtr_a<6144>(vb); vh1[2] = vtr_a<6656>(vb);
            vl0[3] = vtr_a<3072>(vb); vh0[3] = vtr_a<3584>(vb); vl1[3] = vtr_a<7168>(vb); vh1[3] = vtr_a<7680>(vb);
            __builtin_amdgcn_sched_barrier(0);
            if (t == tdiag) {
#pragma unroll
                for (int r = 0; r < 16; ++r) { const int kv = 4 * hi + (r & 3) + 8 * (r >> 2); if (kv > qin) p0[r] = -INFINITY; if (kv + 32 > qin) p1[r] = -INFINITY; }
            }
            if (t == 0) {
#pragma unroll
                for (int r = 0; r < 16; ++r) { const int kv = 4 * hi + (r & 3) + 8 * (r >> 2); if (kv >= 16) p0[r] = -INFINITY; p1[r] = -INFINITY; }
            }
            float mt;
            { float ma = __builtin_fmaxf(__builtin_fmaxf(p0[0], p0[1]), p1[0]), mb = __builtin_fmaxf(__builtin_fmaxf(p0[2], p0[3]), p1[1]); ma = __builtin_fmaxf(__builtin_fmaxf(ma, p1[2]), p1[3]);
#pragma unroll
              for (int r = 4; r < 16; r += 4) { ma = __builtin_fmaxf(__builtin_fmaxf(ma, p0[r]), p0[r + 1]); mb = __builtin_fmaxf(__builtin_fmaxf(mb, p0[r + 2]), p0[r + 3]); ma = __builtin_fmaxf(__builtin_fmaxf(ma, p1[r]), p1[r + 1]); mb = __builtin_fmaxf(__builtin_fmaxf(mb, p1[r + 2]), p1[r + 3]); }
              mt = __builtin_fmaxf(ma, mb); }
            mt = swapmax(mt);
            if (__any(mt > THR)) {
                const float dl = fmaxf(mt, 0.f); mhat += dl; const float f = __builtin_amdgcn_exp2f(-dl); lrun *= f;
#pragma unroll
                for (int r = 0; r < 16; ++r) { p0[r] -= dl; p1[r] -= dl; asm volatile("v_mul_f32 %0, %0, %1" : "+v"(o0[r]) : "v"(f)); asm volatile("v_mul_f32 %0, %0, %1" : "+v"(o1[r]) : "v"(f)); }
            }
#pragma unroll
            for (int r = 0; r < 16; ++r) p0[r] = __builtin_amdgcn_exp2f(p0[r]);
            bf16x8 pb[4];
#pragma unroll
            for (int s = 0; s < 2; ++s) {
                u32x4 w; w.x = pk_bf16(p0[8 * s], p0[8 * s + 1]); w.y = pk_bf16(p0[8 * s + 2], p0[8 * s + 3]); w.z = pk_bf16(p0[8 * s + 4], p0[8 * s + 5]); w.w = pk_bf16(p0[8 * s + 6], p0[8 * s + 7]);
                pb[s] = __builtin_bit_cast(bf16x8, w); }
            __builtin_amdgcn_sched_barrier(0);
            VTR_WAIT(vl0, vh0, vl1, vh1);
            __builtin_amdgcn_sched_barrier(0);
#pragma unroll
            for (int ks = 0; ks < 2; ++ks) {
                const bf16x8 a0 = (bf16x8){vl0[ks][0], vl0[ks][1], vl0[ks][2], vl0[ks][3], vh0[ks][0], vh0[ks][1], vh0[ks][2], vh0[ks][3]};
                const bf16x8 a1 = (bf16x8){vl1[ks][0], vl1[ks][1], vl1[ks][2], vl1[ks][3], vh1[ks][0], vh1[ks][1], vh1[ks][2], vh1[ks][3]};
                o0 = __builtin_amdgcn_mfma_f32_32x32x16_bf16(a0, pb[ks], o0, 0, 0, 0);
                o1 = __builtin_amdgcn_mfma_f32_32x32x16_bf16(a1, pb[ks], o1, 0, 0, 0);
            }
            __builtin_amdgcn_sched_barrier(0);
#pragma unroll
            for (int r = 0; r < 16; ++r) p1[r] = __builtin_amdgcn_exp2f(p1[r]);
            { f32x2_t sa = {p0[0], p0[1]}, sb2 = {p1[0], p1[1]};
#pragma unroll
              for (int r = 2; r < 16; r += 2) { sa += (f32x2_t){p0[r], p0[r + 1]}; sb2 += (f32x2_t){p1[r], p1[r + 1]}; }
              sa += sb2; lrun += sa[0] + sa[1]; }
#pragma unroll
            for (int s = 0; s < 2; ++s) {
                u32x4 w2; w2.x = pk_bf16(p1[8 * s], p1[8 * s + 1]); w2.y = pk_bf16(p1[8 * s + 2], p1[8 * s + 3]); w2.z = pk_bf16(p1[8 * s + 4], p1[8 * s + 5]); w2.w = pk_bf16(p1[8 * s + 6], p1[8 * s + 7]);
                pb[2 + s] = __builtin_bit_cast(bf16x8, w2); }
            __builtin_amdgcn_sched_barrier(0);
#pragma unroll
            for (int ks = 2; ks < 4; ++ks) {
                const bf16x8 a0 = (bf16x8){vl0[ks][0], vl0[ks][1], vl0[ks][2], vl0[ks][3], vh0[ks][0], vh0[ks][1], vh0[ks][2], vh0[ks][3]};
                const bf16x8 a1 = (bf16x8){vl1[ks][0], vl1[ks][1], vl1[ks][2], vl1[ks][3], vh1[ks][0], vh1[ks][1], vh1[ks][2], vh1[ks][3]};
                o0 = __builtin_amdgcn_mfma_f32_32x32x16_bf16(a0, pb[ks], o0, 0, 0, 0);
                o1 = __builtin_amdgcn_mfma_f32_32x32x16_bf16(a1, pb[ks], o1, 0, 0, 0);
            }
            __builtin_amdgcn_sched_barrier(0);
            { const int s2 = (slot >= 1) ? slot - 1 : 2; if (t - 2 >= tau_min) ATT_ISSUE(t - 2, s2); }
        }
        slot = (slot == 2) ? 0 : slot + 1;
    }
#undef ATT_ISSUE
    if (threadIdx.x == 0) ticket = __hip_atomic_fetch_add(qnext, 1u, RLX_AGENT);
    if (wave_on) {
        const float lt = swapsum(lrun);
        const float inv = 1.0f / lt;
        u32x4 st[2][2];
#pragma unroll
        for (int hf = 0; hf < 2; ++hf)
#pragma unroll
            for (int gp = 0; gp < 2; ++gp) { const int g = 2 * gp; const f32x16& oo = hf ? o1 : o0;
                const unsigned ax = pk_bf16(oo[4 * g] * inv, oo[4 * g + 1] * inv), ay = pk_bf16(oo[4 * g + 2] * inv, oo[4 * g + 3] * inv);
                const unsigned bx = pk_bf16(oo[4 * g + 4] * inv, oo[4 * g + 5] * inv), by = pk_bf16(oo[4 * g + 6] * inv, oo[4 * g + 7] * inv);
                const auto sx = __builtin_amdgcn_permlane32_swap(ax, bx, false, false); const auto sy = __builtin_amdgcn_permlane32_swap(ay, by, false, false);
                st[hf][gp] = (u32x4){sx[0], sy[0], sx[1], sy[1]}; }
        if (j > 0 || r32 < 16) {
            bf16_t* op = O + qrow * ldo + 8 * hi;
#pragma unroll
            for (int hf = 0; hf < 2; ++hf)
#pragma unroll
                for (int gp = 0; gp < 2; ++gp) *(u32x4*)(op + 32 * hf + 16 * gp) = st[hf][gp];
        }
    }
    asm volatile("s_waitcnt lgkmcnt(0)" ::: "memory");
    __builtin_amdgcn_s_barrier(); asm volatile("" ::: "memory");
}

struct Args { const float* in[22]; float* out; unsigned char* ws; };
struct Frame {
    LAS unsigned char* lds; volatile LAS unsigned* MISC; unsigned* ctl;
    int tid, lane, wave, vcu, G;
};

template <int QM>
__device__ __forceinline__ void tr_item(const float* colp, int ld, const float* kscale, void* dstv, int K, int n0, int k0, LAS float* scr, int lane, unsigned* cmax) {
    float am = 0.f;
#pragma unroll
    for (int i = 0; i < 32; ++i) { const int kk = 2 * i + (lane >> 5); float v = colp ? colp[(size_t)(k0 + kk) * ld] : 0.f; if (kscale) v *= kscale[k0 + kk];
        if (QM == 1) am = fmaxf(am, fabsf(v)); else scr[kk * 33 + (lane & 31)] = v; }
    if (QM == 1) { am = fmaxf(am, __shfl_xor(am, 32)); if (lane < 32) __hip_atomic_fetch_max(cmax + n0 + lane, __float_as_uint(am), RLX_AGENT); return; }
    LDS_WAIT(); asm volatile("" ::: "memory");
    const int c = lane & 7;
#pragma unroll
    for (int j = 0; j < 4; ++j) { const int n = (lane >> 3) + 8 * j; const LAS float* s = scr + (8 * c) * 33 + n;
        if (QM == 0) { bf16_t* dst = (bf16_t*)dstv;
            u32x4 o; o.x = pk_bf16(s[0 * 33], s[1 * 33]); o.y = pk_bf16(s[2 * 33], s[3 * 33]); o.z = pk_bf16(s[4 * 33], s[5 * 33]); o.w = pk_bf16(s[6 * 33], s[7 * 33]);
            *(u32x4*)(dst + (size_t)(n0 + n) * K + k0 + 8 * c) = o; }
        else { unsigned char* dst = (unsigned char*)dstv; const float cm = __uint_as_float(cmax[n0 + n]); const float inv = cm > 0.f ? 127.0f / cm : 0.f;
            unsigned q[8];
#pragma unroll
            for (int i = 0; i < 8; ++i) q[i] = (unsigned)(int)rintf(s[i * 33] * inv) & 255u;
            u32x2 o; o.x = q[0] | (q[1] << 8) | (q[2] << 16) | (q[3] << 24); o.y = q[4] | (q[5] << 8) | (q[6] << 16) | (q[7] << 24);
            *(u32x2*)(dst + (size_t)(n0 + n) * K + k0 + 8 * c) = o; } }
    LDS_WAIT(); asm volatile("" ::: "memory");
}
__device__ __forceinline__ void quant_strip(const float* colp, bool valid, int ld, unsigned char* dst, int n0, LAS float* scr, LAS float* part, unsigned* cm_out, int wave, int lane) {
    float v[2][32]; float am = 0.f;
    { const float* pp = colp + (size_t)(wave * 128 + (lane >> 5)) * ld; const size_t st2 = (size_t)2 * ld;
#pragma unroll
      for (int sidx = 0; sidx < 2; ++sidx)
#pragma unroll
        for (int i = 0; i < 32; ++i) { v[sidx][i] = *pp; pp += st2; asm volatile("" : "+v"(pp)); } }
    if (!valid) {
#pragma unroll
      for (int sidx = 0; sidx < 2; ++sidx)
#pragma unroll
        for (int i = 0; i < 32; ++i) v[sidx][i] = 0.f; }
#pragma unroll
    for (int sidx = 0; sidx < 2; ++sidx)
#pragma unroll
        for (int i = 0; i < 32; ++i) am = fmaxf(am, fabsf(v[sidx][i]));
    am = fmaxf(am, __shfl_xor(am, 32));
    if (lane < 32) part[wave * 32 + lane] = am;
    __syncthreads();
    float cmx = part[lane & 31];
#pragma unroll
    for (int w = 1; w < 8; ++w) cmx = fmaxf(cmx, part[w * 32 + (lane & 31)]);
    if (wave == 0 && lane < 32) cm_out[n0 + lane] = __float_as_uint(cmx);
    float inv4[4];
#pragma unroll
    for (int j = 0; j < 4; ++j) { const float c = __shfl(cmx, (lane >> 3) + 8 * j); inv4[j] = c > 0.f ? 127.0f / c : 0.f; }
    const int c = lane & 7;
#pragma unroll
    for (int sidx = 0; sidx < 2; ++sidx) {
#pragma unroll
        for (int i = 0; i < 32; ++i) scr[(2 * i + (lane >> 5)) * 33 + (lane & 31)] = v[sidx][i];
        LDS_WAIT(); asm volatile("" ::: "memory");
#pragma unroll
        for (int j = 0; j < 4; ++j) { const int n = (lane >> 3) + 8 * j; const LAS float* sp = scr + (8 * c) * 33 + n;
            unsigned q[8];
#pragma unroll
            for (int i = 0; i < 8; ++i) q[i] = (unsigned)(int)rintf(sp[i * 33] * inv4[j]) & 255u;
            u32x2 o; o.x = q[0] | (q[1] << 8) | (q[2] << 16) | (q[3] << 24); o.y = q[4] | (q[5] << 8) | (q[6] << 16) | (q[7] << 24);
            *(u32x2*)(dst + (size_t)(n0 + n) * 1024 + wave * 128 + sidx * 64 + 8 * c) = o; }
        LDS_WAIT(); asm volatile("" ::: "memory");
    }
    __syncthreads();
}
constexpr int STRIPS_PER_LAYER = 392;
__device__ __forceinline__ void strip_item(const Args& a, bf16_t* W, unsigned* cm, int l, int sidx, LAS float* scr, LAS float* part, int wave, int lane) {
    const int w = lane & 31;
    if (sidx < 72) { const int nb = sidx, n = nb * 32 + w; int col;
        if (n < 1536) col = n; else { const int j = n - 1536; col = j < 384 ? 1544 + j : j < 640 ? 1928 + (j - 384) : j < 672 ? 2184 + (16 * (((j - 640) >> 2) & 1) + 4 * ((j - 640) >> 3) + ((j - 640) & 3)) : j < 680 ? 1536 + (j - 672) : -1; }
        const float* src = a.in[4] + (size_t)l * 1024 * 4264;
        quant_strip(src + (col >= 0 ? col : 0), col >= 0, 4264, (unsigned char*)(W + W_BT1), nb * 32, scr, part, cm, wave, lane); return; }
    sidx -= 72;
    if (sidx < 64) { const int nb = sidx, n = (nb >> 3) * 256 + 64 * (nb & 3) + 16 * (w >> 3) + 8 * ((nb >> 2) & 1) + (w & 7); const float* src = a.in[4] + (size_t)l * 1024 * 4264;
        quant_strip(src + 2216 + n, true, 4264, (unsigned char*)(W + W_BT1), 2304 + nb * 32, scr, part, cm, wave, lane); return; }
    sidx -= 64;
    { const int e = sidx >> 4, nb = sidx & 15;
      const float* src = (((nb >> 2) & 1) ? a.in[18] : a.in[17]) + ((size_t)(l * 16 + e) * 1024) * 256 + (nb >> 3) * 128 + 32 * (nb & 3) + w;
      quant_strip(src, true, 256, (unsigned char*)(W + W_MOE1) + (size_t)e * 512 * 1024, nb * 32, scr, part, cm + 4608 + e * 512, wave, lane); }
}
constexpr int ITEMS_PER_LAYER = 3344;
__device__ __forceinline__ void convert_item(const Args& a, bf16_t* W, int l, int r, LAS float* scr, int lane) {
    const int w = lane & 31; (void)w;
    if (r < 1296) {
    if (r < 256) { const int kb = r / 32, nb = r % 32, n = (nb >> 3) * 256 + 64 * (nb & 3) + 32 * ((nb >> 2) & 1) + w; tr_item<0>(a.in[6] + (size_t)l * 512 * 1024 + n, 1024, nullptr, W + W_FOXO, 1024, nb * 32, kb * 64, scr, lane, nullptr); return; }
    r -= 256;
    if (r < 256) { const int kb = r / 32, nb = r % 32, n = (nb >> 3) * 256 + 64 * (nb & 3) + 32 * ((nb >> 2) & 1) + w; tr_item<0>(a.in[11] + (size_t)l * 512 * 1024 + n, 1024, nullptr, W + W_FOXO + 512, 1024, nb * 32, kb * 64, scr, lane, nullptr); return; }
    r -= 256;
    if (r < 144) { const int kb = r / 24, nb = r % 24, n = nb * 32 + w; tr_item<0>(a.in[8] + (size_t)l * 384 * 768 + n, 768, a.in[7] + l * 384, W + W_UQ, 384, nb * 32, kb * 64, scr, lane, nullptr); return; }
    r -= 144;
    if (r < 128) { const int kb = r / 32, nb = r % 32, n = nb * 32 + w; const int col = n < 512 ? (n >> 6) * 128 + (n & 63) : ((n - 512) >> 6) * 128 + 64 + (n & 63);
        tr_item<0>(a.in[10] + (size_t)l * 256 * 1024 + col, 1024, a.in[9] + l * 256, W + W_UKV, 256, nb * 32, kb * 64, scr, lane, nullptr); return; }
    r -= 128;
    { const int kb = r / 32, nb = r % 32, n = (nb >> 3) * 256 + 64 * (nb & 3) + 32 * ((nb >> 2) & 1) + w; tr_item<0>(a.in[12] + (size_t)l * 1024 * 1024 + n, 1024, nullptr, W + W_OUT, 1024, nb * 32, kb * 64, scr, lane, nullptr); return; } }
    r -= 1296;
    { const int e = r / 128, rr = r % 128, kb = rr / 32, nb = rr % 32, n = (nb >> 3) * 256 + 64 * (nb & 3) + 32 * ((nb >> 2) & 1) + w;
        tr_item<0>(a.in[19] + ((size_t)(l * 16 + e) * 256) * 1024 + n, 1024, nullptr, W + W_MOE2 + (size_t)e * 1024 * 256, 256, nb * 32, kb * 64, scr, lane, nullptr); }
}

template <int R>
__device__ __forceinline__ void quant_rows(const f32x4 (&v)[R][4], unsigned char* const (&qrow)[R], float* const (&srow)[R], int lane) {
    float am[R];
#pragma unroll
    for (int k = 0; k < R; ++k) { am[k] = 0.f;
#pragma unroll
        for (int j = 0; j < 4; ++j) am[k] = fmaxf(am[k], fmaxf(fmaxf(fabsf(v[k][j][0]), fabsf(v[k][j][1])), fmaxf(fabsf(v[k][j][2]), fabsf(v[k][j][3])))); }
#pragma unroll
    for (int o = 1; o < 64; o <<= 1) {
#pragma unroll
        for (int k = 0; k < R; ++k) am[k] = fmaxf(am[k], __shfl_xor(am[k], o)); }
#pragma unroll
    for (int k = 0; k < R; ++k) { if (!qrow[k]) continue; const float inv = am[k] > 0.f ? 127.0f / am[k] : 0.f;
#pragma unroll
        for (int j = 0; j < 4; ++j) { const unsigned q = ((unsigned)(int)rintf(v[k][j][0] * inv) & 255u) | (((unsigned)(int)rintf(v[k][j][1] * inv) & 255u) << 8) | (((unsigned)(int)rintf(v[k][j][2] * inv) & 255u) << 16) | (((unsigned)(int)rintf(v[k][j][3] * inv) & 255u) << 24);
            *(unsigned*)(qrow[k] + 4 * lane + 256 * j) = q; }
        if (lane == 0) *srow[k] = am[k] * (1.0f / 127.0f); }
}

__device__ __forceinline__ void ln16(f32x4 (&v)[4], const float* g, const float* bta, int lane) {
    float s = 0.f;
#pragma unroll
    for (int j = 0; j < 4; ++j) s += (v[j][0] + v[j][1]) + (v[j][2] + v[j][3]);
    const float mean = wave_sum(s) * (1.f / DM); float s2 = 0.f;
#pragma unroll
    for (int j = 0; j < 4; ++j) { v[j] = v[j] - mean; s2 += (v[j][0] * v[j][0] + v[j][1] * v[j][1]) + (v[j][2] * v[j][2] + v[j][3] * v[j][3]); }
    const float rstd = 1.0f / sqrtf(wave_sum(s2) * (1.f / DM) + 1e-5f);
#pragma unroll
    for (int j = 0; j < 4; ++j) { const f32x4 gg = *(const f32x4*)(g + 4 * lane + 256 * j), bb = *(const f32x4*)(bta + 4 * lane + 256 * j); v[j] = v[j] * rstd * gg + bb; }
}
template <int R>
__device__ __forceinline__ void ln16xR(f32x4 (&v)[R][4], const float* g, const float* bta, int lane) {
    float s[R];
#pragma unroll
    for (int k = 0; k < R; ++k) { s[k] = 0.f;
#pragma unroll
        for (int j = 0; j < 4; ++j) s[k] += (v[k][j][0] + v[k][j][1]) + (v[k][j][2] + v[k][j][3]); }
#pragma unroll
    for (int o = 1; o < 64; o <<= 1) {
#pragma unroll
        for (int k = 0; k < R; ++k) s[k] += __shfl_xor(s[k], o); }
    float s2[R];
#pragma unroll
    for (int k = 0; k < R; ++k) { const float mean = s[k] * (1.f / DM); s2[k] = 0.f;
#pragma unroll
        for (int j = 0; j < 4; ++j) { v[k][j] = v[k][j] - mean; s2[k] += (v[k][j][0] * v[k][j][0] + v[k][j][1] * v[k][j][1]) + (v[k][j][2] * v[k][j][2] + v[k][j][3] * v[k][j][3]); } }
#pragma unroll
    for (int o = 1; o < 64; o <<= 1) {
#pragma unroll
        for (int k = 0; k < R; ++k) s2[k] += __shfl_xor(s2[k], o); }
#pragma unroll
    for (int j = 0; j < 4; ++j) { const f32x4 gg = *(const f32x4*)(g + 4 * lane + 256 * j), bb = *(const f32x4*)(bta + 4 * lane + 256 * j);
#pragma unroll
        for (int k = 0; k < R; ++k) { const float rstd = 1.0f / sqrtf(s2[k] * (1.f / DM) + 1e-5f); v[k][j] = v[k][j] * rstd * gg + bb; } }
}
__device__ __forceinline__ void store_row_bf16(bf16_t* orow, const f32x4 (&v)[4], int lane) {
#pragma unroll
    for (int j = 0; j < 4; ++j) { u32x2 w; w.x = pk_bf16(v[j][0], v[j][1]); w.y = pk_bf16(v[j][2], v[j][3]); *(u32x2*)(orow + 4 * lane + 256 * j) = w; }
}

__device__ const double ROPE_INV_REV[16] = {0.15915494309189535, 0.08949940160889101, 0.050329212104487035, 0.0283021958306234, 0.015915494309189534, 0.008949940160889102,
    0.005032921210448704, 0.00283021958306234, 0.0015915494309189536, 0.0008949940160889102, 0.0005032921210448703, 0.00028302195830623395, 0.00015915494309189535,
    8.949940160889102e-05, 5.0329212104487035e-05, 2.8302195830623396e-05};

#define PHASE_IDS int tid = threadIdx.x; asm volatile("" : "+v"(tid)); const int lane = tid & 63; const int wave = __builtin_amdgcn_readfirstlane(tid >> 6); const int gw = F.vcu * 8 + wave; (void)lane; (void)gw;

#define PHASE_PTRS unsigned long long wsi_ = (unsigned long long)args.ws; asm volatile("" : "+s"(wsi_)); unsigned char* wsl = (unsigned char*)(__attribute__((address_space(1))) unsigned char*)wsi_;     \
    float* ropeC = (float*)(wsl + WS_ROPE); float* ropeS = ropeC + LSEQ * 16; float* LFp = (float*)(wsl + WS_LF); float* CSp = (float*)(wsl + WS_CS); \
    unsigned* TOK = (unsigned*)(wsl + WS_TOK); int* LIST = (int*)(wsl + WS_LIST); bf16_t* Wall = (bf16_t*)(wsl + WS_W); bf16_t* HB = (bf16_t*)(wsl + WS_H); unsigned char* X = wsl + WS_X; \
    bf16_t *Qf = (bf16_t*)(X + X_QF), *Kf = (bf16_t*)(X + X_KF), *Vf = (bf16_t*)(X + X_VF), *RAW = (bf16_t*)(X + X_RAW), *Qm = (bf16_t*)(X + X_QM), *Km = (bf16_t*)(X + X_KM), \
           *Vm = (bf16_t*)(X + X_VM), *Om = (bf16_t*)(X + X_OM), *Of = (bf16_t*)(X + X_OF), *GATES = (bf16_t*)(X + X_GATES), *MERGED = (bf16_t*)(X + X_MERGED), *H1 = (bf16_t*)(X + X_H1), \
           *HID = (bf16_t*)(X + X_HID), *YS = (bf16_t*)(X + X_YS); bf16_t* Zb = (bf16_t*)(X + X_Z); unsigned* ctl = (unsigned*)(wsl + WS_CTL); \
    (void)ropeC; (void)ropeS; (void)LFp; (void)CSp; (void)TOK; (void)LIST; (void)Wall; (void)HB; (void)Qf; (void)Kf; (void)Vf; (void)RAW; (void)Qm; (void)Km; (void)Vm; (void)Om; (void)Of; (void)GATES; (void)MERGED; (void)H1; (void)HID; (void)YS; (void)Zb; (void)ctl;


template <int L>
__device__ __forceinline__ void run_layer(const Args& args, const Frame& F, const XcdBarrier& bar, const int NGW) {
    constexpr int l = L;
        for (int rep_ = 0; rep_ < REP_A; ++rep_) {
        {
            PHASE_PTRS const bf16_t* W = Wall + (size_t)l * W_LAYER;
            pg8::SchedStatic S{(const char*)(X + X_HBQ), (const char*)(W + W_BT1), NPANEL, 17, F.G, (int)blockIdx.x, (size_t)256 * DM, (size_t)256 * DM, 1};
            pg8::EpiA E{pg8::EpiA1{Qf, Kf, Vf, RAW, LFp, args.in[5] + l * 8, (float*)(wsl + WS_QKN), (float*)(wsl + WS_SSQ), (bf16_t*)(wsl + WS_KR), ropeC, ropeS, (const float*)(wsl + WS_HBS), ctl + CW_CMAX + 16384 * l}, pg8::EpiA2{(unsigned char*)args.out, (unsigned char*)(wsl + WS_GALT), (const float*)(wsl + WS_HBS), ctl + CW_CMAX + 16384 * l}};
            pg8::gemm_phase<pg8::EpiA, pg8::SchedStatic, false, false, true>(F.lds, 512, 512, 512, S, E);
        }
        xcd_barrier(bar);
        }
        {
            PHASE_IDS
            PHASE_PTRS
            if (blockIdx.x < 64) {
                const int bb = blockIdx.x >> 3, hh = blockIdx.x & 7;
                float v[9];
#pragma unroll
                for (int k = 0; k < 9; ++k) { const int p = 9 * tid + k; v[k] = p < LSEQ ? LFp[(size_t)row_of(bb, p) * 8 + hh] : 0.f; }
#pragma unroll
                for (int k = 1; k < 9; ++k) v[k] += v[k - 1];
                float x = v[8];
#pragma unroll
                for (int d = 1; d < 64; d <<= 1) { const float y = __shfl_up(x, d); if (lane >= d) x += y; }
                LAS float* wt = (LAS float*)(F.lds + 1024);
                if (lane == 63) wt[wave] = x;
                __syncthreads();
                float off = x - v[8];
                for (int w2 = 0; w2 < wave; ++w2) off += wt[w2];
#pragma unroll
                for (int k = 0; k < 9; ++k) { const int p = 9 * tid + k; if (p < CSP) CSp[(size_t)blockIdx.x * CSP + p] = (v[k] + off) * LOG2E; }
                __syncthreads();
                {
                    const float* qkn = (const float*)(wsl + WS_QKN); float mq = 0.f, mk = 0.f;
#pragma unroll
                    for (int k = 0; k < 9; ++k) { const int p = 9 * tid + k; if (p < LSEQ) { const float* r_ = qkn + (size_t)row_of(bb, p) * 32 + 2 * hh;
                        mq = fmaxf(mq, r_[0] + r_[1]); mk = fmaxf(mk, r_[16] + r_[17]); } }
#pragma unroll
                    for (int o = 1; o < 64; o <<= 1) { mq = fmaxf(mq, __shfl_xor(mq, o)); mk = fmaxf(mk, __shfl_xor(mk, o)); }
                    LAS float* wq = (LAS float*)(F.lds + 2048);
                    if (lane == 0) { wq[2 * wave] = mq; wq[2 * wave + 1] = mk; }
                    __syncthreads();
                    if (tid == 0) { float a = 0.f, c = 0.f; for (int w2 = 0; w2 < 8; ++w2) { a = fmaxf(a, wq[2 * w2]); c = fmaxf(c, wq[2 * w2 + 1]); }
                        ctl[CW_QKMAX + 128 * l + blockIdx.x * 2] = __float_as_uint(a); ctl[CW_QKMAX + 128 * l + blockIdx.x * 2 + 1] = __float_as_uint(c); }
                }
            }
        }
        xcd_barrier(bar);
        for (int rep_ = 0; rep_ < REP_C; ++rep_) {
        {
            PHASE_IDS
            PHASE_PTRS const bf16_t* W = Wall + (size_t)l * W_LAYER;
            pg8::SchedStatic S{(const char*)RAW, (const char*)(W + W_UQ), NPANEL, 3, F.G, (int)blockIdx.x, (size_t)256 * 768 * 2, (size_t)256 * 384 * 2, 1};
            pg8::EpiQup E{Qm, ropeC, ropeS, (const float*)(wsl + WS_SSQ)};
            pg8::gemm_phase<pg8::EpiQup, pg8::SchedStatic, false>(F.lds, 384, 768, 384, S, E);
        }
        {
            PHASE_PTRS const bf16_t* W = Wall + (size_t)l * W_LAYER;
            pg8::SchedStatic S{(const char*)(RAW + 384), (const char*)(W + W_UKV), NPANEL, 4, F.G, (int)blockIdx.x, (size_t)256 * 768 * 2, (size_t)256 * 256 * 2, 1};
            pg8::EpiKV E{Km, Vm, (const float*)(wsl + WS_SSQ)};
            pg8::gemm_phase<pg8::EpiKV, pg8::SchedStatic, false>(F.lds, 256, 768, 256, S, E);
        }
        {
            PHASE_IDS
            PHASE_PTRS
            const int myx = (int)(xb_xcc_id() & 7u);
            for (int rep_ = 0; rep_ < REP_FOX; ++rep_)
            for (int xo = 0; xo < 8; ++xo) { const int x = (myx + xo) & 7; unsigned* qc = ctl + CW_QCTR + 64 * ((rep_ * 4 + l * 2 + 1) * 8 + x);
                unsigned ticket = 0u; bool have_ticket = false;
                for (;;) {
                    if (tid == 0) F.MISC[4] = have_ticket ? ticket : __hip_atomic_fetch_add(qc, 1u, RLX_AGENT);
                    __syncthreads();
                    const int id = (int)F.MISC[4];
                    __syncthreads();
                    if (id >= 136) break;
                    have_ticket = true;
                    const int g = id / 34, i = id % 34, j = 16 - (i >> 1), h = 2 * g + (i & 1), b = x;
                    int tmin = 0;
                    if (j > 0) {
                        const float* csr = CSp + (size_t)(b * 8 + h) * CSP;
                        const float q2 = __uint_as_float(__hip_atomic_load(ctl + CW_QKMAX + 128 * l + (b * 8 + h) * 2, RLX_AGENT)), k2 = __uint_as_float(__hip_atomic_load(ctl + CW_QKMAX + 128 * l + (b * 8 + h) * 2 + 1, RLX_AGENT));
                        const float qk = 2.0f * sqrtf(q2 * k2) * 1.0001f + 0.01f;
                        const float cq = csr[16 + 256 * (j - 1)];
                        const float ck = csr[lane == 0 ? 15 : 64 * lane + 15];
                        const bool ok = (qk + cq - ck) >= -64.0f;
                        const unsigned long long m = __ballot(ok);
                        tmin = m ? (int)__builtin_ctzll(m) : 64;
                        const int tfirst = 4 * (j - 1) + 1; tmin = tmin < tfirst ? tmin : tfirst;
                    }
                    tmin = __builtin_amdgcn_readfirstlane(tmin);
                    attn_unit8<64, true>((LAS char*)F.lds, Qf + 64 * h, 512, Kf + 64 * h, 512, Vf + 64 * h, 512, Om + 64 * h, 1024, CSp + (size_t)(b * 8 + h) * CSP, b, j, tmin, qc, ticket);
                } }
        }
        xcd_barrier(bar);
        }
        {
            PHASE_IDS
            PHASE_PTRS
            const int myx = (int)(xb_xcc_id() & 7u);
            for (int rep_ = 0; rep_ < REP_MLA; ++rep_)
            for (int xo = 0; xo < 8; ++xo) { const int x = (myx + xo) & 7; unsigned* qc = ctl + CW_QCTR + 64 * ((rep_ * 4 + l * 2) * 8 + x);
                unsigned ticket = 0u; bool have_ticket = false;
                for (;;) {
                    if (tid == 0) F.MISC[4] = have_ticket ? ticket : __hip_atomic_fetch_add(qc, 1u, RLX_AGENT);
                    __syncthreads();
                    const int id = (int)F.MISC[4];
                    __syncthreads();
                    if (id >= 136) break;
                    have_ticket = true;
                    const int g = id / 34, i = id % 34, j = 16 - (i >> 1), h = 2 * g + (i & 1), b = x;
                    attn_unit8<96, false>((LAS char*)F.lds, Qm + 96 * h, 768, Km + 96 * h, 768, Vm + 64 * h, 512, Om + 512 + 64 * h, 1024, nullptr, b, j, 0, qc, ticket, (const bf16_t*)(wsl + WS_KR));
                } }
        }
        xcd_barrier(bar);
        for (int rep_ = 0; rep_ < REP_E; ++rep_) {
        {
            PHASE_PTRS const bf16_t* W = Wall + (size_t)l * W_LAYER;
            pg8::SchedStatic S{(const char*)Om, (const char*)(W + W_FOXO), (l == 0) ? NPANEL : NPANEL - 1, 4, F.G, (int)blockIdx.x, (size_t)256 * DM * 2, (size_t)256 * DM * 2, (l == 0) ? 1 : 0};
            pg8::EpiOut E{(const unsigned char*)args.out, (const unsigned char*)(wsl + WS_GALT), MERGED};
            pg8::gemm_phase<pg8::EpiOut, pg8::SchedStatic, false, true>(F.lds, 1024, 1024, 1024, S, E);
        }
        xcd_barrier(bar);
        }
        for (int rep_ = 0; rep_ < REP_F; ++rep_) {
        {
            PHASE_PTRS const bf16_t* W = Wall + (size_t)l * W_LAYER;
            pg8::SchedStatic S{(const char*)MERGED, (const char*)(W + W_OUT), (l == 0) ? NPANEL : NPANEL - 1, 4, F.G, (int)blockIdx.x, (size_t)256 * DM * 2, (size_t)256 * DM * 2, (l == 0) ? 1 : 0};
            pg8::EpiF E{HB, Zb};
            pg8::gemm_phase<pg8::EpiF, pg8::SchedStatic, false>(F.lds, 1024, 1024, 1024, S, E);
        }
        xcd_barrier(bar);
        }
        {
            PHASE_IDS
            PHASE_PTRS
            LAS float* rwT = (LAS float*)F.lds;
            LAS int* lcnt = (LAS int*)(F.lds + 65536);
            LAS int* gbase = lcnt + 16;
            LAS int* tE = lcnt + 64;
            LAS int* tP = tE + 384;
            LAS float* tG = (LAS float*)(tP + 384);
            { const f32x4* RWT4 = (const f32x4*)(wsl + WS_RWT); LAS f32x4* d4 = (LAS f32x4*)rwT;
#pragma unroll
              for (int i = 0; i < 8; ++i) d4[tid + 512 * i] = RWT4[tid + 512 * i]; }
            LAS float* lgb = (LAS float*)(F.lds + 65536 + 8192) + wave * 64;
            if (tid < 16) lcnt[tid] = 0;
            __syncthreads();
            const int TG = (l == 0) ? T : NREAL;
            const int rpw = (TG + F.G - 1) / F.G;
            const int r0 = blockIdx.x * rpw, nrows = (r0 + rpw <= TG) ? rpw : (TG > r0 ? TG - r0 : 0);
            const float* rb = args.in[16];
            for (int g4 = wave * 4; g4 < nrows; g4 += 32) {
                f32x4 v[4][4];
#pragma unroll
                for (int k = 0; k < 4; ++k) { const int lr = (g4 + k < nrows) ? g4 + k : nrows - 1; const int row = r0 + lr;
#pragma unroll
                    for (int j = 0; j < 4; ++j) { const u32x2 zv = *(const u32x2*)(Zb + (size_t)row * DM + 4 * lane + 256 * j); v[k][j] = (f32x4){bf_lo(zv.x), bf_hi(zv.x), bf_lo(zv.y), bf_hi(zv.y)}; } }
                ln16xR<4>(v, args.in[13] + l * DM, args.in[14] + l * DM, lane);
#pragma unroll
                for (int k = 0; k < 4; ++k) if (g4 + k < nrows) store_row_bf16(H1 + (size_t)(r0 + g4 + k) * DM, v[k], lane);
                { unsigned char* qr[4]; float* sr[4];
#pragma unroll
                  for (int k = 0; k < 4; ++k) { const bool ok = g4 + k < nrows; qr[k] = ok ? X + X_H1Q + (size_t)(r0 + g4 + k) * DM : nullptr; sr[k] = (float*)(wsl + WS_H1S) + (ok ? r0 + g4 + k : 0); }
                  unsigned char* const qc[4] = {qr[0], qr[1], qr[2], qr[3]}; float* const sc4[4] = {sr[0], sr[1], sr[2], sr[3]};
                  quant_rows<4>(v, qc, sc4, lane); }
                float s[4][16];
#pragma unroll
                for (int e = 0; e < 16; ++e) {
                    f32x4 wv[4];
#pragma unroll
                    for (int j = 0; j < 4; ++j) wv[j] = *(const LAS f32x4*)(rwT + e * 1024 + 4 * lane + 256 * j);
#pragma unroll
                    for (int k = 0; k < 4; ++k) { float a = 0.f;
#pragma unroll
                        for (int j = 0; j < 4; ++j) a += (v[k][j][0] * wv[j][0] + v[k][j][1] * wv[j][1]) + (v[k][j][2] * wv[j][2] + v[k][j][3] * wv[j][3]);
                        s[k][e] = a; }
                }
#pragma unroll
                for (int k = 0; k < 4; ++k) {
#pragma unroll
                    for (int i = 0; i < 8; ++i) { const bool up = (lane & 32) != 0; const float mine = up ? s[k][i + 8] : s[k][i], oth = up ? s[k][i] : s[k][i + 8]; s[k][i] = mine + __shfl_xor(oth, 32); }
#pragma unroll
                    for (int i = 0; i < 4; ++i) { const bool up = (lane & 16) != 0; const float mine = up ? s[k][i + 4] : s[k][i], oth = up ? s[k][i] : s[k][i + 4]; s[k][i] = mine + __shfl_xor(oth, 16); }
#pragma unroll
                    for (int i = 0; i < 2; ++i) { const bool up = (lane & 8) != 0; const float mine = up ? s[k][i + 2] : s[k][i], oth = up ? s[k][i] : s[k][i + 2]; s[k][i] = mine + __shfl_xor(oth, 8); }
                    { const bool up = (lane & 4) != 0; const float mine = up ? s[k][1] : s[k][0], oth = up ? s[k][0] : s[k][1]; s[k][0] = mine + __shfl_xor(oth, 4); }
                    s[k][0] += __shfl_xor(s[k][0], 2); s[k][0] += __shfl_xor(s[k][0], 1);
                }
                if ((lane & 3) == 0) {
#pragma unroll
                    for (int k = 0; k < 4; ++k) lgb[k * 16 + (lane >> 2)] = s[k][0]; }
                LDS_WAIT();
                {
                    const int k = lane & 3;
                    float lg[16];
#pragma unroll
                    for (int q4 = 0; q4 < 4; ++q4) { const f32x4 t4 = *(const LAS f32x4*)(lgb + k * 16 + 4 * q4); lg[4 * q4] = t4[0]; lg[4 * q4 + 1] = t4[1]; lg[4 * q4 + 2] = t4[2]; lg[4 * q4 + 3] = t4[3]; }
                    float sc[16], bi[16];
#pragma unroll
                    for (int e = 0; e < 16; ++e) { sc[e] = __builtin_amdgcn_rcpf(1.0f + __builtin_amdgcn_exp2f(-LOG2E * lg[e])); bi[e] = sc[e] + rb[e]; }
                    int gsel = 0; float gbest = -INFINITY;
#pragma unroll
                    for (int g = 0; g < 4; ++g) { float m1 = bi[4 * g], m2 = -INFINITY;
#pragma unroll
                        for (int kk = 1; kk < 4; ++kk) { const float x = bi[4 * g + kk]; if (x > m1) { m2 = m1; m1 = x; } else if (x > m2) m2 = x; }
                        const float gs = m1 + m2; if (gs > gbest) { gbest = gs; gsel = g; } }
                    float b4[4], s4[4];
#pragma unroll
                    for (int kk = 0; kk < 4; ++kk) { b4[kk] = gsel == 0 ? bi[kk] : gsel == 1 ? bi[4 + kk] : gsel == 2 ? bi[8 + kk] : bi[12 + kk]; s4[kk] = gsel == 0 ? sc[kk] : gsel == 1 ? sc[4 + kk] : gsel == 2 ? sc[8 + kk] : sc[12 + kk]; }
                    int i1 = 0; float bb1 = b4[0], ss1 = s4[0];
#pragma unroll
                    for (int kk = 1; kk < 4; ++kk) if (b4[kk] > bb1) { bb1 = b4[kk]; ss1 = s4[kk]; i1 = kk; }
                    int i2 = -1; float bb2 = -INFINITY, ss2 = 0.f;
#pragma unroll
                    for (int kk = 0; kk < 4; ++kk) if (kk != i1 && b4[kk] > bb2) { bb2 = b4[kk]; ss2 = s4[kk]; i2 = kk; }
                    const float inv = 1.0f / (ss1 + ss2);
                    if (lane < 4 && g4 + k < nrows) {
                        const int lr = g4 + k; const int e0 = gsel * 4 + i1, e1 = gsel * 4 + i2;
                        tE[2 * lr] = e0; tE[2 * lr + 1] = e1;
                        tP[2 * lr] = atomicAdd((int*)&lcnt[e0], 1); tP[2 * lr + 1] = atomicAdd((int*)&lcnt[e1], 1);
                        tG[2 * lr] = ss1 * inv; tG[2 * lr + 1] = ss2 * inv;
                    }
                }
            }
            __syncthreads();
            if (tid < 16) gbase[tid] = (int)__hip_atomic_fetch_add(ctl + CW_ECNT + 64 * (l * 16 + tid), (unsigned)lcnt[tid], RLX_AGENT);
            __syncthreads();
            if (tid < nrows) {
                const int row = r0 + tid; const int e0 = tE[2 * tid], e1 = tE[2 * tid + 1];
                const int p0 = gbase[e0] + tP[2 * tid], p1 = gbase[e1] + tP[2 * tid + 1];
                LIST[(size_t)e0 * TP + p0] = row; LIST[(size_t)e1 * TP + p1] = row;
                u32x4 w0; w0.x = (unsigned)e0; w0.y = (unsigned)p0; w0.z = (unsigned)e1; w0.w = (unsigned)p1;
                *(u32x4*)(TOK + (size_t)row * 8) = w0;
                u32x2 w1; w1.x = __float_as_uint(tG[2 * tid]); w1.y = __float_as_uint(tG[2 * tid + 1]);
                *(u32x2*)(TOK + (size_t)row * 8 + 4) = w1;
            }
        }
        xcd_barrier(bar);
        LAS int* tb = (LAS int*)(F.lds + MISC_OFF) + 16; LAS int* ecnt = (LAS int*)(F.lds + MISC_OFF) + 64;
        if (threadIdx.x == 0) { int acc = 0; for (int e = 0; e < 16; ++e) { const int c = (int)__hip_atomic_load(F.ctl + CW_ECNT + 64 * (l * 16 + e), RLX_AGENT); ecnt[e] = c; tb[e] = acc; acc += (c + 255) >> 8; } tb[16] = acc; }
        __syncthreads();
        for (int rep_ = 0; rep_ < REP_H; ++rep_) {
        {
            PHASE_PTRS const bf16_t* W = Wall + (size_t)l * W_LAYER;
            pg8::SchedMoe S{(const char*)(X + X_H1Q), (const char*)(W + W_MOE1), tb, ecnt, LIST, 1, F.G, (int)blockIdx.x, (size_t)512 * 1024, (size_t)256 * 1024, 0, true, DM};
            pg8::EpiM1 E{HID, (const float*)(wsl + WS_H1S), ctl + CW_CMAX + 16384 * l + 4608, tb, ecnt, LIST};
            pg8::gemm_phase<pg8::EpiM1, pg8::SchedMoe, true, false, true>(F.lds, 512, 512, 512, S, E);
        }
        xcd_barrier(bar);
        }
        for (int rep_ = 0; rep_ < REP_I; ++rep_) {
        {
            PHASE_PTRS const bf16_t* W = Wall + (size_t)l * W_LAYER;
            pg8::SchedMoe S{(const char*)HID, (const char*)(W + W_MOE2), tb, ecnt, LIST, 2, F.G, (int)blockIdx.x, (size_t)1024 * 256 * 2, (size_t)256 * 256 * 2, (size_t)256 * 256 * 2, false, DM * 2};
            pg8::EpiM2 E{YS};
            pg8::gemm_phase<pg8::EpiM2, pg8::SchedMoe, false>(F.lds, 256, 256, 256, S, E);
        }
        xcd_barrier(bar);
        }
        {
            PHASE_IDS
            PHASE_PTRS
            for (int rep_ = 0; rep_ < REP_J; ++rep_)
            for (int r4 = gw * 4; r4 < (l == 0 ? T : NREAL); r4 += NGW * 4) {
                u32x4 w0[4]; u32x2 w1[4];
#pragma unroll
                for (int k = 0; k < 4; ++k) { w0[k] = *(const u32x4*)(TOK + (size_t)(r4 + k) * 8); w1[k] = *(const u32x2*)(TOK + (size_t)(r4 + k) * 8 + 4); }
                u32x2 hv[4][4], ya[4][4], yc[4][4];
#pragma unroll
                for (int k = 0; k < 4; ++k) {
                    const size_t s0 = (size_t)tb[(int)w0[k].x] * 256 + (int)w0[k].y, s1 = (size_t)tb[(int)w0[k].z] * 256 + (int)w0[k].w;
#pragma unroll
                    for (int j = 0; j < 4; ++j) { hv[k][j] = *(const u32x2*)(H1 + (size_t)(r4 + k) * DM + 4 * lane + 256 * j); ya[k][j] = *(const u32x2*)(YS + s0 * DM + 4 * lane + 256 * j); yc[k][j] = *(const u32x2*)(YS + s1 * DM + 4 * lane + 256 * j); } }
                f32x4 v[4][4];
#pragma unroll
                for (int k = 0; k < 4; ++k) { const float g0 = __uint_as_float(w1[k].x), g1 = __uint_as_float(w1[k].y);
#pragma unroll
                    for (int j = 0; j < 4; ++j) {
                        v[k][j][0] = ALPHA * bf_lo(hv[k][j].x) + g0 * bf_lo(ya[k][j].x) + g1 * bf_lo(yc[k][j].x); v[k][j][1] = ALPHA * bf_hi(hv[k][j].x) + g0 * bf_hi(ya[k][j].x) + g1 * bf_hi(yc[k][j].x);
                        v[k][j][2] = ALPHA * bf_lo(hv[k][j].y) + g0 * bf_lo(ya[k][j].y) + g1 * bf_lo(yc[k][j].y); v[k][j][3] = ALPHA * bf_hi(hv[k][j].y) + g0 * bf_hi(ya[k][j].y) + g1 * bf_hi(yc[k][j].y); } }
                ln16xR<4>(v, args.in[20] + l * DM, args.in[21] + l * DM, lane);
                if (l == 0) { unsigned char* const qr[4] = {X + X_HBQ + (size_t)r4 * DM, X + X_HBQ + (size_t)(r4 + 1) * DM, X + X_HBQ + (size_t)(r4 + 2) * DM, X + X_HBQ + (size_t)(r4 + 3) * DM};
                    float* const hs = (float*)(wsl + WS_HBS) + r4; float* const sr[4] = {hs, hs + 1, hs + 2, hs + 3};
                    quant_rows<4>(v, qr, sr, lane); }
#pragma unroll
                for (int k = 0; k < 4; ++k) { const int row = r4 + k;
                    if (l == 0) store_row_bf16(HB + (size_t)row * DM, v[k], lane);
                    else { float* orow = args.out + (size_t)row * DM;
#pragma unroll
                        for (int j = 0; j < 4; ++j) *(f32x4*)(orow + 4 * lane + 256 * j) = v[k][j]; } }
            }
        }
        if (l == 0) xcd_barrier(bar);
}

__global__ void __launch_bounds__(512, 2) fwd_kernel(Args args) {
    extern __shared__ __attribute__((aligned(16))) unsigned char lds_raw[];
    Frame F;
    F.lds = (LAS unsigned char*)lds_raw;
    F.MISC = (volatile LAS unsigned*)(F.lds + MISC_OFF);
    F.tid = threadIdx.x; F.lane = F.tid & 63; F.wave = __builtin_amdgcn_readfirstlane(F.tid >> 6);
    F.G = gridDim.x; { const int bx = blockIdx.x; F.vcu = (F.G % 8 == 0) ? (bx % 8) * (F.G / 8) + bx / 8 : bx; }
    unsigned char* ws = args.ws;
    F.ctl = (unsigned*)(ws + WS_CTL);
    for (int u = F.tid; u < (LDS_BYTES - MISC_OFF) / 4; u += 512) ((LAS unsigned*)(F.lds + MISC_OFF))[u] = 0u;
    __syncthreads();
    XcdBarrier bar = xcd_barrier_post(F.ctl + CW_BAR, F.MISC);
    const int NGW = F.G * 8;
    {
        PHASE_IDS
        PHASE_PTRS
        LAS float* scr = (LAS float*)(F.lds + wave * 16384);
        { LAS float* part = (LAS float*)(F.lds + 12288);
          for (int it = F.vcu; it < 2 * STRIPS_PER_LAYER; it += F.G) { const int l = it / STRIPS_PER_LAYER, sidx = it % STRIPS_PER_LAYER;
              strip_item(args, Wall + (size_t)l * W_LAYER, ctl + CW_CMAX + 16384 * l, l, sidx, scr, part, wave, lane); } }
        for (int it = gw; it < 2 * ITEMS_PER_LAYER; it += NGW) { const int l = it / ITEMS_PER_LAYER, r = it % ITEMS_PER_LAYER; convert_item(args, Wall + (size_t)l * W_LAYER, l, r, scr, lane); }
        for (int r4 = gw * 4; r4 < TP; r4 += NGW * 4) {
            if (r4 >= T) {
#pragma unroll
                for (int k = 0; k < 4; ++k) { bf16_t* orow = HB + (size_t)(r4 + k) * DM; *(u32x4*)(orow + 8 * lane) = (u32x4){0u, 0u, 0u, 0u}; *(u32x4*)(orow + 512 + 8 * lane) = (u32x4){0u, 0u, 0u, 0u};
                    *(u32x4*)(X + X_HBQ + (size_t)(r4 + k) * DM + 16 * lane) = (u32x4){0u, 0u, 0u, 0u}; if (lane == 0) ((float*)(wsl + WS_HBS))[r4 + k] = 0.f; }
                continue; }
            f32x4 v[4][4];
#pragma unroll
            for (int k = 0; k < 4; ++k) { const int row = r4 + k;
                const float* src = row < NREAL ? args.in[0] + (size_t)row * DM : args.in[1] + (size_t)((row - NREAL) & (NMETA - 1)) * DM;
#pragma unroll
                for (int j = 0; j < 4; ++j) v[k][j] = *(const f32x4*)(src + 4 * lane + 256 * j); }
            ln16xR<4>(v, args.in[2], args.in[3], lane);
#pragma unroll
            for (int k = 0; k < 4; ++k) store_row_bf16(HB + (size_t)(r4 + k) * DM, v[k], lane);
            { unsigned char* const qr[4] = {X + X_HBQ + (size_t)r4 * DM, X + X_HBQ + (size_t)(r4 + 1) * DM, X + X_HBQ + (size_t)(r4 + 2) * DM, X + X_HBQ + (size_t)(r4 + 3) * DM};
              float* const hs = (float*)(wsl + WS_HBS) + r4; float* const sr[4] = {hs, hs + 1, hs + 2, hs + 3};
              quant_rows<4>(v, qr, sr, lane); }
        }
        { float* RWT = (float*)(wsl + WS_RWT); const float* rw = args.in[15];
          for (int idx = blockIdx.x * 512 + tid; idx < 16384; idx += F.G * 512) { const int e = idx >> 10, col = idx & 1023; RWT[idx] = rw[col * 16 + e]; } }
        for (int idx = blockIdx.x * 512 + tid; idx < LSEQ * 16; idx += F.G * 512) {
            const int p = idx >> 4, i = idx & 15; double x = (double)p * ROPE_INV_REV[i]; x -= floor(x); const float xr = (float)x;
            ropeC[idx] = __builtin_amdgcn_cosf(xr); ropeS[idx] = __builtin_amdgcn_sinf(xr);
        }
    }
    xcd_barrier(bar);

    run_layer<0>(args, F, bar, NGW);
    run_layer<1>(args, F, bar, NGW);
}

extern "C" void kernel_launch(void* const* d_in, const int* in_sizes, int n_in, void* d_out, int out_size, void* d_ws, size_t ws_size, hipStream_t stream) {
    static int grid = 0;
    if (grid == 0) {
        if (n_in != 22 || ws_size < WS_END) { fprintf(stderr, "kernel_launch: need 22 inputs and %zu bytes of workspace (got %d, %zu)\n", (size_t)WS_END, n_in, ws_size); grid = -1; return; }
        int dev = 0, cus = 0, per_cu = 0;
        if (hipGetDevice(&dev) != hipSuccess || hipDeviceGetAttribute(&cus, hipDeviceAttributeMultiprocessorCount, dev) != hipSuccess) { grid = -1; return; }
        if (hipFuncSetAttribute((const void*)fwd_kernel, hipFuncAttributeMaxDynamicSharedMemorySize, LDS_BYTES) != hipSuccess) { fprintf(stderr, "kernel_launch: hipFuncSetAttribute failed\n"); grid = -1; return; }
        if (hipOccupancyMaxActiveBlocksPerMultiprocessor(&per_cu, (const void*)fwd_kernel, 512, LDS_BYTES) != hipSuccess || per_cu < 1) { fprintf(stderr, "kernel_launch: occupancy query says %d\n", per_cu); }
        (void)hipGetLastError();
        grid = cus;
    }
    if (grid < 0) return;
    if (hipMemsetAsync((char*)d_ws + WS_CTL, 0, CTL_BYTES, stream) != hipSuccess) return;
    Args a{};
    for (int i = 0; i < 22; ++i) a.in[i] = (const float*)d_in[i];
    a.out = (float*)d_out; a.ws = (unsigned char*)d_ws;
    hipLaunchKernelGGL(fwd_kernel, dim3(grid), dim3(512), LDS_BYTES, stream, a);
}
```

```cpp
#include <hip/hip_runtime.h>
#include <cstdio>
#include <cstdint>

#ifndef REP_A
#define REP_A 1
#endif
#ifndef REP_C
#define REP_C 1
#endif
#ifndef REP_E
#define REP_E 1
#endif
#ifndef REP_F
#define REP_F 1
#endif
#ifndef REP_H
#define REP_H 1
#endif
#ifndef REP_I
#define REP_I 1
#endif
#ifndef REP_GEMM
#define REP_GEMM 1
#endif
#ifndef REP_MLA
#define REP_MLA 1
#endif
#ifndef REP2_MODE
#define REP2_MODE 0
#endif
#ifndef REP_FOX
#define REP_FOX 1
#endif
#ifndef REP_J
#define REP_J 1
#endif
#ifndef REP_THIN
#define REP_THIN 1
#endif
#define LAS __attribute__((address_space(3)))
typedef unsigned short bf16_t;
typedef short bf16x8 __attribute__((ext_vector_type(8)));
typedef short s16x4 __attribute__((ext_vector_type(4)));
typedef float f32x4 __attribute__((ext_vector_type(4)));
typedef float f32x2_t __attribute__((ext_vector_type(2)));
typedef __bf16 bf16x2_t __attribute__((ext_vector_type(2)));
typedef float f32x16 __attribute__((ext_vector_type(16)));
typedef unsigned u32x4 __attribute__((ext_vector_type(4)));
typedef unsigned u32x2 __attribute__((ext_vector_type(2)));
typedef int i32x4 __attribute__((ext_vector_type(4)));

constexpr int NB = 8, SEQ = 4096, NMETA = 16, LSEQ = 4112, T = NB * LSEQ  , TP = 33024  , DM = 1024;
constexpr int NPANEL = TP / 256;
constexpr int NREAL = NB * SEQ;
__host__ __device__ __forceinline__ int row_of(int b, int p) { return p < NMETA ? NREAL + NMETA * b + p : SEQ * b + (p - NMETA); }
__host__ __device__ __forceinline__ int pos_of(int row) { return row < NREAL ? NMETA + (row & (SEQ - 1)) : (row - NREAL) & (NMETA - 1); }
constexpr int NEXP = 16;
constexpr float ALPHA = 1.41421356237309515f;
constexpr float LOG2E = 1.4426950408889634f;
constexpr float C2F = 0.125f * LOG2E;
constexpr float C2M = 0.14724444602590310f;
constexpr int CSP = 4160;

constexpr size_t MiB = 1ull << 20;
constexpr size_t WS_CTL = 0, CTL_BYTES = 1 * MiB;
constexpr size_t WS_ROPE = 1 * MiB;
constexpr size_t WS_RWT = 1 * MiB + 640 * 1024;
constexpr size_t WS_LF = 2 * MiB;
constexpr size_t WS_CS = 3 * MiB + 256 * 1024;
constexpr size_t WS_HBS = 8 * MiB + 512 * 1024;
constexpr size_t WS_H1S = 8 * MiB + 768 * 1024;
constexpr size_t WS_SSQ = 9 * MiB;
constexpr size_t WS_TOK = 4 * MiB + 512 * 1024;
constexpr size_t WS_LIST = 5 * MiB + 768 * 1024;
constexpr size_t WS_GALT = 8 * MiB;
constexpr size_t WS_W = 12 * MiB;
constexpr size_t WS_H = 88 * MiB;
constexpr size_t WS_X = 153 * MiB;
constexpr size_t S512 = (size_t)TP * 512 * 2, S768 = (size_t)TP * 768 * 2, S1024 = (size_t)TP * 1024 * 2;
constexpr size_t X_QF = 0, X_KF = S512, X_VF = 2 * S512, X_RAW = 3 * S512, X_QM = 3 * S512 + S768, X_KM = 3 * S512 + 2 * S768,
                 X_VM = 3 * S512 + 3 * S768, X_OM = 4 * S512 + 3 * S768, X_OF = 5 * S512 + 3 * S768, X_END = 6 * S512 + 3 * S768;
constexpr size_t X_HBQ = X_OM;
constexpr size_t X_H1Q = X_RAW;
constexpr size_t X_GATES = X_KF;
constexpr size_t X_MERGED = X_KM;
constexpr size_t X_Z = X_KF;
constexpr size_t X_H1 = X_KM;
constexpr size_t X_HID = X_QF;
constexpr size_t X_YS = 36 * MiB;
constexpr int NSLOT_TILES = 273, NSLOT = NSLOT_TILES * 256;
constexpr size_t WS_QKN = WS_X + X_END;
constexpr size_t WS_KR = WS_QKN + (size_t)TP * 128;
constexpr size_t WS_END = WS_KR + (size_t)TP * 64;
static_assert(X_GATES + (size_t)TP * 2048 * 2 <= X_KM, "gates");
static_assert(X_MERGED + S1024 <= X_OM, "merged");
static_assert(X_HID + (size_t)NSLOT * 256 * 2 <= X_YS, "hid");
static_assert(X_YS + (size_t)NSLOT * 1024 * 2 <= X_KM, "ys");
static_assert(WS_LF + (size_t)TP * 32 <= WS_CS && WS_CS + 64ull * CSP * 4 <= WS_TOK && WS_TOK + (size_t)TP * 32 <= WS_LIST && WS_LIST + 16ull * TP * 4 <= WS_GALT && WS_GALT + MiB <= WS_SSQ && WS_SSQ + (size_t)TP * 80 <= WS_W, "small buffers");
static_assert(WS_W + 2ull * 19693568ull * 2ull <= WS_H, "weights");
static_assert(WS_H + S1024 <= WS_X, "h");
constexpr size_t W_BT1 = 0, W_BT2 = W_BT1 + 2304ull * 1024, W_FOXO = W_BT2 + 2048ull * 1024, W_MLAO = W_FOXO + 1024ull * 512,
                 W_UQ = W_MLAO + 1024ull * 512, W_UKV = W_UQ + 768ull * 384, W_OUT = W_UKV + 1024ull * 256, W_MOE1 = W_OUT + 1024ull * 1024,
                 W_MOE2 = W_MOE1 + 16ull * 512 * 1024, W_LAYER = W_MOE2 + 16ull * 1024 * 256;
static_assert(W_LAYER == 19693568ull, "weights per layer");
constexpr int CW_BAR = 4096;
constexpr int CW_QCTR = 8192;
constexpr int CW_ECNT = 16384;
constexpr int CW_CMAX = 131072;
constexpr int CW_QKMAX = 20480;

constexpr int RING_BYTES = 131072;
constexpr int MISC_OFF = RING_BYTES;
constexpr int LDS_BYTES = 147456;

__device__ __forceinline__ unsigned pk_bf16(float lo, float hi) { f32x2_t v = {lo, hi}; bf16x2_t b = __builtin_convertvector(v, bf16x2_t); return __builtin_bit_cast(unsigned, b); }
__device__ __forceinline__ float bf_lo(unsigned u) { return __uint_as_float(u << 16); }
__device__ __forceinline__ float bf_hi(unsigned u) { return __uint_as_float(u & 0xffff0000u); }
template <int CTRL> __device__ __forceinline__ float dppf(float v) { return __builtin_bit_cast(float, __builtin_amdgcn_update_dpp(0, __builtin_bit_cast(int, v), CTRL, 0xf, 0xf, false)); }
__device__ __forceinline__ float wave_sum(float v) {
    v += dppf<0xB1>(v); v += dppf<0x4E>(v); v += dppf<0x141>(v); v += dppf<0x140>(v);
    { const auto r = __builtin_amdgcn_permlane16_swap(__float_as_uint(v), __float_as_uint(v), false, false); v = __uint_as_float(r[0]) + __uint_as_float(r[1]); }
    { const auto r = __builtin_amdgcn_permlane32_swap(__float_as_uint(v), __float_as_uint(v), false, false); v = __uint_as_float(r[0]) + __uint_as_float(r[1]); }
    return v;
}
__device__ __forceinline__ float wave_max(float v) {
    v = fmaxf(v, dppf<0xB1>(v)); v = fmaxf(v, dppf<0x4E>(v)); v = fmaxf(v, dppf<0x141>(v)); v = fmaxf(v, dppf<0x140>(v));
    { const auto r = __builtin_amdgcn_permlane16_swap(__float_as_uint(v), __float_as_uint(v), false, false); v = fmaxf(__uint_as_float(r[0]), __uint_as_float(r[1])); }
    { const auto r = __builtin_amdgcn_permlane32_swap(__float_as_uint(v), __float_as_uint(v), false, false); v = fmaxf(__uint_as_float(r[0]), __uint_as_float(r[1])); }
    return v;
}
#define LDS_WAIT() asm volatile("s_waitcnt lgkmcnt(0)" ::: "memory")
#define RLX_AGENT __ATOMIC_RELAXED, __HIP_MEMORY_SCOPE_AGENT

#define XB_TMO      128
#define XB_XCNT(j)  (256  + 64 * (j))
#define XB_XSUB(j)  (1280 + 64 * (j))
#define XB_XGEN(j)  (2304 + 64 * (j))
#define XB_TOP      3328
#define XB_TOPGEN   3392
#define XCD_BAR_WORDS 3456
#define XB_SPIN_CAP (1u << 20)
__device__ __forceinline__ unsigned xb_ld(unsigned* p)              { return __hip_atomic_load(p, __ATOMIC_RELAXED, __HIP_MEMORY_SCOPE_AGENT); }
__device__ __forceinline__ unsigned xb_add(unsigned* p, unsigned v) { return __hip_atomic_fetch_add(p, v, __ATOMIC_RELAXED, __HIP_MEMORY_SCOPE_AGENT); }
__device__ __forceinline__ unsigned xb_xcc_id() { return (unsigned)__builtin_amdgcn_s_getreg((3 << 11) | 20) & 0xFu; }
#define XB_SPIN(cond, bar) do { unsigned _sp = 0; while (cond) { __builtin_amdgcn_s_sleep(1); \
    if ((++_sp & 255u) == 0u) { if (xb_ld(&(bar)[XB_TMO])) break; if (_sp > XB_SPIN_CAP) { atomicAdd(&(bar)[XB_TMO], 1u); break; } } } } while (0)
struct XcdBarrier { unsigned* bar; unsigned x; volatile LAS unsigned* st; };
__device__ __forceinline__ XcdBarrier xcd_barrier_post(unsigned* bar, volatile LAS unsigned* st) {
    XcdBarrier b; b.bar = bar; b.x = xb_xcc_id(); b.st = st;
    if (threadIdx.x == 0) (void)xb_add(&bar[XB_XCNT(b.x)], 1u);
    return b;
}
__device__ __forceinline__ void xcd_barrier_complete(unsigned* bar, unsigned x, unsigned& nloc, unsigned& nx) {
    const unsigned G = gridDim.x * gridDim.y * gridDim.z;
    unsigned sum, cnt, mine, sp = 0u;
    for (;;) {
        sum = 0u; cnt = 0u; mine = 0u;
#pragma unroll
        for (unsigned j = 0; j < 16; ++j) { const unsigned c = xb_ld(&bar[XB_XCNT(j)]); sum += c; cnt += (c > 0u) ? 1u : 0u; mine = (j == x) ? c : mine; }
        if (sum == G) break;
        __builtin_amdgcn_s_sleep(1);
        if ((++sp & 255u) == 0u) { if (xb_ld(&bar[XB_TMO])) break; if (sp > XB_SPIN_CAP) { atomicAdd(&bar[XB_TMO], 1u); break; } }
    }
    nloc = mine > 0u ? mine : 1u; nx = cnt > 0u ? cnt : 1u;
}
__device__ __forceinline__ void xcd_barrier(const XcdBarrier& b) {
    asm volatile("s_waitcnt vmcnt(0)" ::: "memory");
    __syncthreads();
    if (threadIdx.x == 0) {
        unsigned* bar = b.bar; unsigned bx = b.x; asm volatile("" : "+s"(bar), "+s"(bx));
        __builtin_amdgcn_s_waitcnt(0);
        unsigned nloc = b.st[0], nx = b.st[1];
        if (nloc == 0u) { xcd_barrier_complete(bar, bx, nloc, nx); b.st[0] = nloc; b.st[1] = nx; }
        const unsigned old = xb_add(&bar[XB_XSUB(bx)], 1u);
        const unsigned gen = old / nloc;
        if (old + 1u == (gen + 1u) * nloc) {
            __builtin_amdgcn_fence(__ATOMIC_RELEASE, "agent");
            asm volatile("s_waitcnt vmcnt(0)" ::: "memory");
            const unsigned og = xb_add(&bar[XB_TOP], 1u);
            const unsigned tg = og / nx;
            if (og + 1u == (tg + 1u) * nx) xb_add(&bar[XB_TOPGEN], 1u);
            else XB_SPIN(xb_ld(&bar[XB_TOPGEN]) == tg, bar);
            __builtin_amdgcn_fence(__ATOMIC_ACQUIRE, "agent");
            xb_add(&bar[XB_XGEN(bx)], 1u);
            asm volatile("s_waitcnt vmcnt(0)" ::: "memory");
        } else {
            XB_SPIN(xb_ld(&bar[XB_XGEN(bx)]) == gen, bar);
            __builtin_amdgcn_fence(__ATOMIC_ACQUIRE, "agent");
            asm volatile("s_waitcnt vmcnt(0)" ::: "memory");
        }
    }
    __syncthreads();
}

namespace pg8 {
constexpr int BM = 256, BK = 64, HALF = 128, HTB = HALF * BK * 2, STAGE_BYTES = 8 * HTB;
__device__ __forceinline__ int lds_byte(int r, int c) { const int st = (r >> 4) * 2 + (c >> 5), rr = r & 15, cc = c & 31, ob = rr * 64 + cc * 2; return st * 1024 + (ob ^ (((ob >> 9) & 1) << 5)); }
__device__ __forceinline__ void stage_rc(int b, int& R, int& C) { const int st = b / 1024, sb = b % 1024, swz = sb ^ (((sb >> 9) & 1) << 5); R = (st >> 1) * 16 + swz / 64; C = (st & 1) * 32 + (swz % 64) / 2; }
__device__ __forceinline__ int perm32(int rho) { const int n = rho >> 4, i = rho & 15; return 8 * (i >> 2) + 4 * n + (i & 3); }
struct Unit { const char* A; const char* B; int pm, pn, aux, half; };
typedef f32x4 Acc[2][2][4][2];

__device__ __forceinline__ void tile_of(int L, int nM, int nN, int& pm, int& pn) {
    const int nwg = nM * nN; int wgid = L;
    { const int q = nwg / 8, r = nwg % 8, xcd = wgid % 8, off = wgid / 8; wgid = (xcd < r ? xcd * (q + 1) : r * (q + 1) + (xcd - r) * q) + off; }
    const int nig = 8 * nN, gid = wgid / nig, fm = gid * 8, gsz = (nM - fm) < 8 ? (nM - fm) : 8;
    pm = fm + ((wgid % nig) % gsz); pn = (wgid % nig) / gsz;
}

template <class Epi, class Sched, bool GATHER, bool MIDHOOK = false, bool I8 = false>
__device__ __forceinline__ void gemm_phase(LAS unsigned char* lds, const int K, const int lda, const int ldb, const Sched& S, const Epi& E) {
    int tid_l = threadIdx.x; asm volatile("" : "+v"(tid_l));
    const int tid = tid_l, wid = __builtin_amdgcn_readfirstlane(tid >> 6), lane = tid & 63, wr = wid >> 2, wc = wid & 3, fr = lane & 15, fq = lane >> 4;
    int nt = K / BK; asm volatile("" : "+s"(nt));
    unsigned voA[2][2], voB[2]; int Rr[2], Cc[2];
#pragma unroll
    for (int i = 0; i < 2; ++i) { int R, C; stage_rc(tid * 16 + i * 8192, R, C); const int Rb = Epi::PERM ? ((R & ~31) + perm32(R & 31)) : R;
        Rr[i] = R; Cc[i] = C; voA[0][i] = (unsigned)(R * lda + C) * 2u; voA[1][i] = (unsigned)((R + HALF) * lda + C) * 2u; voB[i] = (unsigned)(Rb * ldb + C) * 2u; }
    const size_t kstep = (size_t)(BK * 2);
    const size_t hstepB = (size_t)HALF * ldb * 2, hstepA = (size_t)HALF * lda * 2;
    const unsigned ldsw = (unsigned)wid * 1024u;
    const int aoff = lds_byte(wr * 64 + fr, fq * 8), boff = lds_byte(wc * 32 + fr, fq * 8);
#define PG8_SA(b, h) (((b) * 2 + (h)) * HTB)
#define PG8_SB(b, h) ((4 + (b) * 2 + (h)) * HTB)
#define PG8_STAGE2(bufoff, gbase, o0, o1) do { \
        __builtin_amdgcn_global_load_lds((const unsigned*)((const char*)(gbase) + (o0)), (LAS unsigned*)(lds + (bufoff) + ldsw), 16, 0, 0); \
        __builtin_amdgcn_global_load_lds((const unsigned*)((const char*)(gbase) + (o1)), (LAS unsigned*)(lds + (bufoff) + ldsw + 8192), 16, 0, 0); } while (0)
#define PG8_STA(b, h, gbase, VO) do { if constexpr (GATHER) PG8_STAGE2(PG8_SA(b, h), gbase, (VO)[h][0], (VO)[h][1]); else PG8_STAGE2(PG8_SA(b, h), (gbase) + (h) * hstepA, (VO)[0][0], (VO)[0][1]); } while (0)
#define PG8_STB(b, h, gbase) PG8_STAGE2(PG8_SB(b, h), (gbase) + (h) * hstepB, voB[0], voB[1])
#define PG8_LDA(dst, b, h) do { _Pragma("unroll") for (int m = 0; m < 4; ++m) _Pragma("unroll") for (int k = 0; k < 2; ++k) dst[m][k] = *(const LAS bf16x8*)(lds + PG8_SA(b, h) + aoff + m * 2048 + k * 1024); } while (0)
#define PG8_LDB(dst, b, h) do { _Pragma("unroll") for (int n = 0; n < 2; ++n) _Pragma("unroll") for (int k = 0; k < 2; ++k) dst[n][k] = *(const LAS bf16x8*)(lds + PG8_SB(b, h) + boff + n * 2048 + k * 1024); } while (0)
#define PG8_MMA(ai, bj, At, Bt) do { __builtin_amdgcn_s_setprio(1); _Pragma("unroll") for (int m = 0; m < 4; ++m) _Pragma("unroll") for (int n = 0; n < 2; ++n) _Pragma("unroll") for (int k = 0; k < 2; ++k) { \
        if constexpr (I8) acc[ai][bj][m][n] = __builtin_bit_cast(f32x4, __builtin_amdgcn_mfma_i32_16x16x64_i8(__builtin_bit_cast(i32x4, Bt[n][k]), __builtin_bit_cast(i32x4, At[m][k]), __builtin_bit_cast(i32x4, acc[ai][bj][m][n]), 0, 0, 0)); \
        else acc[ai][bj][m][n] = __builtin_amdgcn_mfma_f32_16x16x32_bf16(Bt[n][k], At[m][k], acc[ai][bj][m][n], 0, 0, 0); } __builtin_amdgcn_s_setprio(0); } while (0)
#define PG8_WAIT_V(n) asm volatile("s_waitcnt vmcnt(" #n ")" ::: "memory")
#define PG8_WAIT_L(n) asm volatile("s_waitcnt lgkmcnt(" #n ")" ::: "memory")
#define PG8_BAR __builtin_amdgcn_s_barrier()
#define PG8_SCHED __builtin_amdgcn_sched_barrier(0)
    Unit cur, nxt; int ui = 0;
    if (!S.next(0, cur)) return;
    Acc acc;
#pragma unroll
    for (int a = 0; a < 2; ++a)
#pragma unroll
        for (int b = 0; b < 2; ++b)
#pragma unroll
            for (int m = 0; m < 4; ++m)
#pragma unroll
                for (int n = 0; n < 2; ++n) acc[a][b][m][n] = (f32x4){0.f, 0.f, 0.f, 0.f};
    bf16x8 At[4][2], B0[2][2], B1[2][2];
    const char* cA = cur.A; const char* cB = cur.B;
    if constexpr (GATHER) {
#pragma unroll
        for (int h = 0; h < 2; ++h)
#pragma unroll
            for (int i = 0; i < 2; ++i) voA[h][i] = S.row_off(cur, Rr[i] + h * HALF) + (unsigned)Cc[i] * 2u;
    }
    PG8_STB(0, 0, cB); PG8_STB(0, 1, cB); PG8_STA(0, 0, cA, voA); PG8_STA(0, 1, cA, voA);
    if (wr == 1) PG8_BAR;
    PG8_WAIT_V(2); PG8_BAR;
    PG8_STB(1, 0, cB + kstep); PG8_STA(1, 0, cA + kstep, voA); PG8_STB(1, 1, cB + kstep);
    PG8_WAIT_V(6); PG8_BAR;
    for (;;) {
        const bool has_next = S.next(ui + 1, nxt);
        const char* nA = has_next ? nxt.A : cA; const char* nB = has_next ? nxt.B : cB;
        unsigned vnA[2][2];
        if constexpr (GATHER) {
#pragma unroll
            for (int h = 0; h < 2; ++h)
#pragma unroll
                for (int i = 0; i < 2; ++i) vnA[h][i] = has_next ? (S.row_off(nxt, Rr[i] + h * HALF) + (unsigned)Cc[i] * 2u) : voA[h][i];
        }
        for (int t = 0; t < nt; t += 2) {
            if constexpr (MIDHOOK) { if (t == (nt >> 1)) { int le_ = threadIdx.x & 63; asm volatile("" : "+v"(le_)); E.mid(acc, cur, wr, wc, le_ & 15, le_ >> 4); } }
            const bool last = (t == nt - 2);
            const char* a1 = cA + (size_t)(t + 1) * kstep;
            const char* a2 = last ? nA : cA + (size_t)(t + 2) * kstep; const char* b2 = last ? nB : cB + (size_t)(t + 2) * kstep;
            const char* a3 = a2 + kstep; const char* b3 = b2 + kstep;
            unsigned vs[2][2];
#pragma unroll
            for (int h = 0; h < 2; ++h)
#pragma unroll
                for (int i = 0; i < 2; ++i) { if constexpr (GATHER) vs[h][i] = last ? vnA[h][i] : voA[h][i]; else vs[h][i] = voA[h][i]; }
            PG8_LDB(B0, 0, 0); PG8_LDB(B1, 0, 1); PG8_SCHED; PG8_LDA(At, 0, 0); PG8_STA(1, 1, a1, voA);
            PG8_WAIT_V(8); PG8_WAIT_L(0); PG8_BAR; PG8_MMA(0, 0, At, B0); PG8_MMA(0, 1, At, B1); PG8_BAR; PG8_SCHED;
            PG8_LDA(At, 0, 1); PG8_STB(0, 0, b2); PG8_STB(0, 1, b2); PG8_STA(0, 0, a2, vs);
            PG8_WAIT_V(8); PG8_WAIT_L(0); PG8_BAR; if (!cur.half) { PG8_MMA(1, 0, At, B0); PG8_MMA(1, 1, At, B1); } PG8_BAR; PG8_SCHED;
            PG8_LDB(B0, 1, 0); PG8_LDB(B1, 1, 1); PG8_SCHED; PG8_LDA(At, 1, 0); PG8_STA(0, 1, a2, vs);
            PG8_WAIT_V(8); PG8_WAIT_L(0); PG8_BAR; PG8_MMA(0, 0, At, B0); PG8_MMA(0, 1, At, B1); PG8_BAR; PG8_SCHED;
            PG8_LDA(At, 1, 1); PG8_STB(1, 0, b3); PG8_STB(1, 1, b3); PG8_STA(1, 0, a3, vs);
            PG8_WAIT_V(8); PG8_WAIT_L(0); PG8_BAR; if (!cur.half) { PG8_MMA(1, 0, At, B0); PG8_MMA(1, 1, At, B1); } PG8_BAR; PG8_SCHED;
        }
        if (wr == 0) PG8_BAR;
        { int le_ = threadIdx.x & 63; asm volatile("" : "+v"(le_));
          E(acc, cur, wr, wc, le_ & 15, le_ >> 4); }
        if (!has_next) break;
#pragma unroll
        for (int a = 0; a < 2; ++a)
#pragma unroll
            for (int b = 0; b < 2; ++b)
#pragma unroll
                for (int m = 0; m < 4; ++m)
#pragma unroll
                    for (int n = 0; n < 2; ++n) acc[a][b][m][n] = (f32x4){0.f, 0.f, 0.f, 0.f};
        cur = nxt; cA = nA; cB = nB; ++ui;
        if constexpr (GATHER) {
#pragma unroll
            for (int h = 0; h < 2; ++h)
#pragma unroll
                for (int i = 0; i < 2; ++i) voA[h][i] = vnA[h][i];
        }
        if (wr == 1) PG8_BAR;
    }
    PG8_WAIT_V(0);
    PG8_BAR;
#undef PG8_SA
#undef PG8_SB
#undef PG8_STAGE2
#undef PG8_STA
#undef PG8_STB
#undef PG8_LDA
#undef PG8_LDB
#undef PG8_MMA
#undef PG8_WAIT_V
#undef PG8_WAIT_L
#undef PG8_BAR
#undef PG8_SCHED
}

struct SchedStatic {
    const char* A; const char* B; int nM, nN, G, c; size_t astep, bstep; int tail;
    __device__ __forceinline__ bool next(int i, Unit& u) const {
        const long L = (long)i * G + c; if (L >= (long)nM * nN) return false;
        int pm, pn; const int nfull = (nM - tail) * nN;
        if ((int)L < nfull) { tile_of((int)L, nM - tail, nN, pm, pn); u.half = 0; } else { pm = nM - 1; pn = (int)L - nfull; u.half = 1; }
        u.pm = pm; u.pn = pn; u.aux = 0; u.A = A + (size_t)pm * astep; u.B = B + (size_t)pn * bstep; return true;
    }
    __device__ __forceinline__ unsigned row_off(const Unit&, int) const { return 0u; }
};
struct SchedOut {
    const char* A0; const char* A1; const char* B0; const char* B1; int nM, nN, G, c; size_t astep, bstep;
    __device__ __forceinline__ bool next(int i, Unit& u) const {
        const long L = (long)(i >> 1) * G + c; if (L >= (long)nM * nN) return false;
        int pm, pn; const int nfull = (nM - 1) * nN;
        if ((int)L < nfull) { tile_of((int)L, nM - 1, nN, pm, pn); u.half = 0; } else { pm = nM - 1; pn = (int)L - nfull; u.half = 1; }
        const int pass = i & 1;
        u.pm = pm; u.pn = pn; u.aux = pass; u.A = (pass ? A1 : A0) + (size_t)pm * astep; u.B = (pass ? B1 : B0) + (size_t)pn * bstep; return true;
    }
    __device__ __forceinline__ unsigned row_off(const Unit&, int) const { return 0u; }
};
struct SchedMoe {
    const char* A; const char* B; const LAS int* tb; const LAS int* cnt; const int* list; int npn_shift, G, c; size_t bstep_e, bstep_n, astep; bool gather; int rowbytes;
    __device__ __forceinline__ bool next(int i, Unit& u) const {
        const int L = i * G + c; const int ntile = tb[16];
        if (L >= (ntile << npn_shift)) return false;
        const int ti = L >> npn_shift, pn = L & ((1 << npn_shift) - 1);
        int e = 0; while (ti >= tb[e + 1]) ++e;
        u.pm = ti; u.pn = pn; u.aux = e; u.half = (cnt[e] - (ti - tb[e]) * 256) <= 128 ? 1 : 0;
        u.A = gather ? A : A + (size_t)ti * astep;
        u.B = B + (size_t)e * bstep_e + (size_t)pn * bstep_n; return true;
    }
    __device__ __forceinline__ unsigned row_off(const Unit& u, int r) const {
        const int e = u.aux; int idx = (u.pm - tb[e]) * 256 + r; const int ce = cnt[e]; idx = idx < ce ? idx : ce - 1;
        const int tok = list[(size_t)e * TP + idx];
        return (unsigned)tok * (unsigned)rowbytes;
    }
};

__device__ __forceinline__ f32x4 dq4(const f32x4& a, float srow, const f32x4& scol) { const i32x4 i = __builtin_bit_cast(i32x4, a); return (f32x4){(float)i[0], (float)i[1], (float)i[2], (float)i[3]} * srow * scol; }
__device__ __forceinline__ f32x4 cmscale(const unsigned* cm) { const u32x4 u = *(const u32x4*)cm; return (f32x4){__uint_as_float(u.x), __uint_as_float(u.y), __uint_as_float(u.z), __uint_as_float(u.w)} * (1.0f / 127.0f); }
__device__ __forceinline__ u32x4 pack8(f32x4 v0, f32x4 v1) { u32x4 w; w.x = pk_bf16(v0[0], v0[1]); w.y = pk_bf16(v0[2], v0[3]); w.z = pk_bf16(v1[0], v1[1]); w.w = pk_bf16(v1[2], v1[3]); return w; }
__device__ __forceinline__ float logsig(float x) { return fminf(x, 0.f) - log1pf(__expf(-fabsf(x))); }
__device__ __forceinline__ float sigm(float x) { return __builtin_amdgcn_rcpf(1.0f + __builtin_amdgcn_exp2f(-LOG2E * x)); }

struct EpiA1 {
    static constexpr bool PERM = true;
    bf16_t *Qf, *Kf, *Vf, *RAW; float* LF; const float* fbias; float* qkn; float* ssq; bf16_t* Km; const float* cosT; const float* sinT; const float* hbs; const unsigned* cm;
    __device__ __forceinline__ void operator()(const Acc& acc, const Unit& u, int wr, int wc, int fr, int fq) const {
        const int pn = u.pn; bf16_t* base; int ldc, colt; float sc = 1.f;
        if (pn < 2) { base = Qf; ldc = 512; colt = pn * 256; sc = C2F; } else if (pn < 4) { base = Kf; ldc = 512; colt = (pn - 2) * 256; }
        else if (pn < 6) { base = Vf; ldc = 512; colt = (pn - 4) * 256; } else { base = RAW; ldc = 768; colt = (pn - 6) * 256; }
        const int row0 = u.pm * 256 + wr * 64 + fr, col0 = colt + wc * 32 + 8 * fq;
        f32x4 sb[2][2];
#pragma unroll
        for (int bj = 0; bj < 2; ++bj) { const unsigned* c_ = cm + pn * 256 + bj * 128 + wc * 32 + 8 * fq; sb[bj][0] = cmscale(c_); sb[bj][1] = cmscale(c_ + 4); }
        float sa8[2][4];
#pragma unroll
        for (int ai = 0; ai < 2; ++ai)
#pragma unroll
            for (int m = 0; m < 4; ++m) sa8[ai][m] = hbs[row0 + ai * 128 + m * 16];
#pragma unroll
        for (int ai = 0; ai < 2; ++ai) {
            float ssv[4][2];
#pragma unroll
            for (int m = 0; m < 4; ++m) { if (ai == 1 && u.half && !(pn == 4 || pn == 5)) continue;
                const int row = row0 + ai * 128 + m * 16; bf16_t* rowp = base + (size_t)row * ldc + col0;
                const float sa = sa8[ai][m] * sc;
#pragma unroll
                for (int bj = 0; bj < 2; ++bj) { const u32x4 w = pack8(dq4(acc[ai][bj][m][0], sa, sb[bj][0]), dq4(acc[ai][bj][m][1], sa, sb[bj][1])); *(u32x4*)(rowp + bj * 128) = w;
                    if (pn < 4 || pn >= 6) {
                        const float a0 = bf_lo(w.x), a1 = bf_hi(w.x), a2 = bf_lo(w.y), a3 = bf_hi(w.y), a4 = bf_lo(w.z), a5 = bf_hi(w.z), a6 = bf_lo(w.w), a7 = bf_hi(w.w);
                        float ss = (a0 * a0 + a1 * a1) + (a2 * a2 + a3 * a3) + (a4 * a4 + a5 * a5) + (a6 * a6 + a7 * a7);
                        { auto r16 = __builtin_amdgcn_permlane16_swap(__float_as_uint(ss), __float_as_uint(ss), false, false); ss = __uint_as_float(r16[0]) + __uint_as_float(r16[1]); }
                        { auto r32_ = __builtin_amdgcn_permlane32_swap(__float_as_uint(ss), __float_as_uint(ss), false, false); ss = __uint_as_float(r32_[0]) + __uint_as_float(r32_[1]); }
                        ssv[m][bj] = ss; } } }
            if ((pn < 4 || pn >= 6) && !(ai == 1 && u.half)) {
#pragma unroll
                for (int bj = 0; bj < 2; ++bj) { const float v = fq == 0 ? ssv[0][bj] : fq == 1 ? ssv[1][bj] : fq == 2 ? ssv[2][bj] : ssv[3][bj];
                    const int row = row0 + ai * 128 + fq * 16;
                    if (pn < 4) qkn[(size_t)row * 32 + (pn >> 1) * 16 + (pn & 1) * 8 + bj * 4 + wc] = v;
                    else { const int g32 = (pn - 6) * 8 + bj * 4 + wc;
                        if (g32 < 20) ssq[(size_t)row * 20 + g32] = v; } } } }
        if (pn == 8 && wc == 0) {
#pragma unroll
            for (int aim = 0; aim < 4; ++aim) { const int ai = aim >> 1; if (ai == 1 && u.half) continue;
                f32x4 cs4[2], sn4[2];
#pragma unroll
                for (int mm = 0; mm < 2; ++mm) { const int pos = pos_of(row0 + ai * 128 + ((aim & 1) * 2 + mm) * 16); cs4[mm] = *(const f32x4*)(cosT + pos * 16 + 4 * fq); sn4[mm] = *(const f32x4*)(sinT + pos * 16 + 4 * fq); }
#pragma unroll
                for (int mm = 0; mm < 2; ++mm) { const int m = (aim & 1) * 2 + mm; const int row = row0 + ai * 128 + m * 16;
                    const float sa = sa8[ai][m]; const f32x4 x1 = dq4(acc[ai][1][m][0], sa, sb[1][0]), x2 = dq4(acc[ai][1][m][1], sa, sb[1][1]);
                    const f32x4 cs = cs4[mm], sn = sn4[mm];
                    const f32x4 y1 = x1 * cs - x2 * sn, y2 = x2 * cs + x1 * sn;
                    u32x2 w1, w2; w1.x = pk_bf16(y1[0], y1[1]); w1.y = pk_bf16(y1[2], y1[3]); w2.x = pk_bf16(y2[0], y2[1]); w2.y = pk_bf16(y2[2], y2[3]);
                    bf16_t* kp = Km + (size_t)row * 32 + 4 * fq;
                    *(u32x2*)kp = w1; *(u32x2*)(kp + 16) = w2; } }
        }
        if (pn == 8 && wc == 1 && fq == 0) {
            const f32x4 b0 = *(const f32x4*)fbias, b1 = *(const f32x4*)(fbias + 4);
#pragma unroll
            for (int ai = 0; ai < 2; ++ai)
#pragma unroll
                for (int m = 0; m < 4; ++m) { if (ai == 1 && u.half) continue; const int row = row0 + ai * 128 + m * 16; const float sa = sa8[ai][m]; const f32x4 a = dq4(acc[ai][1][m][0], sa, sb[1][0]) + b0, b = dq4(acc[ai][1][m][1], sa, sb[1][1]) + b1;
                    f32x4 o0, o1;
#pragma unroll
                    for (int j = 0; j < 4; ++j) { o0[j] = logsig(a[j]); o1[j] = logsig(b[j]); }
                    *(f32x4*)(LF + (size_t)row * 8) = o0; *(f32x4*)(LF + (size_t)row * 8 + 4) = o1; }
        }
    }
};
struct EpiA2 {
    static constexpr bool PERM = true;
    unsigned char* Gm; unsigned char* Galt; const float* hbs; const unsigned* cm;
    __device__ __forceinline__ void operator()(const Acc& acc, const Unit& u, int wr, int wc, int fr, int fq) const {
        unsigned char* G = (u.pm == 128) ? Galt - (size_t)32768 * 2048 : Gm;
        const int row0 = u.pm * 256 + wr * 64 + fr, col0 = (u.pn - 9) * 256 + wc * 64 + 16 * fq;
        f32x4 sb[2][2];
#pragma unroll
        for (int bj = 0; bj < 2; ++bj) { const unsigned* c_ = cm + u.pn * 256 + bj * 128 + wc * 32 + 8 * fq; sb[bj][0] = cmscale(c_); sb[bj][1] = cmscale(c_ + 4); }
        float sa8[2][4];
#pragma unroll
        for (int ai = 0; ai < 2; ++ai)
#pragma unroll
            for (int m = 0; m < 4; ++m) sa8[ai][m] = hbs[row0 + ai * 128 + m * 16];
#pragma unroll
        for (int ai = 0; ai < 2; ++ai)
#pragma unroll
            for (int m = 0; m < 4; ++m) { if (ai == 1 && u.half) continue; unsigned char* rowp = G + (size_t)(row0 + ai * 128 + m * 16) * 2048 + col0; const float sa = sa8[ai][m]; u32x2 wv[2];
#pragma unroll
                for (int bj = 0; bj < 2; ++bj) { const f32x4 a = dq4(acc[ai][bj][m][0], sa, sb[bj][0]), b = dq4(acc[ai][bj][m][1], sa, sb[bj][1]); unsigned q[8];
#pragma unroll
                    for (int j = 0; j < 4; ++j) { q[j] = (unsigned)fmaxf(255.0f * sigm(a[j]) + 0.5f, 1.0f); q[4 + j] = (unsigned)fmaxf(255.0f * sigm(b[j]) + 0.5f, 1.0f); }
                    wv[bj].x = q[0] | (q[1] << 8) | (q[2] << 16) | (q[3] << 24); wv[bj].y = q[4] | (q[5] << 8) | (q[6] << 16) | (q[7] << 24); }
                *(u32x4*)rowp = (u32x4){wv[0].x, wv[0].y, wv[1].x, wv[1].y}; }
    }
};
struct EpiA {
    static constexpr bool PERM = true;
    EpiA1 e1; EpiA2 e2;
    __device__ __forceinline__ void operator()(const Acc& acc, const Unit& u, int wr, int wc, int fr, int fq) const { if (u.pn < 9) e1(acc, u, wr, wc, fr, fq); else e2(acc, u, wr, wc, fr, fq); }
};
struct EpiQup {
    static constexpr bool PERM = false;
    bf16_t* Qm; const float* cosT; const float* sinT; const float* ssq;
    __device__ __forceinline__ void operator()(const Acc& acc, const Unit& u, int wr, int wc, int fr, int fq) const {
        const int row0 = u.pm * 256 + wr * 64 + fr;
        float rq8[2][4];
#pragma unroll
        for (int ai = 0; ai < 2; ++ai)
#pragma unroll
            for (int m = 0; m < 4; ++m) { const int row = row0 + ai * 128 + m * 16;
                float sq_; { const f32x4 a = *(const f32x4*)(ssq + (size_t)row * 20), b4 = *(const f32x4*)(ssq + (size_t)row * 20 + 4), c4 = *(const f32x4*)(ssq + (size_t)row * 20 + 8); sq_ = ((a[0] + a[1]) + (a[2] + a[3])) + ((b4[0] + b4[1]) + (b4[2] + b4[3])) + ((c4[0] + c4[1]) + (c4[2] + c4[3])); }
                rq8[ai][m] = C2M * __builtin_amdgcn_rsqf(sq_ * (1.f / 384.f) + 1e-6f);
                if (m & 1) asm volatile("" : "+v"(rq8[ai][m - 1]), "+v"(rq8[ai][m])); }
        const bool anyrot = ((u.pn * 8 + wc) % 3 == 2) || ((u.pn * 8 + 4 + wc) % 3 == 2);
#pragma unroll
        for (int aim = 0; aim < 4; ++aim) { const int ai = aim >> 1; if (ai == 1 && u.half) continue;
            f32x4 cs4[2], sn4[2];
            if (anyrot) {
#pragma unroll
                for (int mm = 0; mm < 2; ++mm) { const int pos = pos_of(row0 + ai * 128 + ((aim & 1) * 2 + mm) * 16); cs4[mm] = *(const f32x4*)(cosT + pos * 16 + 4 * fq); sn4[mm] = *(const f32x4*)(sinT + pos * 16 + 4 * fq); } }
#pragma unroll
            for (int mm = 0; mm < 2; ++mm) { const int m = (aim & 1) * 2 + mm; const int row = row0 + ai * 128 + m * 16;
                const float rq = rq8[ai][m];
#pragma unroll
                for (int bj = 0; bj < 2; ++bj) { const int Gi = u.pn * 8 + bj * 4 + wc; f32x4 x0 = acc[ai][bj][m][0], x1 = acc[ai][bj][m][1];
                    if (Gi % 3 == 2) { const f32x4 cs = cs4[mm], sn = sn4[mm];
                        const f32x4 y0 = x0 * cs - x1 * sn, y1 = x1 * cs + x0 * sn; x0 = y0; x1 = y1; }
                    x0 = x0 * rq; x1 = x1 * rq;
                    u32x2 w0, w1; w0.x = pk_bf16(x0[0], x0[1]); w0.y = pk_bf16(x0[2], x0[3]); w1.x = pk_bf16(x1[0], x1[1]); w1.y = pk_bf16(x1[2], x1[3]);
                    const auto sx = __builtin_amdgcn_permlane16_swap(w0.x, w1.x, false, false); const auto sy = __builtin_amdgcn_permlane16_swap(w0.y, w1.y, false, false);
                    bf16_t* p = Qm + (size_t)row * 768 + Gi * 32 + ((fq & 1) ? 12 + 4 * fq : 4 * fq);
                    *(u32x4*)p = (u32x4){sx[0], sy[0], sx[1], sy[1]}; } } }
    }
};
struct EpiKV {
    static constexpr bool PERM = true;
    bf16_t *Km, *Vm; const float* ssq;
    __device__ __forceinline__ void operator()(const Acc& acc, const Unit& u, int wr, int wc, int fr, int fq) const {
        const int row0 = u.pm * 256 + wr * 64 + fr;
        float rk8[2][4];
#pragma unroll
        for (int ai = 0; ai < 2; ++ai)
#pragma unroll
            for (int m = 0; m < 4; ++m) { const int row = row0 + ai * 128 + m * 16;
                float sk_; { const f32x4 a = *(const f32x4*)(ssq + (size_t)row * 20 + 12), b4 = *(const f32x4*)(ssq + (size_t)row * 20 + 16); sk_ = ((a[0] + a[1]) + (a[2] + a[3])) + ((b4[0] + b4[1]) + (b4[2] + b4[3])); }
                rk8[ai][m] = __builtin_amdgcn_rsqf(sk_ * (1.f / 256.f) + 1e-6f); }
#pragma unroll
        for (int ai = 0; ai < 2; ++ai)
#pragma unroll
            for (int m = 0; m < 4; ++m) { const bool padrows = (ai == 1 && u.half); if (padrows && u.pn < 2) continue; const int row = row0 + ai * 128 + m * 16;
                if (padrows) {
#pragma unroll
                    for (int bj = 0; bj < 2; ++bj) { const int n = u.pn * 256 + bj * 128 + wc * 32 + 8 * fq; *(u32x4*)(Vm + (size_t)row * 512 + (n - 512)) = (u32x4){0u, 0u, 0u, 0u}; }
                    continue; }
                const float rk = rk8[ai][m];
#pragma unroll
                for (int bj = 0; bj < 2; ++bj) { const int n = u.pn * 256 + bj * 128 + wc * 32 + 8 * fq; const u32x4 w = pack8(acc[ai][bj][m][0] * rk, acc[ai][bj][m][1] * rk);
                    if (u.pn < 2) *(u32x4*)(Km + (size_t)row * 768 + 96 * (n >> 6) + (n & 63)) = w;
                    else *(u32x4*)(Vm + (size_t)row * 512 + (n - 512)) = w; } }
    }
};
__device__ __forceinline__ void store_lines16(bf16_t* rp, int ld, const u32x4& w0, const u32x4& w1, int up) {
    const u32x4 keep = up ? w1 : w0, send = up ? w0 : w1; u32x4 recv;
    recv.x = (unsigned)__builtin_amdgcn_update_dpp(0, (int)send.x, 0x128, 0xf, 0xf, false); recv.y = (unsigned)__builtin_amdgcn_update_dpp(0, (int)send.y, 0x128, 0xf, 0xf, false);
    recv.z = (unsigned)__builtin_amdgcn_update_dpp(0, (int)send.z, 0x128, 0xf, 0xf, false); recv.w = (unsigned)__builtin_amdgcn_update_dpp(0, (int)send.w, 0x128, 0xf, 0xf, false);
    *(u32x4*)rp = up ? recv : keep;
    *(u32x4*)(rp + (size_t)8 * ld) = up ? keep : recv;
}
struct EpiOut {
    static constexpr bool PERM = true;
    const unsigned char* Gm; const unsigned char* Galt; bf16_t* Mg;
    __device__ __forceinline__ void mid(Acc& acc, const Unit& u, int wr, int wc, int fr, int fq) const {
        const unsigned char* G = (u.pm == 128) ? Galt - (size_t)32768 * 2048 : Gm;
        const int row0 = u.pm * 256 + wr * 64 + fr, col0 = u.pn * 256 + wc * 64 + 8 * fq;
#pragma unroll
        for (int ai = 0; ai < 2; ++ai)
#pragma unroll
            for (int m = 0; m < 4; ++m) { if (ai == 1 && u.half) continue; const int row = row0 + ai * 128 + m * 16;
#pragma unroll
                for (int bj = 0; bj < 2; ++bj) { const int col = col0 + bj * 32;
                    const u32x2 gf = *(const u32x2*)(G + (size_t)row * 2048 + col), gm = *(const u32x2*)(G + (size_t)row * 2048 + 1024 + col);
                    f32x4& a = acc[ai][bj][m][0]; f32x4& b = acc[ai][bj][m][1];
#pragma unroll
                    for (int j = 0; j < 4; ++j) { a[j] *= (float)((gf.x >> (8 * j)) & 255u) * __builtin_amdgcn_rcpf((float)((gm.x >> (8 * j)) & 255u)); b[j] *= (float)((gf.y >> (8 * j)) & 255u) * __builtin_amdgcn_rcpf((float)((gm.y >> (8 * j)) & 255u)); } }
                if (m == 3) asm volatile("" ::: "memory"); }
    }
    __device__ __forceinline__ void operator()(const Acc& acc, const Unit& u, int wr, int wc, int fr, int fq) const {
        const unsigned char* G = (u.pm == 128) ? Galt - (size_t)32768 * 2048 : Gm;
        const int row0 = u.pm * 256 + wr * 64 + fr, col0 = u.pn * 256 + wc * 64 + 8 * fq;
        const int fr8 = fr & 7, up = fr >> 3;
        bf16_t* mb = Mg + (size_t)(u.pm * 256 + wr * 64 + fr8) * 1024 + u.pn * 256 + wc * 64 + up * 32 + 8 * fq;
#pragma unroll
        for (int ai = 0; ai < 2; ++ai) { if (ai == 1 && u.half) continue;
            u32x2 g8[4][2];
#pragma unroll
            for (int m = 0; m < 4; ++m)
#pragma unroll
                for (int bj = 0; bj < 2; ++bj) g8[m][bj] = *(const u32x2*)(G + (size_t)(row0 + ai * 128 + m * 16) * 2048 + 1024 + col0 + bj * 32);
            if (ai == 0) asm volatile("" ::: "memory");
#pragma unroll
            for (int m = 0; m < 4; ++m) { u32x4 wv[2];
#pragma unroll
                for (int bj = 0; bj < 2; ++bj) {
                    const u32x2 g = g8[m][bj];
                    f32x4 a = acc[ai][bj][m][0], b = acc[ai][bj][m][1];
#pragma unroll
                    for (int j = 0; j < 4; ++j) { a[j] *= (float)((g.x >> (8 * j)) & 255u) * (1.0f / 255.0f); b[j] *= (float)((g.y >> (8 * j)) & 255u) * (1.0f / 255.0f); }
                    wv[bj] = pack8(a, b); }
                store_lines16(mb + (size_t)(ai * 128 + m * 16) * 1024, 1024, wv[0], wv[1], up); } }
    }
};
struct EpiF {
    static constexpr bool PERM = true;
    const bf16_t* H; bf16_t* Z;
    __device__ __forceinline__ void operator()(const Acc& acc, const Unit& u, int wr, int wc, int fr, int fq) const {
        const int row0 = u.pm * 256 + wr * 64 + fr, col0 = u.pn * 256 + wc * 64 + 8 * fq;
        const int fr8 = fr & 7, up = fr >> 3;
        bf16_t* zb = Z + (size_t)(u.pm * 256 + wr * 64 + fr8) * 1024 + u.pn * 256 + wc * 64 + up * 32 + 8 * fq;
#pragma unroll
        for (int ai = 0; ai < 2; ++ai) { if (ai == 1 && u.half) continue;
            u32x4 h8[4][2];
#pragma unroll
            for (int m = 0; m < 4; ++m)
#pragma unroll
                for (int bj = 0; bj < 2; ++bj) h8[m][bj] = *(const u32x4*)(H + (size_t)(row0 + ai * 128 + m * 16) * 1024 + col0 + bj * 32);
#pragma unroll
            for (int m = 0; m < 4; ++m) { u32x4 wv[2];
#pragma unroll
                for (int bj = 0; bj < 2; ++bj) { const u32x4 hv = h8[m][bj]; f32x4 a = acc[ai][bj][m][0], b = acc[ai][bj][m][1];
                    a[0] += ALPHA * bf_lo(hv.x); a[1] += ALPHA * bf_hi(hv.x); a[2] += ALPHA * bf_lo(hv.y); a[3] += ALPHA * bf_hi(hv.y);
                    b[0] += ALPHA * bf_lo(hv.z); b[1] += ALPHA * bf_hi(hv.z); b[2] += ALPHA * bf_lo(hv.w); b[3] += ALPHA * bf_hi(hv.w);
                    wv[bj] = pack8(a, b); }
                store_lines16(zb + (size_t)(ai * 128 + m * 16) * 1024, 1024, wv[0], wv[1], up); } }
    }
};
struct EpiM1 {
    static constexpr bool PERM = true;
    bf16_t* Hid; const float* h1s; const unsigned* cm; const LAS int* tb; const LAS int* cnt; const int* list;
    __device__ __forceinline__ void operator()(const Acc& acc, const Unit& u, int wr, int wc, int fr, int fq) const {
        const int row0 = u.pm * 256 + wr * 64 + fr, hc0 = u.pn * 128 + wc * 32 + 8 * fq;
        const int e = u.aux; const unsigned* cme = cm + e * 512 + u.pn * 256 + wc * 32 + 8 * fq;
        f32x4 sg[2], su[2];
#pragma unroll
        for (int n = 0; n < 2; ++n) { sg[n] = cmscale(cme + 4 * n); su[n] = cmscale(cme + 128 + 4 * n); }
        const int ce = cnt[e], tl = (u.pm - tb[e]) * 256;
        int tk8[2][4]; float sa8[2][4];
#pragma unroll
        for (int ai = 0; ai < 2; ++ai)
#pragma unroll
            for (int m = 0; m < 4; ++m) { int idx = tl + wr * 64 + fr + ai * 128 + m * 16; idx = idx < ce ? idx : ce - 1; tk8[ai][m] = list[(size_t)e * TP + idx]; }
#pragma unroll
        for (int ai = 0; ai < 2; ++ai)
#pragma unroll
            for (int m = 0; m < 4; ++m) sa8[ai][m] = h1s[tk8[ai][m]];
#pragma unroll
        for (int ai = 0; ai < 2; ++ai)
#pragma unroll
            for (int m = 0; m < 4; ++m) { if (ai == 1 && u.half) continue; bf16_t* rowp = Hid + (size_t)(row0 + ai * 128 + m * 16) * 256 + hc0;
                const float sa = sa8[ai][m]; f32x4 o[2];
#pragma unroll
                for (int n = 0; n < 2; ++n) { const f32x4 g = dq4(acc[ai][0][m][n], sa, sg[n]), up = dq4(acc[ai][1][m][n], sa, su[n]);
#pragma unroll
                    for (int j = 0; j < 4; ++j) o[n][j] = g[j] * sigm(g[j]) * up[j]; }
                *(u32x4*)rowp = pack8(o[0], o[1]); }
    }
};
struct EpiM2 {
    static constexpr bool PERM = true;
    bf16_t* Ys;
    __device__ __forceinline__ void operator()(const Acc& acc, const Unit& u, int wr, int wc, int fr, int fq) const {
        const int fr8 = fr & 7, up = fr >> 3;
        bf16_t* base = Ys + (size_t)(u.pm * 256 + wr * 64 + fr8) * 1024 + u.pn * 256 + wc * 64 + up * 32 + 8 * fq;
#pragma unroll
        for (int ai = 0; ai < 2; ++ai)
#pragma unroll
            for (int m = 0; m < 4; ++m) { if (ai == 1 && u.half) continue;
                const u32x4 w0 = pack8(acc[ai][0][m][0], acc[ai][0][m][1]), w1 = pack8(acc[ai][1][m][0], acc[ai][1][m][1]);
                const u32x4 keep = up ? w1 : w0, send = up ? w0 : w1; u32x4 recv;
                recv.x = (unsigned)__builtin_amdgcn_update_dpp(0, (int)send.x, 0x128, 0xf, 0xf, false); recv.y = (unsigned)__builtin_amdgcn_update_dpp(0, (int)send.y, 0x128, 0xf, 0xf, false);
                recv.z = (unsigned)__builtin_amdgcn_update_dpp(0, (int)send.z, 0x128, 0xf, 0xf, false); recv.w = (unsigned)__builtin_amdgcn_update_dpp(0, (int)send.w, 0x128, 0xf, 0xf, false);
                bf16_t* rp = base + (size_t)(ai * 128 + m * 16) * 1024;
                *(u32x4*)rp = up ? recv : keep;
                *(u32x4*)(rp + 8 * 1024) = up ? keep : recv; }
    }
};
}

__device__ __forceinline__ int crow(int r, int hi) { return (r & 3) + 8 * (r >> 2) + 4 * hi; }
typedef short v4i16_t __attribute__((ext_vector_type(4)));
__device__ __forceinline__ s16x4 vtr(const LAS char* p) { return __builtin_bit_cast(s16x4, __builtin_amdgcn_ds_read_tr16_b64_v4i16((LAS v4i16_t*)p)); }
template <int OFF> __device__ __forceinline__ s16x4 vtr_a(unsigned a) { s16x4 r; asm volatile("ds_read_b64_tr_b16 %0, %1 offset:%2" : "=v"(r) : "v"(a), "n"(OFF)); return r; }
#define VTR_WAIT(A, B, C, D) do { \
    asm volatile("s_waitcnt lgkmcnt(0)" : "+v"(A[0]), "+v"(A[1]), "+v"(A[2]), "+v"(A[3]), "+v"(B[0]), "+v"(B[1]), "+v"(B[2]), "+v"(B[3])); \
    asm volatile("" : "+v"(C[0]), "+v"(C[1]), "+v"(C[2]), "+v"(C[3]), "+v"(D[0]), "+v"(D[1]), "+v"(D[2]), "+v"(D[3])); } while (0)
__device__ __forceinline__ float swapmax(float m) { auto rr = __builtin_amdgcn_permlane32_swap(__float_as_uint(m), __float_as_uint(m), false, false); return fmaxf(__uint_as_float(rr[0]), __uint_as_float(rr[1])); }
__device__ __forceinline__ float swapsum(float m) { auto rr = __builtin_amdgcn_permlane32_swap(__float_as_uint(m), __float_as_uint(m), false, false); return __uint_as_float(rr[0]) + __uint_as_float(rr[1]); }

template <int DK, bool FOX>
__device__ __forceinline__ void attn_unit8(LAS char* lds, const bf16_t* Q, int ldq, const bf16_t* Kp, int ldk, const bf16_t* Vp, int ldv, bf16_t* O, int ldo,
                                           const float* cs, int b, int j, int tau_min, unsigned* qnext, unsigned& ticket, const bf16_t* K2 = nullptr) {
    constexpr int NS = DK / 16, KB = 64 * DK * 2, SB = KB + 8192 + 256;
    constexpr float THR = 8.0f;
    int tid_l = threadIdx.x; asm volatile("" : "+v"(tid_l));
    const int tid = tid_l, lane = tid & 63, r32 = lane & 31, hi = lane >> 5; const int wid = __builtin_amdgcn_readfirstlane(tid >> 6);
    const int qp0 = (j == 0) ? 0 : 16 + 256 * (j - 1) + 32 * wid;
    const int qpos = qp0 + r32;
    const size_t qrow = (j == 0) ? (size_t)(NREAL + NMETA * b + r32) : (size_t)(SEQ * b + 256 * (j - 1) + 32 * wid + r32);
    const size_t mrow0 = (size_t)(NREAL + NMETA * b), rrow0 = (size_t)SEQ * b;
    const bool wave_on = (j > 0) || (wid == 0);
    const int tdiag = wave_on ? ((j == 0) ? 0 : 4 * (j - 1) + 1 + (wid >> 1)) : -1;
    const int qin = (j == 0) ? r32 : 32 * (wid & 1) + r32;
    const int NT = 4 * j + 1;
    bf16x8 qf[NS];
#pragma unroll
    for (int s = 0; s < NS; ++s) qf[s] = *(const bf16x8*)(Q + qrow * ldq + 16 * s + 8 * hi);
    float csq = 0.f; if (FOX) csq = cs[qpos];
    const bf16_t* kg = Kp + (size_t)lane * ldk + 8 * wid;
    const bf16_t* kg2 = (DK == 96) ? K2 + (size_t)lane * 32 + 8 * (wid & 3) : Kp;
    const bf16_t* vg = Vp + (size_t)(16 * (wid & 3) + 8 * (lane >> 5) + ((lane >> 2) & 7)) * ldv + 32 * (wid >> 2) + 8 * (lane & 3);
    const int nops = 2 + ((DK == 96) ? (wid < 4 ? 1 : 0) : (FOX ? (wid == 4 ? 1 : 0) : 0));
#define ATT_ISSUE(t, slot) do { const int ts_ = ((t) == 0) ? 0 : 64 * (t) - 48; const size_t tr_ = ((t) == 0) ? mrow0 : rrow0 + 64 * ((t) - 1); LAS char* sb_ = lds + (slot) * SB; \
        __builtin_amdgcn_global_load_lds((const unsigned*)(kg + tr_ * ldk), (LAS unsigned*)(sb_ + wid * 1024), 16, 0, 0); \
        __builtin_amdgcn_global_load_lds((const unsigned*)(vg + tr_ * ldv), (LAS unsigned*)(sb_ + KB + (wid >> 2) * 4096 + (wid & 3) * 1024), 16, 0, 0); \
        if (DK == 96) { if (wid < 4) __builtin_amdgcn_global_load_lds((const unsigned*)(kg2 + tr_ * 32), (LAS unsigned*)(sb_ + (8 + wid) * 1024), 16, 0, 0); } \
        else if (FOX) { if (wid == 4) { if (lane < 16) __builtin_amdgcn_global_load_lds((const unsigned*)(cs + ts_ + 4 * lane), (LAS unsigned*)(sb_ + KB + 8192), 16, 0, 0); } } } while (0)
    int t = NT - 1;
    int slot = 0;
    ATT_ISSUE(t, 0);
    if (t - 1 >= tau_min) ATT_ISSUE(t - 1, 1);
    float mhat = 0.f, lrun = 0.f;
    f32x16 o0 = {}, o1 = {};
    const int vlane = ((lane >> 4) & 1) * 32 + (lane & 3) * 8 + (4 * hi + ((lane & 15) >> 2)) * 64;
    for (; t > tdiag && t >= tau_min; --t) {
        if (t - 1 >= tau_min) { if (nops == 3) asm volatile("s_waitcnt vmcnt(3)" ::: "memory"); else asm volatile("s_waitcnt vmcnt(2)" ::: "memory"); }
        else asm volatile("s_waitcnt vmcnt(0)" ::: "memory");
        __builtin_amdgcn_s_barrier(); asm volatile("" ::: "memory");
        { const int s2 = (slot >= 1) ? slot - 1 : 2; if (t - 2 >= tau_min) ATT_ISSUE(t - 2, s2); }
        const LAS char* cb = lds + slot * SB; (void)cb;
        slot = (slot == 2) ? 0 : slot + 1;
    }
    if (t >= tau_min) {
        if (t - 1 >= tau_min) { if (nops == 3) asm volatile("s_waitcnt vmcnt(3)" ::: "memory"); else asm volatile("s_waitcnt vmcnt(2)" ::: "memory"); }
        else asm volatile("s_waitcnt vmcnt(0)" ::: "memory");
        __builtin_amdgcn_s_barrier(); asm volatile("" ::: "memory");
        const LAS char* cb = lds + slot * SB; (void)cb;
        {
            f32x16 p0, p1;
            if (FOX) {
                const LAS float* cl = (const LAS float*)(cb + KB + 8192); const float base = csq - mhat;
#pragma unroll
                for (int g = 0; g < 4; ++g) { const f32x4 c0 = *(const LAS f32x4*)(cl + 8 * g + 4 * hi), c1 = *(const LAS f32x4*)(cl + 32 + 8 * g + 4 * hi);
#pragma unroll
                    for (int jj = 0; jj < 4; ++jj) { p0[4 * g + jj] = base - c0[jj]; p1[4 * g + jj] = base - c1[jj]; } }
            } else {
                const float nm = -mhat;
#pragma unroll
                for (int r = 0; r < 16; ++r) { p0[r] = nm; p1[r] = nm; }
            }
            bf16x8 ka[NS][2];
#pragma unroll
            for (int s = 0; s < NS; ++s) { const int c = 2 * s + hi; ka[s][0] = *(const LAS bf16x8*)(cb + c * 1024 + r32 * 16); ka[s][1] = *(const LAS bf16x8*)(cb + c * 1024 + 512 + r32 * 16); }
            __builtin_amdgcn_sched_barrier(0);
#pragma unroll
            for (int s = 0; s < NS; ++s) { p0 = __builtin_amdgcn_mfma_f32_32x32x16_bf16(ka[s][0], qf[s], p0, 0, 0, 0); p1 = __builtin_amdgcn_mfma_f32_32x32x16_bf16(ka[s][1], qf[s], p1, 0, 0, 0); }
            __builtin_amdgcn_sched_barrier(0);
            const unsigned vb = (unsigned)(size_t)(cb + KB + vlane);
            s16x4 vl0[4], vh0[4], vl1[4], vh1[4];
            vl0[0] = vtr_a<0>(vb); vh0[0] = vtr_a<512>(vb); vl1[0] = vtr_a<4096>(vb); vh1[0] = vtr_a<4608>(vb);
            vl0[1] = vtr_a<1024>(vb); vh0[1] = vtr_a<1536>(vb); vl1[1] = vtr_a<5120>(vb); vh1[1] = vtr_a<5632>(vb);
            vl0[2] = vtr_a<2048>(vb); vh0[2] = vtr_a<2560>(vb); vl1[2] = vtr_a<6144>(vb); vh1[2] = vtr_a<6656>(vb);
            vl0[3] = vtr_a<3072>(vb); vh0[3] = vtr_a<3584>(vb); vl1[3] = vtr_a<7168>(vb); vh1[3] = vtr_a<7680>(vb);
            __builtin_amdgcn_sched_barrier(0);
            if (t == tdiag) {
#pragma unroll
                for (int r = 0; r < 16; ++r) { const int kv = 4 * hi + (r & 3) + 8 * (r >> 2); if (kv > qin) p0[r] = -INFINITY; if (kv + 32 > qin) p1[r] = -INFINITY; }
            }
            if (t == 0) {
#pragma unroll
                for (int r = 0; r < 16; ++r) { const int kv = 4 * hi + (r & 3) + 8 * (r >> 2); if (kv >= 16) p0[r] = -INFINITY; p1[r] = -INFINITY; }
            }
            float mt;
            { float ma = __builtin_fmaxf(__builtin_fmaxf(p0[0], p0[1]), p1[0]), mb = __builtin_fmaxf(__builtin_fmaxf(p0[2], p0[3]), p1[1]); ma = __builtin_fmaxf(__builtin_fmaxf(ma, p1[2]), p1[3]);
#pragma unroll
              for (int r = 4; r < 16; r += 4) { ma = __builtin_fmaxf(__builtin_fmaxf(ma, p0[r]), p0[r + 1]); mb = __builtin_fmaxf(__builtin_fmaxf(mb, p0[r + 2]), p0[r + 3]); ma = __builtin_fmaxf(__builtin_fmaxf(ma, p1[r]), p1[r + 1]); mb = __builtin_fmaxf(__builtin_fmaxf(mb, p1[r + 2]), p1[r + 3]); }
              mt = __builtin_fmaxf(ma, mb); }
            mt = swapmax(mt);
            { mhat = mt;
#pragma unroll
              for (int r = 0; r < 16; ++r) { p0[r] -= mt; p1[r] -= mt; } }
#pragma unroll
            for (int r = 0; r < 16; ++r) p0[r] = __builtin_amdgcn_exp2f(p0[r]);
            bf16x8 pb[4];
#pragma unroll
            for (int s = 0; s < 2; ++s) {
                u32x4 w; w.x = pk_bf16(p0[8 * s], p0[8 * s + 1]); w.y = pk_bf16(p0[8 * s + 2], p0[8 * s + 3]); w.z = pk_bf16(p0[8 * s + 4], p0[8 * s + 5]); w.w = pk_bf16(p0[8 * s + 6], p0[8 * s + 7]);
                pb[s] = __builtin_bit_cast(bf16x8, w); }
            __builtin_amdgcn_sched_barrier(0);
            VTR_WAIT(vl0, vh0, vl1, vh1);
            __builtin_amdgcn_sched_barrier(0);
#pragma unroll
            for (int ks = 0; ks < 2; ++ks) {
                const bf16x8 a0 = (bf16x8){vl0[ks][0], vl0[ks][1], vl0[ks][2], vl0[ks][3], vh0[ks][0], vh0[ks][1], vh0[ks][2], vh0[ks][3]};
                const bf16x8 a1 = (bf16x8){vl1[ks][0], vl1[ks][1], vl1[ks][2], vl1[ks][3], vh1[ks][0], vh1[ks][1], vh1[ks][2], vh1[ks][3]};
                o0 = __builtin_amdgcn_mfma_f32_32x32x16_bf16(a0, pb[ks], o0, 0, 0, 0);
                o1 = __builtin_amdgcn_mfma_f32_32x32x16_bf16(a1, pb[ks], o1, 0, 0, 0);
            }
            __builtin_amdgcn_sched_barrier(0);
#pragma unroll
            for (int r = 0; r < 16; ++r) p1[r] = __builtin_amdgcn_exp2f(p1[r]);
            { f32x2_t sa = {p0[0], p0[1]}, sb2 = {p1[0], p1[1]};
#pragma unroll
              for (int r = 2; r < 16; r += 2) { sa += (f32x2_t){p0[r], p0[r + 1]}; sb2 += (f32x2_t){p1[r], p1[r + 1]}; }
              sa += sb2; lrun += sa[0] + sa[1]; }
#pragma unroll
            for (int s = 0; s < 2; ++s) {
                u32x4 w2; w2.x = pk_bf16(p1[8 * s], p1[8 * s + 1]); w2.y = pk_bf16(p1[8 * s + 2], p1[8 * s + 3]); w2.z = pk_bf16(p1[8 * s + 4], p1[8 * s + 5]); w2.w = pk_bf16(p1[8 * s + 6], p1[8 * s + 7]);
                pb[2 + s] = __builtin_bit_cast(bf16x8, w2); }
            __builtin_amdgcn_sched_barrier(0);
#pragma unroll
            for (int ks = 2; ks < 4; ++ks) {
                const bf16x8 a0 = (bf16x8){vl0[ks][0], vl0[ks][1], vl0[ks][2], vl0[ks][3], vh0[ks][0], vh0[ks][1], vh0[ks][2], vh0[ks][3]};
                const bf16x8 a1 = (bf16x8){vl1[ks][0], vl1[ks][1], vl1[ks][2], vl1[ks][3], vh1[ks][0], vh1[ks][1], vh1[ks][2], vh1[ks][3]};
                o0 = __builtin_amdgcn_mfma_f32_32x32x16_bf16(a0, pb[ks], o0, 0, 0, 0);
                o1 = __builtin_amdgcn_mfma_f32_32x32x16_bf16(a1, pb[ks], o1, 0, 0, 0);
            }
            __builtin_amdgcn_sched_barrier(0);
            { const int s2 = (slot >= 1) ? slot - 1 : 2; if (t - 2 >= tau_min) ATT_ISSUE(t - 2, s2); }
        }
        slot = (slot == 2) ? 0 : slot + 1;
        --t;
    }
    for (; t >= tau_min; --t) {
        if (t - 1 >= tau_min) { if (nops == 3) asm volatile("s_waitcnt vmcnt(3)" ::: "memory"); else asm volatile("s_waitcnt vmcnt(2)" ::: "memory"); }
        else asm volatile("s_waitcnt vmcnt(0)" ::: "memory");
        __builtin_amdgcn_s_barrier(); asm volatile("" ::: "memory");
        const LAS char* cb = lds + slot * SB; (void)cb;
        {
            f32x16 p0, p1;
            if (FOX) {
                const LAS float* cl = (const LAS float*)(cb + KB + 8192); const float base = csq - mhat;
#pragma unroll
                for (int g = 0; g < 4; ++g) { const f32x4 c0 = *(const LAS f32x4*)(cl + 8 * g + 4 * hi), c1 = *(const LAS f32x4*)(cl + 32 + 8 * g + 4 * hi);
#pragma unroll
                    for (int jj = 0; jj < 4; ++jj) { p0[4 * g + jj] = base - c0[jj]; p1[4 * g + jj] = base - c1[jj]; } }
            } else {
                const float nm = -mhat;
#pragma unroll
                for (int r = 0; r < 16; ++r) { p0[r] = nm; p1[r] = nm; }
            }
            bf16x8 ka[NS][2];
#pragma unroll
            for (int s = 0; s < NS; ++s) { const int c = 2 * s + hi; ka[s][0] = *(const LAS bf16x8*)(cb + c * 1024 + r32 * 16); ka[s][1] = *(const LAS bf16x8*)(cb + c * 1024 + 512 + r32 * 16); }
            __builtin_amdgcn_sched_barrier(0);
#pragma unroll
            for (int s = 0; s < NS; ++s) { p0 = __builtin_amdgcn_mfma_f32_32x32x16_bf16(ka[s][0], qf[s], p0, 0, 0, 0); p1 = __builtin_amdgcn_mfma_f32_32x32x16_bf16(ka[s][1], qf[s], p1, 0, 0, 0); }
            __builtin_amdgcn_sched_barrier(0);
            const unsigned vb = (unsigned)(size_t)(cb + KB + vlane);
            s16x4 vl0[4], vh0[4], vl1[4], vh1[4];
            vl0[0] = vtr_a<0>(vb); vh0[0] = vtr_a<512>(vb); vl1[0] = vtr_a<4096>(vb); vh1[0] = vtr_a<4608>(vb);
            vl0[1] = vtr_a<1024>(vb); vh0[1] = vtr_a<1536>(vb); vl1[1] = vtr_a<5120>(vb); vh1[1] = vtr_a<5632>(vb);
            vl0[2] = vtr_a<2048>(vb); vh0[2] = vtr_a<2560>(vb); vl1[2] = vtr_a<6144>(vb); vh1[2] = vtr_a<6656>(vb);
            vl0[3] = vtr_a<3072>(vb); vh0[3] = vtr_a<3584>(vb); vl1[3] = vtr_a<7168>(vb); vh1[3] = vtr_a<7680>(vb);
            __builtin_amdgcn_sched_barrier(0);
            if (t == tdiag) {
#pragma unroll
                for (int r = 0; r < 16; ++r) { const int kv = 4 * hi + (r & 3) + 8 * (r >> 2); if (kv > qin) p0[r] = -INFINITY; if (kv + 32 > qin) p1[r] = -INFINITY; }
            }
            if (t == 0) {
#pragma unroll
                for (int r = 0; r < 16; ++r) { const int kv = 4 * hi + (r & 3) + 8 * (r >> 2); if (kv >= 16) p0[r] = -INFINITY; p1[r] = -INFINITY; }
            }
            float mt;
            { float ma = __builtin_fmaxf(__builtin_fmaxf(p0[0], p0[1]), p1[0]), mb = __builtin_fmaxf(__builtin_fmaxf(p0[2], p0[3]), p1[1]); ma = __builtin_fmaxf(__builtin_fmaxf(ma, p1[2]), p1[3]);
#pragma unroll
              for (int r = 4; r < 16; r += 4) { ma = __builtin_fmaxf(__builtin_fmaxf(ma, p0[r]), p0[r + 1]); mb = __builtin_fmaxf(__builtin_fmaxf(mb, p0[r + 2]), p0[r + 3]); ma = __builtin_fmaxf(__builtin_fmaxf(ma, p1[r]), p1[r + 1]); mb = __builtin_fmaxf(__builtin_fmaxf(mb, p1[r + 2]), p1[r + 3]); }
              mt = __builtin_fmaxf(ma, mb); }
            mt = swapmax(mt);
            if (__any(mt > THR)) {
                const float dl = fmaxf(mt, 0.f); mhat += dl; const float f = __builtin_amdgcn_exp2f(-dl); lrun *= f;
#pragma unroll
                for (int r = 0; r < 16; ++r) { p0[r] -= dl; p1[r] -= dl; asm volatile("v_mul_f32 %0, %0, %1" : "+v"(o0[r]) : "v"(f)); asm volatile("v_mul_f32 %0, %0, %1" : "+v"(o1[r]) : "v"(f)); }
            }
#pragma unroll
            for (int r = 0; r < 16; ++r) p0[r] = __builtin_amdgcn_exp2f(p0[r]);
            bf16x8 pb[4];
#pragma unroll
            for (int s = 0; s < 2; ++s) {
                u32x4 w; w.x = pk_bf16(p0[8 * s], p0[8 * s + 1]); w.y = pk_bf16(p0[8 * s + 2], p0[8 * s + 3]); w.z = pk_bf16(p0[8 * s + 4], p0[8 * s + 5]); w.w = pk_bf16(p0[8 * s + 6], p0[8 * s + 7]);
                pb[s] = __builtin_bit_cast(bf16x8, w); }
            __builtin_amdgcn_sched_barrier(0);
            VTR_WAIT(vl0, vh0, vl1, vh1);
            __builtin_amdgcn_sched_barrier(0);
#pragma unroll
            for (int ks = 0; ks < 2; ++ks) {
                const bf16x8 a0 = (bf16x8){vl0[ks][0], vl0[ks][1], vl0[ks][2], vl0[ks][3], vh0[ks][0], vh0[ks][1], vh0[ks][2], vh0[ks][3]};
                const bf16x8 a1 = (bf16x8){vl1[ks][0], vl1[ks][1], vl1[ks][2], vl1[ks][3], vh1[ks][0], vh1[ks][1], vh1[ks][2], vh1[ks][3]};
                o0 = __builtin_amdgcn_mfma_f32_32x32x16_bf16(a0, pb[ks], o0, 0, 0, 0);
                o1 = __builtin_amdgcn_mfma_f32_32x32x16_bf16(a1, pb[ks], o1, 0, 0, 0);
            }
            __builtin_amdgcn_sched_barrier(0);
#pragma unroll
            for (int r = 0; r < 16; ++r) p1[r] = __builtin_amdgcn_exp2f(p1[r]);
            { f32x2_t sa = {p0[0], p0[1]}, sb2 = {p1[0], p1[1]};
#pragma unroll
              for (int r = 2; r < 16; r += 2) { sa += (f32x2_t){p0[r], p0[r + 1]}; sb2 += (f32x2_t){p1[r], p1[r + 1]}; }
              sa += sb2; lrun += sa[0] + sa[1]; }
#pragma unroll
            for (int s = 0; s < 2; ++s) {
                u32x4 w2; w2.x = pk_bf16(p1[8 * s], p1[8 * s + 1]); w2.y = pk_bf16(p1[8 * s + 2], p1[8 * s + 3]); w2.z = pk_bf16(p1[8 * s + 4], p1[8 * s + 5]); w2.w = pk_bf16(p1[8 * s + 6], p1[8 * s + 7]);
                pb[2 + s] = __builtin_bit_cast(bf16x8, w2); }
            __builtin_amdgcn_sched_barrier(0);
#pragma unroll
            for (int ks = 2; ks < 4; ++ks) {
                const bf16x8 a0 = (bf16x8){vl0[ks][0], vl0[ks][1], vl0[ks][2], vl0[ks][3], vh0[ks][0], vh0[ks][1], vh0[ks][2], vh0[ks][3]};
                const bf16x8 a1 = (bf16x8){vl1[ks][0], vl1[ks][1], vl1[ks][2], vl1[ks][3], vh1[ks][0], vh1[ks][1], vh1[ks][2], vh1[ks][3]};
                o0 = __builtin_amdgcn_mfma_f32_32x32x16_bf16(a0, pb[ks], o0, 0, 0, 0);
                o1 = __builtin_amdgcn_mfma_f32_32x32x16_bf16(a1, pb[ks], o1, 0, 0, 0);
            }
            __builtin_amdgcn_sched_barrier(0);
            { const int s2 = (slot >= 1) ? slot - 1 : 2; if (t - 2 >= tau_min) ATT_ISSUE(t - 2, s2); }
        }
        slot = (slot == 2) ? 0 : slot + 1;
    }
#undef ATT_ISSUE
    if (threadIdx.x == 0) ticket = __hip_atomic_fetch_add(qnext, 1u, RLX_AGENT);
    if (wave_on) {
        const float lt = swapsum(lrun);
        const float inv = 1.0f / lt;
        u32x4 st[2][2];
#pragma unroll
        for (int hf = 0; hf < 2; ++hf)
#pragma unroll
            for (int gp = 0; gp < 2; ++gp) { const int g = 2 * gp; const f32x16& oo = hf ? o1 : o0;
                const unsigned ax = pk_bf16(oo[4 * g] * inv, oo[4 * g + 1] * inv), ay = pk_bf16(oo[4 * g + 2] * inv, oo[4 * g + 3] * inv);
                const unsigned bx = pk_bf16(oo[4 * g + 4] * inv, oo[4 * g + 5] * inv), by = pk_bf16(oo[4 * g + 6] * inv, oo[4 * g + 7] * inv);
                const auto sx = __builtin_amdgcn_permlane32_swap(ax, bx, false, false); const auto sy = __builtin_amdgcn_permlane32_swap(ay, by, false, false);
                st[hf][gp] = (u32x4){sx[0], sy[0], sx[1], sy[1]}; }
        if (j > 0 || r32 < 16) {
            bf16_t* op = O + qrow * ldo + 8 * hi;
#pragma unroll
            for (int hf = 0; hf < 2; ++hf)
#pragma unroll
                for (int gp = 0; gp < 2; ++gp) *(u32x4*)(op + 32 * hf + 16 * gp) = st[hf][gp];
        }
    }
    asm volatile("s_waitcnt lgkmcnt(0)" ::: "memory");
    __builtin_amdgcn_s_barrier(); asm volatile("" ::: "memory");
}

struct Args { const float* in[22]; float* out; unsigned char* ws; };
struct Frame {
    LAS unsigned char* lds; volatile LAS unsigned* MISC; unsigned* ctl;
    int tid, lane, wave, vcu, G;
};

template <bool KS>
__device__ __forceinline__ void tr_item(const float* colp, int ld, const float* kscale, bf16_t* dst, int K, int n0, int k0, LAS float* scr, int lane) {
    float v[32], ks[32];
#pragma unroll
    for (int i = 0; i < 32; ++i) { v[i] = colp[(size_t)(k0 + 2 * i + (lane >> 5)) * ld]; if (KS) ks[i] = kscale[k0 + 2 * i + (lane >> 5)]; }
#pragma unroll
    for (int i = 0; i < 32; ++i) { const int kk = 2 * i + (lane >> 5); if (KS) v[i] *= ks[i]; scr[kk * 33 + (lane & 31)] = v[i]; }
    LDS_WAIT(); asm volatile("" ::: "memory");
    const int c = lane & 7;
#pragma unroll
    for (int j = 0; j < 4; ++j) { const int n = (lane >> 3) + 8 * j; const LAS float* s = scr + (8 * c) * 33 + n;
        u32x4 o; o.x = pk_bf16(s[0 * 33], s[1 * 33]); o.y = pk_bf16(s[2 * 33], s[3 * 33]); o.z = pk_bf16(s[4 * 33], s[5 * 33]); o.w = pk_bf16(s[6 * 33], s[7 * 33]);
        *(u32x4*)(dst + (size_t)(n0 + n) * K + k0 + 8 * c) = o; }
    LDS_WAIT(); asm volatile("" ::: "memory");
}
__device__ __forceinline__ void quant_strip(const float* colp, bool valid, int ld, unsigned char* dst, int n0, LAS float* scr, LAS float* part, unsigned* cm_out, int wave, int lane) {
    float v[2][32]; float am = 0.f;
    { const float* pp = colp + (size_t)(wave * 128 + (lane >> 5)) * ld; const size_t st2 = (size_t)2 * ld;
#pragma unroll
      for (int sidx = 0; sidx < 2; ++sidx)
#pragma unroll
        for (int i = 0; i < 32; ++i) { v[sidx][i] = *pp; pp += st2; asm volatile("" : "+v"(pp)); } }
    if (!valid) {
#pragma unroll
      for (int sidx = 0; sidx < 2; ++sidx)
#pragma unroll
        for (int i = 0; i < 32; ++i) v[sidx][i] = 0.f; }
#pragma unroll
    for (int sidx = 0; sidx < 2; ++sidx)
#pragma unroll
        for (int i = 0; i < 32; ++i) am = fmaxf(am, fabsf(v[sidx][i]));
    am = fmaxf(am, __shfl_xor(am, 32));
    if (lane < 32) part[wave * 32 + lane] = am;
    __syncthreads();
    float cmx = part[lane & 31];
#pragma unroll
    for (int w = 1; w < 8; ++w) cmx = fmaxf(cmx, part[w * 32 + (lane & 31)]);
    if (wave == 0 && lane < 32) cm_out[n0 + lane] = __float_as_uint(cmx);
    float inv4[4];
#pragma unroll
    for (int j = 0; j < 4; ++j) { const float c = __shfl(cmx, (lane >> 3) + 8 * j); inv4[j] = c > 0.f ? 127.0f / c : 0.f; }
    const int c = lane & 7;
#pragma unroll
    for (int sidx = 0; sidx < 2; ++sidx) {
#pragma unroll
        for (int i = 0; i < 32; ++i) scr[(2 * i + (lane >> 5)) * 33 + (lane & 31)] = v[sidx][i];
        LDS_WAIT(); asm volatile("" ::: "memory");
#pragma unroll
        for (int j = 0; j < 4; ++j) { const int n = (lane >> 3) + 8 * j; const LAS float* sp = scr + (8 * c) * 33 + n;
            unsigned q[8];
#pragma unroll
            for (int i = 0; i < 8; ++i) q[i] = (unsigned)(int)rintf(sp[i * 33] * inv4[j]) & 255u;
            u32x2 o; o.x = q[0] | (q[1] << 8) | (q[2] << 16) | (q[3] << 24); o.y = q[4] | (q[5] << 8) | (q[6] << 16) | (q[7] << 24);
            *(u32x2*)(dst + (size_t)(n0 + n) * 1024 + wave * 128 + sidx * 64 + 8 * c) = o; }
        LDS_WAIT(); asm volatile("" ::: "memory");
    }
    __syncthreads();
}
constexpr int STRIPS_PER_LAYER = 392;
__device__ __forceinline__ void strip_item(const Args& a, bf16_t* W, unsigned* cm, int l, int sidx, LAS float* scr, LAS float* part, int wave, int lane) {
    const int w = lane & 31;
    if (sidx < 72) { const int nb = sidx, n = nb * 32 + w; int col;
        if (n < 1536) col = n; else { const int j = n - 1536; col = j < 384 ? 1544 + j : j < 640 ? 1928 + (j - 384) : j < 672 ? 2184 + (16 * (((j - 640) >> 2) & 1) + 4 * ((j - 640) >> 3) + ((j - 640) & 3)) : j < 680 ? 1536 + (j - 672) : -1; }
        const float* src = a.in[4] + (size_t)l * 1024 * 4264;
        quant_strip(src + (col >= 0 ? col : 0), col >= 0, 4264, (unsigned char*)(W + W_BT1), nb * 32, scr, part, cm, wave, lane); return; }
    sidx -= 72;
    if (sidx < 64) { const int nb = sidx, n = (nb >> 3) * 256 + 64 * (nb & 3) + 16 * (w >> 3) + 8 * ((nb >> 2) & 1) + (w & 7); const float* src = a.in[4] + (size_t)l * 1024 * 4264;
        quant_strip(src + 2216 + n, true, 4264, (unsigned char*)(W + W_BT1), 2304 + nb * 32, scr, part, cm, wave, lane); return; }
    sidx -= 64;
    { const int e = sidx >> 4, nb = sidx & 15;
      const float* src = (((nb >> 2) & 1) ? a.in[18] : a.in[17]) + ((size_t)(l * 16 + e) * 1024) * 256 + (nb >> 3) * 128 + 32 * (nb & 3) + w;
      quant_strip(src, true, 256, (unsigned char*)(W + W_MOE1) + (size_t)e * 512 * 1024, nb * 32, scr, part, cm + 4608 + e * 512, wave, lane); }
}
constexpr int ITEMS_PER_LAYER = 3344;
__device__ __forceinline__ void convert_item(const Args& a, bf16_t* W, int l, int r, LAS float* scr, int lane) {
    const int w = lane & 31; (void)w;
    if (r < 1296) {
    if (r < 256) { const int kb = r / 32, nb = r % 32, n = (nb >> 3) * 256 + 64 * (nb & 3) + 32 * ((nb >> 2) & 1) + w; tr_item<false>(a.in[6] + (size_t)l * 512 * 1024 + n, 1024, nullptr, W + W_FOXO, 1024, nb * 32, kb * 64, scr, lane); return; }
    r -= 256;
    if (r < 256) { const int kb = r / 32, nb = r % 32, n = (nb >> 3) * 256 + 64 * (nb & 3) + 32 * ((nb >> 2) & 1) + w; tr_item<false>(a.in[11] + (size_t)l * 512 * 1024 + n, 1024, nullptr, W + W_FOXO + 512, 1024, nb * 32, kb * 64, scr, lane); return; }
    r -= 256;
    if (r < 144) { const int kb = r / 24, nb = r % 24, n = nb * 32 + w; tr_item<true>(a.in[8] + (size_t)l * 384 * 768 + n, 768, a.in[7] + l * 384, W + W_UQ, 384, nb * 32, kb * 64, scr, lane); return; }
    r -= 144;
    if (r < 128) { const int kb = r / 32, nb = r % 32, n = nb * 32 + w; const int col = n < 512 ? (n >> 6) * 128 + (n & 63) : ((n - 512) >> 6) * 128 + 64 + (n & 63);
        tr_item<true>(a.in[10] + (size_t)l * 256 * 1024 + col, 1024, a.in[9] + l * 256, W + W_UKV, 256, nb * 32, kb * 64, scr, lane); return; }
    r -= 128;
    { const int kb = r / 32, nb = r % 32, n = (nb >> 3) * 256 + 64 * (nb & 3) + 32 * ((nb >> 2) & 1) + w; tr_item<false>(a.in[12] + (size_t)l * 1024 * 1024 + n, 1024, nullptr, W + W_OUT, 1024, nb * 32, kb * 64, scr, lane); return; } }
    r -= 1296;
    { const int e = r / 128, rr = r % 128, kb = rr / 32, nb = rr % 32, n = (nb >> 3) * 256 + 64 * (nb & 3) + 32 * ((nb >> 2) & 1) + w;
        tr_item<false>(a.in[19] + ((size_t)(l * 16 + e) * 256) * 1024 + n, 1024, nullptr, W + W_MOE2 + (size_t)e * 1024 * 256, 256, nb * 32, kb * 64, scr, lane); }
}

template <int R>
__device__ __forceinline__ void quant_rows(const f32x4 (&v)[R][4], unsigned char* const (&qrow)[R], float* const (&srow)[R], int lane) {
    float am[R];
#pragma unroll
    for (int k = 0; k < R; ++k) { am[k] = 0.f;
#pragma unroll
        for (int j = 0; j < 4; ++j) am[k] = fmaxf(am[k], fmaxf(fmaxf(fabsf(v[k][j][0]), fabsf(v[k][j][1])), fmaxf(fabsf(v[k][j][2]), fabsf(v[k][j][3])))); }
#pragma unroll
    for (int k = 0; k < R; ++k) am[k] = wave_max(am[k]);
#pragma unroll
    for (int k = 0; k < R; ++k) { if (!qrow[k]) continue; const float inv = am[k] > 0.f ? 127.0f / am[k] : 0.f;
#pragma unroll
        for (int j = 0; j < 4; ++j) { const unsigned q = ((unsigned)(int)rintf(v[k][j][0] * inv) & 255u) | (((unsigned)(int)rintf(v[k][j][1] * inv) & 255u) << 8) | (((unsigned)(int)rintf(v[k][j][2] * inv) & 255u) << 16) | (((unsigned)(int)rintf(v[k][j][3] * inv) & 255u) << 24);
            *(unsigned*)(qrow[k] + 4 * lane + 256 * j) = q; }
        if (lane == 0) *srow[k] = am[k] * (1.0f / 127.0f); }
}

__device__ __forceinline__ void ln16(f32x4 (&v)[4], const float* g, const float* bta, int lane) {
    float s = 0.f;
#pragma unroll
    for (int j = 0; j < 4; ++j) s += (v[j][0] + v[j][1]) + (v[j][2] + v[j][3]);
    const float mean = wave_sum(s) * (1.f / DM); float s2 = 0.f;
#pragma unroll
    for (int j = 0; j < 4; ++j) { v[j] = v[j] - mean; s2 += (v[j][0] * v[j][0] + v[j][1] * v[j][1]) + (v[j][2] * v[j][2] + v[j][3] * v[j][3]); }
    const float rstd = 1.0f / sqrtf(wave_sum(s2) * (1.f / DM) + 1e-5f);
#pragma unroll
    for (int j = 0; j < 4; ++j) { const f32x4 gg = *(const f32x4*)(g + 4 * lane + 256 * j), bb = *(const f32x4*)(bta + 4 * lane + 256 * j); v[j] = v[j] * rstd * gg + bb; }
}
template <int R>
__device__ __forceinline__ void ln16xR(f32x4 (&v)[R][4], const float* g, const float* bta, int lane) {
    float s[R];
#pragma unroll
    for (int k = 0; k < R; ++k) { s[k] = 0.f;
#pragma unroll
        for (int j = 0; j < 4; ++j) s[k] += (v[k][j][0] + v[k][j][1]) + (v[k][j][2] + v[k][j][3]); }
#pragma unroll
    for (int k = 0; k < R; ++k) s[k] = wave_sum(s[k]);
    float s2[R];
#pragma unroll
    for (int k = 0; k < R; ++k) { const float mean = s[k] * (1.f / DM); s2[k] = 0.f;
#pragma unroll
        for (int j = 0; j < 4; ++j) { v[k][j] = v[k][j] - mean; s2[k] += (v[k][j][0] * v[k][j][0] + v[k][j][1] * v[k][j][1]) + (v[k][j][2] * v[k][j][2] + v[k][j][3] * v[k][j][3]); } }
#pragma unroll
    for (int k = 0; k < R; ++k) s2[k] = wave_sum(s2[k]);
#pragma unroll
    for (int j = 0; j < 4; ++j) { const f32x4 gg = *(const f32x4*)(g + 4 * lane + 256 * j), bb = *(const f32x4*)(bta + 4 * lane + 256 * j);
#pragma unroll
        for (int k = 0; k < R; ++k) { const float rstd = 1.0f / sqrtf(s2[k] * (1.f / DM) + 1e-5f); v[k][j] = v[k][j] * rstd * gg + bb; } }
}
__device__ __forceinline__ void store_row_bf16(bf16_t* orow, const f32x4 (&v)[4], int lane) {
#pragma unroll
    for (int j = 0; j < 4; ++j) { u32x2 w; w.x = pk_bf16(v[j][0], v[j][1]); w.y = pk_bf16(v[j][2], v[j][3]); *(u32x2*)(orow + 4 * lane + 256 * j) = w; }
}

__device__ const double ROPE_INV_REV[16] = {0.15915494309189535, 0.08949940160889101, 0.050329212104487035, 0.0283021958306234, 0.015915494309189534, 0.008949940160889102,
    0.005032921210448704, 0.00283021958306234, 0.0015915494309189536, 0.0008949940160889102, 0.0005032921210448703, 0.00028302195830623395, 0.00015915494309189535,
    8.949940160889102e-05, 5.0329212104487035e-05, 2.8302195830623396e-05};

#define PHASE_IDS int tid = threadIdx.x; asm volatile("" : "+v"(tid)); const int lane = tid & 63; const int wave = __builtin_amdgcn_readfirstlane(tid >> 6); const int gw = F.vcu * 8 + wave; (void)lane; (void)gw;

#define PHASE_PTRS unsigned long long wsi_ = (unsigned long long)args.ws; asm volatile("" : "+s"(wsi_)); unsigned char* wsl = (unsigned char*)(__attribute__((address_space(1))) unsigned char*)wsi_;     \
    float* ropeC = (float*)(wsl + WS_ROPE); float* ropeS = ropeC + LSEQ * 16; float* LFp = (float*)(wsl + WS_LF); float* CSp = (float*)(wsl + WS_CS); \
    unsigned* TOK = (unsigned*)(wsl + WS_TOK); int* LIST = (int*)(wsl + WS_LIST); bf16_t* Wall = (bf16_t*)(wsl + WS_W); bf16_t* HB = (bf16_t*)(wsl + WS_H); unsigned char* X = wsl + WS_X; \
    bf16_t *Qf = (bf16_t*)(X + X_QF), *Kf = (bf16_t*)(X + X_KF), *Vf = (bf16_t*)(X + X_VF), *RAW = (bf16_t*)(X + X_RAW), *Qm = (bf16_t*)(X + X_QM), *Km = (bf16_t*)(X + X_KM), \
           *Vm = (bf16_t*)(X + X_VM), *Om = (bf16_t*)(X + X_OM), *Of = (bf16_t*)(X + X_OF), *GATES = (bf16_t*)(X + X_GATES), *MERGED = (bf16_t*)(X + X_MERGED), *H1 = (bf16_t*)(X + X_H1), \
           *HID = (bf16_t*)(X + X_HID), *YS = (bf16_t*)(X + X_YS); bf16_t* Zb = (bf16_t*)(X + X_Z); unsigned* ctl = (unsigned*)(wsl + WS_CTL); \
    (void)ropeC; (void)ropeS; (void)LFp; (void)CSp; (void)TOK; (void)LIST; (void)Wall; (void)HB; (void)Qf; (void)Kf; (void)Vf; (void)RAW; (void)Qm; (void)Km; (void)Vm; (void)Om; (void)Of; (void)GATES; (void)MERGED; (void)H1; (void)HID; (void)YS; (void)Zb; (void)ctl;


template <int L>
__device__ __forceinline__ void run_layer(const Args& args, const Frame& F, const XcdBarrier& bar, const int NGW) {
    constexpr int l = L;
        for (int rep_ = 0; rep_ < REP_A; ++rep_) {
        {
            PHASE_PTRS const bf16_t* W = Wall + (size_t)l * W_LAYER;
            pg8::SchedStatic S{(const char*)(X + X_HBQ), (const char*)(W + W_BT1), NPANEL, 17, F.G, (int)blockIdx.x, (size_t)256 * DM, (size_t)256 * DM, 1};
            pg8::EpiA E{pg8::EpiA1{Qf, Kf, Vf, RAW, LFp, args.in[5] + l * 8, (float*)(wsl + WS_QKN), (float*)(wsl + WS_SSQ), (bf16_t*)(wsl + WS_KR), ropeC, ropeS, (const float*)(wsl + WS_HBS), ctl + CW_CMAX + 16384 * l}, pg8::EpiA2{(unsigned char*)args.out, (unsigned char*)(wsl + WS_GALT), (const float*)(wsl + WS_HBS), ctl + CW_CMAX + 16384 * l}};
            pg8::gemm_phase<pg8::EpiA, pg8::SchedStatic, false, false, true>(F.lds, 512, 512, 512, S, E);
        }
        xcd_barrier(bar);
        }
        {
            PHASE_IDS
            PHASE_PTRS
            if (blockIdx.x < 64) {
                const int bb = blockIdx.x >> 3, hh = blockIdx.x & 7;
                float v[9];
#pragma unroll
                for (int k = 0; k < 9; ++k) { const int p = 9 * tid + k; const int pc = p < LSEQ ? p : LSEQ - 1; const float x = LFp[(size_t)row_of(bb, pc) * 8 + hh]; v[k] = p < LSEQ ? x : 0.f; }
#pragma unroll
                for (int k = 1; k < 9; ++k) v[k] += v[k - 1];
                float x = v[8];
#pragma unroll
                for (int d = 1; d < 64; d <<= 1) { const float y = __shfl_up(x, d); if (lane >= d) x += y; }
                LAS float* wt = (LAS float*)(F.lds + 1024);
                if (lane == 63) wt[wave] = x;
                __syncthreads();
                float off = x - v[8];
                for (int w2 = 0; w2 < wave; ++w2) off += wt[w2];
#pragma unroll
                for (int k = 0; k < 9; ++k) { const int p = 9 * tid + k; if (p < CSP) CSp[(size_t)blockIdx.x * CSP + p] = (v[k] + off) * LOG2E; }
                __syncthreads();
                {
                    const float* qkn = (const float*)(wsl + WS_QKN); float mq = 0.f, mk = 0.f;
                    f32x2_t qv[9], kv[9];
#pragma unroll
                    for (int k = 0; k < 9; ++k) { const int p = 9 * tid + k; const int pc = p < LSEQ ? p : LSEQ - 1; const float* r_ = qkn + (size_t)row_of(bb, pc) * 32 + 2 * hh;
                        qv[k] = *(const f32x2_t*)r_; kv[k] = *(const f32x2_t*)(r_ + 16); }
#pragma unroll
                    for (int k = 0; k < 9; ++k) { mq = fmaxf(mq, qv[k][0] + qv[k][1]); mk = fmaxf(mk, kv[k][0] + kv[k][1]); }
#pragma unroll
                    for (int o = 1; o < 64; o <<= 1) { mq = fmaxf(mq, __shfl_xor(mq, o)); mk = fmaxf(mk, __shfl_xor(mk, o)); }
                    LAS float* wq = (LAS float*)(F.lds + 2048);
                    if (lane == 0) { wq[2 * wave] = mq; wq[2 * wave + 1] = mk; }
                    __syncthreads();
                    if (tid == 0) { float a = 0.f, c = 0.f; for (int w2 = 0; w2 < 8; ++w2) { a = fmaxf(a, wq[2 * w2]); c = fmaxf(c, wq[2 * w2 + 1]); }
                        ctl[CW_QKMAX + 128 * l + blockIdx.x * 2] = __float_as_uint(a); ctl[CW_QKMAX + 128 * l + blockIdx.x * 2 + 1] = __float_as_uint(c); }
                }
            }
        }
        xcd_barrier(bar);
        for (int rep_ = 0; rep_ < REP_C; ++rep_) {
        {
            PHASE_IDS
            PHASE_PTRS const bf16_t* W = Wall + (size_t)l * W_LAYER;
            pg8::SchedStatic S{(const char*)RAW, (const char*)(W + W_UQ), NPANEL, 3, F.G, (int)blockIdx.x, (size_t)256 * 768 * 2, (size_t)256 * 384 * 2, 1};
            pg8::EpiQup E{Qm, ropeC, ropeS, (const float*)(wsl + WS_SSQ)};
            pg8::gemm_phase<pg8::EpiQup, pg8::SchedStatic, false>(F.lds, 384, 768, 384, S, E);
        }
        {
            PHASE_PTRS const bf16_t* W = Wall + (size_t)l * W_LAYER;
            pg8::SchedStatic S{(const char*)(RAW + 384), (const char*)(W + W_UKV), NPANEL, 4, F.G, (int)blockIdx.x, (size_t)256 * 768 * 2, (size_t)256 * 256 * 2, 1};
            pg8::EpiKV E{Km, Vm, (const float*)(wsl + WS_SSQ)};
            pg8::gemm_phase<pg8::EpiKV, pg8::SchedStatic, false>(F.lds, 256, 768, 256, S, E);
        }
        {
            PHASE_IDS
            PHASE_PTRS
            const int myx = (int)(xb_xcc_id() & 7u);
            for (int rep_ = 0; rep_ < REP_FOX; ++rep_)
            for (int xo = 0; xo < 8; ++xo) { const int x = (myx + xo) & 7; unsigned* qc = ctl + CW_QCTR + 64 * ((rep_ * 4 + l * 2 + 1) * 8 + x);
                unsigned ticket = 0u; bool have_ticket = false;
                for (;;) {
                    if (tid == 0) F.MISC[4] = have_ticket ? ticket : __hip_atomic_fetch_add(qc, 1u, RLX_AGENT);
                    __syncthreads();
                    const int id = (int)F.MISC[4];
                    __syncthreads();
                    if (id >= 136) break;
                    have_ticket = true;
                    const int g = id / 34, i = id % 34, j = 16 - (i >> 1), h = 2 * g + (i & 1), b = x;
                    int tmin = 0;
                    if (j > 0) {
                        const float* csr = CSp + (size_t)(b * 8 + h) * CSP;
                        const float q2 = __uint_as_float(__hip_atomic_load(ctl + CW_QKMAX + 128 * l + (b * 8 + h) * 2, RLX_AGENT)), k2 = __uint_as_float(__hip_atomic_load(ctl + CW_QKMAX + 128 * l + (b * 8 + h) * 2 + 1, RLX_AGENT));
                        const float qk = 2.0f * sqrtf(q2 * k2) * 1.0001f + 0.01f;
                        const float cq = csr[16 + 256 * (j - 1)];
                        const float ck = csr[lane == 0 ? 15 : 64 * lane + 15];
                        const bool ok = (qk + cq - ck) >= -64.0f;
                        const unsigned long long m = __ballot(ok);
                        tmin = m ? (int)__builtin_ctzll(m) : 64;
                        const int tfirst = 4 * (j - 1) + 1; tmin = tmin < tfirst ? tmin : tfirst;
                    }
                    tmin = __builtin_amdgcn_readfirstlane(tmin);
                    attn_unit8<64, true>((LAS char*)F.lds, Qf + 64 * h, 512, Kf + 64 * h, 512, Vf + 64 * h, 512, Om + 64 * h, 1024, CSp + (size_t)(b * 8 + h) * CSP, b, j, tmin, qc, ticket);
                } }
        }
        xcd_barrier(bar);
        }
        {
            PHASE_IDS
            PHASE_PTRS
            const int myx = (int)(xb_xcc_id() & 7u);
            for (int rep_ = 0; rep_ < REP_MLA; ++rep_)
            for (int xo = 0; xo < 8; ++xo) { const int x = (myx + xo) & 7; unsigned* qc = ctl + CW_QCTR + 64 * ((rep_ * 4 + l * 2) * 8 + x);
                unsigned ticket = 0u; bool have_ticket = false;
                for (;;) {
                    if (tid == 0) F.MISC[4] = have_ticket ? ticket : __hip_atomic_fetch_add(qc, 1u, RLX_AGENT);
                    __syncthreads();
                    const int id = (int)F.MISC[4];
                    __syncthreads();
                    if (id >= 136) break;
                    have_ticket = true;
                    const int g = id / 34, i = id % 34, j = 16 - (i >> 1), h = 2 * g + (i & 1), b = x;
                    attn_unit8<96, false>((LAS char*)F.lds, Qm + 96 * h, 768, Km + 96 * h, 768, Vm + 64 * h, 512, Om + 512 + 64 * h, 1024, nullptr, b, j, 0, qc, ticket, (const bf16_t*)(wsl + WS_KR));
                } }
        }
        xcd_barrier(bar);
        for (int rep_ = 0; rep_ < REP_E; ++rep_) {
        {
            PHASE_PTRS const bf16_t* W = Wall + (size_t)l * W_LAYER;
            pg8::SchedStatic S{(const char*)Om, (const char*)(W + W_FOXO), (l == 0) ? NPANEL : NPANEL - 1, 4, F.G, (int)blockIdx.x, (size_t)256 * DM * 2, (size_t)256 * DM * 2, (l == 0) ? 1 : 0};
            pg8::EpiOut E{(const unsigned char*)args.out, (const unsigned char*)(wsl + WS_GALT), MERGED};
            pg8::gemm_phase<pg8::EpiOut, pg8::SchedStatic, false, true>(F.lds, 1024, 1024, 1024, S, E);
        }
        xcd_barrier(bar);
        }
        for (int rep_ = 0; rep_ < REP_F; ++rep_) {
        {
            PHASE_PTRS const bf16_t* W = Wall + (size_t)l * W_LAYER;
            pg8::SchedStatic S{(const char*)MERGED, (const char*)(W + W_OUT), (l == 0) ? NPANEL : NPANEL - 1, 4, F.G, (int)blockIdx.x, (size_t)256 * DM * 2, (size_t)256 * DM * 2, (l == 0) ? 1 : 0};
            pg8::EpiF E{HB, Zb};
            pg8::gemm_phase<pg8::EpiF, pg8::SchedStatic, false>(F.lds, 1024, 1024, 1024, S, E);
        }
        xcd_barrier(bar);
        }
        {
            PHASE_IDS
            PHASE_PTRS
            LAS float* rwT = (LAS float*)F.lds;
            LAS int* lcnt = (LAS int*)(F.lds + 65536);
            LAS int* gbase = lcnt + 16;
            LAS int* tE = lcnt + 64;
            LAS int* tP = tE + 384;
            LAS float* tG = (LAS float*)(tP + 384);
            { const f32x4* RWT4 = (const f32x4*)(wsl + WS_RWT); LAS f32x4* d4 = (LAS f32x4*)rwT;
#pragma unroll
              for (int i = 0; i < 8; ++i) d4[tid + 512 * i] = RWT4[tid + 512 * i]; }
            LAS float* lgb = (LAS float*)(F.lds + 65536 + 8192) + wave * 64;
            if (tid < 16) lcnt[tid] = 0;
            __syncthreads();
            const int TG = (l == 0) ? T : NREAL;
            const int rpw = (TG + F.G - 1) / F.G;
            const int r0 = blockIdx.x * rpw, nrows = (r0 + rpw <= TG) ? rpw : (TG > r0 ? TG - r0 : 0);
            const float* rb = args.in[16];
            for (int g4 = wave * 4; g4 < nrows; g4 += 32) {
                f32x4 v[4][4];
#pragma unroll
                for (int k = 0; k < 4; ++k) { const int lr = (g4 + k < nrows) ? g4 + k : nrows - 1; const int row = r0 + lr;
#pragma unroll
                    for (int j = 0; j < 4; ++j) { const u32x2 zv = *(const u32x2*)(Zb + (size_t)row * DM + 4 * lane + 256 * j); v[k][j] = (f32x4){bf_lo(zv.x), bf_hi(zv.x), bf_lo(zv.y), bf_hi(zv.y)}; } }
                ln16xR<4>(v, args.in[13] + l * DM, args.in[14] + l * DM, lane);
#pragma unroll
                for (int k = 0; k < 4; ++k) if (g4 + k < nrows) store_row_bf16(H1 + (size_t)(r0 + g4 + k) * DM, v[k], lane);
                { unsigned char* qr[4]; float* sr[4];
#pragma unroll
                  for (int k = 0; k < 4; ++k) { const bool ok = g4 + k < nrows; qr[k] = ok ? X + X_H1Q + (size_t)(r0 + g4 + k) * DM : nullptr; sr[k] = (float*)(wsl + WS_H1S) + (ok ? r0 + g4 + k : 0); }
                  unsigned char* const qc[4] = {qr[0], qr[1], qr[2], qr[3]}; float* const sc4[4] = {sr[0], sr[1], sr[2], sr[3]};
                  quant_rows<4>(v, qc, sc4, lane); }
                float s[4][16];
#pragma unroll
                for (int e = 0; e < 16; ++e) {
                    f32x4 wv[4];
#pragma unroll
                    for (int j = 0; j < 4; ++j) wv[j] = *(const LAS f32x4*)(rwT + e * 1024 + 4 * lane + 256 * j);
#pragma unroll
                    for (int k = 0; k < 4; ++k) { f32x2_t a2 = {0.f, 0.f};
#pragma unroll
                        for (int j = 0; j < 4; ++j) { a2 = __builtin_elementwise_fma((f32x2_t){v[k][j][0], v[k][j][1]}, (f32x2_t){wv[j][0], wv[j][1]}, a2); a2 = __builtin_elementwise_fma((f32x2_t){v[k][j][2], v[k][j][3]}, (f32x2_t){wv[j][2], wv[j][3]}, a2); }
                        s[k][e] = a2[0] + a2[1]; }
                }
#pragma unroll
                for (int k = 0; k < 4; ++k) {
#pragma unroll
                    for (int i = 0; i < 8; ++i) { const bool up = (lane & 32) != 0; const float mine = up ? s[k][i + 8] : s[k][i], oth = up ? s[k][i] : s[k][i + 8]; s[k][i] = mine + __shfl_xor(oth, 32); }
#pragma unroll
                    for (int i = 0; i < 4; ++i) { const bool up = (lane & 16) != 0; const float mine = up ? s[k][i + 4] : s[k][i], oth = up ? s[k][i] : s[k][i + 4]; s[k][i] = mine + __shfl_xor(oth, 16); }
#pragma unroll
                    for (int i = 0; i < 2; ++i) { const bool up = (lane & 8) != 0; const float mine = up ? s[k][i + 2] : s[k][i], oth = up ? s[k][i] : s[k][i + 2]; s[k][i] = mine + __shfl_xor(oth, 8); }
                    { const bool up = (lane & 4) != 0; const float mine = up ? s[k][1] : s[k][0], oth = up ? s[k][0] : s[k][1]; s[k][0] = mine + __shfl_xor(oth, 4); }
                    s[k][0] += __shfl_xor(s[k][0], 2); s[k][0] += __shfl_xor(s[k][0], 1);
                }
                if ((lane & 3) == 0) {
#pragma unroll
                    for (int k = 0; k < 4; ++k) lgb[k * 16 + (lane >> 2)] = s[k][0]; }
                LDS_WAIT();
                {
                    const int k = lane & 3;
                    float lg[16];
#pragma unroll
                    for (int q4 = 0; q4 < 4; ++q4) { const f32x4 t4 = *(const LAS f32x4*)(lgb + k * 16 + 4 * q4); lg[4 * q4] = t4[0]; lg[4 * q4 + 1] = t4[1]; lg[4 * q4 + 2] = t4[2]; lg[4 * q4 + 3] = t4[3]; }
                    float sc[16], bi[16];
#pragma unroll
                    for (int e = 0; e < 16; ++e) { sc[e] = __builtin_amdgcn_rcpf(1.0f + __builtin_amdgcn_exp2f(-LOG2E * lg[e])); bi[e] = sc[e] + rb[e]; }
                    int gsel = 0; float gbest = -INFINITY;
#pragma unroll
                    for (int g = 0; g < 4; ++g) { float m1 = bi[4 * g], m2 = -INFINITY;
#pragma unroll
                        for (int kk = 1; kk < 4; ++kk) { const float x = bi[4 * g + kk]; if (x > m1) { m2 = m1; m1 = x; } else if (x > m2) m2 = x; }
                        const float gs = m1 + m2; if (gs > gbest) { gbest = gs; gsel = g; } }
                    float b4[4], s4[4];
#pragma unroll
                    for (int kk = 0; kk < 4; ++kk) { b4[kk] = gsel == 0 ? bi[kk] : gsel == 1 ? bi[4 + kk] : gsel == 2 ? bi[8 + kk] : bi[12 + kk]; s4[kk] = gsel == 0 ? sc[kk] : gsel == 1 ? sc[4 + kk] : gsel == 2 ? sc[8 + kk] : sc[12 + kk]; }
                    int i1 = 0; float bb1 = b4[0], ss1 = s4[0];
#pragma unroll
                    for (int kk = 1; kk < 4; ++kk) if (b4[kk] > bb1) { bb1 = b4[kk]; ss1 = s4[kk]; i1 = kk; }
                    int i2 = -1; float bb2 = -INFINITY, ss2 = 0.f;
#pragma unroll
                    for (int kk = 0; kk < 4; ++kk) if (kk != i1 && b4[kk] > bb2) { bb2 = b4[kk]; ss2 = s4[kk]; i2 = kk; }
                    const float inv = 1.0f / (ss1 + ss2);
                    if (lane < 4 && g4 + k < nrows) {
                        const int lr = g4 + k; const int e0 = gsel * 4 + i1, e1 = gsel * 4 + i2;
                        tE[2 * lr] = e0; tE[2 * lr + 1] = e1;
                        tP[2 * lr] = atomicAdd((int*)&lcnt[e0], 1); tP[2 * lr + 1] = atomicAdd((int*)&lcnt[e1], 1);
                        tG[2 * lr] = ss1 * inv; tG[2 * lr + 1] = ss2 * inv;
                    }
                }
            }
            __syncthreads();
            if (tid < 16) gbase[tid] = (int)__hip_atomic_fetch_add(ctl + CW_ECNT + 64 * (l * 16 + tid), (unsigned)lcnt[tid], RLX_AGENT);
            __syncthreads();
            if (tid < nrows) {
                const int row = r0 + tid; const int e0 = tE[2 * tid], e1 = tE[2 * tid + 1];
                const int p0 = gbase[e0] + tP[2 * tid], p1 = gbase[e1] + tP[2 * tid + 1];
                LIST[(size_t)e0 * TP + p0] = row; LIST[(size_t)e1 * TP + p1] = row;
                u32x4 w0; w0.x = (unsigned)e0; w0.y = (unsigned)p0; w0.z = (unsigned)e1; w0.w = (unsigned)p1;
                *(u32x4*)(TOK + (size_t)row * 8) = w0;
                u32x2 w1; w1.x = __float_as_uint(tG[2 * tid]); w1.y = __float_as_uint(tG[2 * tid + 1]);
                *(u32x2*)(TOK + (size_t)row * 8 + 4) = w1;
            }
        }
        xcd_barrier(bar);
        LAS int* tb = (LAS int*)(F.lds + MISC_OFF) + 16; LAS int* ecnt = (LAS int*)(F.lds + MISC_OFF) + 64;
        if (threadIdx.x < 16) ecnt[threadIdx.x] = (int)__hip_atomic_load(F.ctl + CW_ECNT + 64 * (l * 16 + (int)threadIdx.x), RLX_AGENT);
        __syncthreads();
        if (threadIdx.x == 0) { int acc = 0; for (int e = 0; e < 16; ++e) { tb[e] = acc; acc += (ecnt[e] + 255) >> 8; } tb[16] = acc; }
        __syncthreads();
        for (int rep_ = 0; rep_ < REP_H; ++rep_) {
        {
            PHASE_PTRS const bf16_t* W = Wall + (size_t)l * W_LAYER;
            pg8::SchedMoe S{(const char*)(X + X_H1Q), (const char*)(W + W_MOE1), tb, ecnt, LIST, 1, F.G, F.vcu, (size_t)512 * 1024, (size_t)256 * 1024, 0, true, DM};
            pg8::EpiM1 E{HID, (const float*)(wsl + WS_H1S), ctl + CW_CMAX + 16384 * l + 4608, tb, ecnt, LIST};
            pg8::gemm_phase<pg8::EpiM1, pg8::SchedMoe, true, false, true>(F.lds, 512, 512, 512, S, E);
        }
        xcd_barrier(bar);
        }
        for (int rep_ = 0; rep_ < REP_I; ++rep_) {
        {
            PHASE_PTRS const bf16_t* W = Wall + (size_t)l * W_LAYER;
            pg8::SchedMoe S{(const char*)HID, (const char*)(W + W_MOE2), tb, ecnt, LIST, 2, F.G, F.vcu, (size_t)1024 * 256 * 2, (size_t)256 * 256 * 2, (size_t)256 * 256 * 2, false, DM * 2};
            pg8::EpiM2 E{YS};
            pg8::gemm_phase<pg8::EpiM2, pg8::SchedMoe, false>(F.lds, 256, 256, 256, S, E);
        }
        xcd_barrier(bar);
        }
        {
            PHASE_IDS
            PHASE_PTRS
            for (int rep_ = 0; rep_ < REP_J; ++rep_) {
            const int jlim = (l == 0 ? T : NREAL);
            u32x4 nw0[4]; u32x2 nw1[4];
            if (gw * 4 < jlim) {
#pragma unroll
                for (int k = 0; k < 4; ++k) { nw0[k] = *(const u32x4*)(TOK + (size_t)(gw * 4 + k) * 8); nw1[k] = *(const u32x2*)(TOK + (size_t)(gw * 4 + k) * 8 + 4); } }
            for (int r4 = gw * 4; r4 < jlim; r4 += NGW * 4) {
                u32x4 w0[4]; u32x2 w1[4];
#pragma unroll
                for (int k = 0; k < 4; ++k) { w0[k] = nw0[k]; w1[k] = nw1[k]; }
                u32x2 hv[4][4], ya[4][4], yc[4][4];
#pragma unroll
                for (int k = 0; k < 4; ++k) {
                    const size_t s0 = (size_t)tb[(int)w0[k].x] * 256 + (int)w0[k].y, s1 = (size_t)tb[(int)w0[k].z] * 256 + (int)w0[k].w;
#pragma unroll
                    for (int j = 0; j < 4; ++j) { hv[k][j] = *(const u32x2*)(H1 + (size_t)(r4 + k) * DM + 4 * lane + 256 * j); ya[k][j] = *(const u32x2*)(YS + s0 * DM + 4 * lane + 256 * j); yc[k][j] = *(const u32x2*)(YS + s1 * DM + 4 * lane + 256 * j); } }
                { const int rn = r4 + NGW * 4;
                  if (rn < jlim) {
#pragma unroll
                    for (int k = 0; k < 4; ++k) { nw0[k] = *(const u32x4*)(TOK + (size_t)(rn + k) * 8); nw1[k] = *(const u32x2*)(TOK + (size_t)(rn + k) * 8 + 4); } } }
                f32x4 v[4][4];
#pragma unroll
                for (int k = 0; k < 4; ++k) { const float g0 = __uint_as_float(w1[k].x), g1 = __uint_as_float(w1[k].y);
#pragma unroll
                    for (int j = 0; j < 4; ++j) {
                        v[k][j][0] = ALPHA * bf_lo(hv[k][j].x) + g0 * bf_lo(ya[k][j].x) + g1 * bf_lo(yc[k][j].x); v[k][j][1] = ALPHA * bf_hi(hv[k][j].x) + g0 * bf_hi(ya[k][j].x) + g1 * bf_hi(yc[k][j].x);
                        v[k][j][2] = ALPHA * bf_lo(hv[k][j].y) + g0 * bf_lo(ya[k][j].y) + g1 * bf_lo(yc[k][j].y); v[k][j][3] = ALPHA * bf_hi(hv[k][j].y) + g0 * bf_hi(ya[k][j].y) + g1 * bf_hi(yc[k][j].y); } }
                ln16xR<4>(v, args.in[20] + l * DM, args.in[21] + l * DM, lane);
                if (l == 0) { unsigned char* const qr[4] = {X + X_HBQ + (size_t)r4 * DM, X + X_HBQ + (size_t)(r4 + 1) * DM, X + X_HBQ + (size_t)(r4 + 2) * DM, X + X_HBQ + (size_t)(r4 + 3) * DM};
                    float* const hs = (float*)(wsl + WS_HBS) + r4; float* const sr[4] = {hs, hs + 1, hs + 2, hs + 3};
                    quant_rows<4>(v, qr, sr, lane); }
#pragma unroll
                for (int k = 0; k < 4; ++k) { const int row = r4 + k;
                    if (l == 0) store_row_bf16(HB + (size_t)row * DM, v[k], lane);
                    else { float* orow = args.out + (size_t)row * DM;
#pragma unroll
                        for (int j = 0; j < 4; ++j) *(f32x4*)(orow + 4 * lane + 256 * j) = v[k][j]; } }
            }
            }
        }
        if (l == 0) xcd_barrier(bar);
}

__global__ void __launch_bounds__(512, 2) fwd_kernel(Args args) {
    extern __shared__ __attribute__((aligned(16))) unsigned char lds_raw[];
    Frame F;
    F.lds = (LAS unsigned char*)lds_raw;
    F.MISC = (volatile LAS unsigned*)(F.lds + MISC_OFF);
    F.tid = threadIdx.x; F.lane = F.tid & 63; F.wave = __builtin_amdgcn_readfirstlane(F.tid >> 6);
    F.G = gridDim.x; { const int bx = blockIdx.x; F.vcu = (F.G % 8 == 0) ? (bx % 8) * (F.G / 8) + bx / 8 : bx; }
    unsigned char* ws = args.ws;
    F.ctl = (unsigned*)(ws + WS_CTL);
    for (int u = F.tid; u < (LDS_BYTES - MISC_OFF) / 4; u += 512) ((LAS unsigned*)(F.lds + MISC_OFF))[u] = 0u;
    __syncthreads();
    XcdBarrier bar = xcd_barrier_post(F.ctl + CW_BAR, F.MISC);
    const int NGW = F.G * 8;
    {
        PHASE_IDS
        PHASE_PTRS
        LAS float* scr = (LAS float*)(F.lds + wave * 16384);
        { LAS float* part = (LAS float*)(F.lds + 12288);
          for (int it = F.vcu; it < 2 * STRIPS_PER_LAYER; it += F.G) { const int l = it / STRIPS_PER_LAYER, sidx = it % STRIPS_PER_LAYER;
              strip_item(args, Wall + (size_t)l * W_LAYER, ctl + CW_CMAX + 16384 * l, l, sidx, scr, part, wave, lane); } }
        for (int it = gw; it < 2 * ITEMS_PER_LAYER; it += NGW) { const int l = it / ITEMS_PER_LAYER, r = it % ITEMS_PER_LAYER; convert_item(args, Wall + (size_t)l * W_LAYER, l, r, scr, lane); }
        for (int r4 = gw * 4; r4 < TP; r4 += NGW * 4) {
            if (r4 >= T) {
#pragma unroll
                for (int k = 0; k < 4; ++k) { bf16_t* orow = HB + (size_t)(r4 + k) * DM; *(u32x4*)(orow + 8 * lane) = (u32x4){0u, 0u, 0u, 0u}; *(u32x4*)(orow + 512 + 8 * lane) = (u32x4){0u, 0u, 0u, 0u};
                    *(u32x4*)(X + X_HBQ + (size_t)(r4 + k) * DM + 16 * lane) = (u32x4){0u, 0u, 0u, 0u}; if (lane == 0) ((float*)(wsl + WS_HBS))[r4 + k] = 0.f; }
                continue; }
            f32x4 v[4][4];
#pragma unroll
            for (int k = 0; k < 4; ++k) { const int row = r4 + k;
                const float* src = row < NREAL ? args.in[0] + (size_t)row * DM : args.in[1] + (size_t)((row - NREAL) & (NMETA - 1)) * DM;
#pragma unroll
                for (int j = 0; j < 4; ++j) v[k][j] = *(const f32x4*)(src + 4 * lane + 256 * j); }
            ln16xR<4>(v, args.in[2], args.in[3], lane);
#pragma unroll
            for (int k = 0; k < 4; ++k) store_row_bf16(HB + (size_t)(r4 + k) * DM, v[k], lane);
            { unsigned char* const qr[4] = {X + X_HBQ + (size_t)r4 * DM, X + X_HBQ + (size_t)(r4 + 1) * DM, X + X_HBQ + (size_t)(r4 + 2) * DM, X + X_HBQ + (size_t)(r4 + 3) * DM};
              float* const hs = (float*)(wsl + WS_HBS) + r4; float* const sr[4] = {hs, hs + 1, hs + 2, hs + 3};
              quant_rows<4>(v, qr, sr, lane); }
        }
        { float* RWT = (float*)(wsl + WS_RWT); const float* rw = args.in[15];
          for (int idx = blockIdx.x * 512 + tid; idx < 16384; idx += F.G * 512) { const int e = idx >> 10, col = idx & 1023; RWT[idx] = rw[col * 16 + e]; } }
        for (int idx = blockIdx.x * 512 + tid; idx < LSEQ * 16; idx += F.G * 512) {
            const int p = idx >> 4, i = idx & 15; double x = (double)p * ROPE_INV_REV[i]; x -= floor(x); const float xr = (float)x;
            ropeC[idx] = __builtin_amdgcn_cosf(xr); ropeS[idx] = __builtin_amdgcn_sinf(xr);
        }
    }
    xcd_barrier(bar);

    run_layer<0>(args, F, bar, NGW);
    run_layer<1>(args, F, bar, NGW);
}

extern "C" void kernel_launch(void* const* d_in, const int* in_sizes, int n_in, void* d_out, int out_size, void* d_ws, size_t ws_size, hipStream_t stream) {
    static int grid = 0;
    if (grid == 0) {
        if (n_in != 22 || ws_size < WS_END) { fprintf(stderr, "kernel_launch: need 22 inputs and %zu bytes of workspace (got %d, %zu)\n", (size_t)WS_END, n_in, ws_size); grid = -1; return; }
        int dev = 0, cus = 0, per_cu = 0;
        if (hipGetDevice(&dev) != hipSuccess || hipDeviceGetAttribute(&cus, hipDeviceAttributeMultiprocessorCount, dev) != hipSuccess) { grid = -1; return; }
        if (hipFuncSetAttribute((const void*)fwd_kernel, hipFuncAttributeMaxDynamicSharedMemorySize, LDS_BYTES) != hipSuccess) { fprintf(stderr, "kernel_launch: hipFuncSetAttribute failed\n"); grid = -1; return; }
        if (hipOccupancyMaxActiveBlocksPerMultiprocessor(&per_cu, (const void*)fwd_kernel, 512, LDS_BYTES) != hipSuccess || per_cu < 1) { fprintf(stderr, "kernel_launch: occupancy query says %d\n", per_cu); }
        (void)hipGetLastError();
        grid = cus;
    }
    if (grid < 0) return;
    if (hipMemsetAsync((char*)d_ws + WS_CTL, 0, CTL_BYTES, stream) != hipSuccess) return;
    Args a{};
    for (int i = 0; i < 22; ++i) a.in[i] = (const float*)d_in[i];
    a.out = (float*)d_out; a.ws = (unsigned char*)d_ws;
    hipLaunchKernelGGL(fwd_kernel, dim3(grid), dim3(512), LDS_BYTES, stream, a);
}
```
